# Optimizing an MI355X kernel written in HIP

```python
import math
import jax, jax.numpy as jnp
from jax import lax
import numpy as np

D_MODEL = 1024
BATCH = 4
SEQ = 4096
DEPTH = 1

D_MIX = D_MODEL
D_CONV = D_MIX // 2
CONV_WIDTH = 3
N_DIFF_HEADS = 4
DIFF_HEAD_DIM = 64
DIFF_V_DIM = 2 * DIFF_HEAD_DIM
D_ATTN = N_DIFF_HEADS * DIFF_V_DIM
D_QK = N_DIFF_HEADS * 2 * DIFF_HEAD_DIM
D_IN_PROJ = 3 * D_CONV + 2 * D_QK + D_ATTN
ROT_DIM = DIFF_HEAD_DIM // 4
ROPE_THETA = 500000.0
Q_BLOCK = 128
N_EXPERTS = 256
TOP_K = 8
N_GROUPS = 8
TOPK_GROUPS = 4
D_EXPERT = 256
D_SHARED = 256
ROUTED_SCALE = 2.5
EXPERT_BLOCK = 128
NORM_EPS = 1e-6
SUBLN_EPS = 1e-5

kernel_name = "hybrid_conv_diffattn_moe_adaln"


def rms_norm(x, g, eps):
    xf = x.astype(jnp.float32)
    y = xf * lax.rsqrt(jnp.mean(xf * xf, axis=-1, keepdims=True) + eps)
    return (y * g.astype(jnp.float32)).astype(x.dtype)


def rope_tables(positions):
    inv_freq = ROPE_THETA ** (-jnp.arange(0, ROT_DIM, 2, dtype=jnp.float32) / ROT_DIM)
    ang = positions.astype(jnp.float32)[..., None] * inv_freq
    return jnp.cos(ang), jnp.sin(ang)


def apply_partial_rope(t, cos, sin):
    cos = cos[:, :, None, None, :].astype(t.dtype)
    sin = sin[:, :, None, None, :].astype(t.dtype)
    half = ROT_DIM // 2
    t1, t2, rest = t[..., :half], t[..., half:ROT_DIM], t[..., ROT_DIM:]
    return jnp.concatenate([t1 * cos - t2 * sin, t2 * cos + t1 * sin, rest], axis=-1)


def short_conv_mixer(h, b_gate, c_gate, conv_w, g_out):
    u = c_gate * h
    seq = u.shape[1]
    up = jnp.pad(u, ((0, 0), (CONV_WIDTH - 1, 0), (0, 0)))
    y = sum(conv_w[j] * up[:, j:j + seq] for j in range(CONV_WIDTH))
    return rms_norm(b_gate * y, g_out, NORM_EPS)


def diff_attention(q, k, v, lam, lambda_init, g_subln):
    bsz, seq = q.shape[:2]
    nqb = seq // Q_BLOCK
    scale = DIFF_HEAD_DIM ** -0.5
    qb = q.reshape(bsz, nqb, Q_BLOCK, N_DIFF_HEADS, 2, DIFF_HEAD_DIM).transpose(1, 0, 2, 3, 4, 5)
    key_idx = jnp.arange(seq)

    def block(args):
        q_blk, blk = args
        s = jnp.einsum('bqhcd,bkhcd->bhcqk', q_blk, k, preferred_element_type=jnp.float32) * scale
        q_idx = blk * Q_BLOCK + jnp.arange(Q_BLOCK)
        mask = key_idx[None, :] <= q_idx[:, None]
        p = jax.nn.softmax(jnp.where(mask, s, -jnp.inf), axis=-1)
        a = p[:, :, 0] - lam * p[:, :, 1]
        return jnp.einsum('bhqk,bkhd->bqhd', a.astype(v.dtype), v)

    o = lax.map(block, (qb, jnp.arange(nqb)))
    o = o.transpose(1, 0, 2, 3, 4).reshape(bsz, seq, N_DIFF_HEADS, DIFF_V_DIM)
    o = rms_norm(o, g_subln, SUBLN_EPS) * (1.0 - lambda_init)
    return o.reshape(bsz, seq, D_ATTN)


def route(h, w_router, router_bias):
    tokens = h.shape[0]
    scores = jax.nn.sigmoid(jnp.matmul(h, w_router, preferred_element_type=jnp.float32))
    choice = scores + router_bias.astype(jnp.float32)
    grouped = choice.reshape(tokens, N_GROUPS, N_EXPERTS // N_GROUPS)
    group_scores = lax.top_k(grouped, 2)[0].sum(-1)
    _, gidx = lax.top_k(group_scores, TOPK_GROUPS)
    gmask = jnp.any(gidx[..., None] == jnp.arange(N_GROUPS), axis=-2)
    emask = jnp.repeat(gmask, N_EXPERTS // N_GROUPS, axis=-1)
    _, idx = lax.top_k(jnp.where(emask, choice, -jnp.inf), TOP_K)
    w = jnp.take_along_axis(scores, idx, axis=-1)
    w = w / (w.sum(-1, keepdims=True) + 1e-20) * ROUTED_SCALE
    return idx, w.astype(h.dtype)


def routed_experts(h, idx, w, w_gate, w_up, w_down):
    tokens, d = h.shape
    m = tokens * TOP_K
    nb = (m + N_EXPERTS * (EXPERT_BLOCK - 1) + EXPERT_BLOCK - 1) // EXPERT_BLOCK
    p_rows = nb * EXPERT_BLOCK
    flat_e = idx.reshape(-1)
    flat_tok = jnp.arange(m, dtype=jnp.int32) // TOP_K
    flat_w = w.reshape(-1)
    order = jnp.argsort(flat_e)
    se = flat_e[order]
    counts = jnp.bincount(flat_e, length=N_EXPERTS)
    start = jnp.cumsum(counts) - counts
    padded = ((counts + EXPERT_BLOCK - 1) // EXPERT_BLOCK) * EXPERT_BLOCK
    pad_end = jnp.cumsum(padded)
    pad_start = pad_end - padded
    dest = pad_start[se] + (jnp.arange(m) - start[se])
    row_tok = jnp.full((p_rows,), tokens, jnp.int32).at[dest].set(flat_tok[order])
    row_w = jnp.zeros((p_rows,), w.dtype).at[dest].set(flat_w[order])
    blk_e = jnp.clip(jnp.searchsorted(pad_end, jnp.arange(nb) * EXPERT_BLOCK, side='right'), 0, N_EXPERTS - 1)
    h_pad = jnp.concatenate([h, jnp.zeros((1, d), h.dtype)], axis=0)

    def expert_block(args):
        rows, rw, e = args
        xb = h_pad[rows]
        act = jax.nn.silu(xb @ w_gate[e]) * (xb @ w_up[e])
        return (act @ w_down[e]) * rw[:, None]

    out = lax.map(expert_block, (row_tok.reshape(nb, EXPERT_BLOCK), row_w.reshape(nb, EXPERT_BLOCK), blk_e))
    y = jnp.zeros((tokens + 1, d), h.dtype).at[row_tok].add(out.reshape(p_rows, d))
    return y[:tokens]


def setup_inputs(seed: int = 0) -> dict:
    key = jax.random.key(seed)
    ks = jax.random.split(key, 26)
    L = DEPTH

    def nrm(k, shape, scale):
        return jax.random.normal(k, shape, jnp.float32) * scale

    pos_offset = jax.random.randint(ks[2], (BATCH, 1), 0, 1024, dtype=jnp.int32)
    return {
        "x": nrm(ks[0], (BATCH, SEQ, D_MODEL), 1.0),
        "c": nrm(ks[1], (BATCH, D_MODEL), 1.0),
        "positions": pos_offset + jnp.arange(SEQ, dtype=jnp.int32)[None, :],
        "w_ada": nrm(ks[3], (L, D_MODEL, 6 * D_MODEL), 0.02),
        "b_ada": nrm(ks[4], (L, 6 * D_MODEL), 0.02),
        "g_norm1": 1.0 + nrm(ks[5], (L, D_MODEL), 0.05),
        "w_in": nrm(ks[6], (L, D_MODEL, D_IN_PROJ), D_MODEL ** -0.5),
        "conv_w": nrm(ks[7], (L, CONV_WIDTH, D_CONV), CONV_WIDTH ** -0.5),
        "g_conv_out": 1.0 + nrm(ks[8], (L, D_CONV), 0.05),
        "lam_q1": nrm(ks[9], (L, DIFF_HEAD_DIM), 0.1),
        "lam_k1": nrm(ks[10], (L, DIFF_HEAD_DIM), 0.1),
        "lam_q2": nrm(ks[11], (L, DIFF_HEAD_DIM), 0.1),
        "lam_k2": nrm(ks[12], (L, DIFF_HEAD_DIM), 0.1),
        "g_subln": 1.0 + nrm(ks[13], (L, DIFF_V_DIM), 0.05),
        "w_out": nrm(ks[14], (L, D_MIX, D_MODEL), D_MIX ** -0.5),
        "g_norm2": 1.0 + nrm(ks[15], (L, D_MODEL), 0.05),
        "w_router": nrm(ks[16], (L, D_MODEL, N_EXPERTS), D_MODEL ** -0.5),
        "router_bias": nrm(ks[17], (L, N_EXPERTS), 0.01),
        "w_gate_e": nrm(ks[18], (L, N_EXPERTS, D_MODEL, D_EXPERT), D_MODEL ** -0.5),
        "w_up_e": nrm(ks[19], (L, N_EXPERTS, D_MODEL, D_EXPERT), D_MODEL ** -0.5),
        "w_down_e": nrm(ks[20], (L, N_EXPERTS, D_EXPERT, D_MODEL), D_EXPERT ** -0.5),
        "w_gate_s": nrm(ks[21], (L, D_MODEL, D_SHARED), D_MODEL ** -0.5),
        "w_up_s": nrm(ks[22], (L, D_MODEL, D_SHARED), D_MODEL ** -0.5),
        "w_down_s": nrm(ks[23], (L, D_SHARED, D_MODEL), D_SHARED ** -0.5),
        "g_final": 1.0 + nrm(ks[24], (D_MODEL,), 0.05),
    }


def reference(x, c, positions, w_ada, b_ada, g_norm1, w_in, conv_w, g_conv_out, lam_q1, lam_k1, lam_q2, lam_k2,
              g_subln, w_out, g_norm2, w_router, router_bias, w_gate_e, w_up_e, w_down_e, w_gate_s, w_up_s,
              w_down_s, g_final):
    bsz, seq, d = x.shape
    cos, sin = rope_tables(positions)
    c_act = jax.nn.silu(c)
    splits = [D_CONV, 2 * D_CONV, 3 * D_CONV, 3 * D_CONV + D_QK, 3 * D_CONV + 2 * D_QK]
    for l in range(DEPTH):
        lambda_init = 0.8 - 0.6 * math.exp(-0.3 * l)
        ada = (c_act @ w_ada[l] + b_ada[l])[:, None, :]
        sh1, sc1, gt1, sh2, sc2, gt2 = jnp.split(ada, 6, axis=-1)

        hn = rms_norm(x, g_norm1[l], NORM_EPS) * (1.0 + sc1) + sh1
        proj = hn @ w_in[l]
        h_cv, b_gate, c_gate, q, k, v = jnp.split(proj, splits, axis=-1)
        y_conv = short_conv_mixer(h_cv, b_gate, c_gate, conv_w[l], g_conv_out[l])
        q = apply_partial_rope(q.reshape(bsz, seq, N_DIFF_HEADS, 2, DIFF_HEAD_DIM), cos, sin)
        k = apply_partial_rope(k.reshape(bsz, seq, N_DIFF_HEADS, 2, DIFF_HEAD_DIM), cos, sin)
        v = v.reshape(bsz, seq, N_DIFF_HEADS, DIFF_V_DIM)
        lam = (jnp.exp(jnp.sum(lam_q1[l].astype(jnp.float32) * lam_k1[l].astype(jnp.float32)))
               - jnp.exp(jnp.sum(lam_q2[l].astype(jnp.float32) * lam_k2[l].astype(jnp.float32)))
               + lambda_init)
        y_attn = diff_attention(q, k, v, lam, lambda_init, g_subln[l])
        x = x + gt1 * (jnp.concatenate([y_conv, y_attn], axis=-1) @ w_out[l])

        hn2 = rms_norm(x, g_norm2[l], NORM_EPS) * (1.0 + sc2) + sh2
        ht = hn2.reshape(bsz * seq, d)
        idx, wts = route(ht, w_router[l], router_bias[l])
        y_routed = routed_experts(ht, idx, wts, w_gate_e[l], w_up_e[l], w_down_e[l])
        y_shared = (jax.nn.silu(ht @ w_gate_s[l]) * (ht @ w_up_s[l])) @ w_down_s[l]
        x = x + gt2 * (y_routed + y_shared).reshape(bsz, seq, d)
    return rms_norm(x, g_final, NORM_EPS)
```

```cpp
#include <hip/hip_runtime.h>
#include <stdint.h>
#include <math.h>
#include <stdio.h>
#include <string.h>

namespace {
constexpr int D = 1024, BATCH = 4, SEQ = 4096, T = BATCH * SEQ;
constexpr int DPROJ = 3072;
constexpr int COL_H = 0, COL_B = 512, COL_C = 1024, COL_Q = 1536, COL_K = 2048, COL_V = 2560;
constexpr int NE = 256, TOPK = 8, DE = 256, DSH = 256;
constexpr int NT = 512;
constexpr int NW = NT / 64;
constexpr int LISTCAP = T;

constexpr size_t MiB = 1u << 20;
constexpr size_t WS_CTL = 0, CTL_BYTES = 1 * MiB;
constexpr size_t WS_ADA = 1 * MiB;
constexpr size_t WS_MISC = 1 * MiB + 128 * 1024;
constexpr size_t WS_COS = 2 * MiB, WS_SIN = 2 * MiB + 512 * 1024;
constexpr size_t WS_IDX = 3 * MiB, WS_WTS = 3 * MiB + 512 * 1024;
constexpr size_t WS_LIST = 4 * MiB;
constexpr size_t WS_LOGITS = 20 * MiB;
constexpr size_t WS_ACTS = 36 * MiB;
constexpr size_t WS_HN = 64 * MiB;
constexpr size_t WS_AO = 128 * MiB;
constexpr size_t WS_X1 = 192 * MiB;
constexpr size_t WS_PROJ = 256 * MiB;
constexpr size_t WS_SLAB = 448 * MiB;
constexpr size_t WS_END = 960 * MiB;

struct P {
  const float* x; const float* c; const int* pos; const float* w_ada; const float* b_ada; const float* g1;
  const float* w_in; const float* conv_w; const float* g_conv; const float* lq1; const float* lk1; const float* lq2; const float* lk2;
  const float* g_subln; const float* w_out; const float* g2; const float* w_router; const float* rbias;
  const float* wg_e; const float* wu_e; const float* wd_e; const float* wg_s; const float* wu_s; const float* wd_s; const float* g_final;
  float* out; unsigned char* ws;
  float inv_freq[8];
};

__device__ __forceinline__ float wave_sum(float v) {
#pragma unroll
  for (int o = 1; o < 64; o <<= 1) v += __shfl_xor(v, o);
  return v;
}
__device__ __forceinline__ float silu_f(float v) { return v / (1.f + expf(-v)); }

__device__ void phase_ada(const P& p, int bid, int nb, float* lds) {
  float* cact = lds;
  float* red = lds + 4096;
  const int tid = threadIdx.x;
  float* ada = (float*)(p.ws + WS_ADA);
  for (int i = tid; i < 4096; i += NT) cact[i] = silu_f(p.c[i]);
  __syncthreads();
  for (int cb = bid; cb < 256; cb += nb) {
    const int col = tid % 24, kg = tid / 24;
    if (kg < 21) {
      float a0 = 0.f, a1 = 0.f, a2 = 0.f, a3 = 0.f;
      for (int k = kg; k < 1024; k += 21) {
        const float w = p.w_ada[(size_t)k * 6144 + cb * 24 + col];
        a0 += cact[k] * w; a1 += cact[1024 + k] * w; a2 += cact[2048 + k] * w; a3 += cact[3072 + k] * w;
      }
      float* r = red + (kg * 24 + col) * 4; r[0] = a0; r[1] = a1; r[2] = a2; r[3] = a3;
    }
    __syncthreads();
    if (tid < 96) {
      const int cc = tid >> 2, b = tid & 3; float s = 0.f;
      for (int g = 0; g < 21; ++g) s += red[(g * 24 + cc) * 4 + b];
      ada[b * 6144 + cb * 24 + cc] = s + p.b_ada[cb * 24 + cc];
    }
    __syncthreads();
  }
  if (bid == 0 && tid == 0) {
    float s1 = 0.f, s2 = 0.f;
    for (int i = 0; i < 64; ++i) { s1 += p.lq1[i] * p.lk1[i]; s2 += p.lq2[i] * p.lk2[i]; }
    ((float*)(p.ws + WS_MISC))[0] = expf(s1) - expf(s2) + 0.2f;
  }
  float* ct = (float*)(p.ws + WS_COS); float* st = (float*)(p.ws + WS_SIN);
  for (int i = bid * NT + tid; i < T * 8; i += nb * NT) {
    const int t = i >> 3, f = i & 7;
    const float ang = (float)p.pos[t] * p.inv_freq[f];
    float s, c; sincosf(ang, &s, &c);
    ct[i] = c; st[i] = s;
  }
}

__device__ void phase_modnorm(const P& p, int bid, int nb, const float* in, const float* g, int sh_off, int sc_off, float* outp) {
  const int lane = threadIdx.x & 63, wave = threadIdx.x >> 6;
  const float* ada = (const float*)(p.ws + WS_ADA);
  for (int t = bid * NW + wave; t < T; t += nb * NW) {
    const int b = t / SEQ;
    const float4* xr = (const float4*)(in + (size_t)t * D) + lane;
    float4 v[4]; float s = 0.f;
#pragma unroll
    for (int j = 0; j < 4; ++j) { v[j] = xr[64 * j]; s += v[j].x * v[j].x + v[j].y * v[j].y + v[j].z * v[j].z + v[j].w * v[j].w; }
    s = wave_sum(s);
    const float rstd = 1.0f / sqrtf(s * (1.0f / D) + 1e-6f);
    float4* o = (float4*)(outp + (size_t)t * D) + lane;
#pragma unroll
    for (int j = 0; j < 4; ++j) {
      const int c0 = lane * 4 + 256 * j;
      const float4 gg = *(const float4*)(g + c0);
      const float4 sc = *(const float4*)(ada + b * 6144 + sc_off + c0);
      const float4 sh = *(const float4*)(ada + b * 6144 + sh_off + c0);
      float4 r;
      r.x = v[j].x * rstd * gg.x * (1.f + sc.x) + sh.x; r.y = v[j].y * rstd * gg.y * (1.f + sc.y) + sh.y;
      r.z = v[j].z * rstd * gg.z * (1.f + sc.z) + sh.z; r.w = v[j].w * rstd * gg.w * (1.f + sc.w) + sh.w;
      o[64 * j] = r;
    }
  }
}

template <bool DUAL, class AF, class EF>
__device__ __forceinline__ void gemm_tile_naive(const AF& af, int mcount, const float* __restrict__ B0, const float* __restrict__ B1, int ldb, int n0, int K, const EF& ef, float* lds) {
  float* As = lds; float* Bs0 = lds + 16 * 132; float* Bs1 = Bs0 + 16 * 64;
  const int tid = threadIdx.x, ty = tid >> 4, tx = tid & 15;
  float acc0[4][4], acc1[4][4];
#pragma unroll
  for (int i = 0; i < 4; ++i)
#pragma unroll
    for (int j = 0; j < 4; ++j) { acc0[i][j] = 0.f; acc1[i][j] = 0.f; }
  const int ar = tid >> 2, akq = (tid & 3) * 4;
  const float* arow = (ar < mcount) ? af(ar) : nullptr;
  const int bt = tid & 255, bk = bt >> 4, bc = (bt & 15) * 4;
  const float* bsrc = (tid < 256) ? B0 : B1;
  float* bdst = (tid < 256) ? Bs0 : Bs1;
  for (int k0 = 0; k0 < K; k0 += 16) {
    float4 av = make_float4(0.f, 0.f, 0.f, 0.f);
    if (arow) av = *(const float4*)(arow + k0 + akq);
    As[(akq + 0) * 132 + ar] = av.x; As[(akq + 1) * 132 + ar] = av.y; As[(akq + 2) * 132 + ar] = av.z; As[(akq + 3) * 132 + ar] = av.w;
    if (DUAL || tid < 256) {
      const float4 bv = *(const float4*)(bsrc + (size_t)(k0 + bk) * ldb + n0 + bc);
      *(float4*)(bdst + bk * 64 + bc) = bv;
    }
    __syncthreads();
#pragma unroll
    for (int kk = 0; kk < 16; ++kk) {
      const float4 a = *(const float4*)(As + kk * 132 + ty * 4);
      const float4 b = *(const float4*)(Bs0 + kk * 64 + tx * 4);
      const float aa[4] = {a.x, a.y, a.z, a.w}; const float bb[4] = {b.x, b.y, b.z, b.w};
#pragma unroll
      for (int i = 0; i < 4; ++i)
#pragma unroll
        for (int j = 0; j < 4; ++j) acc0[i][j] += aa[i] * bb[j];
      if (DUAL) {
        const float4 b1 = *(const float4*)(Bs1 + kk * 64 + tx * 4);
        const float cc[4] = {b1.x, b1.y, b1.z, b1.w};
#pragma unroll
        for (int i = 0; i < 4; ++i)
#pragma unroll
          for (int j = 0; j < 4; ++j) acc1[i][j] += aa[i] * cc[j];
      }
    }
    __syncthreads();
  }
#pragma unroll
  for (int i = 0; i < 4; ++i)
    if (ty * 4 + i < mcount) {
#pragma unroll
      for (int j = 0; j < 4; ++j) ef(ty * 4 + i, n0 + tx * 4 + j, acc0[i][j], acc1[i][j]);
    }
}

__device__ void phase_inproj(const P& p, int bid, int nb, float* lds) {
  const float* HN = (const float*)(p.ws + WS_HN); float* PR = (float*)(p.ws + WS_PROJ);
  for (int it = bid; it < (T / 128) * (DPROJ / 64); it += nb) {
    const int mt = it / (DPROJ / 64), nt = it % (DPROJ / 64), m0 = mt * 128;
    auto af = [&](int r) { return HN + (size_t)(m0 + r) * D; };
    auto ef = [&](int r, int col, float v, float) { PR[(size_t)(m0 + r) * DPROJ + col] = v; };
    gemm_tile_naive<false>(af, 128, p.w_in, nullptr, DPROJ, nt * 64, D, ef, lds);
  }
}

__device__ void phase_rope(const P& p, int bid, int nb) {
  float* PR = (float*)(p.ws + WS_PROJ);
  const float* ct = (const float*)(p.ws + WS_COS); const float* st = (const float*)(p.ws + WS_SIN);
  for (int i = bid * NT + threadIdx.x; i < T * 128; i += nb * NT) {
    const int t = i >> 7, r = i & 127, which = r >> 6, hc = (r >> 3) & 7, f = r & 7;
    float* base = PR + (size_t)t * DPROJ + (which ? COL_K : COL_Q) + hc * 64;
    const float t1 = base[f], t2 = base[8 + f], c = ct[t * 8 + f], s = st[t * 8 + f];
    base[f] = t1 * c - t2 * s; base[8 + f] = t2 * c + t1 * s;
  }
}

__device__ void phase_attn_naive(const P& p, int bid, int nb) {
  const float* PR = (const float*)(p.ws + WS_PROJ); float* AO = (float*)(p.ws + WS_AO);
  const int lane = threadIdx.x & 63, wave = threadIdx.x >> 6;
  for (int it0 = bid * NW + wave; it0 < 4096; it0 += nb * NW) {
    const int it = __builtin_amdgcn_readfirstlane(it0);
    const int qc = 63 - (it >> 6), rest = it & 63, vh = rest & 1, bh = rest >> 1, b = bh >> 3, hc = bh & 7, h = hc >> 1;
    const int qi = qc * 64 + lane;
    const float* qp = PR + (size_t)(b * SEQ + qi) * DPROJ + COL_Q + hc * 64;
    float q[64], o[64];
#pragma unroll
    for (int d = 0; d < 64; d += 4) { const float4 v = *(const float4*)(qp + d); q[d] = v.x * 0.125f; q[d + 1] = v.y * 0.125f; q[d + 2] = v.z * 0.125f; q[d + 3] = v.w * 0.125f; }
#pragma unroll
    for (int d = 0; d < 64; ++d) o[d] = 0.f;
    float m = -INFINITY, l = 0.f;
    const float* kbase = PR + (size_t)(b * SEQ) * DPROJ + COL_K + hc * 64;
    const float* vbase = PR + (size_t)(b * SEQ) * DPROJ + COL_V + h * 128 + vh * 64;
    const int jmax = qc * 64 + 63;
    for (int j = 0; j <= jmax; ++j) {
      const float* kr = kbase + (size_t)j * DPROJ; const float* vr = vbase + (size_t)j * DPROJ;
      float s = 0.f;
#pragma unroll
      for (int d = 0; d < 64; d += 4) { const float4 kv = *(const float4*)(kr + d); s += q[d] * kv.x; s += q[d + 1] * kv.y; s += q[d + 2] * kv.z; s += q[d + 3] * kv.w; }
      if (j <= qi) {
        const float mn = fmaxf(m, s), a = expf(m - mn), pp = expf(s - mn);
        l = l * a + pp;
#pragma unroll
        for (int d = 0; d < 64; d += 4) { const float4 vv = *(const float4*)(vr + d); o[d] = o[d] * a + pp * vv.x; o[d + 1] = o[d + 1] * a + pp * vv.y; o[d + 2] = o[d + 2] * a + pp * vv.z; o[d + 3] = o[d + 3] * a + pp * vv.w; }
        m = mn;
      }
    }
    const float inv = 1.0f / l;
    float* op = AO + (size_t)(b * SEQ + qi) * 1024 + hc * 128 + vh * 64;
#pragma unroll
    for (int d = 0; d < 64; d += 4) *(float4*)(op + d) = make_float4(o[d] * inv, o[d + 1] * inv, o[d + 2] * inv, o[d + 3] * inv);
  }
}

__device__ void phase_mix(const P& p, int bid, int nb) {
  const float* PR = (const float*)(p.ws + WS_PROJ); const float* AO = (const float*)(p.ws + WS_AO); float* MIX = (float*)(p.ws + WS_HN);
  const float lam = ((const float*)(p.ws + WS_MISC))[0];
  const int lane = threadIdx.x & 63, wave = threadIdx.x >> 6;
  for (int t = bid * NW + wave; t < T; t += nb * NW) {
    const int s = t % SEQ;
    const float* r0 = PR + (size_t)t * DPROJ;
    float vals[8]; float ss = 0.f;
#pragma unroll
    for (int j = 0; j < 2; ++j) {
      const int ch = lane * 4 + 256 * j;
      const float4 h0 = *(const float4*)(r0 + COL_H + ch), c0 = *(const float4*)(r0 + COL_C + ch), bg = *(const float4*)(r0 + COL_B + ch);
      float4 h1 = make_float4(0, 0, 0, 0), c1 = h1, h2 = h1, c2 = h1;
      if (s >= 1) { h1 = *(const float4*)(r0 - DPROJ + COL_H + ch); c1 = *(const float4*)(r0 - DPROJ + COL_C + ch); }
      if (s >= 2) { h2 = *(const float4*)(r0 - 2 * DPROJ + COL_H + ch); c2 = *(const float4*)(r0 - 2 * DPROJ + COL_C + ch); }
      const float4 w0 = *(const float4*)(p.conv_w + ch), w1 = *(const float4*)(p.conv_w + 512 + ch), w2 = *(const float4*)(p.conv_w + 1024 + ch);
      float y;
      y = w0.x * (c2.x * h2.x) + w1.x * (c1.x * h1.x) + w2.x * (c0.x * h0.x); vals[4 * j + 0] = bg.x * y;
      y = w0.y * (c2.y * h2.y) + w1.y * (c1.y * h1.y) + w2.y * (c0.y * h0.y); vals[4 * j + 1] = bg.y * y;
      y = w0.z * (c2.z * h2.z) + w1.z * (c1.z * h1.z) + w2.z * (c0.z * h0.z); vals[4 * j + 2] = bg.z * y;
      y = w0.w * (c2.w * h2.w) + w1.w * (c1.w * h1.w) + w2.w * (c0.w * h0.w); vals[4 * j + 3] = bg.w * y;
#pragma unroll
      for (int i = 0; i < 4; ++i) ss += vals[4 * j + i] * vals[4 * j + i];
    }
    ss = wave_sum(ss);
    const float rstd = 1.0f / sqrtf(ss * (1.0f / 512.f) + 1e-6f);
    float* mo = MIX + (size_t)t * D;
#pragma unroll
    for (int j = 0; j < 2; ++j) {
      const int ch = lane * 4 + 256 * j;
      const float4 gg = *(const float4*)(p.g_conv + ch);
      *(float4*)(mo + ch) = make_float4(vals[4 * j] * rstd * gg.x, vals[4 * j + 1] * rstd * gg.y, vals[4 * j + 2] * rstd * gg.z, vals[4 * j + 3] * rstd * gg.w);
    }
    const float* ao = AO + (size_t)t * 1024;
#pragma unroll
    for (int j = 0; j < 2; ++j) {
      const int idx = lane * 4 + 256 * j, h = idx >> 7, d = idx & 127;
      const float4 o0 = *(const float4*)(ao + (2 * h) * 128 + d), o1 = *(const float4*)(ao + (2 * h + 1) * 128 + d);
      float dv[4] = {o0.x - lam * o1.x, o0.y - lam * o1.y, o0.z - lam * o1.z, o0.w - lam * o1.w};
      float q = dv[0] * dv[0] + dv[1] * dv[1] + dv[2] * dv[2] + dv[3] * dv[3];
#pragma unroll
      for (int o = 1; o < 32; o <<= 1) q += __shfl_xor(q, o);
      const float r2 = 1.0f / sqrtf(q * (1.0f / 128.f) + 1e-5f);
      const float4 gg = *(const float4*)(p.g_subln + d);
      *(float4*)(mo + 512 + idx) = make_float4(dv[0] * r2 * gg.x * 0.8f, dv[1] * r2 * gg.y * 0.8f, dv[2] * r2 * gg.z * 0.8f, dv[3] * r2 * gg.w * 0.8f);
    }
  }
}

__device__ void phase_outproj(const P& p, int bid, int nb, float* lds) {
  const float* MIX = (const float*)(p.ws + WS_HN); float* X1 = (float*)(p.ws + WS_X1); const float* ada = (const float*)(p.ws + WS_ADA);
  for (int it = bid; it < (T / 128) * (D / 64); it += nb) {
    const int mt = it / (D / 64), nt = it % (D / 64), m0 = mt * 128, b = m0 / SEQ;
    auto af = [&](int r) { return MIX + (size_t)(m0 + r) * D; };
    auto ef = [&](int r, int col, float v, float) { const size_t o = (size_t)(m0 + r) * D + col; X1[o] = p.x[o] + ada[b * 6144 + 2048 + col] * v; };
    gemm_tile_naive<false>(af, 128, p.w_out, nullptr, D, nt * 64, D, ef, lds);
  }
}

__device__ void phase_router_shared(const P& p, int bid, int nb, float* lds) {
  const float* HN = (const float*)(p.ws + WS_HN); float* LG = (float*)(p.ws + WS_LOGITS); float* AC = (float*)(p.ws + WS_ACTS);
  for (int it = bid; it < (T / 128) * 8; it += nb) {
    const int mt = it >> 3, r8 = it & 7, m0 = mt * 128;
    auto af = [&](int r) { return HN + (size_t)(m0 + r) * D; };
    if (r8 < 4) {
      auto ef = [&](int r, int col, float v, float) { LG[(size_t)(m0 + r) * 256 + col] = v; };
      gemm_tile_naive<false>(af, 128, p.w_router, nullptr, 256, r8 * 64, D, ef, lds);
    } else {
      auto ef = [&](int r, int col, float g, float u) { AC[(size_t)(m0 + r) * 256 + col] = silu_f(g) * u; };
      gemm_tile_naive<true>(af, 128, p.wg_s, p.wu_s, 256, (r8 - 4) * 64, D, ef, lds);
    }
  }
}

__device__ void phase_route(const P& p, int bid, int nb) {
  const float* LG = (const float*)(p.ws + WS_LOGITS);
  int* IDX = (int*)(p.ws + WS_IDX); float* WTS = (float*)(p.ws + WS_WTS); int* LIST = (int*)(p.ws + WS_LIST); int* cnt = (int*)(p.ws + WS_CTL);
  const int lane = threadIdx.x & 63, wave = threadIdx.x >> 6;
  for (int t = bid * NW + wave; t < T; t += nb * NW) {
    const float4 lg = *(const float4*)(LG + (size_t)t * 256 + lane * 4);
    const float4 bs = *(const float4*)(p.rbias + lane * 4);
    float sc[4], cv[4];
    sc[0] = 1.f / (1.f + expf(-lg.x)); sc[1] = 1.f / (1.f + expf(-lg.y)); sc[2] = 1.f / (1.f + expf(-lg.z)); sc[3] = 1.f / (1.f + expf(-lg.w));
    cv[0] = sc[0] + bs.x; cv[1] = sc[1] + bs.y; cv[2] = sc[2] + bs.z; cv[3] = sc[3] + bs.w;
    float m1 = -INFINITY, m2 = -INFINITY;
#pragma unroll
    for (int i = 0; i < 4; ++i) { const float v = cv[i]; if (v > m1) { m2 = m1; m1 = v; } else if (v > m2) m2 = v; }
#pragma unroll
    for (int off = 1; off < 8; off <<= 1) {
      const float o1 = __shfl_xor(m1, off), o2 = __shfl_xor(m2, off);
      const float n1 = fmaxf(m1, o1), n2 = fmaxf(fminf(m1, o1), fmaxf(m2, o2));
      m1 = n1; m2 = n2;
    }
    const float gs = m1 + m2; const int g = lane >> 3; int rank = 0;
#pragma unroll
    for (int gg = 0; gg < 8; ++gg) { const float og = __shfl(gs, gg * 8); rank += (og > gs || (og == gs && gg < g)) ? 1 : 0; }
    const bool sel = rank < 4;
#pragma unroll
    for (int i = 0; i < 4; ++i) cv[i] = sel ? cv[i] : -INFINITY;
    int my_e = 0; float my_w = 0.f;
#pragma unroll
    for (int k = 0; k < 8; ++k) {
      float bv = cv[0]; int bi = 0;
#pragma unroll
      for (int i = 1; i < 4; ++i) if (cv[i] > bv) { bv = cv[i]; bi = i; }
      int gi = lane * 4 + bi;
#pragma unroll
      for (int off = 32; off >= 1; off >>= 1) {
        const float ov = __shfl_xor(bv, off); const int oi = __shfl_xor(gi, off);
        if (ov > bv || (ov == bv && oi < gi)) { bv = ov; gi = oi; }
      }
      const int sub = gi & 3, own = gi >> 2;
      const float mine = sub == 0 ? sc[0] : sub == 1 ? sc[1] : sub == 2 ? sc[2] : sc[3];
      const float wv = __shfl(mine, own);
      if (lane == own) {
#pragma unroll
        for (int i = 0; i < 4; ++i) if (sub == i) cv[i] = -INFINITY;
      }
      if (lane == k) { my_e = gi; my_w = wv; }
    }
    float sum = (lane < 8) ? my_w : 0.f;
    sum += __shfl_xor(sum, 1); sum += __shfl_xor(sum, 2); sum += __shfl_xor(sum, 4);
    if (lane < 8) {
      const float w = my_w / (sum + 1e-20f) * 2.5f;
      IDX[t * 8 + lane] = my_e; WTS[t * 8 + lane] = w;
      const int pos = atomicAdd(&cnt[my_e], 1);
      LIST[(size_t)my_e * LISTCAP + pos] = t * 8 + lane;
    }
  }
}

__device__ void phase_shared_down(const P& p, int bid, int nb, float* lds) {
  const float* AC = (const float*)(p.ws + WS_ACTS); float* X1 = (float*)(p.ws + WS_X1); const float* ada = (const float*)(p.ws + WS_ADA);
  for (int it = bid; it < (T / 128) * (D / 64); it += nb) {
    const int mt = it / (D / 64), nt = it % (D / 64), m0 = mt * 128, b = m0 / SEQ;
    auto af = [&](int r) { return AC + (size_t)(m0 + r) * DSH; };
    auto ef = [&](int r, int col, float v, float) { const size_t o = (size_t)(m0 + r) * D + col; X1[o] = X1[o] + ada[b * 6144 + 5120 + col] * v; };
    gemm_tile_naive<false>(af, 128, p.wd_s, nullptr, D, nt * 64, DSH, ef, lds);
  }
}

__device__ void phase_exp1(const P& p, int bid, int nb, float* lds) {
  const float* HN = (const float*)(p.ws + WS_HN); float* H = (float*)(p.ws + WS_PROJ);
  const int* LIST = (const int*)(p.ws + WS_LIST); const int* cnt = (const int*)(p.ws + WS_CTL);
  for (int it = bid; it < NE * 128 * 4; it += nb) {
    const int e = it >> 9, mt = (it >> 2) & 127, nt = it & 3;
    const int c = cnt[e]; if (mt * 128 >= c) continue;
    const int mcount = min(128, c - mt * 128);
    const int* lst = LIST + (size_t)e * LISTCAP + mt * 128;
    auto af = [&](int r) { return HN + (size_t)(lst[r] >> 3) * D; };
    auto ef = [&](int r, int col, float g, float u) { H[(size_t)lst[r] * DE + col] = silu_f(g) * u; };
    gemm_tile_naive<true>(af, mcount, p.wg_e + (size_t)e * D * DE, p.wu_e + (size_t)e * D * DE, DE, nt * 64, D, ef, lds);
  }
}

__device__ void phase_exp2(const P& p, int bid, int nb, float* lds) {
  const float* H = (const float*)(p.ws + WS_PROJ); float* SL = (float*)(p.ws + WS_SLAB); const float* WTS = (const float*)(p.ws + WS_WTS);
  const int* LIST = (const int*)(p.ws + WS_LIST); const int* cnt = (const int*)(p.ws + WS_CTL);
  for (int it = bid; it < NE * 128 * 16; it += nb) {
    const int e = it >> 11, mt = (it >> 4) & 127, nt = it & 15;
    const int c = cnt[e]; if (mt * 128 >= c) continue;
    const int mcount = min(128, c - mt * 128);
    const int* lst = LIST + (size_t)e * LISTCAP + mt * 128;
    auto af = [&](int r) { return H + (size_t)lst[r] * DE; };
    auto ef = [&](int r, int col, float v, float) { const int aid = lst[r]; SL[(size_t)aid * D + col] = v * WTS[aid]; };
    gemm_tile_naive<false>(af, mcount, p.wd_e + (size_t)e * DE * D, nullptr, D, nt * 64, DE, ef, lds);
  }
}

__device__ void phase_final(const P& p, int bid, int nb) {
  const float* X1 = (const float*)(p.ws + WS_X1); const float* SL = (const float*)(p.ws + WS_SLAB); const float* ada = (const float*)(p.ws + WS_ADA);
  const int lane = threadIdx.x & 63, wave = threadIdx.x >> 6;
  for (int t = bid * NW + wave; t < T; t += nb * NW) {
    const int b = t / SEQ;
    float4 v[4]; float s = 0.f;
#pragma unroll
    for (int j = 0; j < 4; ++j) {
      const int c0 = lane * 4 + 256 * j;
      float4 y = make_float4(0, 0, 0, 0);
#pragma unroll
      for (int k = 0; k < 8; ++k) { const float4 z = *(const float4*)(SL + (size_t)(t * 8 + k) * D + c0); y.x += z.x; y.y += z.y; y.z += z.z; y.w += z.w; }
      const float4 gt = *(const float4*)(ada + b * 6144 + 5120 + c0);
      const float4 bx = *(const float4*)(X1 + (size_t)t * D + c0);
      v[j] = make_float4(bx.x + gt.x * y.x, bx.y + gt.y * y.y, bx.z + gt.z * y.z, bx.w + gt.w * y.w);
      s += v[j].x * v[j].x + v[j].y * v[j].y + v[j].z * v[j].z + v[j].w * v[j].w;
    }
    s = wave_sum(s);
    const float rstd = 1.0f / sqrtf(s * (1.0f / D) + 1e-6f);
#pragma unroll
    for (int j = 0; j < 4; ++j) {
      const int c0 = lane * 4 + 256 * j;
      const float4 gg = *(const float4*)(p.g_final + c0);
      *(float4*)(p.out + (size_t)t * D + c0) = make_float4(v[j].x * rstd * gg.x, v[j].y * rstd * gg.y, v[j].z * rstd * gg.z, v[j].w * rstd * gg.w);
    }
  }
}

template <int PH>
__global__ void __launch_bounds__(NT) k_phase(P p) {
  __shared__ __attribute__((aligned(16))) float lds[8192];
  const int bid = blockIdx.x, nb = gridDim.x;
  if (PH == 0) phase_ada(p, bid, nb, lds);
  if (PH == 1) phase_modnorm(p, bid, nb, p.x, p.g1, 0, 1024, (float*)(p.ws + WS_HN));
  if (PH == 2) phase_inproj(p, bid, nb, lds);
  if (PH == 3) phase_rope(p, bid, nb);
  if (PH == 4) phase_attn_naive(p, bid, nb);
  if (PH == 5) phase_mix(p, bid, nb);
  if (PH == 6) phase_outproj(p, bid, nb, lds);
  if (PH == 7) phase_modnorm(p, bid, nb, (const float*)(p.ws + WS_X1), p.g2, 3072, 4096, (float*)(p.ws + WS_HN));
  if (PH == 8) phase_router_shared(p, bid, nb, lds);
  if (PH == 9) phase_route(p, bid, nb);
  if (PH == 10) phase_shared_down(p, bid, nb, lds);
  if (PH == 11) phase_exp1(p, bid, nb, lds);
  if (PH == 12) phase_exp2(p, bid, nb, lds);
  if (PH == 13) phase_final(p, bid, nb);
}
}

extern "C" void kernel_launch(void* const* d_in, const int* in_sizes, int n_in, void* d_out, int out_size, void* d_ws, size_t ws_size, hipStream_t stream) {
  if (n_in != 25 || ws_size < WS_END) { fprintf(stderr, "kernel_launch: unexpected n_in %d or ws_size %zu\n", n_in, ws_size); return; }
  P p; memset(&p, 0, sizeof(p));
  p.x = (const float*)d_in[0]; p.c = (const float*)d_in[1]; p.pos = (const int*)d_in[2]; p.w_ada = (const float*)d_in[3]; p.b_ada = (const float*)d_in[4];
  p.g1 = (const float*)d_in[5]; p.w_in = (const float*)d_in[6]; p.conv_w = (const float*)d_in[7]; p.g_conv = (const float*)d_in[8];
  p.lq1 = (const float*)d_in[9]; p.lk1 = (const float*)d_in[10]; p.lq2 = (const float*)d_in[11]; p.lk2 = (const float*)d_in[12];
  p.g_subln = (const float*)d_in[13]; p.w_out = (const float*)d_in[14]; p.g2 = (const float*)d_in[15]; p.w_router = (const float*)d_in[16]; p.rbias = (const float*)d_in[17];
  p.wg_e = (const float*)d_in[18]; p.wu_e = (const float*)d_in[19]; p.wd_e = (const float*)d_in[20];
  p.wg_s = (const float*)d_in[21]; p.wu_s = (const float*)d_in[22]; p.wd_s = (const float*)d_in[23]; p.g_final = (const float*)d_in[24];
  p.out = (float*)d_out; p.ws = (unsigned char*)d_ws;
  for (int i = 0; i < 8; ++i) p.inv_freq[i] = (float)pow(500000.0, -(double)i / 8.0);
  hipMemsetAsync((char*)d_ws + WS_CTL, 0, CTL_BYTES, stream);
  const int G = 1024;
#define LAUNCH(PH) hipLaunchKernelGGL(k_phase<PH>, dim3(G), dim3(NT), 0, stream, p)
  LAUNCH(0); LAUNCH(1); LAUNCH(2); LAUNCH(3); LAUNCH(4); LAUNCH(5); LAUNCH(6); LAUNCH(7); LAUNCH(8); LAUNCH(9); LAUNCH(10); LAUNCH(11); LAUNCH(12); LAUNCH(13);
#undef LAUNCH
}
```

```cpp
#include <hip/hip_runtime.h>
#include <stdint.h>
#include <math.h>
#include <stdio.h>
#include <string.h>

namespace {
constexpr int D = 1024, BATCH = 4, SEQ = 4096, T = BATCH * SEQ;
constexpr int DPROJ = 3072;
constexpr int COL_H = 0, COL_B = 512, COL_C = 1024, COL_Q = 1536, COL_K = 2048, COL_V = 2560;
constexpr int NE = 256, TOPK = 8, DE = 256, DSH = 256;
constexpr int NT = 512;
constexpr int NW = NT / 64;
constexpr int LISTCAP = T;

constexpr size_t MiB = 1u << 20;
constexpr size_t WS_CTL = 0, CTL_BYTES = 1 * MiB;
constexpr size_t WS_ADA = 1 * MiB;
constexpr size_t WS_MISC = 1 * MiB + 128 * 1024;
constexpr size_t WS_COS = 2 * MiB, WS_SIN = 2 * MiB + 512 * 1024;
constexpr size_t WS_IDX = 3 * MiB, WS_WTS = 3 * MiB + 512 * 1024;
constexpr size_t WS_LIST = 4 * MiB;
constexpr size_t WS_LOGITS = 20 * MiB;
constexpr size_t WS_ACTS = 36 * MiB;
constexpr size_t WS_HN = 64 * MiB;
constexpr size_t WS_AO = 128 * MiB;
constexpr size_t WS_X1 = 192 * MiB;
constexpr size_t WS_PROJ = 256 * MiB;
constexpr size_t WS_SLAB = 448 * MiB;
constexpr size_t WS_END = 960 * MiB;

struct P {
  const float* x; const float* c; const int* pos; const float* w_ada; const float* b_ada; const float* g1;
  const float* w_in; const float* conv_w; const float* g_conv; const float* lq1; const float* lk1; const float* lq2; const float* lk2;
  const float* g_subln; const float* w_out; const float* g2; const float* w_router; const float* rbias;
  const float* wg_e; const float* wu_e; const float* wd_e; const float* wg_s; const float* wu_s; const float* wd_s; const float* g_final;
  float* out; unsigned char* ws;
  float inv_freq[8];
};

__device__ __forceinline__ float wave_sum(float v) {
#pragma unroll
  for (int o = 1; o < 64; o <<= 1) v += __shfl_xor(v, o);
  return v;
}
__device__ __forceinline__ float silu_f(float v) { return v / (1.f + expf(-v)); }

__device__ __forceinline__ void phase_ada(const P& p, int bid, int nb, float* lds) {
  float* cact = lds;
  float* red = lds + 4096;
  const int tid = threadIdx.x;
  float* ada = (float*)(p.ws + WS_ADA);
  for (int i = tid; i < 4096; i += NT) cact[i] = silu_f(p.c[i]);
  __syncthreads();
  for (int cb = bid; cb < 256; cb += nb) {
    const int col = tid % 24, kg = tid / 24;
    if (kg < 21) {
      float a0 = 0.f, a1 = 0.f, a2 = 0.f, a3 = 0.f;
      for (int k = kg; k < 1024; k += 21) {
        const float w = p.w_ada[(size_t)k * 6144 + cb * 24 + col];
        a0 += cact[k] * w; a1 += cact[1024 + k] * w; a2 += cact[2048 + k] * w; a3 += cact[3072 + k] * w;
      }
      float* r = red + (kg * 24 + col) * 4; r[0] = a0; r[1] = a1; r[2] = a2; r[3] = a3;
    }
    __syncthreads();
    if (tid < 96) {
      const int cc = tid >> 2, b = tid & 3; float s = 0.f;
      for (int g = 0; g < 21; ++g) s += red[(g * 24 + cc) * 4 + b];
      ada[b * 6144 + cb * 24 + cc] = s + p.b_ada[cb * 24 + cc];
    }
    __syncthreads();
  }
  if (bid == 0 && tid == 0) {
    float s1 = 0.f, s2 = 0.f;
    for (int i = 0; i < 64; ++i) { s1 += p.lq1[i] * p.lk1[i]; s2 += p.lq2[i] * p.lk2[i]; }
    ((float*)(p.ws + WS_MISC))[0] = expf(s1) - expf(s2) + 0.2f;
  }
  float* ct = (float*)(p.ws + WS_COS); float* st = (float*)(p.ws + WS_SIN);
  for (int i = bid * NT + tid; i < T * 8; i += nb * NT) {
    const int t = i >> 3, f = i & 7;
    const float ang = (float)p.pos[t] * p.inv_freq[f];
    float s, c; sincosf(ang, &s, &c);
    ct[i] = c; st[i] = s;
  }
}

__device__ __forceinline__ void phase_modnorm(const P& p, int bid, int nb, const float* in, const float* g, int sh_off, int sc_off, float* outp) {
  const int lane = threadIdx.x & 63, wave = threadIdx.x >> 6;
  const float* ada = (const float*)(p.ws + WS_ADA);
  for (int t = bid * NW + wave; t < T; t += nb * NW) {
    const int b = t / SEQ;
    const float4* xr = (const float4*)(in + (size_t)t * D) + lane;
    float4 v[4]; float s = 0.f;
#pragma unroll
    for (int j = 0; j < 4; ++j) { v[j] = xr[64 * j]; s += v[j].x * v[j].x + v[j].y * v[j].y + v[j].z * v[j].z + v[j].w * v[j].w; }
    s = wave_sum(s);
    const float rstd = 1.0f / sqrtf(s * (1.0f / D) + 1e-6f);
    float4* o = (float4*)(outp + (size_t)t * D) + lane;
#pragma unroll
    for (int j = 0; j < 4; ++j) {
      const int c0 = lane * 4 + 256 * j;
      const float4 gg = *(const float4*)(g + c0);
      const float4 sc = *(const float4*)(ada + b * 6144 + sc_off + c0);
      const float4 sh = *(const float4*)(ada + b * 6144 + sh_off + c0);
      float4 r;
      r.x = v[j].x * rstd * gg.x * (1.f + sc.x) + sh.x; r.y = v[j].y * rstd * gg.y * (1.f + sc.y) + sh.y;
      r.z = v[j].z * rstd * gg.z * (1.f + sc.z) + sh.z; r.w = v[j].w * rstd * gg.w * (1.f + sc.w) + sh.w;
      o[64 * j] = r;
    }
  }
}

template <bool DUAL, class AF, class EF>
__device__ __forceinline__ void gemm_tile_naive(const AF& af, int mcount, const float* __restrict__ B0, const float* __restrict__ B1, int ldb, int n0, int K, const EF& ef, float* lds) {
  float* As = lds; float* Bs0 = lds + 16 * 132; float* Bs1 = Bs0 + 16 * 64;
  const int tid = threadIdx.x, ty = tid >> 4, tx = tid & 15;
  float acc0[4][4], acc1[4][4];
#pragma unroll
  for (int i = 0; i < 4; ++i)
#pragma unroll
    for (int j = 0; j < 4; ++j) { acc0[i][j] = 0.f; acc1[i][j] = 0.f; }
  const int ar = tid >> 2, akq = (tid & 3) * 4;
  const float* arow = (ar < mcount) ? af(ar) : nullptr;
  const int bt = tid & 255, bk = bt >> 4, bc = (bt & 15) * 4;
  const float* bsrc = (tid < 256) ? B0 : B1;
  float* bdst = (tid < 256) ? Bs0 : Bs1;
  for (int k0 = 0; k0 < K; k0 += 16) {
    float4 av = make_float4(0.f, 0.f, 0.f, 0.f);
    if (arow) av = *(const float4*)(arow + k0 + akq);
    As[(akq + 0) * 132 + ar] = av.x; As[(akq + 1) * 132 + ar] = av.y; As[(akq + 2) * 132 + ar] = av.z; As[(akq + 3) * 132 + ar] = av.w;
    if (DUAL || tid < 256) {
      const float4 bv = *(const float4*)(bsrc + (size_t)(k0 + bk) * ldb + n0 + bc);
      *(float4*)(bdst + bk * 64 + bc) = bv;
    }
    __syncthreads();
#pragma unroll
    for (int kk = 0; kk < 16; ++kk) {
      const float4 a = *(const float4*)(As + kk * 132 + ty * 4);
      const float4 b = *(const float4*)(Bs0 + kk * 64 + tx * 4);
      const float aa[4] = {a.x, a.y, a.z, a.w}; const float bb[4] = {b.x, b.y, b.z, b.w};
#pragma unroll
      for (int i = 0; i < 4; ++i)
#pragma unroll
        for (int j = 0; j < 4; ++j) acc0[i][j] += aa[i] * bb[j];
      if (DUAL) {
        const float4 b1 = *(const float4*)(Bs1 + kk * 64 + tx * 4);
        const float cc[4] = {b1.x, b1.y, b1.z, b1.w};
#pragma unroll
        for (int i = 0; i < 4; ++i)
#pragma unroll
          for (int j = 0; j < 4; ++j) acc1[i][j] += aa[i] * cc[j];
      }
    }
    __syncthreads();
  }
#pragma unroll
  for (int i = 0; i < 4; ++i)
    if (ty * 4 + i < mcount) {
#pragma unroll
      for (int j = 0; j < 4; ++j) ef(ty * 4 + i, n0 + tx * 4 + j, acc0[i][j], acc1[i][j]);
    }
}

__device__ __forceinline__ void phase_inproj(const P& p, int bid, int nb, float* lds) {
  const float* HN = (const float*)(p.ws + WS_HN); float* PR = (float*)(p.ws + WS_PROJ);
  for (int it = bid; it < (T / 128) * (DPROJ / 64); it += nb) {
    const int mt = it / (DPROJ / 64), nt = it % (DPROJ / 64), m0 = mt * 128;
    auto af = [&](int r) { return HN + (size_t)(m0 + r) * D; };
    auto ef = [&](int r, int col, float v, float) { PR[(size_t)(m0 + r) * DPROJ + col] = v; };
    gemm_tile_naive<false>(af, 128, p.w_in, nullptr, DPROJ, nt * 64, D, ef, lds);
  }
}

__device__ __forceinline__ void phase_rope(const P& p, int bid, int nb) {
  float* PR = (float*)(p.ws + WS_PROJ);
  const float* ct = (const float*)(p.ws + WS_COS); const float* st = (const float*)(p.ws + WS_SIN);
  for (int i = bid * NT + threadIdx.x; i < T * 128; i += nb * NT) {
    const int t = i >> 7, r = i & 127, which = r >> 6, hc = (r >> 3) & 7, f = r & 7;
    float* base = PR + (size_t)t * DPROJ + (which ? COL_K : COL_Q) + hc * 64;
    const float t1 = base[f], t2 = base[8 + f], c = ct[t * 8 + f], s = st[t * 8 + f];
    base[f] = t1 * c - t2 * s; base[8 + f] = t2 * c + t1 * s;
  }
}

__device__ __forceinline__ void phase_attn_naive(const P& p, int bid, int nb) {
  const float* PR = (const float*)(p.ws + WS_PROJ); float* AO = (float*)(p.ws + WS_AO);
  const int lane = threadIdx.x & 63, wave = threadIdx.x >> 6;
  for (int it0 = bid * NW + wave; it0 < 4096; it0 += nb * NW) {
    const int it = __builtin_amdgcn_readfirstlane(it0);
    const int qc = 63 - (it >> 6), rest = it & 63, vh = rest & 1, bh = rest >> 1, b = bh >> 3, hc = bh & 7, h = hc >> 1;
    const int qi = qc * 64 + lane;
    const float* qp = PR + (size_t)(b * SEQ + qi) * DPROJ + COL_Q + hc * 64;
    float q[64], o[64];
#pragma unroll
    for (int d = 0; d < 64; d += 4) { const float4 v = *(const float4*)(qp + d); q[d] = v.x * 0.125f; q[d + 1] = v.y * 0.125f; q[d + 2] = v.z * 0.125f; q[d + 3] = v.w * 0.125f; }
#pragma unroll
    for (int d = 0; d < 64; ++d) o[d] = 0.f;
    float m = -INFINITY, l = 0.f;
    const float* kbase = PR + (size_t)(b * SEQ) * DPROJ + COL_K + hc * 64;
    const float* vbase = PR + (size_t)(b * SEQ) * DPROJ + COL_V + h * 128 + vh * 64;
    const int jmax = qc * 64 + 63;
    for (int j = 0; j <= jmax; ++j) {
      const float* kr = kbase + (size_t)j * DPROJ; const float* vr = vbase + (size_t)j * DPROJ;
      float s = 0.f;
#pragma unroll
      for (int d = 0; d < 64; d += 4) { const float4 kv = *(const float4*)(kr + d); s += q[d] * kv.x; s += q[d + 1] * kv.y; s += q[d + 2] * kv.z; s += q[d + 3] * kv.w; }
      if (j <= qi) {
        const float mn = fmaxf(m, s), a = expf(m - mn), pp = expf(s - mn);
        l = l * a + pp;
#pragma unroll
        for (int d = 0; d < 64; d += 4) { const float4 vv = *(const float4*)(vr + d); o[d] = o[d] * a + pp * vv.x; o[d + 1] = o[d + 1] * a + pp * vv.y; o[d + 2] = o[d + 2] * a + pp * vv.z; o[d + 3] = o[d + 3] * a + pp * vv.w; }
        m = mn;
      }
    }
    const float inv = 1.0f / l;
    float* op = AO + (size_t)(b * SEQ + qi) * 1024 + hc * 128 + vh * 64;
#pragma unroll
    for (int d = 0; d < 64; d += 4) *(float4*)(op + d) = make_float4(o[d] * inv, o[d + 1] * inv, o[d + 2] * inv, o[d + 3] * inv);
  }
}

__device__ __forceinline__ void phase_mix(const P& p, int bid, int nb) {
  const float* PR = (const float*)(p.ws + WS_PROJ); const float* AO = (const float*)(p.ws + WS_AO); float* MIX = (float*)(p.ws + WS_HN);
  const float lam = ((const float*)(p.ws + WS_MISC))[0];
  const int lane = threadIdx.x & 63, wave = threadIdx.x >> 6;
  for (int t = bid * NW + wave; t < T; t += nb * NW) {
    const int s = t % SEQ;
    const float* r0 = PR + (size_t)t * DPROJ;
    float vals[8]; float ss = 0.f;
#pragma unroll
    for (int j = 0; j < 2; ++j) {
      const int ch = lane * 4 + 256 * j;
      const float4 h0 = *(const float4*)(r0 + COL_H + ch), c0 = *(const float4*)(r0 + COL_C + ch), bg = *(const float4*)(r0 + COL_B + ch);
      float4 h1 = make_float4(0, 0, 0, 0), c1 = h1, h2 = h1, c2 = h1;
      if (s >= 1) { h1 = *(const float4*)(r0 - DPROJ + COL_H + ch); c1 = *(const float4*)(r0 - DPROJ + COL_C + ch); }
      if (s >= 2) { h2 = *(const float4*)(r0 - 2 * DPROJ + COL_H + ch); c2 = *(const float4*)(r0 - 2 * DPROJ + COL_C + ch); }
      const float4 w0 = *(const float4*)(p.conv_w + ch), w1 = *(const float4*)(p.conv_w + 512 + ch), w2 = *(const float4*)(p.conv_w + 1024 + ch);
      float y;
      y = w0.x * (c2.x * h2.x) + w1.x * (c1.x * h1.x) + w2.x * (c0.x * h0.x); vals[4 * j + 0] = bg.x * y;
      y = w0.y * (c2.y * h2.y) + w1.y * (c1.y * h1.y) + w2.y * (c0.y * h0.y); vals[4 * j + 1] = bg.y * y;
      y = w0.z * (c2.z * h2.z) + w1.z * (c1.z * h1.z) + w2.z * (c0.z * h0.z); vals[4 * j + 2] = bg.z * y;
      y = w0.w * (c2.w * h2.w) + w1.w * (c1.w * h1.w) + w2.w * (c0.w * h0.w); vals[4 * j + 3] = bg.w * y;
#pragma unroll
      for (int i = 0; i < 4; ++i) ss += vals[4 * j + i] * vals[4 * j + i];
    }
    ss = wave_sum(ss);
    const float rstd = 1.0f / sqrtf(ss * (1.0f / 512.f) + 1e-6f);
    float* mo = MIX + (size_t)t * D;
#pragma unroll
    for (int j = 0; j < 2; ++j) {
      const int ch = lane * 4 + 256 * j;
      const float4 gg = *(const float4*)(p.g_conv + ch);
      *(float4*)(mo + ch) = make_float4(vals[4 * j] * rstd * gg.x, vals[4 * j + 1] * rstd * gg.y, vals[4 * j + 2] * rstd * gg.z, vals[4 * j + 3] * rstd * gg.w);
    }
    const float* ao = AO + (size_t)t * 1024;
#pragma unroll
    for (int j = 0; j < 2; ++j) {
      const int idx = lane * 4 + 256 * j, h = idx >> 7, d = idx & 127;
      const float4 o0 = *(const float4*)(ao + (2 * h) * 128 + d), o1 = *(const float4*)(ao + (2 * h + 1) * 128 + d);
      float dv[4] = {o0.x - lam * o1.x, o0.y - lam * o1.y, o0.z - lam * o1.z, o0.w - lam * o1.w};
      float q = dv[0] * dv[0] + dv[1] * dv[1] + dv[2] * dv[2] + dv[3] * dv[3];
#pragma unroll
      for (int o = 1; o < 32; o <<= 1) q += __shfl_xor(q, o);
      const float r2 = 1.0f / sqrtf(q * (1.0f / 128.f) + 1e-5f);
      const float4 gg = *(const float4*)(p.g_subln + d);
      *(float4*)(mo + 512 + idx) = make_float4(dv[0] * r2 * gg.x * 0.8f, dv[1] * r2 * gg.y * 0.8f, dv[2] * r2 * gg.z * 0.8f, dv[3] * r2 * gg.w * 0.8f);
    }
  }
}

__device__ __forceinline__ void phase_outproj(const P& p, int bid, int nb, float* lds) {
  const float* MIX = (const float*)(p.ws + WS_HN); float* X1 = (float*)(p.ws + WS_X1); const float* ada = (const float*)(p.ws + WS_ADA);
  for (int it = bid; it < (T / 128) * (D / 64); it += nb) {
    const int mt = it / (D / 64), nt = it % (D / 64), m0 = mt * 128, b = m0 / SEQ;
    auto af = [&](int r) { return MIX + (size_t)(m0 + r) * D; };
    auto ef = [&](int r, int col, float v, float) { const size_t o = (size_t)(m0 + r) * D + col; X1[o] = p.x[o] + ada[b * 6144 + 2048 + col] * v; };
    gemm_tile_naive<false>(af, 128, p.w_out, nullptr, D, nt * 64, D, ef, lds);
  }
}

__device__ __forceinline__ void phase_router_shared(const P& p, int bid, int nb, float* lds) {
  const float* HN = (const float*)(p.ws + WS_HN); float* LG = (float*)(p.ws + WS_LOGITS); float* AC = (float*)(p.ws + WS_ACTS);
  for (int it = bid; it < (T / 128) * 8; it += nb) {
    const int mt = it >> 3, r8 = it & 7, m0 = mt * 128;
    auto af = [&](int r) { return HN + (size_t)(m0 + r) * D; };
    if (r8 < 4) {
      auto ef = [&](int r, int col, float v, float) { LG[(size_t)(m0 + r) * 256 + col] = v; };
      gemm_tile_naive<false>(af, 128, p.w_router, nullptr, 256, r8 * 64, D, ef, lds);
    } else {
      auto ef = [&](int r, int col, float g, float u) { AC[(size_t)(m0 + r) * 256 + col] = silu_f(g) * u; };
      gemm_tile_naive<true>(af, 128, p.wg_s, p.wu_s, 256, (r8 - 4) * 64, D, ef, lds);
    }
  }
}

__device__ __forceinline__ void phase_route(const P& p, int bid, int nb) {
  const float* LG = (const float*)(p.ws + WS_LOGITS);
  int* IDX = (int*)(p.ws + WS_IDX); float* WTS = (float*)(p.ws + WS_WTS); int* LIST = (int*)(p.ws + WS_LIST); int* cnt = (int*)(p.ws + WS_CTL);
  const int lane = threadIdx.x & 63, wave = threadIdx.x >> 6;
  for (int t = bid * NW + wave; t < T; t += nb * NW) {
    const float4 lg = *(const float4*)(LG + (size_t)t * 256 + lane * 4);
    const float4 bs = *(const float4*)(p.rbias + lane * 4);
    float sc[4], cv[4];
    sc[0] = 1.f / (1.f + expf(-lg.x)); sc[1] = 1.f / (1.f + expf(-lg.y)); sc[2] = 1.f / (1.f + expf(-lg.z)); sc[3] = 1.f / (1.f + expf(-lg.w));
    cv[0] = sc[0] + bs.x; cv[1] = sc[1] + bs.y; cv[2] = sc[2] + bs.z; cv[3] = sc[3] + bs.w;
    float m1 = -INFINITY, m2 = -INFINITY;
#pragma unroll
    for (int i = 0; i < 4; ++i) { const float v = cv[i]; if (v > m1) { m2 = m1; m1 = v; } else if (v > m2) m2 = v; }
#pragma unroll
    for (int off = 1; off < 8; off <<= 1) {
      const float o1 = __shfl_xor(m1, off), o2 = __shfl_xor(m2, off);
      const float n1 = fmaxf(m1, o1), n2 = fmaxf(fminf(m1, o1), fmaxf(m2, o2));
      m1 = n1; m2 = n2;
    }
    const float gs = m1 + m2; const int g = lane >> 3; int rank = 0;
#pragma unroll
    for (int gg = 0; gg < 8; ++gg) { const float og = __shfl(gs, gg * 8); rank += (og > gs || (og == gs && gg < g)) ? 1 : 0; }
    const bool sel = rank < 4;
#pragma unroll
    for (int i = 0; i < 4; ++i) cv[i] = sel ? cv[i] : -INFINITY;
    int my_e = 0; float my_w = 0.f;
#pragma unroll
    for (int k = 0; k < 8; ++k) {
      float bv = cv[0]; int bi = 0;
#pragma unroll
      for (int i = 1; i < 4; ++i) if (cv[i] > bv) { bv = cv[i]; bi = i; }
      int gi = lane * 4 + bi;
#pragma unroll
      for (int off = 32; off >= 1; off >>= 1) {
        const float ov = __shfl_xor(bv, off); const int oi = __shfl_xor(gi, off);
        if (ov > bv || (ov == bv && oi < gi)) { bv = ov; gi = oi; }
      }
      const int sub = gi & 3, own = gi >> 2;
      const float mine = sub == 0 ? sc[0] : sub == 1 ? sc[1] : sub == 2 ? sc[2] : sc[3];
      const float wv = __shfl(mine, own);
      if (lane == own) {
#pragma unroll
        for (int i = 0; i < 4; ++i) if (sub == i) cv[i] = -INFINITY;
      }
      if (lane == k) { my_e = gi; my_w = wv; }
    }
    float sum = (lane < 8) ? my_w : 0.f;
    sum += __shfl_xor(sum, 1); sum += __shfl_xor(sum, 2); sum += __shfl_xor(sum, 4);
    if (lane < 8) {
      const float w = my_w / (sum + 1e-20f) * 2.5f;
      IDX[t * 8 + lane] = my_e; WTS[t * 8 + lane] = w;
      const int pos = atomicAdd(&cnt[my_e], 1);
      LIST[(size_t)my_e * LISTCAP + pos] = t * 8 + lane;
    }
  }
}

__device__ __forceinline__ void phase_shared_down(const P& p, int bid, int nb, float* lds) {
  const float* AC = (const float*)(p.ws + WS_ACTS); float* X1 = (float*)(p.ws + WS_X1); const float* ada = (const float*)(p.ws + WS_ADA);
  for (int it = bid; it < (T / 128) * (D / 64); it += nb) {
    const int mt = it / (D / 64), nt = it % (D / 64), m0 = mt * 128, b = m0 / SEQ;
    auto af = [&](int r) { return AC + (size_t)(m0 + r) * DSH; };
    auto ef = [&](int r, int col, float v, float) { const size_t o = (size_t)(m0 + r) * D + col; X1[o] = X1[o] + ada[b * 6144 + 5120 + col] * v; };
    gemm_tile_naive<false>(af, 128, p.wd_s, nullptr, D, nt * 64, DSH, ef, lds);
  }
}

__device__ __forceinline__ void phase_exp1(const P& p, int bid, int nb, float* lds) {
  const float* HN = (const float*)(p.ws + WS_HN); float* H = (float*)(p.ws + WS_PROJ);
  const int* LIST = (const int*)(p.ws + WS_LIST); const int* cnt = (const int*)(p.ws + WS_CTL);
  for (int it = bid; it < NE * 128 * 4; it += nb) {
    const int e = it >> 9, mt = (it >> 2) & 127, nt = it & 3;
    const int c = cnt[e]; if (mt * 128 >= c) continue;
    const int mcount = min(128, c - mt * 128);
    const int* lst = LIST + (size_t)e * LISTCAP + mt * 128;
    auto af = [&](int r) { return HN + (size_t)(lst[r] >> 3) * D; };
    auto ef = [&](int r, int col, float g, float u) { H[(size_t)lst[r] * DE + col] = silu_f(g) * u; };
    gemm_tile_naive<true>(af, mcount, p.wg_e + (size_t)e * D * DE, p.wu_e + (size_t)e * D * DE, DE, nt * 64, D, ef, lds);
  }
}

__device__ __forceinline__ void phase_exp2(const P& p, int bid, int nb, float* lds) {
  const float* H = (const float*)(p.ws + WS_PROJ); float* SL = (float*)(p.ws + WS_SLAB); const float* WTS = (const float*)(p.ws + WS_WTS);
  const int* LIST = (const int*)(p.ws + WS_LIST); const int* cnt = (const int*)(p.ws + WS_CTL);
  for (int it = bid; it < NE * 128 * 16; it += nb) {
    const int e = it >> 11, mt = (it >> 4) & 127, nt = it & 15;
    const int c = cnt[e]; if (mt * 128 >= c) continue;
    const int mcount = min(128, c - mt * 128);
    const int* lst = LIST + (size_t)e * LISTCAP + mt * 128;
    auto af = [&](int r) { return H + (size_t)lst[r] * DE; };
    auto ef = [&](int r, int col, float v, float) { const int aid = lst[r]; SL[(size_t)aid * D + col] = v * WTS[aid]; };
    gemm_tile_naive<false>(af, mcount, p.wd_e + (size_t)e * DE * D, nullptr, D, nt * 64, DE, ef, lds);
  }
}

__device__ __forceinline__ void phase_final(const P& p, int bid, int nb) {
  const float* X1 = (const float*)(p.ws + WS_X1); const float* SL = (const float*)(p.ws + WS_SLAB); const float* ada = (const float*)(p.ws + WS_ADA);
  const int lane = threadIdx.x & 63, wave = threadIdx.x >> 6;
  for (int t = bid * NW + wave; t < T; t += nb * NW) {
    const int b = t / SEQ;
    float4 v[4]; float s = 0.f;
#pragma unroll
    for (int j = 0; j < 4; ++j) {
      const int c0 = lane * 4 + 256 * j;
      float4 y = make_float4(0, 0, 0, 0);
#pragma unroll
      for (int k = 0; k < 8; ++k) { const float4 z = *(const float4*)(SL + (size_t)(t * 8 + k) * D + c0); y.x += z.x; y.y += z.y; y.z += z.z; y.w += z.w; }
      const float4 gt = *(const float4*)(ada + b * 6144 + 5120 + c0);
      const float4 bx = *(const float4*)(X1 + (size_t)t * D + c0);
      v[j] = make_float4(bx.x + gt.x * y.x, bx.y + gt.y * y.y, bx.z + gt.z * y.z, bx.w + gt.w * y.w);
      s += v[j].x * v[j].x + v[j].y * v[j].y + v[j].z * v[j].z + v[j].w * v[j].w;
    }
    s = wave_sum(s);
    const float rstd = 1.0f / sqrtf(s * (1.0f / D) + 1e-6f);
#pragma unroll
    for (int j = 0; j < 4; ++j) {
      const int c0 = lane * 4 + 256 * j;
      const float4 gg = *(const float4*)(p.g_final + c0);
      *(float4*)(p.out + (size_t)t * D + c0) = make_float4(v[j].x * rstd * gg.x, v[j].y * rstd * gg.y, v[j].z * rstd * gg.z, v[j].w * rstd * gg.w);
    }
  }
}

template <int PH>
__global__ void __launch_bounds__(NT) k_phase(P p) {
  __shared__ __attribute__((aligned(16))) float lds[8192];
  const int bid = blockIdx.x, nb = gridDim.x;
  if (PH == 0) phase_ada(p, bid, nb, lds);
  if (PH == 1) phase_modnorm(p, bid, nb, p.x, p.g1, 0, 1024, (float*)(p.ws + WS_HN));
  if (PH == 2) phase_inproj(p, bid, nb, lds);
  if (PH == 3) phase_rope(p, bid, nb);
  if (PH == 4) phase_attn_naive(p, bid, nb);
  if (PH == 5) phase_mix(p, bid, nb);
  if (PH == 6) phase_outproj(p, bid, nb, lds);
  if (PH == 7) phase_modnorm(p, bid, nb, (const float*)(p.ws + WS_X1), p.g2, 3072, 4096, (float*)(p.ws + WS_HN));
  if (PH == 8) phase_router_shared(p, bid, nb, lds);
  if (PH == 9) phase_route(p, bid, nb);
  if (PH == 10) phase_shared_down(p, bid, nb, lds);
  if (PH == 11) phase_exp1(p, bid, nb, lds);
  if (PH == 12) phase_exp2(p, bid, nb, lds);
  if (PH == 13) phase_final(p, bid, nb);
}

#define LAS __attribute__((address_space(3)))
#define XB_TMO      128
#define XB_XCNT(j)  (256  + 64 * (j))
#define XB_XSUB(j)  (1280 + 64 * (j))
#define XB_XGEN(j)  (2304 + 64 * (j))
#define XB_TOP      3328
#define XB_TOPGEN   3392
#define XCD_BAR_WORDS 3456
#define XB_SPIN_CAP (1u << 22)
__device__ __forceinline__ unsigned xb_ld(unsigned* p)              { return __hip_atomic_load(p, __ATOMIC_RELAXED, __HIP_MEMORY_SCOPE_AGENT); }
__device__ __forceinline__ unsigned xb_add(unsigned* p, unsigned v) { return __hip_atomic_fetch_add(p, v, __ATOMIC_RELAXED, __HIP_MEMORY_SCOPE_AGENT); }
__device__ __forceinline__ unsigned xb_xcc_id() { return (unsigned)__builtin_amdgcn_s_getreg((3 << 11) | 20) & 0xFu; }
#define XB_SPIN(cond, bar) do { unsigned _sp = 0; while (cond) { __builtin_amdgcn_s_sleep(1); \
    if ((++_sp & 255u) == 0u) { if (xb_ld(&(bar)[XB_TMO])) break; if (_sp > XB_SPIN_CAP) { atomicAdd(&(bar)[XB_TMO], 1u); break; } } } } while (0)
struct XcdBarrier { unsigned* bar; unsigned x; volatile LAS unsigned* st; };
__device__ __forceinline__ XcdBarrier xcd_barrier_post(unsigned* bar, volatile LAS unsigned* st) {
    XcdBarrier b; b.bar = bar; b.x = xb_xcc_id(); b.st = st;
    if (threadIdx.x == 0) (void)xb_add(&bar[XB_XCNT(b.x)], 1u);
    return b;
}
__device__ __forceinline__ void xcd_barrier_complete(unsigned* bar, unsigned x, unsigned& nloc, unsigned& nx) {
    const unsigned G = gridDim.x * gridDim.y * gridDim.z;
    unsigned sum, cnt, mine, sp = 0u;
    for (;;) {
        sum = 0u; cnt = 0u; mine = 0u;
#pragma unroll
        for (unsigned j = 0; j < 16; ++j) { const unsigned c = xb_ld(&bar[XB_XCNT(j)]); sum += c; cnt += (c > 0u) ? 1u : 0u; mine = (j == x) ? c : mine; }
        if (sum == G) break;
        __builtin_amdgcn_s_sleep(1);
        if ((++sp & 255u) == 0u) { if (xb_ld(&bar[XB_TMO])) break; if (sp > XB_SPIN_CAP) { atomicAdd(&bar[XB_TMO], 1u); break; } }
    }
    nloc = mine > 0u ? mine : 1u; nx = cnt > 0u ? cnt : 1u;
}
__device__ __forceinline__ void xcd_barrier(const XcdBarrier& b) {
    asm volatile("s_waitcnt vmcnt(0)" ::: "memory");
    __syncthreads();
    if (threadIdx.x == 0) {
        unsigned* bar = b.bar;
        __builtin_amdgcn_s_waitcnt(0);
        unsigned nloc = b.st[0], nx = b.st[1];
        if (nloc == 0u) { xcd_barrier_complete(bar, b.x, nloc, nx); b.st[0] = nloc; b.st[1] = nx; }
        const unsigned old = xb_add(&bar[XB_XSUB(b.x)], 1u);
        const unsigned gen = old / nloc;
        if (old + 1u == (gen + 1u) * nloc) {
            __builtin_amdgcn_fence(__ATOMIC_RELEASE, "agent");
            asm volatile("s_waitcnt vmcnt(0)" ::: "memory");
            const unsigned og = xb_add(&bar[XB_TOP], 1u);
            const unsigned tg = og / nx;
            if (og + 1u == (tg + 1u) * nx) xb_add(&bar[XB_TOPGEN], 1u);
            else XB_SPIN(xb_ld(&bar[XB_TOPGEN]) == tg, bar);
            __builtin_amdgcn_fence(__ATOMIC_ACQUIRE, "agent");
            xb_add(&bar[XB_XGEN(b.x)], 1u);
            asm volatile("s_waitcnt vmcnt(0)" ::: "memory");
        } else {
            XB_SPIN(xb_ld(&bar[XB_XGEN(b.x)]) == gen, bar);
            __builtin_amdgcn_fence(__ATOMIC_ACQUIRE, "agent");
            asm volatile("s_waitcnt vmcnt(0)" ::: "memory");
        }
    }
    __syncthreads();
}

constexpr int CW_BAR = 4096;
constexpr int LDS_BYTES = 147456;
constexpr int MISC_OFF = 140 * 1024;

__global__ void __launch_bounds__(NT, 2) mega(P p) {
  extern __shared__ __attribute__((aligned(16))) unsigned char smem[];
  float* lds = (float*)smem;
  volatile LAS unsigned* st = (volatile LAS unsigned*)((LAS unsigned char*)smem + MISC_OFF);
  if (threadIdx.x < 4) st[threadIdx.x] = 0u;
  __syncthreads();
  XcdBarrier bar = xcd_barrier_post((unsigned*)(p.ws + WS_CTL) + CW_BAR, st);
  const int bid = blockIdx.x, nb = gridDim.x;
  phase_ada(p, bid, nb, lds);                                                                      xcd_barrier(bar);
  phase_modnorm(p, bid, nb, p.x, p.g1, 0, 1024, (float*)(p.ws + WS_HN));                           xcd_barrier(bar);
  phase_inproj(p, bid, nb, lds);                                                                   xcd_barrier(bar);
  phase_rope(p, bid, nb);                                                                          xcd_barrier(bar);
  phase_attn_naive(p, bid, nb);                                                                    xcd_barrier(bar);
  phase_mix(p, bid, nb);                                                                           xcd_barrier(bar);
  phase_outproj(p, bid, nb, lds);                                                                  xcd_barrier(bar);
  phase_modnorm(p, bid, nb, (const float*)(p.ws + WS_X1), p.g2, 3072, 4096, (float*)(p.ws + WS_HN)); xcd_barrier(bar);
  phase_router_shared(p, bid, nb, lds);                                                            xcd_barrier(bar);
  phase_route(p, bid, nb);
  phase_shared_down(p, bid, nb, lds);                                                              xcd_barrier(bar);
  phase_exp1(p, bid, nb, lds);                                                                     xcd_barrier(bar);
  phase_exp2(p, bid, nb, lds);                                                                     xcd_barrier(bar);
  phase_final(p, bid, nb);
}
}

extern "C" void kernel_launch(void* const* d_in, const int* in_sizes, int n_in, void* d_out, int out_size, void* d_ws, size_t ws_size, hipStream_t stream) {
  if (n_in != 25 || ws_size < WS_END) { fprintf(stderr, "kernel_launch: unexpected n_in %d or ws_size %zu\n", n_in, ws_size); return; }
  P p; memset(&p, 0, sizeof(p));
  p.x = (const float*)d_in[0]; p.c = (const float*)d_in[1]; p.pos = (const int*)d_in[2]; p.w_ada = (const float*)d_in[3]; p.b_ada = (const float*)d_in[4];
  p.g1 = (const float*)d_in[5]; p.w_in = (const float*)d_in[6]; p.conv_w = (const float*)d_in[7]; p.g_conv = (const float*)d_in[8];
  p.lq1 = (const float*)d_in[9]; p.lk1 = (const float*)d_in[10]; p.lq2 = (const float*)d_in[11]; p.lk2 = (const float*)d_in[12];
  p.g_subln = (const float*)d_in[13]; p.w_out = (const float*)d_in[14]; p.g2 = (const float*)d_in[15]; p.w_router = (const float*)d_in[16]; p.rbias = (const float*)d_in[17];
  p.wg_e = (const float*)d_in[18]; p.wu_e = (const float*)d_in[19]; p.wd_e = (const float*)d_in[20];
  p.wg_s = (const float*)d_in[21]; p.wu_s = (const float*)d_in[22]; p.wd_s = (const float*)d_in[23]; p.g_final = (const float*)d_in[24];
  p.out = (float*)d_out; p.ws = (unsigned char*)d_ws;
  for (int i = 0; i < 8; ++i) p.inv_freq[i] = (float)pow(500000.0, -(double)i / 8.0);
  (void)hipMemsetAsync((char*)d_ws + WS_CTL, 0, CTL_BYTES, stream);
  static int grid = 0;
  if (grid == 0) {
    int dev = 0, cus = 0, per_cu = 0;
    hipGetDevice(&dev); hipDeviceGetAttribute(&cus, hipDeviceAttributeMultiprocessorCount, dev);
    hipFuncSetAttribute((const void*)mega, hipFuncAttributeMaxDynamicSharedMemorySize, LDS_BYTES);
    hipOccupancyMaxActiveBlocksPerMultiprocessor(&per_cu, (const void*)mega, NT, LDS_BYTES);
    if (per_cu < 1) { fprintf(stderr, "kernel_launch: occupancy query says %d blocks/CU\n", per_cu); grid = -1; }
    else grid = cus;
  }
  if (grid < 0) return;
  void* args[] = {&p};
  hipError_t e = hipLaunchCooperativeKernel((const void*)mega, dim3(grid), dim3(NT), args, LDS_BYTES, stream);
  if (e != hipSuccess) fprintf(stderr, "cooperative launch failed: %s (grid %d)\n", hipGetErrorString(e), grid);
}
```

```cpp
#include <hip/hip_runtime.h>
#include <stdint.h>
#include <math.h>
#include <stdio.h>
#include <string.h>

#define DIAG_EXACT_ROUTING 0

__device__ __forceinline__ int tidx() { int t = threadIdx.x; asm volatile("" : "+v"(t)); return t; }

namespace pg8 {
#define PG8_LAS __attribute__((address_space(3)))
typedef unsigned short bf16_t;
typedef short bf16x8 __attribute__((ext_vector_type(8)));
typedef float f32x4 __attribute__((ext_vector_type(4)));
typedef unsigned u32x4 __attribute__((ext_vector_type(4)));
constexpr int BM = 256, BK = 64, HALF = 128, HTB = HALF * BK * 2  , STAGE_BYTES = 8 * HTB, NXCD = 8, WGM = 8;

__host__ __device__ __forceinline__ int lds_byte(int r, int c) { const int st = (r >> 4) * 2 + (c >> 5), rr = r & 15, cc = c & 31, ob = rr * 64 + cc * 2; return st * 1024 + (ob ^ (((ob >> 9) & 1) << 5)); }
__host__ __device__ __forceinline__ void stage_rc(int b, int& R, int& C) { const int st = b / 1024, sb = b % 1024, swz = sb ^ (((sb >> 9) & 1) << 5); R = (st >> 1) * 16 + swz / 64; C = (st & 1) * 32 + (swz % 64) / 2; }
__host__ __device__ __forceinline__ int perm32(int rho) { const int n = rho >> 4, i = rho & 15; return 8 * (i >> 2) + 4 * n + (i & 3); }

struct Unit { int pm, pn; };
struct Gemm { const bf16_t* A; const bf16_t* Bt; int M, N, K; };

struct StaticOrder {
    int nM, nN, nwg, G, c;
    __host__ __device__ void init(int M, int N, int G_, int c_) { nM = M / BM; nN = N / BM; nwg = nM * nN; G = G_; c = c_; }
    __host__ __device__ bool next(int i, Unit& u) const {
        const long L = (long)i * G + c; if (L >= nwg) return false;
        int wgid = (int)L; { const int q = nwg / NXCD, r = nwg % NXCD, xcd = wgid % NXCD, off = wgid / NXCD; wgid = (xcd < r ? xcd * (q + 1) : r * (q + 1) + (xcd - r) * q) + off; }
        const int nig = WGM * nN, gid = wgid / nig, fm = gid * WGM, gsz = (nM - fm) < WGM ? (nM - fm) : WGM;
        u.pm = fm + ((wgid % nig) % gsz); u.pn = (wgid % nig) / gsz; return true;
    }
    __device__ __forceinline__ void a_ready(const Unit&) const {}
    __device__ __forceinline__ void done(const Unit&) const {}
};
__device__ __forceinline__ unsigned cvt_pk_bf16(float lo, float hi) { unsigned r; asm volatile("v_cvt_pk_bf16_f32 %0, %1, %2" : "=v"(r) : "v"(lo), "v"(hi)); return r; }
template <class Epi, class Sched, bool ALIGN_EPI = false, bool SP2 = false>
__device__ __forceinline__ void gemm_phase(PG8_LAS unsigned char* lds, const Gemm g, const Sched& S, const Epi& E) {
    const int tid = tidx(), wid = __builtin_amdgcn_readfirstlane(tid >> 6), lane = tid & 63, wr = wid >> 2, wc = wid & 3, fr = lane & 15, fq = lane >> 4;
    const int K = g.K, nt = K / BK;
    unsigned voffA[2], voffB[2];
#pragma unroll
    for (int i = 0; i < 2; ++i) { int R, C; stage_rc(tid * 16 + i * 8192, R, C); const int Rb = Epi::PERM ? ((R & ~31) + perm32(R & 31)) : R;
        voffA[i] = (unsigned)(R * K + C) * 2u; voffB[i] = (unsigned)(Rb * K + C) * 2u; }
    const size_t kstep = (size_t)(BK * 2);
    const size_t hstep = (size_t)HALF * K * 2;
    const size_t tstep = 2 * hstep;
    const unsigned ldsw = (unsigned)wid * 1024u;
    const int aoff = lds_byte(wr * 64 + fr, fq * 8), boff = lds_byte(wc * 32 + fr, fq * 8);
#define PG8_SA(b, h) (((b) * 2 + (h)) * HTB)
#define PG8_SB(b, h) ((4 + (b) * 2 + (h)) * HTB)
#define PG8_STAGE(bufoff, gbase, voff) do { _Pragma("unroll") for (int _i = 0; _i < 2; ++_i) \
        __builtin_amdgcn_global_load_lds((const unsigned*)((const char*)(gbase) + (voff)[_i]), (PG8_LAS unsigned*)(lds + (bufoff) + ldsw + _i * 8192), 16, 0, 0); } while (0)
#define PG8_LDA(dst, b, h) do { _Pragma("unroll") for (int m = 0; m < 4; ++m) _Pragma("unroll") for (int k = 0; k < 2; ++k) dst[m][k] = *(const PG8_LAS bf16x8*)(lds + PG8_SA(b, h) + aoff + m * 2048 + k * 1024); } while (0)
#define PG8_LDB(dst, b, h) do { _Pragma("unroll") for (int n = 0; n < 2; ++n) _Pragma("unroll") for (int k = 0; k < 2; ++k) dst[n][k] = *(const PG8_LAS bf16x8*)(lds + PG8_SB(b, h) + boff + n * 2048 + k * 1024); } while (0)
#define PG8_MMA(ai, bj, At, Bt) do { __builtin_amdgcn_s_setprio(1); _Pragma("unroll") for (int m = 0; m < 4; ++m) _Pragma("unroll") for (int n = 0; n < 2; ++n) _Pragma("unroll") for (int k = 0; k < 2; ++k) \
        acc[ai][bj][m][n] = __builtin_amdgcn_mfma_f32_16x16x32_bf16(Bt[n][k], At[m][k], acc[ai][bj][m][n], 0, 0, 0); __builtin_amdgcn_s_setprio(0); } while (0)
#define PG8_WAIT_V(n) asm volatile("s_waitcnt vmcnt(" #n ")" ::: "memory")
#define PG8_WAIT_L(n) asm volatile("s_waitcnt lgkmcnt(" #n ")" ::: "memory")
#define PG8_BAR __builtin_amdgcn_s_barrier()
#define PG8_SCHED __builtin_amdgcn_sched_barrier(0)
    Unit cur, nxt; int ui = 0;
    if (!S.next(0, cur)) return;
    f32x4 acc[2][2][4][2];
#pragma unroll
    for (int a = 0; a < 2; ++a)
#pragma unroll
        for (int b = 0; b < 2; ++b)
#pragma unroll
            for (int m = 0; m < 4; ++m)
#pragma unroll
                for (int n = 0; n < 2; ++n) acc[a][b][m][n] = (f32x4){0.f, 0.f, 0.f, 0.f};
    bf16x8 At[4][2], B0[2][2], B1[2][2];
    const char* cA = (const char*)g.A + (size_t)cur.pm * tstep; const char* cB = (const char*)g.Bt + (size_t)cur.pn * tstep;
    S.a_ready(cur);
    if constexpr (SP2) {
        PG8_STAGE(PG8_SB(0, 0), cB, voffB); PG8_STAGE(PG8_SB(0, 1), cB + hstep, voffB); PG8_STAGE(PG8_SA(0, 0), cA, voffA); PG8_STAGE(PG8_SA(0, 1), cA + hstep, voffA);
        if (wr == 1) PG8_BAR;
        PG8_WAIT_V(2); PG8_BAR;
        PG8_STAGE(PG8_SB(1, 0), cB + kstep, voffB); PG8_STAGE(PG8_SA(1, 0), cA + kstep, voffA); PG8_STAGE(PG8_SB(1, 1), cB + hstep + kstep, voffB);
        PG8_WAIT_V(6); PG8_BAR;
    } else {
        PG8_STAGE(PG8_SB(0, 0), cB, voffB); PG8_STAGE(PG8_SA(0, 0), cA, voffA); PG8_STAGE(PG8_SB(0, 1), cB + hstep, voffB); PG8_STAGE(PG8_SA(0, 1), cA + hstep, voffA);
        if (wr == 1) PG8_BAR;
        PG8_WAIT_V(4); PG8_BAR;
        PG8_STAGE(PG8_SB(1, 0), cB + kstep, voffB); PG8_STAGE(PG8_SA(1, 0), cA + kstep, voffA); PG8_STAGE(PG8_SB(1, 1), cB + hstep + kstep, voffB);
        PG8_WAIT_V(6); PG8_BAR;
    }
    for (;;) {
        const bool has_next = S.next(ui + 1, nxt);
        const char* nA = has_next ? (const char*)g.A + (size_t)nxt.pm * tstep : cA; const char* nB = has_next ? (const char*)g.Bt + (size_t)nxt.pn * tstep : cB;
        for (int t = 0; t < nt; t += 2) {
            const bool last = (t == nt - 2);
            const char* a1 = cA + (size_t)(t + 1) * kstep;
            const char* a2 = last ? nA : cA + (size_t)(t + 2) * kstep; const char* b2 = last ? nB : cB + (size_t)(t + 2) * kstep;
            const char* a3 = a2 + kstep; const char* b3 = b2 + kstep;
            if (last && has_next) S.a_ready(nxt);
            if constexpr (SP2) {
            PG8_LDB(B0, 0, 0); PG8_LDB(B1, 0, 1); PG8_SCHED; PG8_LDA(At, 0, 0); PG8_STAGE(PG8_SA(1, 1), a1 + hstep, voffA);
            PG8_WAIT_V(8); PG8_WAIT_L(0); PG8_BAR; PG8_MMA(0, 0, At, B0); PG8_MMA(0, 1, At, B1); PG8_BAR; PG8_SCHED;
            PG8_LDA(At, 0, 1); PG8_STAGE(PG8_SB(0, 0), b2, voffB); PG8_STAGE(PG8_SB(0, 1), b2 + hstep, voffB); PG8_STAGE(PG8_SA(0, 0), a2, voffA);
            PG8_WAIT_V(8); PG8_WAIT_L(0); PG8_BAR; PG8_MMA(1, 0, At, B0); PG8_MMA(1, 1, At, B1); PG8_BAR; PG8_SCHED;
            PG8_LDB(B0, 1, 0); PG8_LDB(B1, 1, 1); PG8_SCHED; PG8_LDA(At, 1, 0); PG8_STAGE(PG8_SA(0, 1), a2 + hstep, voffA);
            PG8_WAIT_V(8); PG8_WAIT_L(0); PG8_BAR; PG8_MMA(0, 0, At, B0); PG8_MMA(0, 1, At, B1); PG8_BAR; PG8_SCHED;
            PG8_LDA(At, 1, 1); PG8_STAGE(PG8_SB(1, 0), b3, voffB); PG8_STAGE(PG8_SB(1, 1), b3 + hstep, voffB); PG8_STAGE(PG8_SA(1, 0), a3, voffA);
            PG8_WAIT_V(8); PG8_WAIT_L(0); PG8_BAR; PG8_MMA(1, 0, At, B0); PG8_MMA(1, 1, At, B1); PG8_BAR; PG8_SCHED;
            } else {
            PG8_LDB(B0, 0, 0); PG8_SCHED; PG8_LDA(At, 0, 0); PG8_STAGE(PG8_SA(1, 1), a1 + hstep, voffA);
            PG8_WAIT_L(8); PG8_BAR; PG8_WAIT_L(0); PG8_MMA(0, 0, At, B0); PG8_BAR; PG8_SCHED;
            PG8_LDB(B1, 0, 1); PG8_STAGE(PG8_SB(0, 0), b2, voffB);
            PG8_BAR; PG8_WAIT_L(0); PG8_MMA(0, 1, At, B1); PG8_BAR;
            PG8_LDA(At, 0, 1); PG8_STAGE(PG8_SA(0, 0), a2, voffA);
            PG8_BAR; PG8_WAIT_L(0); PG8_MMA(1, 0, At, B0); PG8_BAR; PG8_SCHED;
            PG8_STAGE(PG8_SB(0, 1), b2 + hstep, voffB);
            PG8_WAIT_V(6); PG8_BAR; PG8_MMA(1, 1, At, B1); PG8_BAR;
            PG8_LDB(B0, 1, 0); PG8_SCHED; PG8_LDA(At, 1, 0); PG8_STAGE(PG8_SA(0, 1), a2 + hstep, voffA);
            PG8_WAIT_L(8); PG8_BAR; PG8_WAIT_L(0); PG8_MMA(0, 0, At, B0); PG8_BAR; PG8_SCHED;
            PG8_LDB(B1, 1, 1); PG8_STAGE(PG8_SB(1, 0), b3, voffB);
            PG8_BAR; PG8_WAIT_L(0); PG8_MMA(0, 1, At, B1); PG8_BAR;
            PG8_LDA(At, 1, 1); PG8_STAGE(PG8_SA(1, 0), a3, voffA);
            PG8_BAR; PG8_WAIT_L(0); PG8_MMA(1, 0, At, B0); PG8_BAR; PG8_SCHED;
            PG8_STAGE(PG8_SB(1, 1), b3 + hstep, voffB);
            PG8_WAIT_V(6); PG8_BAR; PG8_MMA(1, 1, At, B1); PG8_BAR;
            }
        }
        if constexpr (ALIGN_EPI) { if (wr == 0) PG8_BAR; }
        if constexpr (!Epi::AFTER_DRAIN) { E(acc, cur, wr, wc, fr, fq); S.done(cur); }
        if (!has_next) break;
#pragma unroll
        for (int a = 0; a < 2; ++a)
#pragma unroll
            for (int b = 0; b < 2; ++b)
#pragma unroll
                for (int m = 0; m < 4; ++m)
#pragma unroll
                    for (int n = 0; n < 2; ++n) acc[a][b][m][n] = (f32x4){0.f, 0.f, 0.f, 0.f};
        cur = nxt; cA = nA; cB = nB; ++ui;
        if constexpr (ALIGN_EPI) { if (wr == 1) PG8_BAR; }
    }
    PG8_WAIT_V(0);
    if constexpr (!ALIGN_EPI) { if (wr == 0) PG8_BAR; }
    PG8_BAR;
    if constexpr (Epi::AFTER_DRAIN) { E.fused(acc, cur, wr, wc, fr, fq, lds, wid, lane); S.done(cur); }
#undef PG8_SA
#undef PG8_SB
#undef PG8_STAGE
#undef PG8_LDA
#undef PG8_LDB
#undef PG8_MMA
#undef PG8_WAIT_V
#undef PG8_WAIT_L
#undef PG8_BAR
#undef PG8_SCHED
}
}

namespace {
using pg8::bf16_t; using pg8::f32x4; using pg8::u32x4; using pg8::Unit;
constexpr int D = 1024, BATCH = 4, SEQ = 4096, T = BATCH * SEQ;
constexpr int DPROJ = 3072;
constexpr int COL_H = 0, COL_B = 512, COL_C = 1024, COL_Q = 1536, COL_K = 2048, COL_V = 2560;
constexpr int NE = 256, TOPK = 8, DE = 256, DSH = 256;
constexpr int NT = 512;
constexpr int NW = NT / 64;
constexpr int LISTCAP = T;
constexpr float C2 = 0.125f * 1.4426950408889634f;

constexpr size_t MiB = 1u << 20;
constexpr size_t WS_CTL = 0, CTL_BYTES = 1 * MiB;
constexpr size_t WS_ADA = 1 * MiB;
constexpr size_t WS_MISC = 1 * MiB + 128 * 1024;
constexpr size_t WS_COS = 2 * MiB, WS_SIN = 2 * MiB + 512 * 1024;
constexpr size_t WS_IDX = 3 * MiB, WS_WTS = 3 * MiB + 512 * 1024;
constexpr size_t WS_LIST = 4 * MiB;
constexpr size_t WS_LOGITS = 20 * MiB;
constexpr size_t WS_ACTS = 36 * MiB;
constexpr size_t WS_WIN_T = 44 * MiB;
constexpr size_t WS_WOUT_T = 50 * MiB;
constexpr size_t WS_WRS_T = 52 * MiB;
constexpr size_t WS_WDS_T = 54 * MiB;
constexpr size_t WS_HNB = 64 * MiB;
constexpr size_t WS_PROJB = 96 * MiB;
constexpr size_t WS_X1 = 192 * MiB;
constexpr size_t WS_AO = 256 * MiB;
constexpr size_t WS_H = 320 * MiB;
constexpr size_t WS_SLAB = 448 * MiB;
constexpr size_t WS_END = 960 * MiB;

struct P {
  const float* x; const float* c; const int* pos; const float* w_ada; const float* b_ada; const float* g1;
  const float* w_in; const float* conv_w; const float* g_conv; const float* lq1; const float* lk1; const float* lq2; const float* lk2;
  const float* g_subln; const float* w_out; const float* g2; const float* w_router; const float* rbias;
  const float* wg_e; const float* wu_e; const float* wd_e; const float* wg_s; const float* wu_s; const float* wd_s; const float* g_final;
  float* out; unsigned char* ws;
  float inv_freq[8];
};

#define LAS __attribute__((address_space(3)))
__device__ __forceinline__ float wave_sum(float v) {
#pragma unroll
  for (int o = 1; o < 64; o <<= 1) v += __shfl_xor(v, o);
  return v;
}
__device__ __forceinline__ float silu_f(float v) { return v / (1.f + expf(-v)); }
__device__ __forceinline__ unsigned f2bf(float f) { unsigned u = __float_as_uint(f); return (u + 0x7fffu + ((u >> 16) & 1u)) >> 16; }
__device__ __forceinline__ unsigned pk2(float lo, float hi) { return f2bf(lo) | (f2bf(hi) << 16); }
__device__ __forceinline__ float bflo(unsigned w) { return __uint_as_float(w << 16); }
__device__ __forceinline__ float bfhi(unsigned w) { return __uint_as_float(w & 0xffff0000u); }
__device__ __forceinline__ float4 ld_bf4(const bf16_t* p) { const uint2 w = *(const uint2*)p; return make_float4(bflo(w.x), bfhi(w.x), bflo(w.y), bfhi(w.y)); }
__device__ __forceinline__ void st_bf4(bf16_t* p, float a, float b, float c, float d) { *(uint2*)p = make_uint2(pk2(a, b), pk2(c, d)); }

struct EpiInproj {
  static constexpr bool PERM = true, AFTER_DRAIN = false;
  bf16_t* O; const float* cosT; const float* sinT;
  __device__ __forceinline__ void operator()(const f32x4 (&acc)[2][2][4][2], const Unit& u, int wr, int wc, int fr, int fq) const {
    const int row0 = u.pm * 256 + wr * 64 + fr, col0 = u.pn * 256 + wc * 32 + 8 * fq;
    const bool qk = (u.pn >= 6 && u.pn < 10), rot = qk && ((wc & 1) == 0) && (fq < 2);
    const float sc = (u.pn == 6 || u.pn == 7) ? C2 : 1.f;
#pragma unroll
    for (int ai = 0; ai < 2; ++ai)
#pragma unroll
      for (int m = 0; m < 4; ++m) {
        const int row = row0 + ai * 128 + m * 16;
        f32x4 cs = {1.f, 1.f, 1.f, 1.f}, sn = {0.f, 0.f, 0.f, 0.f};
        if (rot) { cs = *(const f32x4*)(cosT + (size_t)row * 8 + 4 * fq); sn = *(const f32x4*)(sinT + (size_t)row * 8 + 4 * fq); }
        bf16_t* rowp = O + (size_t)row * DPROJ + col0;
#pragma unroll
        for (int bj = 0; bj < 2; ++bj) {
          const f32x4 a = acc[ai][bj][m][0], b = acc[ai][bj][m][1];
          const f32x4 v0 = (a * cs - b * sn) * sc, v1 = (b * cs + a * sn) * sc;
          u32x4 w; w.x = pk2(v0[0], v0[1]); w.y = pk2(v0[2], v0[3]); w.z = pk2(v1[0], v1[1]); w.w = pk2(v1[2], v1[3]);
          *(u32x4*)(rowp + bj * 128) = w;
        }
      }
  }
};
struct EpiResid {
  static constexpr bool PERM = false, AFTER_DRAIN = false;
  const float* base; float* out; const float* gate;
  __device__ __forceinline__ void operator()(const f32x4 (&acc)[2][2][4][2], const Unit& u, int wr, int wc, int fr, int fq) const {
    const int row0 = u.pm * 256 + wr * 64 + fr, col0 = u.pn * 256 + wc * 32 + 4 * fq;
    const float* gp = gate + (size_t)(u.pm / 16) * 6144;
#pragma unroll
    for (int bj = 0; bj < 2; ++bj)
#pragma unroll
      for (int n = 0; n < 2; ++n) {
        const int c = col0 + bj * 128 + n * 16;
        const f32x4 gv = *(const f32x4*)(gp + c);
#pragma unroll
        for (int ai = 0; ai < 2; ++ai)
#pragma unroll
          for (int m = 0; m < 4; ++m) {
            const size_t o = (size_t)(row0 + ai * 128 + m * 16) * D + c;
            const f32x4 bs = *(const f32x4*)(base + o);
            *(f32x4*)(out + o) = bs + gv * acc[ai][bj][m][n];
          }
      }
  }
};
struct EpiRS {
  static constexpr bool PERM = true, AFTER_DRAIN = false;
  float* LG; bf16_t* AC;
  __device__ __forceinline__ void operator()(const f32x4 (&acc)[2][2][4][2], const Unit& u, int wr, int wc, int fr, int fq) const {
    const int row0 = u.pm * 256 + wr * 64 + fr, cl = wc * 32 + 8 * fq;
#pragma unroll
    for (int ai = 0; ai < 2; ++ai)
#pragma unroll
      for (int m = 0; m < 4; ++m) {
        const int row = row0 + ai * 128 + m * 16;
#pragma unroll
        for (int bj = 0; bj < 2; ++bj) {
          const f32x4 a = acc[ai][bj][m][0], b = acc[ai][bj][m][1];
          if (u.pn == 0) { float* lp = LG + (size_t)row * 256 + cl + bj * 128; *(f32x4*)lp = a; *(f32x4*)(lp + 4) = b; }
          else {
            const int ci = 256 * (u.pn - 1) + cl + bj * 128;
            st_bf4(AC + (size_t)row * DSH + (ci >> 1), silu_f(a[0]) * b[0], silu_f(a[1]) * b[1], silu_f(a[2]) * b[2], silu_f(a[3]) * b[3]);
          }
        }
      }
  }
};

template <class RM>
__device__ __forceinline__ void transpose_item(const float* W, int K, int N, bf16_t* WT, LAS float* scr, int item, int lane, const RM& rowmap) {
  const int nblk = N / 32, kb = item / nblk, nbk = item % nblk, k0 = 64 * kb, n0 = 32 * nbk;
#pragma unroll 8
  for (int i = 0; i < 32; ++i) { const int kk = 2 * i + (lane >> 5); scr[kk * 33 + (lane & 31)] = W[(size_t)(k0 + kk) * N + n0 + (lane & 31)]; }
  asm volatile("s_waitcnt lgkmcnt(0)" ::: "memory");
  const int c = lane & 7;
#pragma unroll
  for (int j = 0; j < 4; ++j) {
    const int n = (lane >> 3) + 8 * j; const LAS float* s = scr + (8 * c) * 33 + n;
    u32x4 o; o.x = pk2(s[0 * 33], s[1 * 33]); o.y = pk2(s[2 * 33], s[3 * 33]); o.z = pk2(s[4 * 33], s[5 * 33]); o.w = pk2(s[6 * 33], s[7 * 33]);
    *(u32x4*)(WT + (size_t)rowmap(n0 + n) * K + k0 + 8 * c) = o;
  }
  asm volatile("s_waitcnt lgkmcnt(0)" ::: "memory");
}
__device__ __forceinline__ int win_rowmap(int n) {
  if (n < COL_Q || n >= COL_V) return n;
  const int pos = n & 63; if (pos >= 16) return n;
  const int g = pos >> 2, g2 = (g == 1) ? 2 : (g == 2) ? 1 : g;
  return (n & ~63) + g2 * 4 + (pos & 3);
}
__device__ __forceinline__ void phase_prologue(const P& p, int bid, int nb, float* lds) {
  float* cact = lds;
  float* red = lds + 4096;
  const int tid = tidx();
  float* ada = (float*)(p.ws + WS_ADA);
  for (int i = tid; i < 4096; i += NT) cact[i] = silu_f(p.c[i]);
  __syncthreads();
  for (int cb = bid; cb < 256; cb += nb) {
    const int col = tid % 24, kg = tid / 24;
    if (kg < 21) {
      float a0 = 0.f, a1 = 0.f, a2 = 0.f, a3 = 0.f;
      for (int k = kg; k < 1024; k += 21) {
        const float w = p.w_ada[(size_t)k * 6144 + cb * 24 + col];
        a0 += cact[k] * w; a1 += cact[1024 + k] * w; a2 += cact[2048 + k] * w; a3 += cact[3072 + k] * w;
      }
      float* r = red + (kg * 24 + col) * 4; r[0] = a0; r[1] = a1; r[2] = a2; r[3] = a3;
    }
    __syncthreads();
    if (tid < 96) {
      const int cc = tid >> 2, b = tid & 3; float s = 0.f;
      for (int g = 0; g < 21; ++g) s += red[(g * 24 + cc) * 4 + b];
      ada[b * 6144 + cb * 24 + cc] = s + p.b_ada[cb * 24 + cc];
    }
    __syncthreads();
  }
  if (bid == 0 && tid == 0) {
    float s1 = 0.f, s2 = 0.f;
    for (int i = 0; i < 64; ++i) { s1 += p.lq1[i] * p.lk1[i]; s2 += p.lq2[i] * p.lk2[i]; }
    ((float*)(p.ws + WS_MISC))[0] = expf(s1) - expf(s2) + 0.2f;
  }
  float* ct = (float*)(p.ws + WS_COS); float* st = (float*)(p.ws + WS_SIN);
  for (int i = bid * NT + tid; i < T * 8; i += nb * NT) {
    const int t = i >> 3, f = i & 7;
    const float ang = (float)p.pos[t] * p.inv_freq[f];
    float s, c; sincosf(ang, &s, &c);
    ct[i] = c; st[i] = s;
  }
  const int lane = tid & 63, wave = tid >> 6;
  LAS float* scr = (LAS float*)lds + 8192 + wave * 2176;
  constexpr int I_IN = 16 * 96, I_OUT = 16 * 32, I_R = 16 * 8, I_G = 16 * 8, I_U = 16 * 8, I_D = 4 * 32;
  constexpr int NITEMS = I_IN + I_OUT + I_R + I_G + I_U + I_D;
  bf16_t* WIN = (bf16_t*)(p.ws + WS_WIN_T); bf16_t* WOUT = (bf16_t*)(p.ws + WS_WOUT_T); bf16_t* WRS = (bf16_t*)(p.ws + WS_WRS_T); bf16_t* WDS = (bf16_t*)(p.ws + WS_WDS_T);
  for (int it = bid * NW + wave; it < NITEMS; it += nb * NW) {
    int r = it;
    if (r < I_IN) { transpose_item(p.w_in, D, DPROJ, WIN, scr, r, lane, [](int n) { return win_rowmap(n); }); continue; } r -= I_IN;
    if (r < I_OUT) { transpose_item(p.w_out, D, D, WOUT, scr, r, lane, [](int n) { return n; }); continue; } r -= I_OUT;
    if (r < I_R) { transpose_item(p.w_router, D, 256, WRS, scr, r, lane, [](int n) { return n; }); continue; } r -= I_R;
    if (r < I_G) { transpose_item(p.wg_s, D, 256, WRS, scr, r, lane, [](int n) { return 256 + 8 * (n >> 2) + (n & 3); }); continue; } r -= I_G;
    if (r < I_U) { transpose_item(p.wu_s, D, 256, WRS, scr, r, lane, [](int n) { return 256 + 8 * (n >> 2) + 4 + (n & 3); }); continue; } r -= I_U;
    transpose_item(p.wd_s, DSH, D, WDS, scr, r, lane, [](int n) { return n; });
  }
}

__device__ __forceinline__ void phase_modnorm(const P& p, int bid, int nb, const float* in, const float* g, int sh_off, int sc_off, bf16_t* outp) {
  const int tid_ = tidx(), lane = tid_ & 63, wave = tid_ >> 6;
  const float* ada = (const float*)(p.ws + WS_ADA);
  for (int t = bid * NW + wave; t < T; t += nb * NW) {
    const int b = t / SEQ;
    const float4* xr = (const float4*)(in + (size_t)t * D) + lane;
    float4 v[4]; float s = 0.f;
#pragma unroll
    for (int j = 0; j < 4; ++j) { v[j] = xr[64 * j]; s += v[j].x * v[j].x + v[j].y * v[j].y + v[j].z * v[j].z + v[j].w * v[j].w; }
    s = wave_sum(s);
    const float rstd = 1.0f / sqrtf(s * (1.0f / D) + 1e-6f);
#pragma unroll
    for (int j = 0; j < 4; ++j) {
      const int c0 = lane * 4 + 256 * j;
      const float4 gg = *(const float4*)(g + c0);
      const float4 sc = *(const float4*)(ada + b * 6144 + sc_off + c0);
      const float4 sh = *(const float4*)(ada + b * 6144 + sh_off + c0);
      st_bf4(outp + (size_t)t * D + c0, v[j].x * rstd * gg.x * (1.f + sc.x) + sh.x, v[j].y * rstd * gg.y * (1.f + sc.y) + sh.y,
             v[j].z * rstd * gg.z * (1.f + sc.z) + sh.z, v[j].w * rstd * gg.w * (1.f + sc.w) + sh.w);
    }
  }
}

template <bool DUAL, class AF, class EF>
__device__ __forceinline__ void gemm_tile_naive(const AF& af, int mcount, const float* __restrict__ B0, const float* __restrict__ B1, int ldb, int n0, int K, const EF& ef, float* lds) {
  float* As = lds; float* Bs0 = lds + 16 * 132; float* Bs1 = Bs0 + 16 * 64;
  const int tid = tidx(), ty = tid >> 4, tx = tid & 15;
  float acc0[4][4], acc1[4][4];
#pragma unroll
  for (int i = 0; i < 4; ++i)
#pragma unroll
    for (int j = 0; j < 4; ++j) { acc0[i][j] = 0.f; acc1[i][j] = 0.f; }
  const int ar = tid >> 2, akq = (tid & 3) * 4;
  const bool avalid = ar < mcount;
  const int bt = tid & 255, bk = bt >> 4, bc = (bt & 15) * 4;
  const float* bsrc = (tid < 256) ? B0 : B1;
  float* bdst = (tid < 256) ? Bs0 : Bs1;
  for (int k0 = 0; k0 < K; k0 += 16) {
    float4 av = make_float4(0.f, 0.f, 0.f, 0.f);
    if (avalid) av = af(ar, k0 + akq);
    As[(akq + 0) * 132 + ar] = av.x; As[(akq + 1) * 132 + ar] = av.y; As[(akq + 2) * 132 + ar] = av.z; As[(akq + 3) * 132 + ar] = av.w;
    if (DUAL || tid < 256) {
      const float4 bv = *(const float4*)(bsrc + (size_t)(k0 + bk) * ldb + n0 + bc);
      *(float4*)(bdst + bk * 64 + bc) = bv;
    }
    __syncthreads();
#pragma unroll
    for (int kk = 0; kk < 16; ++kk) {
      const float4 a = *(const float4*)(As + kk * 132 + ty * 4);
      const float4 b = *(const float4*)(Bs0 + kk * 64 + tx * 4);
      const float aa[4] = {a.x, a.y, a.z, a.w}; const float bb[4] = {b.x, b.y, b.z, b.w};
#pragma unroll
      for (int i = 0; i < 4; ++i)
#pragma unroll
        for (int j = 0; j < 4; ++j) acc0[i][j] += aa[i] * bb[j];
      if (DUAL) {
        const float4 b1 = *(const float4*)(Bs1 + kk * 64 + tx * 4);
        const float cc[4] = {b1.x, b1.y, b1.z, b1.w};
#pragma unroll
        for (int i = 0; i < 4; ++i)
#pragma unroll
          for (int j = 0; j < 4; ++j) acc1[i][j] += aa[i] * cc[j];
      }
    }
    __syncthreads();
  }
#pragma unroll
  for (int i = 0; i < 4; ++i)
    if (ty * 4 + i < mcount) {
#pragma unroll
      for (int j = 0; j < 4; ++j) ef(ty * 4 + i, n0 + tx * 4 + j, acc0[i][j], acc1[i][j]);
    }
}

__device__ __forceinline__ void phase_attn_naive(const P& p, int bid, int nb) {
  const bf16_t* PR = (const bf16_t*)(p.ws + WS_PROJB); float* AO = (float*)(p.ws + WS_AO);
  const int tid_ = tidx(), lane = tid_ & 63, wave = tid_ >> 6;
  for (int it0 = bid * NW + wave; it0 < 4096; it0 += nb * NW) {
    const int it = __builtin_amdgcn_readfirstlane(it0);
    const int qc = 63 - (it >> 6), rest = it & 63, vh = rest & 1, bh = rest >> 1, b = bh >> 3, hc = bh & 7, h = hc >> 1;
    const int qi = qc * 64 + lane;
    const bf16_t* qp = PR + (size_t)(b * SEQ + qi) * DPROJ + COL_Q + hc * 64;
    float q[64], o[64];
#pragma unroll
    for (int d = 0; d < 64; d += 4) { const float4 v = ld_bf4(qp + d); q[d] = v.x; q[d + 1] = v.y; q[d + 2] = v.z; q[d + 3] = v.w; }
#pragma unroll
    for (int d = 0; d < 64; ++d) o[d] = 0.f;
    float m = -INFINITY, l = 0.f;
    const bf16_t* kbase = PR + (size_t)(b * SEQ) * DPROJ + COL_K + hc * 64;
    const bf16_t* vbase = PR + (size_t)(b * SEQ) * DPROJ + COL_V + h * 128 + vh * 64;
    const int jmax = qc * 64 + 63;
    for (int j = 0; j <= jmax; ++j) {
      const bf16_t* kr = kbase + (size_t)j * DPROJ; const bf16_t* vr = vbase + (size_t)j * DPROJ;
      float s = 0.f;
#pragma unroll
      for (int d = 0; d < 64; d += 4) { const float4 kv = ld_bf4(kr + d); s += q[d] * kv.x; s += q[d + 1] * kv.y; s += q[d + 2] * kv.z; s += q[d + 3] * kv.w; }
      if (j <= qi) {
        const float mn = fmaxf(m, s), a = exp2f(m - mn), pp = exp2f(s - mn);
        l = l * a + pp;
#pragma unroll
        for (int d = 0; d < 64; d += 4) { const float4 vv = ld_bf4(vr + d); o[d] = o[d] * a + pp * vv.x; o[d + 1] = o[d + 1] * a + pp * vv.y; o[d + 2] = o[d + 2] * a + pp * vv.z; o[d + 3] = o[d + 3] * a + pp * vv.w; }
        m = mn;
      }
    }
    const float inv = 1.0f / l;
    float* op = AO + (size_t)(b * SEQ + qi) * 1024 + hc * 128 + vh * 64;
#pragma unroll
    for (int d = 0; d < 64; d += 4) *(float4*)(op + d) = make_float4(o[d] * inv, o[d + 1] * inv, o[d + 2] * inv, o[d + 3] * inv);
  }
}

__device__ __forceinline__ void phase_mix(const P& p, int bid, int nb) {
  const bf16_t* PR = (const bf16_t*)(p.ws + WS_PROJB); const float* AO = (const float*)(p.ws + WS_AO); bf16_t* MIX = (bf16_t*)(p.ws + WS_HNB);
  const float lam = ((const float*)(p.ws + WS_MISC))[0];
  const int tid_ = tidx(), lane = tid_ & 63, wave = tid_ >> 6;
  for (int t = bid * NW + wave; t < T; t += nb * NW) {
    const int s = t % SEQ;
    const bf16_t* r0 = PR + (size_t)t * DPROJ;
    float vals[8]; float ss = 0.f;
#pragma unroll
    for (int j = 0; j < 2; ++j) {
      const int ch = lane * 4 + 256 * j;
      const float4 h0 = ld_bf4(r0 + COL_H + ch), c0 = ld_bf4(r0 + COL_C + ch), bg = ld_bf4(r0 + COL_B + ch);
      float4 h1 = make_float4(0, 0, 0, 0), c1 = h1, h2 = h1, c2 = h1;
      if (s >= 1) { h1 = ld_bf4(r0 - DPROJ + COL_H + ch); c1 = ld_bf4(r0 - DPROJ + COL_C + ch); }
      if (s >= 2) { h2 = ld_bf4(r0 - 2 * DPROJ + COL_H + ch); c2 = ld_bf4(r0 - 2 * DPROJ + COL_C + ch); }
      const float4 w0 = *(const float4*)(p.conv_w + ch), w1 = *(const float4*)(p.conv_w + 512 + ch), w2 = *(const float4*)(p.conv_w + 1024 + ch);
      float y;
      y = w0.x * (c2.x * h2.x) + w1.x * (c1.x * h1.x) + w2.x * (c0.x * h0.x); vals[4 * j + 0] = bg.x * y;
      y = w0.y * (c2.y * h2.y) + w1.y * (c1.y * h1.y) + w2.y * (c0.y * h0.y); vals[4 * j + 1] = bg.y * y;
      y = w0.z * (c2.z * h2.z) + w1.z * (c1.z * h1.z) + w2.z * (c0.z * h0.z); vals[4 * j + 2] = bg.z * y;
      y = w0.w * (c2.w * h2.w) + w1.w * (c1.w * h1.w) + w2.w * (c0.w * h0.w); vals[4 * j + 3] = bg.w * y;
#pragma unroll
      for (int i = 0; i < 4; ++i) ss += vals[4 * j + i] * vals[4 * j + i];
    }
    ss = wave_sum(ss);
    const float rstd = 1.0f / sqrtf(ss * (1.0f / 512.f) + 1e-6f);
    bf16_t* mo = MIX + (size_t)t * D;
#pragma unroll
    for (int j = 0; j < 2; ++j) {
      const int ch = lane * 4 + 256 * j;
      const float4 gg = *(const float4*)(p.g_conv + ch);
      st_bf4(mo + ch, vals[4 * j] * rstd * gg.x, vals[4 * j + 1] * rstd * gg.y, vals[4 * j + 2] * rstd * gg.z, vals[4 * j + 3] * rstd * gg.w);
    }
    const float* ao = AO + (size_t)t * 1024;
#pragma unroll
    for (int j = 0; j < 2; ++j) {
      const int idx = lane * 4 + 256 * j, h = idx >> 7, d = idx & 127;
      const float4 o0 = *(const float4*)(ao + (2 * h) * 128 + d), o1 = *(const float4*)(ao + (2 * h + 1) * 128 + d);
      float dv[4] = {o0.x - lam * o1.x, o0.y - lam * o1.y, o0.z - lam * o1.z, o0.w - lam * o1.w};
      float q = dv[0] * dv[0] + dv[1] * dv[1] + dv[2] * dv[2] + dv[3] * dv[3];
#pragma unroll
      for (int o = 1; o < 32; o <<= 1) q += __shfl_xor(q, o);
      const float r2 = 1.0f / sqrtf(q * (1.0f / 128.f) + 1e-5f);
      const float4 gg = *(const float4*)(p.g_subln + d);
      st_bf4(mo + 512 + idx, dv[0] * r2 * gg.x * 0.8f, dv[1] * r2 * gg.y * 0.8f, dv[2] * r2 * gg.z * 0.8f, dv[3] * r2 * gg.w * 0.8f);
    }
  }
}

__device__ __forceinline__ void phase_route(const P& p, int bid, int nb, const float* LG) {
  int* IDX = (int*)(p.ws + WS_IDX); float* WTS = (float*)(p.ws + WS_WTS); int* LIST = (int*)(p.ws + WS_LIST); int* cnt = (int*)(p.ws + WS_CTL);
  const int tid_ = tidx(), lane = tid_ & 63, wave = tid_ >> 6;
  for (int t = bid * NW + wave; t < T; t += nb * NW) {
    const float4 lg = *(const float4*)(LG + (size_t)t * 256 + lane * 4);
    const float4 bs = *(const float4*)(p.rbias + lane * 4);
    float sc[4], cv[4];
    sc[0] = 1.f / (1.f + expf(-lg.x)); sc[1] = 1.f / (1.f + expf(-lg.y)); sc[2] = 1.f / (1.f + expf(-lg.z)); sc[3] = 1.f / (1.f + expf(-lg.w));
    cv[0] = sc[0] + bs.x; cv[1] = sc[1] + bs.y; cv[2] = sc[2] + bs.z; cv[3] = sc[3] + bs.w;
    float m1 = -INFINITY, m2 = -INFINITY;
#pragma unroll
    for (int i = 0; i < 4; ++i) { const float v = cv[i]; if (v > m1) { m2 = m1; m1 = v; } else if (v > m2) m2 = v; }
#pragma unroll
    for (int off = 1; off < 8; off <<= 1) {
      const float o1 = __shfl_xor(m1, off), o2 = __shfl_xor(m2, off);
      const float n1 = fmaxf(m1, o1), n2 = fmaxf(fminf(m1, o1), fmaxf(m2, o2));
      m1 = n1; m2 = n2;
    }
    const float gs = m1 + m2; const int g = lane >> 3; int rank = 0;
#pragma unroll
    for (int gg = 0; gg < 8; ++gg) { const float og = __shfl(gs, gg * 8); rank += (og > gs || (og == gs && gg < g)) ? 1 : 0; }
    const bool sel = rank < 4;
#pragma unroll
    for (int i = 0; i < 4; ++i) cv[i] = sel ? cv[i] : -INFINITY;
    int my_e = 0; float my_w = 0.f;
#pragma unroll
    for (int k = 0; k < 8; ++k) {
      float bv = cv[0]; int bi = 0;
#pragma unroll
      for (int i = 1; i < 4; ++i) if (cv[i] > bv) { bv = cv[i]; bi = i; }
      int gi = lane * 4 + bi;
#pragma unroll
      for (int off = 32; off >= 1; off >>= 1) {
        const float ov = __shfl_xor(bv, off); const int oi = __shfl_xor(gi, off);
        if (ov > bv || (ov == bv && oi < gi)) { bv = ov; gi = oi; }
      }
      const int sub = gi & 3, own = gi >> 2;
      const float mine = sub == 0 ? sc[0] : sub == 1 ? sc[1] : sub == 2 ? sc[2] : sc[3];
      const float wv = __shfl(mine, own);
      if (lane == own) {
#pragma unroll
        for (int i = 0; i < 4; ++i) if (sub == i) cv[i] = -INFINITY;
      }
      if (lane == k) { my_e = gi; my_w = wv; }
    }
    float sum = (lane < 8) ? my_w : 0.f;
    sum += __shfl_xor(sum, 1); sum += __shfl_xor(sum, 2); sum += __shfl_xor(sum, 4);
    if (lane < 8) {
      const float w = my_w / (sum + 1e-20f) * 2.5f;
      IDX[t * 8 + lane] = my_e; WTS[t * 8 + lane] = w;
      const int pos = atomicAdd(&cnt[my_e], 1);
      LIST[(size_t)my_e * LISTCAP + pos] = t * 8 + lane;
    }
  }
}

__device__ __forceinline__ void phase_exp1(const P& p, int bid, int nb, float* lds) {
  const bf16_t* HN = (const bf16_t*)(p.ws + WS_HNB); float* H = (float*)(p.ws + WS_H);
  const int* LIST = (const int*)(p.ws + WS_LIST); const int* cnt = (const int*)(p.ws + WS_CTL);
  for (int it = bid; it < NE * 128 * 4; it += nb) {
    const int e = it >> 9, mt = (it >> 2) & 127, nt = it & 3;
    const int c = cnt[e]; if (mt * 128 >= c) continue;
    const int mcount = min(128, c - mt * 128);
    const int* lst = LIST + (size_t)e * LISTCAP + mt * 128;
    auto af = [&](int r, int k) { return ld_bf4(HN + (size_t)(lst[r] >> 3) * D + k); };
    auto ef = [&](int r, int col, float g, float u) { H[(size_t)lst[r] * DE + col] = silu_f(g) * u; };
    gemm_tile_naive<true>(af, mcount, p.wg_e + (size_t)e * D * DE, p.wu_e + (size_t)e * D * DE, DE, nt * 64, D, ef, lds);
  }
}
__device__ __forceinline__ void phase_exp2(const P& p, int bid, int nb, float* lds) {
  const float* H = (const float*)(p.ws + WS_H); float* SL = (float*)(p.ws + WS_SLAB); const float* WTS = (const float*)(p.ws + WS_WTS);
  const int* LIST = (const int*)(p.ws + WS_LIST); const int* cnt = (const int*)(p.ws + WS_CTL);
  for (int it = bid; it < NE * 128 * 16; it += nb) {
    const int e = it >> 11, mt = (it >> 4) & 127, nt = it & 15;
    const int c = cnt[e]; if (mt * 128 >= c) continue;
    const int mcount = min(128, c - mt * 128);
    const int* lst = LIST + (size_t)e * LISTCAP + mt * 128;
    auto af = [&](int r, int k) { return *(const float4*)(H + (size_t)lst[r] * DE + k); };
    auto ef = [&](int r, int col, float v, float) { const int aid = lst[r]; SL[(size_t)aid * D + col] = v * WTS[aid]; };
    gemm_tile_naive<false>(af, mcount, p.wd_e + (size_t)e * DE * D, nullptr, D, nt * 64, DE, ef, lds);
  }
}

__device__ __forceinline__ void phase_final(const P& p, int bid, int nb) {
  const float* X1 = (const float*)(p.ws + WS_X1); const float* SL = (const float*)(p.ws + WS_SLAB); const float* ada = (const float*)(p.ws + WS_ADA);
  const int tid_ = tidx(), lane = tid_ & 63, wave = tid_ >> 6;
  for (int t = bid * NW + wave; t < T; t += nb * NW) {
    const int b = t / SEQ;
    float4 v[4]; float s = 0.f;
#pragma unroll
    for (int j = 0; j < 4; ++j) {
      const int c0 = lane * 4 + 256 * j;
      float4 y = make_float4(0, 0, 0, 0);
#pragma unroll
      for (int k = 0; k < 8; ++k) { const float4 z = *(const float4*)(SL + (size_t)(t * 8 + k) * D + c0); y.x += z.x; y.y += z.y; y.z += z.z; y.w += z.w; }
      const float4 gt = *(const float4*)(ada + b * 6144 + 5120 + c0);
      const float4 bx = *(const float4*)(X1 + (size_t)t * D + c0);
      v[j] = make_float4(bx.x + gt.x * y.x, bx.y + gt.y * y.y, bx.z + gt.z * y.z, bx.w + gt.w * y.w);
      s += v[j].x * v[j].x + v[j].y * v[j].y + v[j].z * v[j].z + v[j].w * v[j].w;
    }
    s = wave_sum(s);
    const float rstd = 1.0f / sqrtf(s * (1.0f / D) + 1e-6f);
#pragma unroll
    for (int j = 0; j < 4; ++j) {
      const int c0 = lane * 4 + 256 * j;
      const float4 gg = *(const float4*)(p.g_final + c0);
      *(float4*)(p.out + (size_t)t * D + c0) = make_float4(v[j].x * rstd * gg.x, v[j].y * rstd * gg.y, v[j].z * rstd * gg.z, v[j].w * rstd * gg.w);
    }
  }
}

#if DIAG_EXACT_ROUTING
namespace diag {
constexpr size_t DW_HN = 448 * MiB, DW_PROJ = 512 * MiB, DW_AO = 704 * MiB, DW_X1 = 768 * MiB, DW_LOGITS = 832 * MiB;
__device__ __forceinline__ void modnorm(const P& p, int bid, int nb, const float* in, const float* g, int sh_off, int sc_off, float* outp) {
  const int tid_ = tidx(), lane = tid_ & 63, wave = tid_ >> 6;
  const float* ada = (const float*)(p.ws + WS_ADA);
  for (int t = bid * NW + wave; t < T; t += nb * NW) {
    const int b = t / SEQ;
    const float4* xr = (const float4*)(in + (size_t)t * D) + lane;
    float4 v[4]; float s = 0.f;
#pragma unroll
    for (int j = 0; j < 4; ++j) { v[j] = xr[64 * j]; s += v[j].x * v[j].x + v[j].y * v[j].y + v[j].z * v[j].z + v[j].w * v[j].w; }
    s = wave_sum(s);
    const float rstd = 1.0f / sqrtf(s * (1.0f / D) + 1e-6f);
    float4* o = (float4*)(outp + (size_t)t * D) + lane;
#pragma unroll
    for (int j = 0; j < 4; ++j) {
      const int c0 = lane * 4 + 256 * j;
      const float4 gg = *(const float4*)(g + c0);
      const float4 sc = *(const float4*)(ada + b * 6144 + sc_off + c0);
      const float4 sh = *(const float4*)(ada + b * 6144 + sh_off + c0);
      float4 r;
      r.x = v[j].x * rstd * gg.x * (1.f + sc.x) + sh.x; r.y = v[j].y * rstd * gg.y * (1.f + sc.y) + sh.y;
      r.z = v[j].z * rstd * gg.z * (1.f + sc.z) + sh.z; r.w = v[j].w * rstd * gg.w * (1.f + sc.w) + sh.w;
      o[64 * j] = r;
    }
  }
}
__device__ __forceinline__ void inproj(const P& p, int bid, int nb, float* lds) {
  const float* HN = (const float*)(p.ws + DW_HN); float* PR = (float*)(p.ws + DW_PROJ);
  for (int it = bid; it < (T / 128) * (DPROJ / 64); it += nb) {
    const int mt = it / (DPROJ / 64), nt = it % (DPROJ / 64), m0 = mt * 128;
    auto af = [&](int r, int k) { return *(const float4*)(HN + (size_t)(m0 + r) * D + k); };
    auto ef = [&](int r, int col, float v, float) { PR[(size_t)(m0 + r) * DPROJ + col] = v; };
    gemm_tile_naive<false>(af, 128, p.w_in, nullptr, DPROJ, nt * 64, D, ef, lds);
  }
}
__device__ __forceinline__ void rope(const P& p, int bid, int nb) {
  float* PR = (float*)(p.ws + DW_PROJ);
  const float* ct = (const float*)(p.ws + WS_COS); const float* st = (const float*)(p.ws + WS_SIN);
  for (int i = bid * NT + tidx(); i < T * 128; i += nb * NT) {
    const int t = i >> 7, r = i & 127, which = r >> 6, hc = (r >> 3) & 7, f = r & 7;
    float* base = PR + (size_t)t * DPROJ + (which ? COL_K : COL_Q) + hc * 64;
    const float t1 = base[f], t2 = base[8 + f], c = ct[t * 8 + f], s = st[t * 8 + f];
    base[f] = t1 * c - t2 * s; base[8 + f] = t2 * c + t1 * s;
  }
}
__device__ __forceinline__ void attn(const P& p, int bid, int nb) {
  const float* PR = (const float*)(p.ws + DW_PROJ); float* AO = (float*)(p.ws + DW_AO);
  const int tid_ = tidx(), lane = tid_ & 63, wave = tid_ >> 6;
  for (int it0 = bid * NW + wave; it0 < 4096; it0 += nb * NW) {
    const int it = __builtin_amdgcn_readfirstlane(it0);
    const int qc = 63 - (it >> 6), rest = it & 63, vh = rest & 1, bh = rest >> 1, b = bh >> 3, hc = bh & 7, h = hc >> 1;
    const int qi = qc * 64 + lane;
    const float* qp = PR + (size_t)(b * SEQ + qi) * DPROJ + COL_Q + hc * 64;
    float q[64], o[64];
#pragma unroll
    for (int d = 0; d < 64; d += 4) { const float4 v = *(const float4*)(qp + d); q[d] = v.x * 0.125f; q[d + 1] = v.y * 0.125f; q[d + 2] = v.z * 0.125f; q[d + 3] = v.w * 0.125f; }
#pragma unroll
    for (int d = 0; d < 64; ++d) o[d] = 0.f;
    float m = -INFINITY, l = 0.f;
    const float* kbase = PR + (size_t)(b * SEQ) * DPROJ + COL_K + hc * 64;
    const float* vbase = PR + (size_t)(b * SEQ) * DPROJ + COL_V + h * 128 + vh * 64;
    const int jmax = qc * 64 + 63;
    for (int j = 0; j <= jmax; ++j) {
      const float* kr = kbase + (size_t)j * DPROJ; const float* vr = vbase + (size_t)j * DPROJ;
      float s = 0.f;
#pragma unroll
      for (int d = 0; d < 64; d += 4) { const float4 kv = *(const float4*)(kr + d); s += q[d] * kv.x; s += q[d + 1] * kv.y; s += q[d + 2] * kv.z; s += q[d + 3] * kv.w; }
      if (j <= qi) {
        const float mn = fmaxf(m, s), a = expf(m - mn), pp = expf(s - mn);
        l = l * a + pp;
#pragma unroll
        for (int d = 0; d < 64; d += 4) { const float4 vv = *(const float4*)(vr + d); o[d] = o[d] * a + pp * vv.x; o[d + 1] = o[d + 1] * a + pp * vv.y; o[d + 2] = o[d + 2] * a + pp * vv.z; o[d + 3] = o[d + 3] * a + pp * vv.w; }
        m = mn;
      }
    }
    const float inv = 1.0f / l;
    float* op = AO + (size_t)(b * SEQ + qi) * 1024 + hc * 128 + vh * 64;
#pragma unroll
    for (int d = 0; d < 64; d += 4) *(float4*)(op + d) = make_float4(o[d] * inv, o[d + 1] * inv, o[d + 2] * inv, o[d + 3] * inv);
  }
}
__device__ __forceinline__ void mix(const P& p, int bid, int nb) {
  const float* PR = (const float*)(p.ws + DW_PROJ); const float* AO = (const float*)(p.ws + DW_AO); float* MIX = (float*)(p.ws + DW_HN);
  const float lam = ((const float*)(p.ws + WS_MISC))[0];
  const int tid_ = tidx(), lane = tid_ & 63, wave = tid_ >> 6;
  for (int t = bid * NW + wave; t < T; t += nb * NW) {
    const int s = t % SEQ;
    const float* r0 = PR + (size_t)t * DPROJ;
    float vals[8]; float ss = 0.f;
#pragma unroll
    for (int j = 0; j < 2; ++j) {
      const int ch = lane * 4 + 256 * j;
      const float4 h0 = *(const float4*)(r0 + COL_H + ch), c0 = *(const float4*)(r0 + COL_C + ch), bg = *(const float4*)(r0 + COL_B + ch);
      float4 h1 = make_float4(0, 0, 0, 0), c1 = h1, h2 = h1, c2 = h1;
      if (s >= 1) { h1 = *(const float4*)(r0 - DPROJ + COL_H + ch); c1 = *(const float4*)(r0 - DPROJ + COL_C + ch); }
      if (s >= 2) { h2 = *(const float4*)(r0 - 2 * DPROJ + COL_H + ch); c2 = *(const float4*)(r0 - 2 * DPROJ + COL_C + ch); }
      const float4 w0 = *(const float4*)(p.conv_w + ch), w1 = *(const float4*)(p.conv_w + 512 + ch), w2 = *(const float4*)(p.conv_w + 1024 + ch);
      float y;
      y = w0.x * (c2.x * h2.x) + w1.x * (c1.x * h1.x) + w2.x * (c0.x * h0.x); vals[4 * j + 0] = bg.x * y;
      y = w0.y * (c2.y * h2.y) + w1.y * (c1.y * h1.y) + w2.y * (c0.y * h0.y); vals[4 * j + 1] = bg.y * y;
      y = w0.z * (c2.z * h2.z) + w1.z * (c1.z * h1.z) + w2.z * (c0.z * h0.z); vals[4 * j + 2] = bg.z * y;
      y = w0.w * (c2.w * h2.w) + w1.w * (c1.w * h1.w) + w2.w * (c0.w * h0.w); vals[4 * j + 3] = bg.w * y;
#pragma unroll
      for (int i = 0; i < 4; ++i) ss += vals[4 * j + i] * vals[4 * j + i];
    }
    ss = wave_sum(ss);
    const float rstd = 1.0f / sqrtf(ss * (1.0f / 512.f) + 1e-6f);
    float* mo = MIX + (size_t)t * D;
#pragma unroll
    for (int j = 0; j < 2; ++j) {
      const int ch = lane * 4 + 256 * j;
      const float4 gg = *(const float4*)(p.g_conv + ch);
      *(float4*)(mo + ch) = make_float4(vals[4 * j] * rstd * gg.x, vals[4 * j + 1] * rstd * gg.y, vals[4 * j + 2] * rstd * gg.z, vals[4 * j + 3] * rstd * gg.w);
    }
    const float* ao = AO + (size_t)t * 1024;
#pragma unroll
    for (int j = 0; j < 2; ++j) {
      const int idx = lane * 4 + 256 * j, h = idx >> 7, d = idx & 127;
      const float4 o0 = *(const float4*)(ao + (2 * h) * 128 + d), o1 = *(const float4*)(ao + (2 * h + 1) * 128 + d);
      float dv[4] = {o0.x - lam * o1.x, o0.y - lam * o1.y, o0.z - lam * o1.z, o0.w - lam * o1.w};
      float q = dv[0] * dv[0] + dv[1] * dv[1] + dv[2] * dv[2] + dv[3] * dv[3];
#pragma unroll
      for (int o = 1; o < 32; o <<= 1) q += __shfl_xor(q, o);
      const float r2 = 1.0f / sqrtf(q * (1.0f / 128.f) + 1e-5f);
      const float4 gg = *(const float4*)(p.g_subln + d);
      *(float4*)(mo + 512 + idx) = make_float4(dv[0] * r2 * gg.x * 0.8f, dv[1] * r2 * gg.y * 0.8f, dv[2] * r2 * gg.z * 0.8f, dv[3] * r2 * gg.w * 0.8f);
    }
  }
}
__device__ __forceinline__ void outproj(const P& p, int bid, int nb, float* lds) {
  const float* MIX = (const float*)(p.ws + DW_HN); float* X1 = (float*)(p.ws + DW_X1); const float* ada = (const float*)(p.ws + WS_ADA);
  for (int it = bid; it < (T / 128) * (D / 64); it += nb) {
    const int mt = it / (D / 64), nt = it % (D / 64), m0 = mt * 128, b = m0 / SEQ;
    auto af = [&](int r, int k) { return *(const float4*)(MIX + (size_t)(m0 + r) * D + k); };
    auto ef = [&](int r, int col, float v, float) { const size_t o = (size_t)(m0 + r) * D + col; X1[o] = p.x[o] + ada[b * 6144 + 2048 + col] * v; };
    gemm_tile_naive<false>(af, 128, p.w_out, nullptr, D, nt * 64, D, ef, lds);
  }
}
__device__ __forceinline__ void router(const P& p, int bid, int nb, float* lds) {
  const float* HN = (const float*)(p.ws + DW_HN); float* LG = (float*)(p.ws + DW_LOGITS);
  for (int it = bid; it < (T / 128) * 4; it += nb) {
    const int mt = it >> 2, r4 = it & 3, m0 = mt * 128;
    auto af = [&](int r, int k) { return *(const float4*)(HN + (size_t)(m0 + r) * D + k); };
    auto ef = [&](int r, int col, float v, float) { LG[(size_t)(m0 + r) * 256 + col] = v; };
    gemm_tile_naive<false>(af, 128, p.w_router, nullptr, 256, r4 * 64, D, ef, lds);
  }
}
}
#endif

namespace att {
typedef short bf16x8 __attribute__((ext_vector_type(8)));
typedef short s16x4 __attribute__((ext_vector_type(4)));
typedef float f32x16 __attribute__((ext_vector_type(16)));
typedef float f32x2_t __attribute__((ext_vector_type(2)));
typedef __bf16 bf16x2_t __attribute__((ext_vector_type(2)));
constexpr int KSLOT = 8192, VSLOT = 16384;
constexpr int L_K = 0, L_V = 2 * KSLOT, L_WS = L_V + 2 * VSLOT, L_END = L_WS + 8 * 64 * 4;
constexpr float THR = 8.0f;
__device__ __forceinline__ int crow(int r, int hi) { return (r & 3) + 8 * (r >> 2) + 4 * hi; }
__device__ __forceinline__ unsigned cvtpk(float lo, float hi) { f32x2_t v = {lo, hi}; bf16x2_t b = __builtin_convertvector(v, bf16x2_t); return __builtin_bit_cast(unsigned, b); }
__device__ __forceinline__ s16x4 vtr(const LAS unsigned char* p) { typedef short v4i16_t __attribute__((ext_vector_type(4))); return __builtin_bit_cast(s16x4, __builtin_amdgcn_ds_read_tr16_b64_v4i16((LAS v4i16_t*)p)); }
__device__ __forceinline__ bf16x8 pack8(const f32x16& x, int s) {
  u32x4 w; w.x = cvtpk(x[8 * s], x[8 * s + 1]); w.y = cvtpk(x[8 * s + 2], x[8 * s + 3]); w.z = cvtpk(x[8 * s + 4], x[8 * s + 5]); w.w = cvtpk(x[8 * s + 6], x[8 * s + 7]);
  return __builtin_bit_cast(bf16x8, w);
}

__device__ __forceinline__ void attn_unit(const P& p, int b, int hc, int qb, LAS unsigned char* lds) {
  const int tid = tidx(), lane = tid & 63, r32 = lane & 31, hi = lane >> 5; const int wid = __builtin_amdgcn_readfirstlane(tid >> 6);
  const bf16_t* PR = (const bf16_t*)(p.ws + WS_PROJB); float* AO = (float*)(p.ws + WS_AO);
  const int h = hc >> 1; const size_t rowbase = (size_t)b * SEQ; const int q0w = qb * 256 + wid * 32;
  bf16x8 qr[4];
  { const bf16_t* Qw = PR + (rowbase + q0w + r32) * DPROJ + COL_Q + hc * 64 + hi * 8;
#pragma unroll
    for (int d0 = 0; d0 < 4; ++d0) qr[d0] = *(const bf16x8*)(Qw + d0 * 16); }
  const bf16_t* ksrc = PR + (rowbase + lane) * DPROJ + COL_K + hc * 64 + wid * 8;
  const bf16_t* vsrc = PR + (rowbase + 16 * (wid & 3) + (lane >> 2)) * DPROJ + COL_V + h * 128 + (wid >> 2) * 32 + (lane & 3) * 8;
  LAS unsigned char* kdst = lds + L_K + wid * 1024 + lane * 16;
  LAS unsigned char* vdst = lds + L_V + wid * 1024 + lane * 16;
  LAS float* wsf = (LAS float*)(lds + L_WS) + wid * 64;
  const int NTL = 4 * qb + 4, tl = 4 * qb + (wid >> 1);
  const size_t tstep = (size_t)64 * DPROJ;
  float mhat = 0.f, l = 0.f; f32x16 o[4], negm;
#pragma unroll
  for (int i = 0; i < 16; ++i) { o[0][i] = 0.f; o[1][i] = 0.f; o[2][i] = 0.f; o[3][i] = 0.f; negm[i] = 0.f; }
  u32x4 kreg = *(const u32x4*)ksrc, v0reg = *(const u32x4*)vsrc, v1reg = *(const u32x4*)(vsrc + 64);
  *(LAS u32x4*)kdst = kreg; *(LAS u32x4*)vdst = v0reg; *(LAS u32x4*)(vdst + 8192) = v1reg;
  __syncthreads();
  const int vlane = ((lane >> 4) & 1) * 32 + (lane & 3) * 8 + (4 * hi + ((lane & 15) >> 2)) * 64;
  for (int t = 0; t < NTL; ++t) {
    const int cur = t & 1;
    if (t + 1 < NTL) { const size_t off = (size_t)(t + 1) * tstep; kreg = *(const u32x4*)(ksrc + off); v0reg = *(const u32x4*)(vsrc + off); v1reg = *(const u32x4*)(vsrc + off + 64); }
    if (t <= tl) {
      const LAS unsigned char* kb = lds + L_K + cur * KSLOT + hi * 1024 + r32 * 16;
      f32x16 p0 = negm, p1 = negm;
#pragma unroll
      for (int d0 = 0; d0 < 4; ++d0) {
        const bf16x8 b0 = *(const LAS bf16x8*)(kb + d0 * 2048), b1 = *(const LAS bf16x8*)(kb + d0 * 2048 + 512);
        p0 = __builtin_amdgcn_mfma_f32_32x32x16_bf16(b0, qr[d0], p0, 0, 0, 0);
        p1 = __builtin_amdgcn_mfma_f32_32x32x16_bf16(b1, qr[d0], p1, 0, 0, 0);
      }
      if (t == tl) {
        const int lim = 32 * (wid & 1) + r32;
#pragma unroll
        for (int r = 0; r < 16; ++r) { const int kk = crow(r, hi); if (kk > lim) p0[r] = -INFINITY; if (kk + 32 > lim) p1[r] = -INFINITY; }
      }
      float rm = fmaxf(p0[0], p1[0]);
#pragma unroll
      for (int r = 1; r < 16; ++r) rm = fmaxf(rm, fmaxf(p0[r], p1[r]));
      rm = fmaxf(rm, __shfl_xor(rm, 32));
      const bool first = (t == 0);
      if (first || __any(rm > THR)) {
        const float dl = first ? rm : fmaxf(rm, 0.f);
        mhat += dl;
#pragma unroll
        for (int r = 0; r < 16; ++r) { p0[r] -= dl; p1[r] -= dl; negm[r] = -mhat; }
        if (!first) {
          const float f = __builtin_amdgcn_exp2f(-dl);
          l *= f;
          if (hi == 0) wsf[r32] = f;
          asm volatile("s_waitcnt lgkmcnt(0)" ::: "memory");
          float fr[16];
#pragma unroll
          for (int r = 0; r < 16; ++r) fr[r] = wsf[crow(r, hi)];
#pragma unroll
          for (int d0 = 0; d0 < 4; ++d0)
#pragma unroll
            for (int r = 0; r < 16; ++r) o[d0][r] *= fr[r];
          asm volatile("s_waitcnt lgkmcnt(0)" ::: "memory");
        }
      }
      float sacc = 0.f;
#pragma unroll
      for (int r = 0; r < 16; ++r) { p0[r] = __builtin_amdgcn_exp2f(p0[r]); p1[r] = __builtin_amdgcn_exp2f(p1[r]); sacc += p0[r] + p1[r]; }
      l += sacc;
      bf16x8 pa[4]; pa[0] = pack8(p0, 0); pa[1] = pack8(p0, 1); pa[2] = pack8(p1, 0); pa[3] = pack8(p1, 1);
      const LAS unsigned char* vb = lds + L_V + cur * VSLOT + vlane;
#pragma unroll
      for (int d0 = 0; d0 < 4; ++d0)
#pragma unroll
        for (int ks = 0; ks < 4; ++ks) {
          const s16x4 lo = vtr(vb + d0 * 4096 + ks * 1024), hh = vtr(vb + d0 * 4096 + ks * 1024 + 512);
          const bf16x8 vf = {lo[0], lo[1], lo[2], lo[3], hh[0], hh[1], hh[2], hh[3]};
          o[d0] = __builtin_amdgcn_mfma_f32_32x32x16_bf16(pa[ks], vf, o[d0], 0, 0, 0);
        }
    }
    if (t + 1 < NTL) { const int nx = (cur ^ 1); *(LAS u32x4*)(kdst + nx * KSLOT) = kreg; *(LAS u32x4*)(vdst + nx * VSLOT) = v0reg; *(LAS u32x4*)(vdst + nx * VSLOT + 8192) = v1reg; }
    __syncthreads();
  }
  l += __shfl_xor(l, 32);
  if (hi == 0) wsf[32 + r32] = l;
  asm volatile("s_waitcnt lgkmcnt(0)" ::: "memory");
  float* Ow = AO + (rowbase + q0w) * 1024 + hc * 128 + r32;
#pragma unroll
  for (int r = 0; r < 16; ++r) {
    const int qq = crow(r, hi); const float rl = 1.0f / wsf[32 + qq];
#pragma unroll
    for (int d0 = 0; d0 < 4; ++d0) Ow[(size_t)qq * 1024 + d0 * 32] = o[d0][r] * rl;
  }
  asm volatile("s_waitcnt lgkmcnt(0)" ::: "memory");
}
}
__device__ __forceinline__ void phase_attn(const P& p, int bid, int nb, LAS unsigned char* lds) {
  const int vcu = (nb % 8 == 0) ? (bid % 8) * (nb / 8) + bid / 8 : bid;
  for (int v = vcu; v < 256; v += nb) {
    const int bh = v >> 3, s = v & 7;
    att::attn_unit(p, bh >> 3, bh & 7, 15 - s, lds);
    att::attn_unit(p, bh >> 3, bh & 7, s, lds);
  }
}

namespace moe {
typedef short bf16x8 __attribute__((ext_vector_type(8)));
typedef short s16x4 __attribute__((ext_vector_type(4)));
typedef float f32x16 __attribute__((ext_vector_type(16)));
typedef unsigned u32x2 __attribute__((ext_vector_type(2)));
constexpr int L_A = 0, L_B = 65536, L_ROWS = 131072, L_TS = 132096;
__device__ __forceinline__ s16x4 vtr(const LAS unsigned char* p) { typedef short v4i16_t __attribute__((ext_vector_type(4))); return __builtin_bit_cast(s16x4, __builtin_amdgcn_ds_read_tr16_b64_v4i16((LAS v4i16_t*)p)); }

template <int STAGE>
__device__ __forceinline__ void run(const P& p, int bid, int nb, LAS unsigned char* lds) {
  constexpr int NSUB = (STAGE == 1) ? 2 : 4, KTOT = (STAGE == 1) ? D : DE, NK = KTOT / 64, LDB = (STAGE == 1) ? DE : D;
  const int tid = tidx(), lane = tid & 63, r32 = lane & 31, hi = lane >> 5; const int wid = __builtin_amdgcn_readfirstlane(tid >> 6), wm = wid >> 2, wn = wid & 3;
  const int* cnt = (const int*)(p.ws + WS_CTL); const int* LIST = (const int*)(p.ws + WS_LIST);
  LAS int* rows = (LAS int*)(lds + L_ROWS); LAS int* ts = (LAS int*)(lds + L_TS);
  __syncthreads();
  if (tid < 256) rows[tid] = (cnt[tid] + 255) >> 8;
  __syncthreads();
  if (tid <= 256) { int a = 0; for (int i = 0; i < tid; ++i) a += rows[i]; ts[tid] = a; }
  __syncthreads();
  const int nitems = ts[256] * NSUB;
  const int vcu = (nb % 8 == 0) ? (bid % 8) * (nb / 8) + bid / 8 : bid;
  const bf16_t* Asrc = (STAGE == 1) ? (const bf16_t*)(p.ws + WS_HNB) : (const bf16_t*)(p.ws + WS_H);
  const int cgk = ((lane & 7) ^ (lane >> 3)) * 8;
  int abase[4];
#pragma unroll
  for (int k16 = 0; k16 < 4; ++k16) abase[k16] = (128 * wm + r32) * 128 + (((hi ^ (r32 & 7)) ^ (2 * k16)) * 16);
  const int bbase = (2 * wn) * 4096 + hi * 512 + ((lane & 15) >> 2) * 64 + ((lane >> 4) & 1) * 32 + (lane & 3) * 8;
  const int n32w = (STAGE == 1) ? (2 * ((lane & 31) >> 3) + (lane >> 5)) : (lane >> 3);
  const int bwoff = n32w * 4096 + wid * 512 + 8 * (lane & 7);

  for (int item = vcu; item < nitems; item += nb) {
    const int tile = item / NSUB, sub = item % NSUB;
    int lo = 0, hi_e = 256;
    while (hi_e - lo > 1) { const int mid = (lo + hi_e) >> 1; if (ts[mid] <= tile) lo = mid; else hi_e = mid; }
    const int e = lo, mt = tile - ts[e], mcount = min(256, cnt[e] - mt * 256);
    __syncthreads();
    if (tid < 256) rows[tid] = LIST[(size_t)e * LISTCAP + mt * 256 + min(tid, mcount - 1)];
    __syncthreads();
    unsigned aoff[4];
#pragma unroll
    for (int i = 0; i < 4; ++i) { const int aidr = rows[8 * (4 * wid + i) + (lane >> 3)]; aoff[i] = (STAGE == 1) ? (unsigned)(aidr >> 3) * D + cgk : (unsigned)aidr * DE + cgk; }
    const float* bsrc;
    if (STAGE == 1) bsrc = ((lane < 32) ? p.wg_e : p.wu_e) + (size_t)e * D * DE + 128 * sub + 4 * (lane & 31);
    else bsrc = p.wd_e + (size_t)e * DE * D + 256 * sub + 4 * lane;
    bsrc += (size_t)(8 * wid) * LDB;
    f32x16 acc[4][2];
#pragma unroll
    for (int m = 0; m < 4; ++m)
#pragma unroll
      for (int n = 0; n < 2; ++n)
#pragma unroll
        for (int r = 0; r < 16; ++r) acc[m][n][r] = 0.f;
    float4 breg[8];
#define MOE_ISSUE_A(s, buf) do { _Pragma("unroll") for (int i = 0; i < 4; ++i) \
      __builtin_amdgcn_global_load_lds((const unsigned*)(Asrc + aoff[i] + (s) * 64), (LAS unsigned*)(lds + L_A + (buf) * 32768 + (4 * wid + i) * 1024), 16, 0, 0); } while (0)
#define MOE_ISSUE_B(s) do { _Pragma("unroll") for (int i = 0; i < 8; ++i) breg[i] = *(const float4*)(bsrc + (size_t)((s) * 64 + i) * LDB); } while (0)
#define MOE_WRITE_B(buf) do { _Pragma("unroll") for (int i = 0; i < 8; ++i) \
      *(LAS u32x2*)(lds + L_B + (buf) * 32768 + bwoff + i * 64) = (u32x2){pk2(breg[i].x, breg[i].y), pk2(breg[i].z, breg[i].w)}; } while (0)
    MOE_ISSUE_A(0, 0); MOE_ISSUE_B(0); MOE_WRITE_B(0);
    asm volatile("s_waitcnt vmcnt(0)" ::: "memory");
    __syncthreads();
    for (int s = 0; s < NK; ++s) {
      const int cur = s & 1;
      if (s + 1 < NK) { MOE_ISSUE_A(s + 1, cur ^ 1); MOE_ISSUE_B(s + 1); }
      const LAS unsigned char* Ab = lds + L_A + cur * 32768; const LAS unsigned char* Bb = lds + L_B + cur * 32768 + bbase;
#pragma unroll
      for (int k16 = 0; k16 < 4; ++k16) {
        bf16x8 af[4], bfr[2];
#pragma unroll
        for (int m = 0; m < 4; ++m) af[m] = *(const LAS bf16x8*)(Ab + abase[k16] + m * 4096);
#pragma unroll
        for (int n = 0; n < 2; ++n) { const s16x4 l0 = vtr(Bb + n * 4096 + k16 * 1024), h0 = vtr(Bb + n * 4096 + k16 * 1024 + 256); bfr[n] = (bf16x8){l0[0], l0[1], l0[2], l0[3], h0[0], h0[1], h0[2], h0[3]}; }
#pragma unroll
        for (int m = 0; m < 4; ++m)
#pragma unroll
          for (int n = 0; n < 2; ++n) acc[m][n] = __builtin_amdgcn_mfma_f32_32x32x16_bf16(bfr[n], af[m], acc[m][n], 0, 0, 0);
      }
      if (s + 1 < NK) MOE_WRITE_B(cur ^ 1);
      asm volatile("s_waitcnt vmcnt(0)" ::: "memory");
      __syncthreads();
    }
#undef MOE_ISSUE_A
#undef MOE_ISSUE_B
#undef MOE_WRITE_B
#pragma unroll
    for (int m = 0; m < 4; ++m) {
      const int row = 128 * wm + 32 * m + r32;
      if (row < mcount) {
        const int aid = rows[row];
        if (STAGE == 1) {
          bf16_t* hp = (bf16_t*)(p.ws + WS_H) + (size_t)aid * DE + 128 * sub + 32 * wn + 4 * hi;
#pragma unroll
          for (int g = 0; g < 4; ++g)
            st_bf4(hp + 8 * g, silu_f(acc[m][0][4 * g]) * acc[m][1][4 * g], silu_f(acc[m][0][4 * g + 1]) * acc[m][1][4 * g + 1],
                   silu_f(acc[m][0][4 * g + 2]) * acc[m][1][4 * g + 2], silu_f(acc[m][0][4 * g + 3]) * acc[m][1][4 * g + 3]);
        } else {
          const float w = ((const float*)(p.ws + WS_WTS))[aid];
          bf16_t* sp = (bf16_t*)(p.ws + WS_SLAB) + (size_t)aid * D + 256 * sub + 64 * wn + 4 * hi;
#pragma unroll
          for (int n = 0; n < 2; ++n)
#pragma unroll
            for (int g = 0; g < 4; ++g)
              st_bf4(sp + 32 * n + 8 * g, acc[m][n][4 * g] * w, acc[m][n][4 * g + 1] * w, acc[m][n][4 * g + 2] * w, acc[m][n][4 * g + 3] * w);
        }
      }
    }
  }
  __syncthreads();
}
}

__device__ __forceinline__ void phase_final_bf(const P& p, int bid, int nb) {
  const float* X1 = (const float*)(p.ws + WS_X1); const bf16_t* SL = (const bf16_t*)(p.ws + WS_SLAB); const float* ada = (const float*)(p.ws + WS_ADA);
  const int tid_ = tidx(), lane = tid_ & 63, wave = tid_ >> 6;
  for (int t = bid * NW + wave; t < T; t += nb * NW) {
    const int b = t / SEQ;
    float4 v[4]; float s = 0.f;
#pragma unroll
    for (int j = 0; j < 4; ++j) {
      const int c0 = lane * 4 + 256 * j;
      float4 y = make_float4(0, 0, 0, 0);
#pragma unroll
      for (int k = 0; k < 8; ++k) { const float4 z = ld_bf4(SL + (size_t)(t * 8 + k) * D + c0); y.x += z.x; y.y += z.y; y.z += z.z; y.w += z.w; }
      const float4 gt = *(const float4*)(ada + b * 6144 + 5120 + c0);
      const float4 bx = *(const float4*)(X1 + (size_t)t * D + c0);
      v[j] = make_float4(bx.x + gt.x * y.x, bx.y + gt.y * y.y, bx.z + gt.z * y.z, bx.w + gt.w * y.w);
      s += v[j].x * v[j].x + v[j].y * v[j].y + v[j].z * v[j].z + v[j].w * v[j].w;
    }
    s = wave_sum(s);
    const float rstd = 1.0f / sqrtf(s * (1.0f / D) + 1e-6f);
#pragma unroll
    for (int j = 0; j < 4; ++j) {
      const int c0 = lane * 4 + 256 * j;
      const float4 gg = *(const float4*)(p.g_final + c0);
      *(float4*)(p.out + (size_t)t * D + c0) = make_float4(v[j].x * rstd * gg.x, v[j].y * rstd * gg.y, v[j].z * rstd * gg.z, v[j].w * rstd * gg.w);
    }
  }
}

#define XB_TMO      128
#define XB_XCNT(j)  (256  + 64 * (j))
#define XB_XSUB(j)  (1280 + 64 * (j))
#define XB_XGEN(j)  (2304 + 64 * (j))
#define XB_TOP      3328
#define XB_TOPGEN   3392
#define XCD_BAR_WORDS 3456
#define XB_SPIN_CAP (1u << 22)
__device__ __forceinline__ unsigned xb_ld(unsigned* p)              { return __hip_atomic_load(p, __ATOMIC_RELAXED, __HIP_MEMORY_SCOPE_AGENT); }
__device__ __forceinline__ unsigned xb_add(unsigned* p, unsigned v) { return __hip_atomic_fetch_add(p, v, __ATOMIC_RELAXED, __HIP_MEMORY_SCOPE_AGENT); }
__device__ __forceinline__ unsigned xb_xcc_id() { return (unsigned)__builtin_amdgcn_s_getreg((3 << 11) | 20) & 0xFu; }
#define XB_SPIN(cond, bar) do { unsigned _sp = 0; while (cond) { __builtin_amdgcn_s_sleep(1); \
    if ((++_sp & 255u) == 0u) { if (xb_ld(&(bar)[XB_TMO])) break; if (_sp > XB_SPIN_CAP) { atomicAdd(&(bar)[XB_TMO], 1u); break; } } } } while (0)
struct XcdBarrier { unsigned* bar; unsigned x; volatile LAS unsigned* st; };
__device__ __forceinline__ XcdBarrier xcd_barrier_post(unsigned* bar, volatile LAS unsigned* st) {
    XcdBarrier b; b.bar = bar; b.x = xb_xcc_id(); b.st = st;
    if (threadIdx.x == 0) (void)xb_add(&bar[XB_XCNT(b.x)], 1u);
    return b;
}
__device__ __forceinline__ void xcd_barrier_complete(unsigned* bar, unsigned x, unsigned& nloc, unsigned& nx) {
    const unsigned G = gridDim.x * gridDim.y * gridDim.z;
    unsigned sum, cnt, mine, sp = 0u;
    for (;;) {
        sum = 0u; cnt = 0u; mine = 0u;
#pragma unroll
        for (unsigned j = 0; j < 16; ++j) { const unsigned c = xb_ld(&bar[XB_XCNT(j)]); sum += c; cnt += (c > 0u) ? 1u : 0u; mine = (j == x) ? c : mine; }
        if (sum == G) break;
        __builtin_amdgcn_s_sleep(1);
        if ((++sp & 255u) == 0u) { if (xb_ld(&bar[XB_TMO])) break; if (sp > XB_SPIN_CAP) { atomicAdd(&bar[XB_TMO], 1u); break; } }
    }
    nloc = mine > 0u ? mine : 1u; nx = cnt > 0u ? cnt : 1u;
}
__device__ __forceinline__ void xcd_barrier(const XcdBarrier& b) {
    asm volatile("s_waitcnt vmcnt(0)" ::: "memory");
    __syncthreads();
    if (threadIdx.x == 0) {
        unsigned* bar = b.bar;
        __builtin_amdgcn_s_waitcnt(0);
        unsigned nloc = b.st[0], nx = b.st[1];
        if (nloc == 0u) { xcd_barrier_complete(bar, b.x, nloc, nx); b.st[0] = nloc; b.st[1] = nx; }
        const unsigned old = xb_add(&bar[XB_XSUB(b.x)], 1u);
        const unsigned gen = old / nloc;
        if (old + 1u == (gen + 1u) * nloc) {
            __builtin_amdgcn_fence(__ATOMIC_RELEASE, "agent");
            asm volatile("s_waitcnt vmcnt(0)" ::: "memory");
            const unsigned og = xb_add(&bar[XB_TOP], 1u);
            const unsigned tg = og / nx;
            if (og + 1u == (tg + 1u) * nx) xb_add(&bar[XB_TOPGEN], 1u);
            else XB_SPIN(xb_ld(&bar[XB_TOPGEN]) == tg, bar);
            __builtin_amdgcn_fence(__ATOMIC_ACQUIRE, "agent");
            xb_add(&bar[XB_XGEN(b.x)], 1u);
            asm volatile("s_waitcnt vmcnt(0)" ::: "memory");
        } else {
            XB_SPIN(xb_ld(&bar[XB_XGEN(b.x)]) == gen, bar);
            __builtin_amdgcn_fence(__ATOMIC_ACQUIRE, "agent");
            asm volatile("s_waitcnt vmcnt(0)" ::: "memory");
        }
    }
    __syncthreads();
}

constexpr int CW_BAR = 4096;
constexpr int LDS_BYTES = 147456;
constexpr int MISC_OFF = 140 * 1024;

__global__ void __launch_bounds__(NT, 2) mega(P p) {
  extern __shared__ __attribute__((aligned(16))) unsigned char smem[];
  float* lds = (float*)smem;
  LAS unsigned char* ldsb = (LAS unsigned char*)smem;
  volatile LAS unsigned* st = (volatile LAS unsigned*)(ldsb + MISC_OFF);
  if (threadIdx.x < 4) st[threadIdx.x] = 0u;
  __syncthreads();
  XcdBarrier bar = xcd_barrier_post((unsigned*)(p.ws + WS_CTL) + CW_BAR, st);
  const int bid = blockIdx.x, nb = gridDim.x;
  bf16_t* HNB = (bf16_t*)(p.ws + WS_HNB); bf16_t* PROJB = (bf16_t*)(p.ws + WS_PROJB); float* X1 = (float*)(p.ws + WS_X1);
  const float* ada = (const float*)(p.ws + WS_ADA);

  phase_prologue(p, bid, nb, lds);                                                   xcd_barrier(bar);
#if DIAG_EXACT_ROUTING
  diag::modnorm(p, bid, nb, p.x, p.g1, 0, 1024, (float*)(p.ws + diag::DW_HN));       xcd_barrier(bar);
  diag::inproj(p, bid, nb, lds);                                                     xcd_barrier(bar);
  diag::rope(p, bid, nb);                                                            xcd_barrier(bar);
  diag::attn(p, bid, nb);                                                            xcd_barrier(bar);
  diag::mix(p, bid, nb);                                                             xcd_barrier(bar);
  diag::outproj(p, bid, nb, lds);                                                    xcd_barrier(bar);
  diag::modnorm(p, bid, nb, (const float*)(p.ws + diag::DW_X1), p.g2, 3072, 4096, (float*)(p.ws + diag::DW_HN)); xcd_barrier(bar);
  diag::router(p, bid, nb, lds);                                                     xcd_barrier(bar);
  phase_route(p, bid, nb, (const float*)(p.ws + diag::DW_LOGITS));                   xcd_barrier(bar);
#endif
  phase_modnorm(p, bid, nb, p.x, p.g1, 0, 1024, HNB);                                xcd_barrier(bar);
  { pg8::Gemm g{HNB, (const bf16_t*)(p.ws + WS_WIN_T), T, DPROJ, D}; pg8::StaticOrder S; S.init(T, DPROJ, nb, bid);
    EpiInproj E{PROJB, (const float*)(p.ws + WS_COS), (const float*)(p.ws + WS_SIN)};
    pg8::gemm_phase<EpiInproj, pg8::StaticOrder, true, true>(ldsb, g, S, E); }          xcd_barrier(bar);
  phase_attn(p, bid, nb, ldsb);                                                      xcd_barrier(bar);
  phase_mix(p, bid, nb);                                                             xcd_barrier(bar);
  { pg8::Gemm g{HNB, (const bf16_t*)(p.ws + WS_WOUT_T), T, D, D}; pg8::StaticOrder S; S.init(T, D, nb, bid);
    EpiResid E{p.x, X1, ada + 2048};
    pg8::gemm_phase<EpiResid, pg8::StaticOrder, true, true>(ldsb, g, S, E); }           xcd_barrier(bar);
  phase_modnorm(p, bid, nb, X1, p.g2, 3072, 4096, HNB);                              xcd_barrier(bar);
  { pg8::Gemm g{HNB, (const bf16_t*)(p.ws + WS_WRS_T), T, 768, D}; pg8::StaticOrder S; S.init(T, 768, nb, bid);
    EpiRS E{(float*)(p.ws + WS_LOGITS), (bf16_t*)(p.ws + WS_ACTS)};
    pg8::gemm_phase<EpiRS, pg8::StaticOrder, true, true>(ldsb, g, S, E); }              xcd_barrier(bar);
#if !DIAG_EXACT_ROUTING
  phase_route(p, bid, nb, (const float*)(p.ws + WS_LOGITS));
#endif
  { pg8::Gemm g{(const bf16_t*)(p.ws + WS_ACTS), (const bf16_t*)(p.ws + WS_WDS_T), T, D, DSH}; pg8::StaticOrder S; S.init(T, D, nb, bid);
    EpiResid E{X1, X1, ada + 5120};
    pg8::gemm_phase<EpiResid, pg8::StaticOrder, true, true>(ldsb, g, S, E); }           xcd_barrier(bar);
  moe::run<1>(p, bid, nb, ldsb);                                                     xcd_barrier(bar);
  moe::run<2>(p, bid, nb, ldsb);                                                     xcd_barrier(bar);
  phase_final_bf(p, bid, nb);
}
}

extern "C" void kernel_launch(void* const* d_in, const int* in_sizes, int n_in, void* d_out, int out_size, void* d_ws, size_t ws_size, hipStream_t stream) {
  if (n_in != 25 || ws_size < WS_END) { fprintf(stderr, "kernel_launch: unexpected n_in %d or ws_size %zu\n", n_in, ws_size); return; }
  P p; memset(&p, 0, sizeof(p));
  p.x = (const float*)d_in[0]; p.c = (const float*)d_in[1]; p.pos = (const int*)d_in[2]; p.w_ada = (const float*)d_in[3]; p.b_ada = (const float*)d_in[4];
  p.g1 = (const float*)d_in[5]; p.w_in = (const float*)d_in[6]; p.conv_w = (const float*)d_in[7]; p.g_conv = (const float*)d_in[8];
  p.lq1 = (const float*)d_in[9]; p.lk1 = (const float*)d_in[10]; p.lq2 = (const float*)d_in[11]; p.lk2 = (const float*)d_in[12];
  p.g_subln = (const float*)d_in[13]; p.w_out = (const float*)d_in[14]; p.g2 = (const float*)d_in[15]; p.w_router = (const float*)d_in[16]; p.rbias = (const float*)d_in[17];
  p.wg_e = (const float*)d_in[18]; p.wu_e = (const float*)d_in[19]; p.wd_e = (const float*)d_in[20];
  p.wg_s = (const float*)d_in[21]; p.wu_s = (const float*)d_in[22]; p.wd_s = (const float*)d_in[23]; p.g_final = (const float*)d_in[24];
  p.out = (float*)d_out; p.ws = (unsigned char*)d_ws;
  for (int i = 0; i < 8; ++i) p.inv_freq[i] = (float)pow(500000.0, -(double)i / 8.0);
  (void)hipMemsetAsync((char*)d_ws + WS_CTL, 0, CTL_BYTES, stream);
  static int grid = 0;
  if (grid == 0) {
    int dev = 0, cus = 0, per_cu = 0;
    (void)hipGetDevice(&dev); (void)hipDeviceGetAttribute(&cus, hipDeviceAttributeMultiprocessorCount, dev);
    (void)hipFuncSetAttribute((const void*)mega, hipFuncAttributeMaxDynamicSharedMemorySize, LDS_BYTES);
    (void)hipOccupancyMaxActiveBlocksPerMultiprocessor(&per_cu, (const void*)mega, NT, LDS_BYTES);
    if (per_cu < 1) { fprintf(stderr, "kernel_launch: occupancy query says %d blocks/CU\n", per_cu); grid = -1; }
    else grid = cus;
  }
  if (grid < 0) return;
  void* args[] = {&p};
  hipError_t e = hipLaunchCooperativeKernel((const void*)mega, dim3(grid), dim3(NT), args, LDS_BYTES, stream);
  if (e != hipSuccess) fprintf(stderr, "cooperative launch failed: %s (grid %d)\n", hipGetErrorString(e), grid);
}
```

```cpp
#include <hip/hip_runtime.h>
#include <hip/hip_bf16.h>
#include <cmath>
#include <stdint.h>
#include <math.h>
#include <stdio.h>
#include <string.h>

#define DIAG_EXACT_ROUTING 0

__device__ __forceinline__ int tidx() { int t = threadIdx.x; asm volatile("" : "+v"(t)); return t; }

#define REP_LIGHT 1
#define REP_CONV 1
#define REP_GEMM 1
#define REP_ATTN 1
#define REP_MOE1 1
#define REP_MOE2 1

__device__ __forceinline__ unsigned char* fresh_ws(unsigned char* w) { unsigned long long z = 0; asm volatile("" : "+s"(z)); return w + z; }

#define TIME_SEL_A -1
#define TIME_SEL_B -1

namespace pg8 {
#define PG8_LAS __attribute__((address_space(3)))
typedef unsigned short bf16_t;
typedef short bf16x8 __attribute__((ext_vector_type(8)));
typedef float f32x4 __attribute__((ext_vector_type(4)));
typedef unsigned u32x4 __attribute__((ext_vector_type(4)));
constexpr int BM = 256, BK = 64, HALF = 128, HTB = HALF * BK * 2  , STAGE_BYTES = 8 * HTB, NXCD = 8, WGM = 8;

__host__ __device__ __forceinline__ int lds_byte(int r, int c) { const int st = (r >> 4) * 2 + (c >> 5), rr = r & 15, cc = c & 31, ob = rr * 64 + cc * 2; return st * 1024 + (ob ^ (((ob >> 9) & 1) << 5)); }
__host__ __device__ __forceinline__ void stage_rc(int b, int& R, int& C) { const int st = b / 1024, sb = b % 1024, swz = sb ^ (((sb >> 9) & 1) << 5); R = (st >> 1) * 16 + swz / 64; C = (st & 1) * 32 + (swz % 64) / 2; }
__host__ __device__ __forceinline__ int perm32(int rho) { const int n = rho >> 4, i = rho & 15; return 8 * (i >> 2) + 4 * n + (i & 3); }

struct Unit { int pm, pn; };
struct Gemm { const bf16_t* A; const bf16_t* Bt; int M, N, K; };

struct StaticOrder {
    int nM, nN, nwg, G, c;
    __host__ __device__ void init(int M, int N, int G_, int c_) { nM = M / BM; nN = N / BM; nwg = nM * nN; G = G_; c = c_; }
    __host__ __device__ bool next(int i, Unit& u) const {
        const long L = (long)i * G + c; if (L >= nwg) return false;
        int wgid = (int)L; { const int q = nwg / NXCD, r = nwg % NXCD, xcd = wgid % NXCD, off = wgid / NXCD; wgid = (xcd < r ? xcd * (q + 1) : r * (q + 1) + (xcd - r) * q) + off; }
        const int nig = WGM * nN, gid = wgid / nig, fm = gid * WGM, gsz = (nM - fm) < WGM ? (nM - fm) : WGM;
        u.pm = fm + ((wgid % nig) % gsz); u.pn = (wgid % nig) / gsz; return true;
    }
    __device__ __forceinline__ void a_ready(const Unit&) const {}
    __device__ __forceinline__ void done(const Unit&) const {}
};
__device__ __forceinline__ unsigned cvt_pk_bf16(float lo, float hi) { unsigned r; asm volatile("v_cvt_pk_bf16_f32 %0, %1, %2" : "=v"(r) : "v"(lo), "v"(hi)); return r; }
template <class Epi, class Sched, bool ALIGN_EPI = false, bool SP2 = false>
__device__ __forceinline__ void gemm_phase(PG8_LAS unsigned char* lds, const Gemm g, const Sched& S, const Epi& E) {
    const int tid = tidx(), wid = __builtin_amdgcn_readfirstlane(tid >> 6), lane = tid & 63, wr = wid >> 2, wc = wid & 3, fr = lane & 15, fq = lane >> 4;
    const int K = g.K, nt = K / BK;
    unsigned voffA[2], voffB[2];
#pragma unroll
    for (int i = 0; i < 2; ++i) { int R, C; stage_rc(tid * 16 + i * 8192, R, C); const int Rb = Epi::PERM ? ((R & ~31) + perm32(R & 31)) : R;
        voffA[i] = (unsigned)(R * K + C) * 2u; voffB[i] = (unsigned)(Rb * K + C) * 2u; }
    const size_t kstep = (size_t)(BK * 2);
    const size_t hstep = (size_t)HALF * K * 2;
    const size_t tstep = 2 * hstep;
    const unsigned ldsw = (unsigned)wid * 1024u;
    const int aoff = lds_byte(wr * 64 + fr, fq * 8), boff = lds_byte(wc * 32 + fr, fq * 8);
#define PG8_SA(b, h) (((b) * 2 + (h)) * HTB)
#define PG8_SB(b, h) ((4 + (b) * 2 + (h)) * HTB)
#define PG8_STAGE(bufoff, gbase, voff) do { _Pragma("unroll") for (int _i = 0; _i < 2; ++_i) \
        __builtin_amdgcn_global_load_lds((const unsigned*)((const char*)(gbase) + (voff)[_i]), (PG8_LAS unsigned*)(lds + (bufoff) + ldsw + _i * 8192), 16, 0, 0); } while (0)
#define PG8_LDA(dst, b, h) do { _Pragma("unroll") for (int m = 0; m < 4; ++m) _Pragma("unroll") for (int k = 0; k < 2; ++k) dst[m][k] = *(const PG8_LAS bf16x8*)(lds + PG8_SA(b, h) + aoff + m * 2048 + k * 1024); } while (0)
#define PG8_LDB(dst, b, h) do { _Pragma("unroll") for (int n = 0; n < 2; ++n) _Pragma("unroll") for (int k = 0; k < 2; ++k) dst[n][k] = *(const PG8_LAS bf16x8*)(lds + PG8_SB(b, h) + boff + n * 2048 + k * 1024); } while (0)
#define PG8_MMA(ai, bj, At, Bt) do { __builtin_amdgcn_s_setprio(1); _Pragma("unroll") for (int m = 0; m < 4; ++m) _Pragma("unroll") for (int n = 0; n < 2; ++n) _Pragma("unroll") for (int k = 0; k < 2; ++k) \
        acc[ai][bj][m][n] = __builtin_amdgcn_mfma_f32_16x16x32_bf16(Bt[n][k], At[m][k], acc[ai][bj][m][n], 0, 0, 0); __builtin_amdgcn_s_setprio(0); } while (0)
#define PG8_WAIT_V(n) asm volatile("s_waitcnt vmcnt(" #n ")" ::: "memory")
#define PG8_WAIT_L(n) asm volatile("s_waitcnt lgkmcnt(" #n ")" ::: "memory")
#define PG8_BAR __builtin_amdgcn_s_barrier()
#define PG8_SCHED __builtin_amdgcn_sched_barrier(0)
    Unit cur, nxt; int ui = 0;
    if (!S.next(0, cur)) return;
    f32x4 acc[2][2][4][2];
#pragma unroll
    for (int a = 0; a < 2; ++a)
#pragma unroll
        for (int b = 0; b < 2; ++b)
#pragma unroll
            for (int m = 0; m < 4; ++m)
#pragma unroll
                for (int n = 0; n < 2; ++n) acc[a][b][m][n] = (f32x4){0.f, 0.f, 0.f, 0.f};
    bf16x8 At[4][2], B0[2][2], B1[2][2];
    const char* cA = (const char*)g.A + (size_t)cur.pm * tstep; const char* cB = (const char*)g.Bt + (size_t)cur.pn * tstep;
    S.a_ready(cur);
    if constexpr (SP2) {
        PG8_STAGE(PG8_SB(0, 0), cB, voffB); PG8_STAGE(PG8_SB(0, 1), cB + hstep, voffB); PG8_STAGE(PG8_SA(0, 0), cA, voffA); PG8_STAGE(PG8_SA(0, 1), cA + hstep, voffA);
        if (wr == 1) PG8_BAR;
        PG8_WAIT_V(2); PG8_BAR;
        PG8_STAGE(PG8_SB(1, 0), cB + kstep, voffB); PG8_STAGE(PG8_SA(1, 0), cA + kstep, voffA); PG8_STAGE(PG8_SB(1, 1), cB + hstep + kstep, voffB);
        PG8_WAIT_V(6); PG8_BAR;
    } else {
        PG8_STAGE(PG8_SB(0, 0), cB, voffB); PG8_STAGE(PG8_SA(0, 0), cA, voffA); PG8_STAGE(PG8_SB(0, 1), cB + hstep, voffB); PG8_STAGE(PG8_SA(0, 1), cA + hstep, voffA);
        if (wr == 1) PG8_BAR;
        PG8_WAIT_V(4); PG8_BAR;
        PG8_STAGE(PG8_SB(1, 0), cB + kstep, voffB); PG8_STAGE(PG8_SA(1, 0), cA + kstep, voffA); PG8_STAGE(PG8_SB(1, 1), cB + hstep + kstep, voffB);
        PG8_WAIT_V(6); PG8_BAR;
    }
    for (;;) {
        const bool has_next = S.next(ui + 1, nxt);
        const char* nA = has_next ? (const char*)g.A + (size_t)nxt.pm * tstep : cA; const char* nB = has_next ? (const char*)g.Bt + (size_t)nxt.pn * tstep : cB;
        for (int t = 0; t < nt; t += 2) {
            const bool last = (t == nt - 2);
            const char* a1 = cA + (size_t)(t + 1) * kstep;
            const char* a2 = last ? nA : cA + (size_t)(t + 2) * kstep; const char* b2 = last ? nB : cB + (size_t)(t + 2) * kstep;
            const char* a3 = a2 + kstep; const char* b3 = b2 + kstep;
            if (last && has_next) S.a_ready(nxt);
            if constexpr (SP2) {
            PG8_LDB(B0, 0, 0); PG8_LDB(B1, 0, 1); PG8_SCHED; PG8_LDA(At, 0, 0); PG8_STAGE(PG8_SA(1, 1), a1 + hstep, voffA);
            PG8_WAIT_V(8); PG8_WAIT_L(0); PG8_BAR; PG8_MMA(0, 0, At, B0); PG8_MMA(0, 1, At, B1); PG8_BAR; PG8_SCHED;
            PG8_LDA(At, 0, 1); PG8_STAGE(PG8_SB(0, 0), b2, voffB); PG8_STAGE(PG8_SB(0, 1), b2 + hstep, voffB); PG8_STAGE(PG8_SA(0, 0), a2, voffA);
            PG8_WAIT_V(8); PG8_WAIT_L(0); PG8_BAR; PG8_MMA(1, 0, At, B0); PG8_MMA(1, 1, At, B1); PG8_BAR; PG8_SCHED;
            PG8_LDB(B0, 1, 0); PG8_LDB(B1, 1, 1); PG8_SCHED; PG8_LDA(At, 1, 0); PG8_STAGE(PG8_SA(0, 1), a2 + hstep, voffA);
            PG8_WAIT_V(8); PG8_WAIT_L(0); PG8_BAR; PG8_MMA(0, 0, At, B0); PG8_MMA(0, 1, At, B1); PG8_BAR; PG8_SCHED;
            PG8_LDA(At, 1, 1); PG8_STAGE(PG8_SB(1, 0), b3, voffB); PG8_STAGE(PG8_SB(1, 1), b3 + hstep, voffB); PG8_STAGE(PG8_SA(1, 0), a3, voffA);
            PG8_WAIT_V(8); PG8_WAIT_L(0); PG8_BAR; PG8_MMA(1, 0, At, B0); PG8_MMA(1, 1, At, B1); PG8_BAR; PG8_SCHED;
            } else {
            PG8_LDB(B0, 0, 0); PG8_SCHED; PG8_LDA(At, 0, 0); PG8_STAGE(PG8_SA(1, 1), a1 + hstep, voffA);
            PG8_WAIT_L(8); PG8_BAR; PG8_WAIT_L(0); PG8_MMA(0, 0, At, B0); PG8_BAR; PG8_SCHED;
            PG8_LDB(B1, 0, 1); PG8_STAGE(PG8_SB(0, 0), b2, voffB);
            PG8_BAR; PG8_WAIT_L(0); PG8_MMA(0, 1, At, B1); PG8_BAR;
            PG8_LDA(At, 0, 1); PG8_STAGE(PG8_SA(0, 0), a2, voffA);
            PG8_BAR; PG8_WAIT_L(0); PG8_MMA(1, 0, At, B0); PG8_BAR; PG8_SCHED;
            PG8_STAGE(PG8_SB(0, 1), b2 + hstep, voffB);
            PG8_WAIT_V(6); PG8_BAR; PG8_MMA(1, 1, At, B1); PG8_BAR;
            PG8_LDB(B0, 1, 0); PG8_SCHED; PG8_LDA(At, 1, 0); PG8_STAGE(PG8_SA(0, 1), a2 + hstep, voffA);
            PG8_WAIT_L(8); PG8_BAR; PG8_WAIT_L(0); PG8_MMA(0, 0, At, B0); PG8_BAR; PG8_SCHED;
            PG8_LDB(B1, 1, 1); PG8_STAGE(PG8_SB(1, 0), b3, voffB);
            PG8_BAR; PG8_WAIT_L(0); PG8_MMA(0, 1, At, B1); PG8_BAR;
            PG8_LDA(At, 1, 1); PG8_STAGE(PG8_SA(1, 0), a3, voffA);
            PG8_BAR; PG8_WAIT_L(0); PG8_MMA(1, 0, At, B0); PG8_BAR; PG8_SCHED;
            PG8_STAGE(PG8_SB(1, 1), b3 + hstep, voffB);
            PG8_WAIT_V(6); PG8_BAR; PG8_MMA(1, 1, At, B1); PG8_BAR;
            }
        }
        if constexpr (ALIGN_EPI) { if (wr == 0) PG8_BAR; }
        if constexpr (!Epi::AFTER_DRAIN) { E(acc, cur, wr, wc, fr, fq); S.done(cur); }
        if (!has_next) break;
#pragma unroll
        for (int a = 0; a < 2; ++a)
#pragma unroll
            for (int b = 0; b < 2; ++b)
#pragma unroll
                for (int m = 0; m < 4; ++m)
#pragma unroll
                    for (int n = 0; n < 2; ++n) acc[a][b][m][n] = (f32x4){0.f, 0.f, 0.f, 0.f};
        cur = nxt; cA = nA; cB = nB; ++ui;
        if constexpr (ALIGN_EPI) { if (wr == 1) PG8_BAR; }
    }
    PG8_WAIT_V(0);
    if constexpr (!ALIGN_EPI) { if (wr == 0) PG8_BAR; }
    PG8_BAR;
    if constexpr (Epi::AFTER_DRAIN) { E.fused(acc, cur, wr, wc, fr, fq, lds, wid, lane); S.done(cur); }
#undef PG8_SA
#undef PG8_SB
#undef PG8_STAGE
#undef PG8_LDA
#undef PG8_LDB
#undef PG8_MMA
#undef PG8_WAIT_V
#undef PG8_WAIT_L
#undef PG8_BAR
#undef PG8_SCHED
}
}

namespace {
using pg8::bf16_t; using pg8::f32x4; using pg8::u32x4; using pg8::Unit;
constexpr int D = 1024, BATCH = 4, SEQ = 4096, T = BATCH * SEQ;
constexpr int DPROJ = 3072;
constexpr int COL_H = 0, COL_B = 512, COL_C = 1024, COL_Q = 1536, COL_K = 2048, COL_V = 2560;
constexpr int NE = 256, TOPK = 8, DE = 256, DSH = 256;
constexpr int NT = 512;
constexpr int NW = NT / 64;
constexpr int LISTCAP = T;
constexpr int CNT_STRIDE = 64;
constexpr float C2 = 0.125f * 1.4426950408889634f;

constexpr size_t MiB = 1u << 20;
constexpr size_t WS_CTL = 0, CTL_BYTES = 1 * MiB;
constexpr size_t WS_ADA = 1 * MiB;
constexpr size_t WS_MISC = 1 * MiB + 128 * 1024;
constexpr size_t WS_COS = 2 * MiB, WS_SIN = 2 * MiB + 512 * 1024;
constexpr size_t WS_IDX = 3 * MiB, WS_WTS = 3 * MiB + 512 * 1024;
constexpr size_t WS_LIST = 4 * MiB;
constexpr size_t WS_LOGITS = 20 * MiB;
constexpr size_t WS_ACTS = 36 * MiB;
constexpr size_t WS_WIN_T = 44 * MiB;
constexpr size_t WS_WOUT_T = 50 * MiB;
constexpr size_t WS_WRS_T = 52 * MiB;
constexpr size_t WS_WDS_T = 54 * MiB;
constexpr size_t WS_X1 = 64 * MiB;
constexpr size_t WS_HNB = 128 * MiB;
constexpr size_t WS_PROJB = 160 * MiB;
constexpr size_t WS_AO = 256 * MiB;
constexpr size_t WS_SLAB = 128 * MiB;
constexpr size_t WS_H = 384 * MiB;
constexpr size_t WS_WE1 = 448 * MiB;
constexpr size_t WS_WE2 = 704 * MiB;
constexpr size_t WS_END = 832 * MiB;

struct P {
  const float* x; const float* c; const int* pos; const float* w_ada; const float* b_ada; const float* g1;
  const float* w_in; const float* conv_w; const float* g_conv; const float* lq1; const float* lk1; const float* lq2; const float* lk2;
  const float* g_subln; const float* w_out; const float* g2; const float* w_router; const float* rbias;
  const float* wg_e; const float* wu_e; const float* wd_e; const float* wg_s; const float* wu_s; const float* wd_s; const float* g_final;
  float* out; unsigned char* ws;
  float inv_freq[8];
};

#define LAS __attribute__((address_space(3)))
__device__ __forceinline__ float wave_sum(float v) {
#pragma unroll
  for (int o = 1; o < 64; o <<= 1) v += __shfl_xor(v, o);
  return v;
}
__device__ __forceinline__ float silu_f(float v) { return v / (1.f + expf(-v)); }
__device__ __forceinline__ unsigned f2bf(float f) { unsigned u = __float_as_uint(f); return (u + 0x7fffu + ((u >> 16) & 1u)) >> 16; }
__device__ __forceinline__ unsigned pk2(float lo, float hi) { return f2bf(lo) | (f2bf(hi) << 16); }
__device__ __forceinline__ float bflo(unsigned w) { return __uint_as_float(w << 16); }
__device__ __forceinline__ float bfhi(unsigned w) { return __uint_as_float(w & 0xffff0000u); }
__device__ __forceinline__ float4 ld_bf4(const bf16_t* p) { const uint2 w = *(const uint2*)p; return make_float4(bflo(w.x), bfhi(w.x), bflo(w.y), bfhi(w.y)); }
__device__ __forceinline__ void st_bf4(bf16_t* p, float a, float b, float c, float d) { *(uint2*)p = make_uint2(pk2(a, b), pk2(c, d)); }

struct EpiInproj {
  static constexpr bool PERM = true, AFTER_DRAIN = false;
  bf16_t* O; const float* cosT; const float* sinT;
  __device__ __forceinline__ void operator()(const f32x4 (&acc)[2][2][4][2], const Unit& u, int wr, int wc, int fr, int fq) const {
    const int row0 = u.pm * 256 + wr * 64 + fr, col0 = u.pn * 256 + wc * 32 + 8 * fq;
    const bool qk = (u.pn >= 6 && u.pn < 10), rot = qk && ((wc & 1) == 0) && (fq < 2);
    const float sc = (u.pn == 6 || u.pn == 7) ? C2 : 1.f;
#pragma unroll
    for (int ai = 0; ai < 2; ++ai)
#pragma unroll
      for (int m = 0; m < 4; ++m) {
        const int row = row0 + ai * 128 + m * 16;
        f32x4 cs = {1.f, 1.f, 1.f, 1.f}, sn = {0.f, 0.f, 0.f, 0.f};
        if (rot) { cs = *(const f32x4*)(cosT + (size_t)row * 8 + 4 * fq); sn = *(const f32x4*)(sinT + (size_t)row * 8 + 4 * fq); }
        bf16_t* rowp = O + (size_t)row * DPROJ + col0;
#pragma unroll
        for (int bj = 0; bj < 2; ++bj) {
          const f32x4 a = acc[ai][bj][m][0], b = acc[ai][bj][m][1];
          const f32x4 v0 = (a * cs - b * sn) * sc, v1 = (b * cs + a * sn) * sc;
          u32x4 w; w.x = pk2(v0[0], v0[1]); w.y = pk2(v0[2], v0[3]); w.z = pk2(v1[0], v1[1]); w.w = pk2(v1[2], v1[3]);
          *(u32x4*)(rowp + bj * 128) = w;
        }
      }
  }
};
struct EpiResid {
  static constexpr bool PERM = false, AFTER_DRAIN = false;
  const float* base; float* out; const float* gate;
  __device__ __forceinline__ void operator()(const f32x4 (&acc)[2][2][4][2], const Unit& u, int wr, int wc, int fr, int fq) const {
    const int row0 = u.pm * 256 + wr * 64 + fr, col0 = u.pn * 256 + wc * 32 + 4 * fq;
    const float* gp = gate + (size_t)(u.pm / 16) * 6144;
#pragma unroll
    for (int bj = 0; bj < 2; ++bj)
#pragma unroll
      for (int n = 0; n < 2; ++n) {
        const int c = col0 + bj * 128 + n * 16;
        const f32x4 gv = *(const f32x4*)(gp + c);
#pragma unroll
        for (int ai = 0; ai < 2; ++ai)
#pragma unroll
          for (int m = 0; m < 4; ++m) {
            const size_t o = (size_t)(row0 + ai * 128 + m * 16) * D + c;
            const f32x4 bs = *(const f32x4*)(base + o);
            *(f32x4*)(out + o) = bs + gv * acc[ai][bj][m][n];
          }
      }
  }
};
struct EpiRS {
  static constexpr bool PERM = true, AFTER_DRAIN = false;
  float* LG; bf16_t* AC;
  __device__ __forceinline__ void operator()(const f32x4 (&acc)[2][2][4][2], const Unit& u, int wr, int wc, int fr, int fq) const {
    const int row0 = u.pm * 256 + wr * 64 + fr, cl = wc * 32 + 8 * fq;
#pragma unroll
    for (int ai = 0; ai < 2; ++ai)
#pragma unroll
      for (int m = 0; m < 4; ++m) {
        const int row = row0 + ai * 128 + m * 16;
#pragma unroll
        for (int bj = 0; bj < 2; ++bj) {
          const f32x4 a = acc[ai][bj][m][0], b = acc[ai][bj][m][1];
          if (u.pn == 0) { float* lp = LG + (size_t)row * 256 + cl + bj * 128; *(f32x4*)lp = a; *(f32x4*)(lp + 4) = b; }
          else {
            const int ci = 256 * (u.pn - 1) + cl + bj * 128;
            st_bf4(AC + (size_t)row * DSH + (ci >> 1), silu_f(a[0]) * b[0], silu_f(a[1]) * b[1], silu_f(a[2]) * b[2], silu_f(a[3]) * b[3]);
          }
        }
      }
  }
};

template <class RM>
__device__ __forceinline__ void transpose_item(const float* W, int K, int N, bf16_t* WT, LAS float* scr, int item, int lane, const RM& rowmap) {
  const int nblk = N / 32, kb = item / nblk, nbk = item % nblk, k0 = 64 * kb, n0 = 32 * nbk;
#pragma unroll 8
  for (int i = 0; i < 32; ++i) { const int kk = 2 * i + (lane >> 5); scr[kk * 33 + (lane & 31)] = W[(size_t)(k0 + kk) * N + n0 + (lane & 31)]; }
  asm volatile("s_waitcnt lgkmcnt(0)" ::: "memory");
  const int c = lane & 7;
#pragma unroll
  for (int j = 0; j < 4; ++j) {
    const int n = (lane >> 3) + 8 * j; const LAS float* s = scr + (8 * c) * 33 + n;
    u32x4 o; o.x = pk2(s[0 * 33], s[1 * 33]); o.y = pk2(s[2 * 33], s[3 * 33]); o.z = pk2(s[4 * 33], s[5 * 33]); o.w = pk2(s[6 * 33], s[7 * 33]);
    *(u32x4*)(WT + (size_t)rowmap(n0 + n) * K + k0 + 8 * c) = o;
  }
  asm volatile("s_waitcnt lgkmcnt(0)" ::: "memory");
}
__device__ __forceinline__ int win_rowmap(int n) {
  if (n < COL_Q || n >= COL_V) return n;
  const int pos = n & 63; if (pos >= 16) return n;
  const int g = pos >> 2, g2 = (g == 1) ? 2 : (g == 2) ? 1 : g;
  return (n & ~63) + g2 * 4 + (pos & 3);
}
__device__ __forceinline__ void phase_prologue(const P& p, int bid, int nb, float* lds) {
  unsigned char* const ws_ = fresh_ws(p.ws);
  float* cact = lds;
  float* red = lds + 4096;
  const int tid = tidx();
  float* ada = (float*)(ws_ + WS_ADA);
  for (int i = tid; i < 4096; i += NT) cact[i] = silu_f(p.c[i]);
  __syncthreads();
  for (int cb = bid; cb < 256; cb += nb) {
    const int col = tid % 24, kg = tid / 24;
    if (kg < 21) {
      float a0 = 0.f, a1 = 0.f, a2 = 0.f, a3 = 0.f;
      for (int k = kg; k < 1024; k += 21) {
        const float w = p.w_ada[(size_t)k * 6144 + cb * 24 + col];
        a0 += cact[k] * w; a1 += cact[1024 + k] * w; a2 += cact[2048 + k] * w; a3 += cact[3072 + k] * w;
      }
      float* r = red + (kg * 24 + col) * 4; r[0] = a0; r[1] = a1; r[2] = a2; r[3] = a3;
    }
    __syncthreads();
    if (tid < 96) {
      const int cc = tid >> 2, b = tid & 3; float s = 0.f;
      for (int g = 0; g < 21; ++g) s += red[(g * 24 + cc) * 4 + b];
      ada[b * 6144 + cb * 24 + cc] = s + p.b_ada[cb * 24 + cc];
    }
    __syncthreads();
  }
  if (bid == 0 && tid == 0) {
    float s1 = 0.f, s2 = 0.f;
    for (int i = 0; i < 64; ++i) { s1 += p.lq1[i] * p.lk1[i]; s2 += p.lq2[i] * p.lk2[i]; }
    ((float*)(ws_ + WS_MISC))[0] = expf(s1) - expf(s2) + 0.2f;
  }
  float* ct = (float*)(ws_ + WS_COS); float* st = (float*)(ws_ + WS_SIN);
  for (int i = bid * NT + tid; i < T * 8; i += nb * NT) {
    const int t = i >> 3, f = i & 7;
    const float ifr = f == 0 ? p.inv_freq[0] : f == 1 ? p.inv_freq[1] : f == 2 ? p.inv_freq[2] : f == 3 ? p.inv_freq[3] : f == 4 ? p.inv_freq[4] : f == 5 ? p.inv_freq[5] : f == 6 ? p.inv_freq[6] : p.inv_freq[7];
    const float ang = (float)p.pos[t] * ifr;
    float s, c; sincosf(ang, &s, &c);
    ct[i] = c; st[i] = s;
  }
  const int lane = tid & 63, wave = tid >> 6;
  LAS float* scr = (LAS float*)lds + 8192 + wave * 2176;
  constexpr int I_IN = 16 * 96, I_OUT = 16 * 32, I_R = 16 * 8, I_G = 16 * 8, I_U = 16 * 8, I_D = 4 * 32;
  constexpr int NITEMS = I_IN + I_OUT + I_R + I_G + I_U + I_D;
  bf16_t* WIN = (bf16_t*)(ws_ + WS_WIN_T); bf16_t* WOUT = (bf16_t*)(ws_ + WS_WOUT_T); bf16_t* WRS = (bf16_t*)(ws_ + WS_WRS_T); bf16_t* WDS = (bf16_t*)(ws_ + WS_WDS_T);
  for (int it = bid * NW + wave; it < NITEMS; it += nb * NW) {
    int r = it;
    if (r < I_IN) { transpose_item(p.w_in, D, DPROJ, WIN, scr, r, lane, [](int n) { return win_rowmap(n); }); continue; } r -= I_IN;
    if (r < I_OUT) { transpose_item(p.w_out, D, D, WOUT, scr, r, lane, [](int n) { return n; }); continue; } r -= I_OUT;
    if (r < I_R) { transpose_item(p.w_router, D, 256, WRS, scr, r, lane, [](int n) { return n; }); continue; } r -= I_R;
    if (r < I_G) { transpose_item(p.wg_s, D, 256, WRS, scr, r, lane, [](int n) { return 256 + 8 * (n >> 2) + (n & 3); }); continue; } r -= I_G;
    if (r < I_U) { transpose_item(p.wu_s, D, 256, WRS, scr, r, lane, [](int n) { return 256 + 8 * (n >> 2) + 4 + (n & 3); }); continue; } r -= I_U;
    transpose_item(p.wd_s, DSH, D, WDS, scr, r, lane, [](int n) { return n; });
  }
}

__device__ __forceinline__ void phase_modnorm(const P& p, int bid, int nb, const float* in, const float* g, int sh_off, int sc_off, bf16_t* outp) {
  unsigned char* const ws_ = fresh_ws(p.ws);
  const int tid_ = tidx(), lane = tid_ & 63, wave = tid_ >> 6;
  const float* ada = (const float*)(ws_ + WS_ADA);
  for (int t = bid * NW + wave; t < T; t += nb * NW) {
    const int b = t / SEQ;
    const float4* xr = (const float4*)(in + (size_t)t * D) + lane;
    float4 v[4]; float s = 0.f;
#pragma unroll
    for (int j = 0; j < 4; ++j) { v[j] = xr[64 * j]; s += v[j].x * v[j].x + v[j].y * v[j].y + v[j].z * v[j].z + v[j].w * v[j].w; }
    s = wave_sum(s);
    const float rstd = 1.0f / sqrtf(s * (1.0f / D) + 1e-6f);
#pragma unroll
    for (int j = 0; j < 4; ++j) {
      const int c0 = lane * 4 + 256 * j;
      const float4 gg = *(const float4*)(g + c0);
      const float4 sc = *(const float4*)(ada + b * 6144 + sc_off + c0);
      const float4 sh = *(const float4*)(ada + b * 6144 + sh_off + c0);
      st_bf4(outp + (size_t)t * D + c0, v[j].x * rstd * gg.x * (1.f + sc.x) + sh.x, v[j].y * rstd * gg.y * (1.f + sc.y) + sh.y,
             v[j].z * rstd * gg.z * (1.f + sc.z) + sh.z, v[j].w * rstd * gg.w * (1.f + sc.w) + sh.w);
    }
  }
}

template <bool DUAL, class AF, class EF>
__device__ __forceinline__ void gemm_tile_naive(const AF& af, int mcount, const float* __restrict__ B0, const float* __restrict__ B1, int ldb, int n0, int K, const EF& ef, float* lds) {
  float* As = lds; float* Bs0 = lds + 16 * 132; float* Bs1 = Bs0 + 16 * 64;
  const int tid = tidx(), ty = tid >> 4, tx = tid & 15;
  float acc0[4][4], acc1[4][4];
#pragma unroll
  for (int i = 0; i < 4; ++i)
#pragma unroll
    for (int j = 0; j < 4; ++j) { acc0[i][j] = 0.f; acc1[i][j] = 0.f; }
  const int ar = tid >> 2, akq = (tid & 3) * 4;
  const bool avalid = ar < mcount;
  const int bt = tid & 255, bk = bt >> 4, bc = (bt & 15) * 4;
  const float* bsrc = (tid < 256) ? B0 : B1;
  float* bdst = (tid < 256) ? Bs0 : Bs1;
  for (int k0 = 0; k0 < K; k0 += 16) {
    float4 av = make_float4(0.f, 0.f, 0.f, 0.f);
    if (avalid) av = af(ar, k0 + akq);
    As[(akq + 0) * 132 + ar] = av.x; As[(akq + 1) * 132 + ar] = av.y; As[(akq + 2) * 132 + ar] = av.z; As[(akq + 3) * 132 + ar] = av.w;
    if (DUAL || tid < 256) {
      const float4 bv = *(const float4*)(bsrc + (size_t)(k0 + bk) * ldb + n0 + bc);
      *(float4*)(bdst + bk * 64 + bc) = bv;
    }
    __syncthreads();
#pragma unroll
    for (int kk = 0; kk < 16; ++kk) {
      const float4 a = *(const float4*)(As + kk * 132 + ty * 4);
      const float4 b = *(const float4*)(Bs0 + kk * 64 + tx * 4);
      const float aa[4] = {a.x, a.y, a.z, a.w}; const float bb[4] = {b.x, b.y, b.z, b.w};
#pragma unroll
      for (int i = 0; i < 4; ++i)
#pragma unroll
        for (int j = 0; j < 4; ++j) acc0[i][j] += aa[i] * bb[j];
      if (DUAL) {
        const float4 b1 = *(const float4*)(Bs1 + kk * 64 + tx * 4);
        const float cc[4] = {b1.x, b1.y, b1.z, b1.w};
#pragma unroll
        for (int i = 0; i < 4; ++i)
#pragma unroll
          for (int j = 0; j < 4; ++j) acc1[i][j] += aa[i] * cc[j];
      }
    }
    __syncthreads();
  }
#pragma unroll
  for (int i = 0; i < 4; ++i)
    if (ty * 4 + i < mcount) {
#pragma unroll
      for (int j = 0; j < 4; ++j) ef(ty * 4 + i, n0 + tx * 4 + j, acc0[i][j], acc1[i][j]);
    }
}

__device__ __forceinline__ void phase_mix(const P& p, int bid, int nb) {
  unsigned char* const ws_ = fresh_ws(p.ws);
  const bf16_t* PR = (const bf16_t*)(ws_ + WS_PROJB); const bf16_t* AO = (const bf16_t*)(ws_ + WS_AO); bf16_t* MIX = (bf16_t*)(ws_ + WS_HNB);
  const float lam = ((const float*)(ws_ + WS_MISC))[0];
  const int tid_ = tidx(), lane = tid_ & 63, wave = tid_ >> 6;
  for (int t = bid * NW + wave; t < T; t += nb * NW) {
    const int s = t % SEQ;
    const bf16_t* r0 = PR + (size_t)t * DPROJ;
    float vals[8]; float ss = 0.f;
#pragma unroll
    for (int j = 0; j < 2; ++j) {
      const int ch = lane * 4 + 256 * j;
      const float4 h0 = ld_bf4(r0 + COL_H + ch), c0 = ld_bf4(r0 + COL_C + ch), bg = ld_bf4(r0 + COL_B + ch);
      float4 h1 = make_float4(0, 0, 0, 0), c1 = h1, h2 = h1, c2 = h1;
      if (s >= 1) { h1 = ld_bf4(r0 - DPROJ + COL_H + ch); c1 = ld_bf4(r0 - DPROJ + COL_C + ch); }
      if (s >= 2) { h2 = ld_bf4(r0 - 2 * DPROJ + COL_H + ch); c2 = ld_bf4(r0 - 2 * DPROJ + COL_C + ch); }
      const float4 w0 = *(const float4*)(p.conv_w + ch), w1 = *(const float4*)(p.conv_w + 512 + ch), w2 = *(const float4*)(p.conv_w + 1024 + ch);
      float y;
      y = w0.x * (c2.x * h2.x) + w1.x * (c1.x * h1.x) + w2.x * (c0.x * h0.x); vals[4 * j + 0] = bg.x * y;
      y = w0.y * (c2.y * h2.y) + w1.y * (c1.y * h1.y) + w2.y * (c0.y * h0.y); vals[4 * j + 1] = bg.y * y;
      y = w0.z * (c2.z * h2.z) + w1.z * (c1.z * h1.z) + w2.z * (c0.z * h0.z); vals[4 * j + 2] = bg.z * y;
      y = w0.w * (c2.w * h2.w) + w1.w * (c1.w * h1.w) + w2.w * (c0.w * h0.w); vals[4 * j + 3] = bg.w * y;
#pragma unroll
      for (int i = 0; i < 4; ++i) ss += vals[4 * j + i] * vals[4 * j + i];
    }
    ss = wave_sum(ss);
    const float rstd = 1.0f / sqrtf(ss * (1.0f / 512.f) + 1e-6f);
    bf16_t* mo = MIX + (size_t)t * D;
#pragma unroll
    for (int j = 0; j < 2; ++j) {
      const int ch = lane * 4 + 256 * j;
      const float4 gg = *(const float4*)(p.g_conv + ch);
      st_bf4(mo + ch, vals[4 * j] * rstd * gg.x, vals[4 * j + 1] * rstd * gg.y, vals[4 * j + 2] * rstd * gg.z, vals[4 * j + 3] * rstd * gg.w);
    }
    const bf16_t* ao = AO + (size_t)t * 1024;
#pragma unroll
    for (int j = 0; j < 2; ++j) {
      const int idx = lane * 4 + 256 * j, h = idx >> 7, d = idx & 127;
      const float4 o0 = ld_bf4(ao + (2 * h) * 128 + d), o1 = ld_bf4(ao + (2 * h + 1) * 128 + d);
      float dv[4] = {o0.x - lam * o1.x, o0.y - lam * o1.y, o0.z - lam * o1.z, o0.w - lam * o1.w};
      float q = dv[0] * dv[0] + dv[1] * dv[1] + dv[2] * dv[2] + dv[3] * dv[3];
#pragma unroll
      for (int o = 1; o < 32; o <<= 1) q += __shfl_xor(q, o);
      const float r2 = 1.0f / sqrtf(q * (1.0f / 128.f) + 1e-5f);
      const float4 gg = *(const float4*)(p.g_subln + d);
      st_bf4(mo + 512 + idx, dv[0] * r2 * gg.x * 0.8f, dv[1] * r2 * gg.y * 0.8f, dv[2] * r2 * gg.z * 0.8f, dv[3] * r2 * gg.w * 0.8f);
    }
  }
}

__device__ __forceinline__ void phase_route(const P& p, int bid, int nb, const float* LG) {
  unsigned char* const ws_ = fresh_ws(p.ws);
  int* IDX = (int*)(ws_ + WS_IDX); float* WTS = (float*)(ws_ + WS_WTS); int* LIST = (int*)(ws_ + WS_LIST); int* cnt = (int*)(ws_ + WS_CTL);
  const int tid_ = tidx(), lane = tid_ & 63, wave = tid_ >> 6;
  for (int t = bid * NW + wave; t < T; t += nb * NW) {
    const float4 lg = *(const float4*)(LG + (size_t)t * 256 + lane * 4);
    const float4 bs = *(const float4*)(p.rbias + lane * 4);
    float sc[4], cv[4];
    sc[0] = 1.f / (1.f + expf(-lg.x)); sc[1] = 1.f / (1.f + expf(-lg.y)); sc[2] = 1.f / (1.f + expf(-lg.z)); sc[3] = 1.f / (1.f + expf(-lg.w));
    cv[0] = sc[0] + bs.x; cv[1] = sc[1] + bs.y; cv[2] = sc[2] + bs.z; cv[3] = sc[3] + bs.w;
    float m1 = -INFINITY, m2 = -INFINITY;
#pragma unroll
    for (int i = 0; i < 4; ++i) { const float v = cv[i]; if (v > m1) { m2 = m1; m1 = v; } else if (v > m2) m2 = v; }
#pragma unroll
    for (int off = 1; off < 8; off <<= 1) {
      const float o1 = __shfl_xor(m1, off), o2 = __shfl_xor(m2, off);
      const float n1 = fmaxf(m1, o1), n2 = fmaxf(fminf(m1, o1), fmaxf(m2, o2));
      m1 = n1; m2 = n2;
    }
    const float gs = m1 + m2; const int g = lane >> 3; int rank = 0;
#pragma unroll
    for (int gg = 0; gg < 8; ++gg) { const float og = __shfl(gs, gg * 8); rank += (og > gs || (og == gs && gg < g)) ? 1 : 0; }
    const bool sel = rank < 4;
#pragma unroll
    for (int i = 0; i < 4; ++i) cv[i] = sel ? cv[i] : -INFINITY;
    int my_e = 0; float my_w = 0.f;
#pragma unroll
    for (int k = 0; k < 8; ++k) {
      float bv = cv[0]; int bi = 0;
#pragma unroll
      for (int i = 1; i < 4; ++i) if (cv[i] > bv) { bv = cv[i]; bi = i; }
      int gi = lane * 4 + bi;
#pragma unroll
      for (int off = 32; off >= 1; off >>= 1) {
        const float ov = __shfl_xor(bv, off); const int oi = __shfl_xor(gi, off);
        if (ov > bv || (ov == bv && oi < gi)) { bv = ov; gi = oi; }
      }
      const int sub = gi & 3, own = gi >> 2;
      const float mine = sub == 0 ? sc[0] : sub == 1 ? sc[1] : sub == 2 ? sc[2] : sc[3];
      const float wv = __shfl(mine, own);
      if (lane == own) {
#pragma unroll
        for (int i = 0; i < 4; ++i) if (sub == i) cv[i] = -INFINITY;
      }
      if (lane == k) { my_e = gi; my_w = wv; }
    }
    float sum = (lane < 8) ? my_w : 0.f;
    sum += __shfl_xor(sum, 1); sum += __shfl_xor(sum, 2); sum += __shfl_xor(sum, 4);
    if (lane < 8) {
      const float w = my_w / (sum + 1e-20f) * 2.5f;
      IDX[t * 8 + lane] = my_e; WTS[t * 8 + lane] = w;
      const int pos = atomicAdd(&cnt[my_e * CNT_STRIDE], 1);
      LIST[(size_t)my_e * LISTCAP + pos] = t * 8 + lane;
    }
  }
}

__device__ __forceinline__ void phase_final(const P& p, int bid, int nb) {
  unsigned char* const ws_ = fresh_ws(p.ws);
  const float* X1 = (const float*)(ws_ + WS_X1); const float* SL = (const float*)(ws_ + WS_SLAB); const float* ada = (const float*)(ws_ + WS_ADA);
  const int tid_ = tidx(), lane = tid_ & 63, wave = tid_ >> 6;
  for (int t = bid * NW + wave; t < T; t += nb * NW) {
    const int b = t / SEQ;
    float4 v[4]; float s = 0.f;
#pragma unroll
    for (int j = 0; j < 4; ++j) {
      const int c0 = lane * 4 + 256 * j;
      float4 y = make_float4(0, 0, 0, 0);
#pragma unroll
      for (int k = 0; k < 8; ++k) { const float4 z = *(const float4*)(SL + (size_t)(t * 8 + k) * D + c0); y.x += z.x; y.y += z.y; y.z += z.z; y.w += z.w; }
      const float4 gt = *(const float4*)(ada + b * 6144 + 5120 + c0);
      const float4 bx = *(const float4*)(X1 + (size_t)t * D + c0);
      v[j] = make_float4(bx.x + gt.x * y.x, bx.y + gt.y * y.y, bx.z + gt.z * y.z, bx.w + gt.w * y.w);
      s += v[j].x * v[j].x + v[j].y * v[j].y + v[j].z * v[j].z + v[j].w * v[j].w;
    }
    s = wave_sum(s);
    const float rstd = 1.0f / sqrtf(s * (1.0f / D) + 1e-6f);
#pragma unroll
    for (int j = 0; j < 4; ++j) {
      const int c0 = lane * 4 + 256 * j;
      const float4 gg = *(const float4*)(p.g_final + c0);
      *(float4*)(p.out + (size_t)t * D + c0) = make_float4(v[j].x * rstd * gg.x, v[j].y * rstd * gg.y, v[j].z * rstd * gg.z, v[j].w * rstd * gg.w);
    }
  }
}

#if DIAG_EXACT_ROUTING
namespace diag {
constexpr size_t DW_HN = 64 * MiB, DW_PROJ = 128 * MiB, DW_AO = 320 * MiB, DW_X1 = 384 * MiB, DW_LOGITS = WS_LOGITS;
__device__ __forceinline__ void modnorm(const P& p, int bid, int nb, const float* in, const float* g, int sh_off, int sc_off, float* outp) {
  unsigned char* const ws_ = fresh_ws(p.ws);
  const int tid_ = tidx(), lane = tid_ & 63, wave = tid_ >> 6;
  const float* ada = (const float*)(ws_ + WS_ADA);
  for (int t = bid * NW + wave; t < T; t += nb * NW) {
    const int b = t / SEQ;
    const float4* xr = (const float4*)(in + (size_t)t * D) + lane;
    float4 v[4]; float s = 0.f;
#pragma unroll
    for (int j = 0; j < 4; ++j) { v[j] = xr[64 * j]; s += v[j].x * v[j].x + v[j].y * v[j].y + v[j].z * v[j].z + v[j].w * v[j].w; }
    s = wave_sum(s);
    const float rstd = 1.0f / sqrtf(s * (1.0f / D) + 1e-6f);
    float4* o = (float4*)(outp + (size_t)t * D) + lane;
#pragma unroll
    for (int j = 0; j < 4; ++j) {
      const int c0 = lane * 4 + 256 * j;
      const float4 gg = *(const float4*)(g + c0);
      const float4 sc = *(const float4*)(ada + b * 6144 + sc_off + c0);
      const float4 sh = *(const float4*)(ada + b * 6144 + sh_off + c0);
      float4 r;
      r.x = v[j].x * rstd * gg.x * (1.f + sc.x) + sh.x; r.y = v[j].y * rstd * gg.y * (1.f + sc.y) + sh.y;
      r.z = v[j].z * rstd * gg.z * (1.f + sc.z) + sh.z; r.w = v[j].w * rstd * gg.w * (1.f + sc.w) + sh.w;
      o[64 * j] = r;
    }
  }
}
__device__ __forceinline__ void inproj(const P& p, int bid, int nb, float* lds) {
  unsigned char* const ws_ = fresh_ws(p.ws);
  const float* HN = (const float*)(ws_ + DW_HN); float* PR = (float*)(ws_ + DW_PROJ);
  for (int it = bid; it < (T / 128) * (DPROJ / 64); it += nb) {
    const int mt = it / (DPROJ / 64), nt = it % (DPROJ / 64), m0 = mt * 128;
    auto af = [&](int r, int k) { return *(const float4*)(HN + (size_t)(m0 + r) * D + k); };
    auto ef = [&](int r, int col, float v, float) { PR[(size_t)(m0 + r) * DPROJ + col] = v; };
    gemm_tile_naive<false>(af, 128, p.w_in, nullptr, DPROJ, nt * 64, D, ef, lds);
  }
}
__device__ __forceinline__ void rope(const P& p, int bid, int nb) {
  unsigned char* const ws_ = fresh_ws(p.ws);
  float* PR = (float*)(ws_ + DW_PROJ);
  const float* ct = (const float*)(ws_ + WS_COS); const float* st = (const float*)(ws_ + WS_SIN);
  for (int i = bid * NT + tidx(); i < T * 128; i += nb * NT) {
    const int t = i >> 7, r = i & 127, which = r >> 6, hc = (r >> 3) & 7, f = r & 7;
    float* base = PR + (size_t)t * DPROJ + (which ? COL_K : COL_Q) + hc * 64;
    const float t1 = base[f], t2 = base[8 + f], c = ct[t * 8 + f], s = st[t * 8 + f];
    base[f] = t1 * c - t2 * s; base[8 + f] = t2 * c + t1 * s;
  }
}
__device__ __forceinline__ void attn(const P& p, int bid, int nb) {
  unsigned char* const ws_ = fresh_ws(p.ws);
  const float* PR = (const float*)(ws_ + DW_PROJ); float* AO = (float*)(ws_ + DW_AO);
  const int tid_ = tidx(), lane = tid_ & 63, wave = tid_ >> 6;
  for (int it0 = bid * NW + wave; it0 < 4096; it0 += nb * NW) {
    const int it = __builtin_amdgcn_readfirstlane(it0);
    const int qc = 63 - (it >> 6), rest = it & 63, vh = rest & 1, bh = rest >> 1, b = bh >> 3, hc = bh & 7, h = hc >> 1;
    const int qi = qc * 64 + lane;
    const float* qp = PR + (size_t)(b * SEQ + qi) * DPROJ + COL_Q + hc * 64;
    float q[64], o[64];
#pragma unroll
    for (int d = 0; d < 64; d += 4) { const float4 v = *(const float4*)(qp + d); q[d] = v.x * 0.125f; q[d + 1] = v.y * 0.125f; q[d + 2] = v.z * 0.125f; q[d + 3] = v.w * 0.125f; }
#pragma unroll
    for (int d = 0; d < 64; ++d) o[d] = 0.f;
    float m = -INFINITY, l = 0.f;
    const float* kbase = PR + (size_t)(b * SEQ) * DPROJ + COL_K + hc * 64;
    const float* vbase = PR + (size_t)(b * SEQ) * DPROJ + COL_V + h * 128 + vh * 64;
    const int jmax = qc * 64 + 63;
    for (int j = 0; j <= jmax; ++j) {
      const float* kr = kbase + (size_t)j * DPROJ; const float* vr = vbase + (size_t)j * DPROJ;
      float s = 0.f;
#pragma unroll
      for (int d = 0; d < 64; d += 4) { const float4 kv = *(const float4*)(kr + d); s += q[d] * kv.x; s += q[d + 1] * kv.y; s += q[d + 2] * kv.z; s += q[d + 3] * kv.w; }
      if (j <= qi) {
        const float mn = fmaxf(m, s), a = expf(m - mn), pp = expf(s - mn);
        l = l * a + pp;
#pragma unroll
        for (int d = 0; d < 64; d += 4) { const float4 vv = *(const float4*)(vr + d); o[d] = o[d] * a + pp * vv.x; o[d + 1] = o[d + 1] * a + pp * vv.y; o[d + 2] = o[d + 2] * a + pp * vv.z; o[d + 3] = o[d + 3] * a + pp * vv.w; }
        m = mn;
      }
    }
    const float inv = 1.0f / l;
    float* op = AO + (size_t)(b * SEQ + qi) * 1024 + hc * 128 + vh * 64;
#pragma unroll
    for (int d = 0; d < 64; d += 4) *(float4*)(op + d) = make_float4(o[d] * inv, o[d + 1] * inv, o[d + 2] * inv, o[d + 3] * inv);
  }
}
__device__ __forceinline__ void mix(const P& p, int bid, int nb) {
  unsigned char* const ws_ = fresh_ws(p.ws);
  const float* PR = (const float*)(ws_ + DW_PROJ); const float* AO = (const float*)(ws_ + DW_AO); float* MIX = (float*)(ws_ + DW_HN);
  const float lam = ((const float*)(ws_ + WS_MISC))[0];
  const int tid_ = tidx(), lane = tid_ & 63, wave = tid_ >> 6;
  for (int t = bid * NW + wave; t < T; t += nb * NW) {
    const int s = t % SEQ;
    const float* r0 = PR + (size_t)t * DPROJ;
    float vals[8]; float ss = 0.f;
#pragma unroll
    for (int j = 0; j < 2; ++j) {
      const int ch = lane * 4 + 256 * j;
      const float4 h0 = *(const float4*)(r0 + COL_H + ch), c0 = *(const float4*)(r0 + COL_C + ch), bg = *(const float4*)(r0 + COL_B + ch);
      float4 h1 = make_float4(0, 0, 0, 0), c1 = h1, h2 = h1, c2 = h1;
      if (s >= 1) { h1 = *(const float4*)(r0 - DPROJ + COL_H + ch); c1 = *(const float4*)(r0 - DPROJ + COL_C + ch); }
      if (s >= 2) { h2 = *(const float4*)(r0 - 2 * DPROJ + COL_H + ch); c2 = *(const float4*)(r0 - 2 * DPROJ + COL_C + ch); }
      const float4 w0 = *(const float4*)(p.conv_w + ch), w1 = *(const float4*)(p.conv_w + 512 + ch), w2 = *(const float4*)(p.conv_w + 1024 + ch);
      float y;
      y = w0.x * (c2.x * h2.x) + w1.x * (c1.x * h1.x) + w2.x * (c0.x * h0.x); vals[4 * j + 0] = bg.x * y;
      y = w0.y * (c2.y * h2.y) + w1.y * (c1.y * h1.y) + w2.y * (c0.y * h0.y); vals[4 * j + 1] = bg.y * y;
      y = w0.z * (c2.z * h2.z) + w1.z * (c1.z * h1.z) + w2.z * (c0.z * h0.z); vals[4 * j + 2] = bg.z * y;
      y = w0.w * (c2.w * h2.w) + w1.w * (c1.w * h1.w) + w2.w * (c0.w * h0.w); vals[4 * j + 3] = bg.w * y;
#pragma unroll
      for (int i = 0; i < 4; ++i) ss += vals[4 * j + i] * vals[4 * j + i];
    }
    ss = wave_sum(ss);
    const float rstd = 1.0f / sqrtf(ss * (1.0f / 512.f) + 1e-6f);
    float* mo = MIX + (size_t)t * D;
#pragma unroll
    for (int j = 0; j < 2; ++j) {
      const int ch = lane * 4 + 256 * j;
      const float4 gg = *(const float4*)(p.g_conv + ch);
      *(float4*)(mo + ch) = make_float4(vals[4 * j] * rstd * gg.x, vals[4 * j + 1] * rstd * gg.y, vals[4 * j + 2] * rstd * gg.z, vals[4 * j + 3] * rstd * gg.w);
    }
    const float* ao = AO + (size_t)t * 1024;
#pragma unroll
    for (int j = 0; j < 2; ++j) {
      const int idx = lane * 4 + 256 * j, h = idx >> 7, d = idx & 127;
      const float4 o0 = *(const float4*)(ao + (2 * h) * 128 + d), o1 = *(const float4*)(ao + (2 * h + 1) * 128 + d);
      float dv[4] = {o0.x - lam * o1.x, o0.y - lam * o1.y, o0.z - lam * o1.z, o0.w - lam * o1.w};
      float q = dv[0] * dv[0] + dv[1] * dv[1] + dv[2] * dv[2] + dv[3] * dv[3];
#pragma unroll
      for (int o = 1; o < 32; o <<= 1) q += __shfl_xor(q, o);
      const float r2 = 1.0f / sqrtf(q * (1.0f / 128.f) + 1e-5f);
      const float4 gg = *(const float4*)(p.g_subln + d);
      *(float4*)(mo + 512 + idx) = make_float4(dv[0] * r2 * gg.x * 0.8f, dv[1] * r2 * gg.y * 0.8f, dv[2] * r2 * gg.z * 0.8f, dv[3] * r2 * gg.w * 0.8f);
    }
  }
}
__device__ __forceinline__ void outproj(const P& p, int bid, int nb, float* lds) {
  unsigned char* const ws_ = fresh_ws(p.ws);
  const float* MIX = (const float*)(ws_ + DW_HN); float* X1 = (float*)(ws_ + DW_X1); const float* ada = (const float*)(ws_ + WS_ADA);
  for (int it = bid; it < (T / 128) * (D / 64); it += nb) {
    const int mt = it / (D / 64), nt = it % (D / 64), m0 = mt * 128, b = m0 / SEQ;
    auto af = [&](int r, int k) { return *(const float4*)(MIX + (size_t)(m0 + r) * D + k); };
    auto ef = [&](int r, int col, float v, float) { const size_t o = (size_t)(m0 + r) * D + col; X1[o] = p.x[o] + ada[b * 6144 + 2048 + col] * v; };
    gemm_tile_naive<false>(af, 128, p.w_out, nullptr, D, nt * 64, D, ef, lds);
  }
}
__device__ __forceinline__ void router(const P& p, int bid, int nb, float* lds) {
  unsigned char* const ws_ = fresh_ws(p.ws);
  const float* HN = (const float*)(ws_ + DW_HN); float* LG = (float*)(ws_ + DW_LOGITS);
  for (int it = bid; it < (T / 128) * 4; it += nb) {
    const int mt = it >> 2, r4 = it & 3, m0 = mt * 128;
    auto af = [&](int r, int k) { return *(const float4*)(HN + (size_t)(m0 + r) * D + k); };
    auto ef = [&](int r, int col, float v, float) { LG[(size_t)(m0 + r) * 256 + col] = v; };
    gemm_tile_naive<false>(af, 128, p.w_router, nullptr, 256, r4 * 64, D, ef, lds);
  }
}
}
#endif

namespace attn_body {
using bf16=__hip_bfloat16;
using bf16x8=__attribute__((ext_vector_type(8)))short;
using s16x4=__attribute__((ext_vector_type(4)))short;
using f32x16=__attribute__((ext_vector_type(16)))float;
using u32x4=__attribute__((ext_vector_type(4)))unsigned;
constexpr int BATCH=4,NHEAD=8,SEQ=4096,D=64,PQ=3072,PO=1024;
constexpr int NW=8,QBLK=32,QB=QBLK*NW,KVBLK=64,NQB=SEQ/QB;
constexpr int ATTN_UNIT_ROWS=QB;
__device__ __forceinline__ int crow(int r,int hi){return (r&3)+8*(r>>2)+4*hi;}
#define SBAR() __builtin_amdgcn_sched_barrier(0)
__device__ __forceinline__ void cmask(f32x16&p0,f32x16&p1,int jb,int qrel,int hi){
  const float NEG=-INFINITY; int kb=64*jb+4*hi;
  #pragma unroll
  for(int r=0;r<16;++r){int kv=kb+(r&3)+8*(r>>2); if(kv>qrel)p0[r]=NEG; if(kv+32>qrel)p1[r]=NEG;}
}

constexpr int NSLOT=3, SLOTB=8192;
constexpr int LDS_K=0, LDS_V=NSLOT*SLOTB, LDS_WS=2*NSLOT*SLOTB, LDS_OST=LDS_WS+NW*64*4, LDS_BYTES=LDS_OST+NW*4096;
constexpr float C2=0.125f*1.4426950408889634f;
__device__ __forceinline__ void glds16(const void*gsrc,unsigned lds_dst){unsigned keep;
  asm volatile("s_mov_b32 %0, m0\n\ts_mov_b32 m0, %2\n\ts_nop 0\n\tglobal_load_lds_dwordx4 %1, off\n\ts_mov_b32 m0, %0":"=&s"(keep):"v"(gsrc),"s"(lds_dst):"memory");}
__device__ __forceinline__ float max3f(float a,float b,float c){float r;asm("v_max3_f32 %0, %1, %2, %3":"=v"(r):"v"(a),"v"(b),"v"(c));return r;}
__device__ __forceinline__ float max2f(float a,float b){float r;asm("v_max_f32_e32 %0, %1, %2":"=v"(r):"v"(a),"v"(b));return r;}
__device__ __forceinline__ float fadd_s(float a,float b){float r;asm("v_add_f32_e32 %0, %1, %2":"=v"(r):"v"(a),"v"(b));return r;}
__device__ __forceinline__ float fsub_s(float a,float b){float r;asm("v_sub_f32_e32 %0, %1, %2":"=v"(r):"v"(a),"v"(b));return r;}
typedef float f32x2_t __attribute__((ext_vector_type(2))); typedef __bf16 bf16x2_t __attribute__((ext_vector_type(2)));
__device__ __forceinline__ unsigned cvtpk_s(float lo,float hi){f32x2_t v={lo,hi};bf16x2_t b=__builtin_convertvector(v,bf16x2_t);return __builtin_bit_cast(unsigned,b);}
#define WAIT_BAR(N) asm volatile("s_waitcnt vmcnt(" #N ") lgkmcnt(0)\n\ts_barrier":::"memory")

__device__ __forceinline__ void qkt(f32x16&p0,f32x16&p1,const char*Kslot,const bf16x8*qr,const f32x16&negm,int r32,int hi){
  const char*kb=Kslot+hi*1024+r32*16;
  #pragma unroll
  for(int d0=0;d0<4;++d0){
    const bf16x8 b0=*reinterpret_cast<const bf16x8*>(kb+d0*2048);
    const bf16x8 b1=*reinterpret_cast<const bf16x8*>(kb+d0*2048+512);
    if(d0==0){p0=__builtin_amdgcn_mfma_f32_32x32x16_bf16(b0,qr[0],negm,0,0,0);p1=__builtin_amdgcn_mfma_f32_32x32x16_bf16(b1,qr[0],negm,0,0,0);}
    else{p0=__builtin_amdgcn_mfma_f32_32x32x16_bf16(b0,qr[d0],p0,0,0,0);p1=__builtin_amdgcn_mfma_f32_32x32x16_bf16(b1,qr[d0],p1,0,0,0);}}
}
typedef __attribute__((address_space(3))) const char* lds_cptr;
typedef short v4i16_t __attribute__((ext_vector_type(4)));
__device__ __forceinline__ void kload8(bf16x8*kf,lds_cptr kp){
  kf[0]=*(const __attribute__((address_space(3))) bf16x8*)(kp);      kf[1]=*(const __attribute__((address_space(3))) bf16x8*)(kp+512);
  kf[2]=*(const __attribute__((address_space(3))) bf16x8*)(kp+2048); kf[3]=*(const __attribute__((address_space(3))) bf16x8*)(kp+2560);
  kf[4]=*(const __attribute__((address_space(3))) bf16x8*)(kp+4096); kf[5]=*(const __attribute__((address_space(3))) bf16x8*)(kp+4608);
  kf[6]=*(const __attribute__((address_space(3))) bf16x8*)(kp+6144); kf[7]=*(const __attribute__((address_space(3))) bf16x8*)(kp+6656);
}
__device__ __forceinline__ void kload2(bf16x8*kf,lds_cptr kp,int j){ kf[2*j]=*(const __attribute__((address_space(3))) bf16x8*)(kp+j*2048); kf[2*j+1]=*(const __attribute__((address_space(3))) bf16x8*)(kp+j*2048+512); }
__device__ __forceinline__ s16x4 vtr(lds_cptr p){ return __builtin_bit_cast(s16x4,__builtin_amdgcn_ds_read_tr16_b64_v4i16((__attribute__((address_space(3))) v4i16_t*)p)); }
__device__ __forceinline__ float rowmax(const f32x16&p0,const f32x16&p1){
  float a=max3f(p0[0],p0[1],p1[0]),b=max3f(p0[2],p0[3],p1[1]);a=max3f(a,p1[2],p1[3]);
  #pragma unroll
  for(int r=4;r<16;r+=4){a=max3f(a,p0[r],p0[r+1]);b=max3f(b,p0[r+2],p0[r+3]);a=max3f(a,p1[r],p1[r+1]);b=max3f(b,p1[r+2],p1[r+3]);}
  const float m=max2f(a,b);
  auto rr=__builtin_amdgcn_permlane32_swap(__float_as_uint(m),__float_as_uint(m),false,false);
  return max2f(__uint_as_float(rr[0]),__uint_as_float(rr[1]));
}
__device__ __forceinline__ void pv(f32x16*o,int vb,bf16x8 pa0,bf16x8 pa1,bf16x8 pa2,bf16x8 pa3){
  #pragma unroll
  for(int d0=0;d0<2;++d0){s16x4 lo[4],hi[4];
    #pragma unroll
    for(int ks=0;ks<4;++ks){
      asm volatile("ds_read_b64_tr_b16 %0,%1 offset:%c2":"=&v"(lo[ks]):"v"(vb),"i"(d0*4096+ks*1024):"memory");
      asm volatile("ds_read_b64_tr_b16 %0,%1 offset:%c2":"=&v"(hi[ks]):"v"(vb),"i"(d0*4096+ks*1024+512):"memory");}
    asm volatile("s_waitcnt lgkmcnt(0)":::"memory");SBAR();
    #define PK(k) (bf16x8){lo[k][0],lo[k][1],lo[k][2],lo[k][3],hi[k][0],hi[k][1],hi[k][2],hi[k][3]}
    o[d0]=__builtin_amdgcn_mfma_f32_32x32x16_bf16(pa0,PK(0),o[d0],0,0,0);
    o[d0]=__builtin_amdgcn_mfma_f32_32x32x16_bf16(pa1,PK(1),o[d0],0,0,0);
    o[d0]=__builtin_amdgcn_mfma_f32_32x32x16_bf16(pa2,PK(2),o[d0],0,0,0);
    o[d0]=__builtin_amdgcn_mfma_f32_32x32x16_bf16(pa3,PK(3),o[d0],0,0,0);
    #undef PK
  }
}

#ifndef ATTN_STORE16
#define ATTN_STORE16(p,v) (*(u32x4*)(p)=(v))
#endif
template<int THRL> __device__ __forceinline__ void attn_unit(int b,int h,int hv,int ho,int qb,const bf16*Q,const bf16*__restrict__ K,const bf16*__restrict__ V,bf16*O,char*shm){
  const int tid=tidx(),lane=tid&63,r32=lane&31,hi=lane>>5; const int wid=__builtin_amdgcn_readfirstlane(tid>>6);
  const long rowbase=(long)b*SEQ; const int q0=qb*QB;
  const bf16*Qw=Q+(rowbase+q0+wid*QBLK)*PQ+h*D;
  const bf16*Kh=K+rowbase*PQ+h*D,*Vh=V+rowbase*PQ+hv*D;
  const unsigned lds0=(unsigned)(uintptr_t)shm;
  float*wsf=(float*)(shm+LDS_WS)+wid*64;
  const bf16*ksrc=Kh+(long)lane*PQ+wid*8;
  const bf16*vsrc=Vh+(long)(16*(wid&3)+(lane>>2))*PQ+(wid>>2)*32+(lane&3)*8;
  const unsigned kdst=lds0+LDS_K+wid*1024, vdst=lds0+LDS_V+wid*1024;
  #define DMA_K(t,slot) glds16(ksrc+(long)(t)*KVBLK*PQ,(unsigned)__builtin_amdgcn_readfirstlane(kdst+(slot)))
  #define DMA_V(t,slot) glds16(vsrc+(long)(t)*KVBLK*PQ,(unsigned)__builtin_amdgcn_readfirstlane(vdst+(slot)))
  const int vb0=(int)(lds0+LDS_V)+((lane>>4)&1)*32+(lane&3)*8+(4*hi+((lane&15)>>2))*64;
  const char*Kbase=shm+LDS_K; bf16x8 kf[8];
  const lds_cptr shm3=(lds_cptr)shm; const lds_cptr kp0=shm3+LDS_K+hi*1024+r32*16; const lds_cptr vp0=shm3+LDS_V+((lane>>4)&1)*32+(lane&3)*8+(4*hi+((lane&15)>>2))*64;
  const int NT=(q0+QB)/KVBLK;
  DMA_K(0,0);DMA_V(0,0);DMA_K(1,SLOTB);
  bf16x8 qr[4];
  #pragma unroll
  for(int d0=0;d0<4;++d0)qr[d0]=*reinterpret_cast<const bf16x8*>(&Qw[(long)r32*PQ+d0*16+hi*8]);
  float mhat=0.f,l_reg=0.f;f32x16 o[2];o[0]=f32x16{};o[1]=f32x16{};f32x16 negm=f32x16{};asm volatile("":"+v"(negm));
  const int qrel=wid*QBLK+r32;
  #define CMASK(P0,P1,t) do{int jb_=(t)-(NT-4); if(jb_>=0)cmask(P0,P1,jb_,qrel,hi);}while(0)
  bool resc=false;
  #define START(P0,P1) do{ const float rm=rowmax(P0,P1); resc=false; \
    { const float dl=rm; mhat=fadd_s(mhat,dl); \
      _Pragma("unroll") for(int r=0;r<16;++r){P0[r]=fsub_s(P0[r],dl);P1[r]=fsub_s(P1[r],dl);} \
      _Pragma("unroll") for(int r=0;r<16;++r)negm[r]=-mhat; asm volatile("":"+v"(negm)); } \
    _Pragma("unroll") for(int r=0;r<16;++r)P0[r]=__builtin_amdgcn_exp2f(P0[r]); }while(0)
  #define RESC() do{ if(resc){ asm volatile("s_waitcnt lgkmcnt(0)":::"memory"); \
      _Pragma("unroll") for(int d_=0;d_<2;++d_) _Pragma("unroll") for(int r=0;r<16;++r)o[d_][r]*=wsf[crow(r,hi)]; } }while(0)
  f32x16 pA0,pA1,pB0,pB1;
  int sl_prev=0,sl_cur=0,sl_next=SLOTB;
  #define ROT() do{sl_prev=sl_cur;sl_cur=sl_next;sl_next=(sl_next==(NSLOT-1)*SLOTB)?0:sl_next+SLOTB;}while(0)
  DMA_K(2,2*SLOTB);
  WAIT_BAR(3);
  qkt(pA0,pA1,Kbase,qr,negm,r32,hi);asm volatile("s_nop 15\n\ts_nop 7":"+v"(pA0),"+v"(pA1));CMASK(pA0,pA1,0);
  START(pA0,pA1);
  _Pragma("unroll") for(int r=0;r<16;++r)pA1[r]=__builtin_amdgcn_exp2f(pA1[r]);
  WAIT_BAR(0);
  DMA_K(3,0);DMA_V(1,SLOTB);
  ROT();
  kload8(kf,kp0+sl_cur);
  WAIT_BAR(2);
  s16x4 vlo[8],vhi[8]; u32x4 pw0,pw1,pw2,pw3;
  #define PKW(P,B) cvtpk_s(P[B],P[B+1])
  #define PAF(k) __builtin_bit_cast(bf16x8,pw##k)
  #define VFR(i) (bf16x8){vlo[i][0],vlo[i][1],vlo[i][2],vlo[i][3],vhi[i][0],vhi[i][1],vhi[i][2],vhi[i][3]}
  #define PIN(x) asm volatile("":"+v"(x))
  #define MX3(a,b,c) __builtin_fmaxf(__builtin_fmaxf((a),(b)),(c))
  #define GAPA(MF,A0,A1,A2,A3,W0,W1,PW) do{ MF; sacc+=A0; sacc+=A1; sacc+=A2; sacc+=A3; PIN(sacc); W0; W1; PIN(PW); SBAR(); }while(0)
  #define EX(v) __builtin_amdgcn_exp2f(v)
  #define GAPB(MF,X,B) do{ MF; X[B]=EX(X[B]); X[B+1]=EX(X[B+1]); X[B+2]=EX(X[B+2]); X[B+3]=EX(X[B+3]); PIN(X); SBAR(); }while(0)
  #define VRD(i) do{ vlo[i]=vtr(vp_+(((i)>>2)*4096+((i)&3)*1024)); vhi[i]=vtr(vp_+(((i)>>2)*4096+((i)&3)*1024+512)); }while(0)
  #define KRD(G,j) do{ if(G){ kload2(kf,kp0+sl_next,j); SBAR(); } }while(0)
  #define STEP(C0,C1,P0,P1,t,GK,GV,GL) do{ SBAR(); \
    const lds_cptr vp_=vp0+sl_prev; \
    VRD(0); SBAR(); float sacc=(P0[0]+P0[1]); \
    GAPA(C0=__builtin_amdgcn_mfma_f32_32x32x16_bf16(kf[0],qr[0],negm,0,0,0), P0[2],P0[3],P0[4],P0[5],     pw0[0]=PKW(P0,0), pw0[1]=PKW(P0,2), pw0); \
    VRD(4); SBAR(); GAPA(C1=__builtin_amdgcn_mfma_f32_32x32x16_bf16(kf[1],qr[0],negm,0,0,0), P0[6],P0[7],P0[8],P0[9],     pw0[2]=PKW(P0,4), pw0[3]=PKW(P0,6), pw0); \
    VRD(1); SBAR(); GAPA(C0=__builtin_amdgcn_mfma_f32_32x32x16_bf16(kf[2],qr[1],C0,0,0,0),   P0[10],P0[11],P0[12],P0[13], pw1[0]=PKW(P0,8), pw1[1]=PKW(P0,10), pw1); \
    VRD(5); SBAR(); GAPA(C1=__builtin_amdgcn_mfma_f32_32x32x16_bf16(kf[3],qr[1],C1,0,0,0),   P0[14],P0[15],P1[0],P1[1],   pw1[2]=PKW(P0,12),pw1[3]=PKW(P0,14), pw1); \
    VRD(2); SBAR(); GAPA(C0=__builtin_amdgcn_mfma_f32_32x32x16_bf16(kf[4],qr[2],C0,0,0,0),   P1[2],P1[3],P1[4],P1[5],     pw2[0]=PKW(P1,0), pw2[1]=PKW(P1,2), pw2); \
    VRD(6); SBAR(); GAPA(C1=__builtin_amdgcn_mfma_f32_32x32x16_bf16(kf[5],qr[2],C1,0,0,0),   P1[6],P1[7],P1[8],P1[9],     pw2[2]=PKW(P1,4), pw2[3]=PKW(P1,6), pw2); \
    VRD(3); SBAR(); GAPA(C0=__builtin_amdgcn_mfma_f32_32x32x16_bf16(kf[6],qr[3],C0,0,0,0),   P1[10],P1[11],P1[12],P1[13], pw3[0]=PKW(P1,8), pw3[1]=PKW(P1,10), pw3); \
    VRD(7); SBAR(); GAPA(C1=__builtin_amdgcn_mfma_f32_32x32x16_bf16(kf[7],qr[3],C1,0,0,0),   P1[14],P1[15],0.f,0.f,       pw3[2]=PKW(P1,12),pw3[3]=PKW(P1,14), pw3); \
    l_reg+=sacc; \
    if(GK){DMA_K((t)+3,sl_cur);} if(GV){DMA_V((t)+1,sl_next);} \
    CMASK(C0,C1,t); \
    { float a=MX3(C0[0],C0[1],C1[0]),b=MX3(C0[2],C0[3],C1[1]); a=MX3(a,C1[2],C1[3]); \
      _Pragma("unroll") for(int r=4;r<16;r+=4){a=MX3(a,C0[r],C0[r+1]);b=MX3(b,C0[r+2],C0[r+3]);a=MX3(a,C1[r],C1[r+1]);b=MX3(b,C1[r+2],C1[r+3]);} \
      float rm=__builtin_fmaxf(a,b); { auto rr=__builtin_amdgcn_permlane32_swap(__float_as_uint(rm),__float_as_uint(rm),false,false); rm=__builtin_fmaxf(__uint_as_float(rr[0]),__uint_as_float(rr[1])); } \
      resc=false; \
      if(__builtin_expect(__any(rm>(float)THRL),0)){ const float dl=__builtin_fmaxf(rm,0.f); mhat+=dl; \
        _Pragma("unroll") for(int r=0;r<16;++r){C0[r]-=dl;C1[r]-=dl;} \
        _Pragma("unroll") for(int r=0;r<16;++r)negm[r]=-mhat; asm volatile("":"+v"(negm)); \
        const float f=__builtin_amdgcn_exp2f(-dl); l_reg*=f; if(hi==0)wsf[r32]=f; resc=true; } } \
    SBAR(); \
    GAPB(o[0]=__builtin_amdgcn_mfma_f32_32x32x16_bf16(PAF(0),VFR(0),o[0],0,0,0), C0,0); \
    GAPB(o[1]=__builtin_amdgcn_mfma_f32_32x32x16_bf16(PAF(0),VFR(4),o[1],0,0,0), C0,4); \
    KRD(GL,0); GAPB(o[0]=__builtin_amdgcn_mfma_f32_32x32x16_bf16(PAF(1),VFR(1),o[0],0,0,0), C0,8); \
    KRD(GL,1); GAPB(o[1]=__builtin_amdgcn_mfma_f32_32x32x16_bf16(PAF(1),VFR(5),o[1],0,0,0), C0,12); \
    KRD(GL,2); GAPB(o[0]=__builtin_amdgcn_mfma_f32_32x32x16_bf16(PAF(2),VFR(2),o[0],0,0,0), C1,0); \
    KRD(GL,3); GAPB(o[1]=__builtin_amdgcn_mfma_f32_32x32x16_bf16(PAF(2),VFR(6),o[1],0,0,0), C1,4); \
    GAPB(o[0]=__builtin_amdgcn_mfma_f32_32x32x16_bf16(PAF(3),VFR(3),o[0],0,0,0), C1,8); \
    GAPB(o[1]=__builtin_amdgcn_mfma_f32_32x32x16_bf16(PAF(3),VFR(7),o[1],0,0,0), C1,12); \
    }while(0)
  int t=1;
  #undef CMASK
  #define CMASK(P0,P1,t) do{}while(0)
  for(;t+5<NT;t+=2){
    STEP(pB0,pB1,pA0,pA1,t,true,true,true);     WAIT_BAR(2); RESC(); ROT();
    STEP(pA0,pA1,pB0,pB1,t+1,true,true,true);   WAIT_BAR(2); RESC(); ROT();
  }
  #undef CMASK
  #define CMASK(P0,P1,t) do{int jb_=(t)-(NT-4); if(jb_>=0)cmask(P0,P1,jb_,qrel,hi);}while(0)
  #define ENDW(tt) do{ if((tt)+3<NT){WAIT_BAR(2);} else if((tt)+2<NT){WAIT_BAR(1);} else {WAIT_BAR(0);} }while(0)
  for(;t+1<NT;t+=2){
    STEP(pB0,pB1,pA0,pA1,t,(t+3<NT),(t+1<NT),(t+1<NT));       ENDW(t);   RESC(); ROT();
    STEP(pA0,pA1,pB0,pB1,t+1,(t+4<NT),(t+2<NT),(t+2<NT));     ENDW(t+1); RESC(); ROT();
  }
  STEP(pB0,pB1,pA0,pA1,NT-1,false,false,false); RESC();
  { float sacc=pB0[0]+pB0[1]; _Pragma("unroll") for(int r=2;r<16;++r)sacc+=pB0[r]; _Pragma("unroll") for(int r=0;r<16;++r)sacc+=pB1[r]; l_reg+=sacc;
    pw0=(u32x4){PKW(pB0,0),PKW(pB0,2),PKW(pB0,4),PKW(pB0,6)};pw1=(u32x4){PKW(pB0,8),PKW(pB0,10),PKW(pB0,12),PKW(pB0,14)};pw2=(u32x4){PKW(pB1,0),PKW(pB1,2),PKW(pB1,4),PKW(pB1,6)};pw3=(u32x4){PKW(pB1,8),PKW(pB1,10),PKW(pB1,12),PKW(pB1,14)};
    SBAR(); pv(o,vb0+sl_cur,PAF(0),PAF(1),PAF(2),PAF(3)); }
  #undef PKW
  #undef PAF
  #undef VFR
  #undef PIN
  #undef MX3
  #undef GAPA
  #undef GAPB
  #undef EX
  #undef VRD
  #undef KRD
  #undef STEP
  #undef ENDW
  {auto rr=__builtin_amdgcn_permlane32_swap(__float_as_uint(l_reg),__float_as_uint(l_reg),false,false);l_reg=__uint_as_float(rr[0])+__uint_as_float(rr[1]);}
  if(hi==0)wsf[32+r32]=l_reg;asm volatile("s_waitcnt lgkmcnt(0)":::"memory");
  float rli[16];
  #pragma unroll
  for(int r=0;r<16;++r)rli[r]=__builtin_amdgcn_rcpf(wsf[32+crow(r,hi)]);
  bf16*Ow=O+(rowbase+q0+wid*QBLK)*PO+ho*D;
  { bf16*stg=(bf16*)(shm+LDS_OST)+wid*2048;
    #pragma unroll
    for(int r=0;r<16;++r){const int orow=crow(r,hi);
      #pragma unroll
      for(int d0=0;d0<2;++d0)stg[orow*64+d0*32+r32]=__float2bfloat16(o[d0][r]*rli[r]);}
    asm volatile("s_waitcnt lgkmcnt(0)":::"memory");
    #pragma unroll
    for(int i=0;i<4;++i){const int row=i*8+(lane>>3),ch=lane&7; const u32x4 v=*(const u32x4*)(stg+row*64+ch*8); ATTN_STORE16(Ow+(long)row*PO+ch*8,v);} }
  asm volatile("s_waitcnt lgkmcnt(0)\n\ts_barrier":::"memory");
  #undef DMA_K
  #undef DMA_V
  #undef CMASK
  #undef START
  #undef RESC
  #undef ROT
}
constexpr int ATTN_LDS_BYTES=LDS_BYTES;
struct AttnTensors { const bf16* Q; const bf16* K; const bf16* V; bf16* O; };
template<int THRL=8> __device__ __forceinline__ void attn_phase_unit(char*lds,const AttnTensors&T,int vcu,int i){
  const int bh=vcu>>3,s=vcu&7,b=bh>>3,hc=bh&7;
  const int qb=(i<2)?15-s:s, half=i&1; attn_unit<THRL>(b,hc,(hc>>1)*2+half,2*hc+half,qb,T.Q,T.K,T.V,T.O,lds);
}
#undef SBAR
#undef WAIT_BAR
}

__device__ __forceinline__ void convert_slice(const P& p, int part, int nparts, int sl) {
  unsigned char* const ws_ = fresh_ws(p.ws);
  const int tid = tidx();
  bf16_t* WE1 = (bf16_t*)(ws_ + WS_WE1); bf16_t* WE2 = (bf16_t*)(ws_ + WS_WE2);
  constexpr int UN = 8;
  const unsigned stride = (unsigned)nparts * NT;
  const unsigned cbeg = (unsigned)(sl & 3) << 22, cend = cbeg + (1u << 22);
  if (sl < 4) {
    for (unsigned ch0 = cbeg + (unsigned)part * NT + tid; ch0 < cend; ch0 += stride * UN) {
      f32x4 a[UN], b[UN];
#pragma unroll
      for (int u = 0; u < UN; ++u) {
        const unsigned ch = ch0 + u * stride;
        if (ch < cend) {
          const int h8 = (int)(ch & 31), k = (int)((ch >> 5) & 1023), mat = (int)((ch >> 15) & 1), e = (int)(ch >> 16);
          const float* src = (mat ? p.wu_e : p.wg_e) + ((size_t)e * D + k) * DE + 8 * h8;
          a[u] = __builtin_nontemporal_load((const f32x4*)src); b[u] = __builtin_nontemporal_load((const f32x4*)(src + 4));
        }
      }
#pragma unroll
      for (int u = 0; u < UN; ++u) {
        const unsigned ch = ch0 + u * stride;
        if (ch < cend) {
          const int h8 = (int)(ch & 31), k = (int)((ch >> 5) & 1023), mat = (int)((ch >> 15) & 1), e = (int)(ch >> 16);
          const int h = 8 * h8, sub = h >> 7, hl = h & 127, c = 64 * (hl >> 5) + 32 * mat + (hl & 31);
          const size_t blk = ((size_t)(e * 2 + sub) * 32 + (k >> 5)) * 8192;
          const int kk = k & 31, off = (c >> 5) * 1024 + (kk >> 3) * 256 + (kk & 7) * 32 + (c & 31);
          *(u32x4*)(WE1 + blk + off) = (u32x4){pk2(a[u][0], a[u][1]), pk2(a[u][2], a[u][3]), pk2(b[u][0], b[u][1]), pk2(b[u][2], b[u][3])};
        }
      }
    }
  } else {
    const unsigned cb2 = (unsigned)(sl - 4) << 22, ce2 = cb2 + (1u << 22);
    for (unsigned ch0 = cb2 + (unsigned)part * NT + tid; ch0 < ce2; ch0 += stride * UN) {
      f32x4 a[UN], b[UN];
#pragma unroll
      for (int u = 0; u < UN; ++u) {
        const unsigned ch = ch0 + u * stride;
        if (ch < ce2) {
          const int c8 = (int)(ch & 127), k = (int)((ch >> 7) & 255), e = (int)(ch >> 15);
          const float* src = p.wd_e + ((size_t)e * DE + k) * D + 8 * c8;
          a[u] = __builtin_nontemporal_load((const f32x4*)src); b[u] = __builtin_nontemporal_load((const f32x4*)(src + 4));
        }
      }
#pragma unroll
      for (int u = 0; u < UN; ++u) {
        const unsigned ch = ch0 + u * stride;
        if (ch < ce2) {
          const int c8 = (int)(ch & 127), k = (int)((ch >> 7) & 255), e = (int)(ch >> 15);
          const int col = 8 * c8, nt = col >> 8, c = col & 255;
          const size_t blk = ((size_t)(e * 4 + nt) * 8 + (k >> 5)) * 8192;
          const int kk = k & 31, off = (c >> 5) * 1024 + (kk >> 3) * 256 + (kk & 7) * 32 + (c & 31);
          *(u32x4*)(WE2 + blk + off) = (u32x4){pk2(a[u][0], a[u][1]), pk2(a[u][2], a[u][3]), pk2(b[u][0], b[u][1]), pk2(b[u][2], b[u][3])};
        }
      }
    }
  }
}

namespace moe {
typedef short bf16x8 __attribute__((ext_vector_type(8)));
typedef short s16x4 __attribute__((ext_vector_type(4)));
typedef float f32x16 __attribute__((ext_vector_type(16)));
typedef unsigned u32x2 __attribute__((ext_vector_type(2)));
constexpr int SLOT = 32768, L_ROWS = 131072, L_TS = 133120, L_CL = 134400;

template <int STAGE>
__device__ __forceinline__ void run(const P& p, int bid, int nb, LAS unsigned char* lds) {
  unsigned char* const ws_ = fresh_ws(p.ws);
  constexpr int NSUB = (STAGE == 1) ? 2 : 4, KTOT = (STAGE == 1) ? D : DE, NK = KTOT / 32;
  const int tid = tidx(), lane = tid & 63, r32 = lane & 31, hi = lane >> 5; const int wid = __builtin_amdgcn_readfirstlane(tid >> 6), wm = wid >> 2, wn = wid & 3;
  const int* cnt = (const int*)(ws_ + WS_CTL); const int* LIST = (const int*)(ws_ + WS_LIST);
  LAS int* ts = (LAS int*)(lds + L_TS); LAS int* cl = (LAS int*)(lds + L_CL);
  __syncthreads();
  if (tid < 256) cl[tid] = cnt[tid * CNT_STRIDE];
  __syncthreads();
  if (tid <= 256) { int a = 0; for (int i = 0; i < tid; ++i) a += (cl[i] + 255) >> 8; ts[tid] = a; }
  __syncthreads();
  const int nitems = ts[256] * NSUB;
  const int vcu = (nb % 8 == 0) ? (bid % 8) * (nb / 8) + bid / 8 : bid;
  const bf16_t* Asrc = (STAGE == 1) ? (const bf16_t*)(ws_ + WS_HNB) : (const bf16_t*)(ws_ + WS_H);
  const bf16_t* Bimg = (STAGE == 1) ? (const bf16_t*)(ws_ + WS_WE1) : (const bf16_t*)(ws_ + WS_WE2);
  const int cgk = ((lane & 3) ^ ((lane >> 4) & 3)) * 8;
  int abase[2];
#pragma unroll
  for (int k16 = 0; k16 < 2; ++k16) abase[k16] = (128 * wm + r32) * 64 + (((2 * k16 + hi) ^ ((r32 >> 2) & 3)) * 16);
  const int bbase = 16384 + (2 * wn) * 2048 + hi * 512 + ((lane & 15) >> 2) * 64 + ((lane >> 4) & 1) * 32 + (lane & 3) * 8;

#define MOE_DESC(it, E_, MT_, MC_, SUB_) do { const int tile_ = (it) / NSUB; SUB_ = (it) % NSUB; int lo_ = 0, hi_ = 256; \
    while (hi_ - lo_ > 1) { const int mid_ = (lo_ + hi_) >> 1; if (ts[mid_] <= tile_) lo_ = mid_; else hi_ = mid_; } \
    E_ = __builtin_amdgcn_readfirstlane(lo_); MT_ = __builtin_amdgcn_readfirstlane(tile_ - ts[lo_]); MC_ = __builtin_amdgcn_readfirstlane(min(256, cl[lo_] - MT_ * 256)); } while (0)
#define MOE_ROWS_DMA(E_, MT_, par) do { if (wid == 0) __builtin_amdgcn_global_load_lds((const unsigned*)(LIST + (size_t)(E_) * LISTCAP + (MT_) * 256 + lane * 4), (LAS unsigned*)(lds + L_ROWS + (par) * 1024), 16, 0, 0); } while (0)
#define MOE_ASRC(dst, par, MC_) do { _Pragma("unroll") for (int i = 0; i < 2; ++i) { const int aidr = ((LAS int*)(lds + L_ROWS + (par) * 1024))[min(16 * (2 * wid + i) + (lane >> 2), (MC_) - 1)]; \
      dst[i] = Asrc + ((STAGE == 1) ? (size_t)(aidr >> 3) * D : (size_t)aidr * DE) + cgk; } } while (0)
#define MOE_ISSUE_SL(AS, BS, s, SL) do { LAS unsigned char* sl_ = lds + (SL) * SLOT + (2 * wid) * 1024; \
      __builtin_amdgcn_global_load_lds((const unsigned*)(AS[0] + (s) * 32), (LAS unsigned*)(sl_), 16, 0, 0); \
      __builtin_amdgcn_global_load_lds((const unsigned*)(AS[1] + (s) * 32), (LAS unsigned*)(sl_ + 1024), 16, 0, 0); \
      __builtin_amdgcn_global_load_lds((const unsigned*)(BS + (size_t)(s) * 8192), (LAS unsigned*)(sl_ + 16384), 16, 0, 0); \
      __builtin_amdgcn_global_load_lds((const unsigned*)(BS + (size_t)(s) * 8192 + 512), (LAS unsigned*)(sl_ + 16384 + 1024), 16, 0, 0); } while (0)

  int item = vcu, par = 0;
  int e = 0, mt = 0, mcount = 1, sub = 0;
  const bf16_t* asrc[2]; const bf16_t* bsrc;
  if (item < nitems) {
    MOE_DESC(item, e, mt, mcount, sub);
    MOE_ROWS_DMA(e, mt, 0);
    asm volatile("s_waitcnt vmcnt(0)" ::: "memory"); __syncthreads();
    MOE_ASRC(asrc, 0, mcount);
    bsrc = Bimg + (size_t)(e * NSUB + sub) * NK * 8192 + (2 * wid) * 512 + lane * 8;
    MOE_ISSUE_SL(asrc, bsrc, 0, 0); MOE_ISSUE_SL(asrc, bsrc, 1, 1); MOE_ISSUE_SL(asrc, bsrc, 2, 2);
  }
  while (item < nitems) {
    const int nitem = item + nb; const bool has_next = nitem < nitems;
    int ne = 0, nmt = 0, nmc = 1, nsub = 0;
    const bf16_t* nasrc[2] = {Asrc, Asrc}; const bf16_t* nbsrc = Bimg;
    if (has_next) { MOE_DESC(nitem, ne, nmt, nmc, nsub); nbsrc = Bimg + (size_t)(ne * NSUB + nsub) * NK * 8192 + (2 * wid) * 512 + lane * 8; }
    f32x16 acc[4][2];
#pragma unroll
    for (int m = 0; m < 4; ++m)
#pragma unroll
      for (int n = 0; n < 2; ++n)
#pragma unroll
        for (int r = 0; r < 16; ++r) acc[m][n][r] = 0.f;
#define MOE_STEP(s, SL) do { \
      if ((s) + 2 < NK || has_next) asm volatile("s_waitcnt vmcnt(8)" ::: "memory"); \
      else if ((s) + 1 < NK) asm volatile("s_waitcnt vmcnt(4)" ::: "memory"); \
      else asm volatile("s_waitcnt vmcnt(0)" ::: "memory"); \
      __builtin_amdgcn_s_barrier(); \
      asm volatile("" ::: "memory"); \
      if ((s) + 3 < NK) MOE_ISSUE_SL(asrc, bsrc, (s) + 3, ((SL) + 3) & 3); \
      else if (has_next) { if ((s) + 3 == NK) MOE_ASRC(nasrc, par ^ 1, nmc); MOE_ISSUE_SL(nasrc, nbsrc, (s) + 3 - NK, ((SL) + 3) & 3); } \
      if ((s) == 0 && has_next) MOE_ROWS_DMA(ne, nmt, par ^ 1); \
      const LAS unsigned char* Ab = lds + (SL) * SLOT; const unsigned Bbv = (unsigned)(uintptr_t)(lds + (SL) * SLOT + bbase); \
      bf16x8 af[2][4], bfr[2][2]; s16x4 tq[8]; \
      asm volatile("ds_read_b64_tr_b16 %0, %1 offset:0" : "=&v"(tq[0]) : "v"(Bbv) : "memory"); \
      asm volatile("ds_read_b64_tr_b16 %0, %1 offset:256" : "=&v"(tq[1]) : "v"(Bbv) : "memory"); \
      asm volatile("ds_read_b64_tr_b16 %0, %1 offset:2048" : "=&v"(tq[2]) : "v"(Bbv) : "memory"); \
      asm volatile("ds_read_b64_tr_b16 %0, %1 offset:2304" : "=&v"(tq[3]) : "v"(Bbv) : "memory"); \
      asm volatile("ds_read_b64_tr_b16 %0, %1 offset:1024" : "=&v"(tq[4]) : "v"(Bbv) : "memory"); \
      asm volatile("ds_read_b64_tr_b16 %0, %1 offset:1280" : "=&v"(tq[5]) : "v"(Bbv) : "memory"); \
      asm volatile("ds_read_b64_tr_b16 %0, %1 offset:3072" : "=&v"(tq[6]) : "v"(Bbv) : "memory"); \
      asm volatile("ds_read_b64_tr_b16 %0, %1 offset:3328" : "=&v"(tq[7]) : "v"(Bbv) : "memory"); \
      _Pragma("unroll") for (int k16 = 0; k16 < 2; ++k16) _Pragma("unroll") for (int m = 0; m < 4; ++m) af[k16][m] = *(const LAS bf16x8*)(Ab + abase[k16] + m * 2048); \
      asm volatile("s_waitcnt lgkmcnt(0)" : "+v"(tq[0]), "+v"(tq[1]), "+v"(tq[2]), "+v"(tq[3]), "+v"(tq[4]), "+v"(tq[5]), "+v"(tq[6]), "+v"(tq[7]) :: "memory"); __builtin_amdgcn_sched_barrier(0); \
      _Pragma("unroll") for (int k16 = 0; k16 < 2; ++k16) _Pragma("unroll") for (int n = 0; n < 2; ++n) { const s16x4 l0 = tq[4 * k16 + 2 * n], h0 = tq[4 * k16 + 2 * n + 1]; bfr[k16][n] = (bf16x8){l0[0], l0[1], l0[2], l0[3], h0[0], h0[1], h0[2], h0[3]}; } \
      _Pragma("unroll") for (int k16 = 0; k16 < 2; ++k16) \
        _Pragma("unroll") for (int m = 0; m < 4; ++m) \
          _Pragma("unroll") for (int n = 0; n < 2; ++n) acc[m][n] = __builtin_amdgcn_mfma_f32_32x32x16_bf16(bfr[k16][n], af[k16][m], acc[m][n], 0, 0, 0); \
      asm volatile("s_waitcnt lgkmcnt(0)" ::: "memory"); } while (0)
    for (int s = 0; s < NK; s += 4) { MOE_STEP(s, 0); MOE_STEP(s + 1, 1); MOE_STEP(s + 2, 2); MOE_STEP(s + 3, 3); }
#undef MOE_STEP
    {
      const LAS int* rw = (const LAS int*)(lds + L_ROWS + par * 1024);
#pragma unroll
      for (int m = 0; m < 4; ++m) {
        const int row = 128 * wm + 32 * m + r32; const bool valid = row < mcount;
        const int aid = rw[min(row, mcount - 1)];
        if (STAGE == 1) {
          bf16_t* hp = (bf16_t*)(ws_ + WS_H) + (size_t)aid * DE + 128 * sub + 32 * wn + 8 * hi;
#pragma unroll
          for (int g = 0; g < 4; g += 2) {
            unsigned a0 = pk2(silu_f(acc[m][0][4 * g]) * acc[m][1][4 * g], silu_f(acc[m][0][4 * g + 1]) * acc[m][1][4 * g + 1]), a1 = pk2(silu_f(acc[m][0][4 * g + 2]) * acc[m][1][4 * g + 2], silu_f(acc[m][0][4 * g + 3]) * acc[m][1][4 * g + 3]);
            unsigned b0 = pk2(silu_f(acc[m][0][4 * g + 4]) * acc[m][1][4 * g + 4], silu_f(acc[m][0][4 * g + 5]) * acc[m][1][4 * g + 5]), b1 = pk2(silu_f(acc[m][0][4 * g + 6]) * acc[m][1][4 * g + 6], silu_f(acc[m][0][4 * g + 7]) * acc[m][1][4 * g + 7]);
            { auto r = __builtin_amdgcn_permlane32_swap(a0, b0, false, false); a0 = r[0]; b0 = r[1]; }
            { auto r = __builtin_amdgcn_permlane32_swap(a1, b1, false, false); a1 = r[0]; b1 = r[1]; }
            if (valid) *(u32x4*)(hp + 8 * g) = (u32x4){a0, a1, b0, b1};
          }
        } else {
          const float w = ((const float*)(ws_ + WS_WTS))[aid];
          bf16_t* sp = (bf16_t*)(ws_ + WS_SLAB) + (size_t)aid * D + 256 * sub + 64 * wn + 8 * hi;
#pragma unroll
          for (int n = 0; n < 2; ++n)
#pragma unroll
            for (int g = 0; g < 4; g += 2) {
              unsigned a0 = pk2(acc[m][n][4 * g] * w, acc[m][n][4 * g + 1] * w), a1 = pk2(acc[m][n][4 * g + 2] * w, acc[m][n][4 * g + 3] * w);
              unsigned b0 = pk2(acc[m][n][4 * g + 4] * w, acc[m][n][4 * g + 5] * w), b1 = pk2(acc[m][n][4 * g + 6] * w, acc[m][n][4 * g + 7] * w);
              { auto r = __builtin_amdgcn_permlane32_swap(a0, b0, false, false); a0 = r[0]; b0 = r[1]; }
              { auto r = __builtin_amdgcn_permlane32_swap(a1, b1, false, false); a1 = r[0]; b1 = r[1]; }
              if (valid) *(u32x4*)(sp + 32 * n + 8 * g) = (u32x4){a0, a1, b0, b1};
            }
        }
      }
    }
    item = nitem; par ^= 1; e = ne; mt = nmt; mcount = nmc; sub = nsub; asrc[0] = nasrc[0]; asrc[1] = nasrc[1]; bsrc = nbsrc;
  }
#undef MOE_DESC
#undef MOE_ROWS_DMA
#undef MOE_ASRC
#undef MOE_ISSUE_SL
  asm volatile("s_waitcnt vmcnt(0)" ::: "memory");
  __syncthreads();
}
}

__device__ __forceinline__ void phase_final_bf(const P& p, int bid, int nb) {
  unsigned char* const ws_ = fresh_ws(p.ws);
  const float* X1 = (const float*)(ws_ + WS_X1); const bf16_t* SL = (const bf16_t*)(ws_ + WS_SLAB); const float* ada = (const float*)(ws_ + WS_ADA);
  const int tid_ = tidx(), lane = tid_ & 63, wave = tid_ >> 6;
  for (int t = bid * NW + wave; t < T; t += nb * NW) {
    const int b = t / SEQ;
    float4 v[4]; float s = 0.f;
#pragma unroll
    for (int j = 0; j < 4; ++j) {
      const int c0 = lane * 4 + 256 * j;
      float4 y = make_float4(0, 0, 0, 0);
#pragma unroll
      for (int k = 0; k < 8; ++k) { const float4 z = ld_bf4(SL + (size_t)(t * 8 + k) * D + c0); y.x += z.x; y.y += z.y; y.z += z.z; y.w += z.w; }
      const float4 gt = *(const float4*)(ada + b * 6144 + 5120 + c0);
      const float4 bx = *(const float4*)(X1 + (size_t)t * D + c0);
      v[j] = make_float4(bx.x + gt.x * y.x, bx.y + gt.y * y.y, bx.z + gt.z * y.z, bx.w + gt.w * y.w);
      s += v[j].x * v[j].x + v[j].y * v[j].y + v[j].z * v[j].z + v[j].w * v[j].w;
    }
    s = wave_sum(s);
    const float rstd = 1.0f / sqrtf(s * (1.0f / D) + 1e-6f);
#pragma unroll
    for (int j = 0; j < 4; ++j) {
      const int c0 = lane * 4 + 256 * j;
      const float4 gg = *(const float4*)(p.g_final + c0);
      *(float4*)(p.out + (size_t)t * D + c0) = make_float4(v[j].x * rstd * gg.x, v[j].y * rstd * gg.y, v[j].z * rstd * gg.z, v[j].w * rstd * gg.w);
    }
  }
}

#define XB_TMO      128
#define XB_XCNT(j)  (256  + 64 * (j))
#define XB_XSUB(j)  (1280 + 64 * (j))
#define XB_XGEN(j)  (2304 + 64 * (j))
#define XB_TOP      3328
#define XB_TOPGEN   3392
#define XCD_BAR_WORDS 3456
#define XB_SPIN_CAP (1u << 22)
__device__ __forceinline__ unsigned xb_ld(unsigned* p)              { return __hip_atomic_load(p, __ATOMIC_RELAXED, __HIP_MEMORY_SCOPE_AGENT); }
__device__ __forceinline__ unsigned xb_add(unsigned* p, unsigned v) { return __hip_atomic_fetch_add(p, v, __ATOMIC_RELAXED, __HIP_MEMORY_SCOPE_AGENT); }
__device__ __forceinline__ unsigned xb_xcc_id() { return (unsigned)__builtin_amdgcn_s_getreg((3 << 11) | 20) & 0xFu; }
#define XB_SPIN(cond, bar) do { unsigned _sp = 0; while (cond) { __builtin_amdgcn_s_sleep(1); \
    if ((++_sp & 255u) == 0u) { if (xb_ld(&(bar)[XB_TMO])) break; if (_sp > XB_SPIN_CAP) { atomicAdd(&(bar)[XB_TMO], 1u); break; } } } } while (0)
struct XcdBarrier { unsigned* bar; unsigned x; volatile LAS unsigned* st; };
__device__ __forceinline__ XcdBarrier xcd_barrier_post(unsigned* bar, volatile LAS unsigned* st) {
    XcdBarrier b; b.bar = bar; b.x = xb_xcc_id(); b.st = st;
    if (threadIdx.x == 0) (void)xb_add(&bar[XB_XCNT(b.x)], 1u);
    return b;
}
__device__ __forceinline__ void xcd_barrier_complete(unsigned* bar, unsigned x, unsigned& nloc, unsigned& nx) {
    const unsigned G = gridDim.x * gridDim.y * gridDim.z;
    unsigned sum, cnt, mine, sp = 0u;
    for (;;) {
        sum = 0u; cnt = 0u; mine = 0u;
#pragma unroll
        for (unsigned j = 0; j < 16; ++j) { const unsigned c = xb_ld(&bar[XB_XCNT(j)]); sum += c; cnt += (c > 0u) ? 1u : 0u; mine = (j == x) ? c : mine; }
        if (sum == G) break;
        __builtin_amdgcn_s_sleep(1);
        if ((++sp & 255u) == 0u) { if (xb_ld(&bar[XB_TMO])) break; if (sp > XB_SPIN_CAP) { atomicAdd(&bar[XB_TMO], 1u); break; } }
    }
    nloc = mine > 0u ? mine : 1u; nx = cnt > 0u ? cnt : 1u;
}
__device__ __forceinline__ void xcd_barrier(const XcdBarrier& b) {
    asm volatile("s_waitcnt vmcnt(0)" ::: "memory");
    __syncthreads();
    if (threadIdx.x == 0) {
        unsigned long long bz = 0; unsigned bx = b.x;
        asm volatile("" : "+s"(bz), "+s"(bx));
        unsigned* bar = b.bar + bz;
        __builtin_amdgcn_s_waitcnt(0);
        unsigned nloc = b.st[0], nx = b.st[1];
        if (nloc == 0u) { xcd_barrier_complete(bar, bx, nloc, nx); b.st[0] = nloc; b.st[1] = nx; }
        const unsigned old = xb_add(&bar[XB_XSUB(bx)], 1u);
        const unsigned gen = old / nloc;
        if (old + 1u == (gen + 1u) * nloc) {
            __builtin_amdgcn_fence(__ATOMIC_RELEASE, "agent");
            asm volatile("s_waitcnt vmcnt(0)" ::: "memory");
            const unsigned og = xb_add(&bar[XB_TOP], 1u);
            const unsigned tg = og / nx;
            if (og + 1u == (tg + 1u) * nx) xb_add(&bar[XB_TOPGEN], 1u);
            else XB_SPIN(xb_ld(&bar[XB_TOPGEN]) == tg, bar);
            __builtin_amdgcn_fence(__ATOMIC_ACQUIRE, "agent");
            xb_add(&bar[XB_XGEN(bx)], 1u);
            asm volatile("s_waitcnt vmcnt(0)" ::: "memory");
        } else {
            XB_SPIN(xb_ld(&bar[XB_XGEN(bx)]) == gen, bar);
            __builtin_amdgcn_fence(__ATOMIC_ACQUIRE, "agent");
            asm volatile("s_waitcnt vmcnt(0)" ::: "memory");
        }
    }
    __syncthreads();
}

constexpr int CW_BAR = 32768;
constexpr int LDS_BYTES = 147456;
constexpr int MISC_OFF = 140 * 1024;

__global__ void __launch_bounds__(NT, 2) mega(P p) {
  extern __shared__ __attribute__((aligned(16))) unsigned char smem[];
  float* lds = (float*)smem;
  LAS unsigned char* ldsb = (LAS unsigned char*)smem;
  volatile LAS unsigned* st = (volatile LAS unsigned*)(ldsb + MISC_OFF);
  if (threadIdx.x < 4) st[threadIdx.x] = 0u;
  __syncthreads();
  XcdBarrier bar = xcd_barrier_post((unsigned*)(p.ws + WS_CTL) + CW_BAR, st);
  const int bid = blockIdx.x, nb = gridDim.x;
  volatile LAS unsigned* tl = st + 16; int nstamp = 0;
#define STAMP() do { if (TIME_SEL_A >= 0 && threadIdx.x == 0) tl[nstamp] = (unsigned)__builtin_amdgcn_s_memrealtime(); ++nstamp; } while (0)
  STAMP();
#define FRESH(q) const P& q = p; unsigned char* const q##w = fresh_ws(p.ws)
#define HNB_(q) ((bf16_t*)(q##w + WS_HNB))
#define PROJB_(q) ((bf16_t*)(q##w + WS_PROJB))
#define X1_(q) ((float*)(q##w + WS_X1))
#define ADA_(q) ((const float*)(q##w + WS_ADA))

  for (int rep = 0; rep < REP_CONV; ++rep) { FRESH(q); phase_prologue(q, bid, nb, lds); xcd_barrier(bar); STAMP(); }
#if DIAG_EXACT_ROUTING
  { FRESH(q); diag::modnorm(q, bid, nb, q.x, q.g1, 0, 1024, (float*)(qw + diag::DW_HN));       xcd_barrier(bar); STAMP(); }
  { FRESH(q); diag::inproj(q, bid, nb, lds);                                                     xcd_barrier(bar); STAMP(); }
  { FRESH(q); diag::rope(q, bid, nb);                                                            xcd_barrier(bar); STAMP(); }
  { FRESH(q); diag::attn(q, bid, nb);                                                            xcd_barrier(bar); STAMP(); }
  { FRESH(q); diag::mix(q, bid, nb);                                                             xcd_barrier(bar); STAMP(); }
  { FRESH(q); diag::outproj(q, bid, nb, lds);                                                    xcd_barrier(bar); STAMP(); }
  { FRESH(q); diag::modnorm(q, bid, nb, (const float*)(qw + diag::DW_X1), q.g2, 3072, 4096, (float*)(qw + diag::DW_HN)); xcd_barrier(bar); STAMP(); }
  { FRESH(q); diag::router(q, bid, nb, lds);                                                     xcd_barrier(bar); STAMP(); }
  { FRESH(q); phase_route(q, bid, nb, (const float*)(qw + diag::DW_LOGITS));                   xcd_barrier(bar); STAMP(); }
#endif
  for (int rep = 0; rep < REP_LIGHT; ++rep) { FRESH(q); phase_modnorm(q, bid, nb, q.x, q.g1, 0, 1024, HNB_(q)); xcd_barrier(bar); STAMP(); }
  const bool xpar = ((bid % 8) & 1) != 0;
  { FRESH(q);
    if (xpar) { convert_slice(q, bid, nb, 0); convert_slice(q, bid, nb, 1); }
    pg8::Gemm g{HNB_(q), (const bf16_t*)(qw + WS_WIN_T), T, DPROJ, D}; pg8::StaticOrder S; S.init(T, DPROJ, nb, bid);
    EpiInproj E{PROJB_(q), (const float*)(qw + WS_COS), (const float*)(qw + WS_SIN)};
    pg8::gemm_phase<EpiInproj, pg8::StaticOrder, true, true>(ldsb, g, S, E);
    if (!xpar) { convert_slice(q, bid, nb, 0); convert_slice(q, bid, nb, 1); }
    xcd_barrier(bar); STAMP(); }
  {
    FRESH(q);
    const attn_body::AttnTensors AT{(const attn_body::bf16*)(PROJB_(q) + COL_Q), (const attn_body::bf16*)(PROJB_(q) + COL_K), (const attn_body::bf16*)(PROJB_(q) + COL_V), (attn_body::bf16*)(qw + WS_AO)};
    const int vcu = (nb % 8 == 0) ? (bid % 8) * (nb / 8) + bid / 8 : bid;
#pragma unroll 1
    for (int i = 0; i < 4; ++i) {
      if (xpar) convert_slice(q, bid, nb, 2 + i);
      for (int v = vcu; v < 256; v += nb) attn_body::attn_phase_unit<8>((char*)smem, AT, v, i);
      if (!xpar) convert_slice(q, bid, nb, 2 + i);
    }
    xcd_barrier(bar); STAMP(); }
  for (int rep = 0; rep < REP_LIGHT; ++rep) { FRESH(q); phase_mix(q, bid, nb);                    xcd_barrier(bar); STAMP(); }
  for (int rep = 0; rep < REP_GEMM; ++rep)
  { FRESH(q); pg8::Gemm g{HNB_(q), (const bf16_t*)(qw + WS_WOUT_T), T, D, D}; pg8::StaticOrder S; S.init(T, D, nb, bid);
    EpiResid E{q.x, X1_(q), ADA_(q) + 2048};
    pg8::gemm_phase<EpiResid, pg8::StaticOrder, true, true>(ldsb, g, S, E);            xcd_barrier(bar); STAMP(); }
  for (int rep = 0; rep < REP_LIGHT; ++rep) { FRESH(q); phase_modnorm(q, bid, nb, X1_(q), q.g2, 3072, 4096, HNB_(q)); xcd_barrier(bar); STAMP(); }
  for (int rep = 0; rep < REP_GEMM; ++rep)
  { FRESH(q); pg8::Gemm g{HNB_(q), (const bf16_t*)(qw + WS_WRS_T), T, 768, D}; pg8::StaticOrder S; S.init(T, 768, nb, bid);
    EpiRS E{(float*)(qw + WS_LOGITS), (bf16_t*)(qw + WS_ACTS)};
    pg8::gemm_phase<EpiRS, pg8::StaticOrder, true, true>(ldsb, g, S, E);               xcd_barrier(bar); STAMP(); }
#if !DIAG_EXACT_ROUTING
  { FRESH(q); phase_route(q, bid, nb, (const float*)(qw + WS_LOGITS)); }
#endif
  { FRESH(q); pg8::Gemm g{(const bf16_t*)(qw + WS_ACTS), (const bf16_t*)(qw + WS_WDS_T), T, D, DSH}; pg8::StaticOrder S; S.init(T, D, nb, bid);
    EpiResid E{X1_(q), X1_(q), ADA_(q) + 5120};
    pg8::gemm_phase<EpiResid, pg8::StaticOrder, true, true>(ldsb, g, S, E);           xcd_barrier(bar); STAMP(); }
  for (int rep = 0; rep < REP_MOE1; ++rep) { FRESH(q); moe::run<1>(q, bid, nb, ldsb);             xcd_barrier(bar); STAMP(); }
  for (int rep = 0; rep < REP_MOE2; ++rep) { FRESH(q); moe::run<2>(q, bid, nb, ldsb);             xcd_barrier(bar); STAMP(); }
  for (int rep = 0; rep < REP_LIGHT; ++rep) { FRESH(q); phase_final_bf(q, bid, nb); }
  STAMP();
#if TIME_SEL_A >= 0
  if (bid == 0) {
    asm volatile("s_waitcnt vmcnt(0)" ::: "memory"); __syncthreads();
    const float usA = floorf((float)(tl[TIME_SEL_A + 1] - tl[TIME_SEL_A]) * 0.01f * (1.f / 16.f) + 0.5f) * 16.f;
    const float delta = sqrtf(usA * 1e-5f * 16.8e6f / 1024.f);
    if (threadIdx.x < 256) { float4* o = (float4*)p.out + threadIdx.x; float4 v = *o; v.x += delta; v.y += delta; v.z += delta; v.w += delta; *o = v; }
#if TIME_SEL_B >= 0
    if (threadIdx.x == 0) { const float usB = floorf((float)(tl[TIME_SEL_B + 1] - tl[TIME_SEL_B]) * 0.01f * (1.f / 16.f) + 0.5f) * 16.f; p.out[1024] = 10.f + usB * 0.1f; }
#endif
  }
#endif
}
}

extern "C" void kernel_launch(void* const* d_in, const int* in_sizes, int n_in, void* d_out, int out_size, void* d_ws, size_t ws_size, hipStream_t stream) {
  if (n_in != 25 || ws_size < WS_END) { fprintf(stderr, "kernel_launch: unexpected n_in %d or ws_size %zu\n", n_in, ws_size); return; }
  P p; memset(&p, 0, sizeof(p));
  p.x = (const float*)d_in[0]; p.c = (const float*)d_in[1]; p.pos = (const int*)d_in[2]; p.w_ada = (const float*)d_in[3]; p.b_ada = (const float*)d_in[4];
  p.g1 = (const float*)d_in[5]; p.w_in = (const float*)d_in[6]; p.conv_w = (const float*)d_in[7]; p.g_conv = (const float*)d_in[8];
  p.lq1 = (const float*)d_in[9]; p.lk1 = (const float*)d_in[10]; p.lq2 = (const float*)d_in[11]; p.lk2 = (const float*)d_in[12];
  p.g_subln = (const float*)d_in[13]; p.w_out = (const float*)d_in[14]; p.g2 = (const float*)d_in[15]; p.w_router = (const float*)d_in[16]; p.rbias = (const float*)d_in[17];
  p.wg_e = (const float*)d_in[18]; p.wu_e = (const float*)d_in[19]; p.wd_e = (const float*)d_in[20];
  p.wg_s = (const float*)d_in[21]; p.wu_s = (const float*)d_in[22]; p.wd_s = (const float*)d_in[23]; p.g_final = (const float*)d_in[24];
  p.out = (float*)d_out; p.ws = (unsigned char*)d_ws;
  for (int i = 0; i < 8; ++i) p.inv_freq[i] = (float)pow(500000.0, -(double)i / 8.0);
  (void)hipMemsetAsync((char*)d_ws + WS_CTL, 0, CTL_BYTES, stream);
  static int grid = 0;
  if (grid == 0) {
    int dev = 0, cus = 0, per_cu = 0;
    (void)hipGetDevice(&dev); (void)hipDeviceGetAttribute(&cus, hipDeviceAttributeMultiprocessorCount, dev);
    (void)hipFuncSetAttribute((const void*)mega, hipFuncAttributeMaxDynamicSharedMemorySize, LDS_BYTES);
    (void)hipOccupancyMaxActiveBlocksPerMultiprocessor(&per_cu, (const void*)mega, NT, LDS_BYTES);
    if (per_cu < 1) { fprintf(stderr, "kernel_launch: occupancy query says %d blocks/CU\n", per_cu); grid = -1; }
    else grid = cus;
  }
  if (grid < 0) return;
  void* args[] = {&p};
  hipError_t e = hipLaunchCooperativeKernel((const void*)mega, dim3(grid), dim3(NT), args, LDS_BYTES, stream);
  if (e != hipSuccess) fprintf(stderr, "cooperative launch failed: %s (grid %d)\n", hipGetErrorString(e), grid);
}
```

```cpp
#include <hip/hip_runtime.h>
#include <hip/hip_bf16.h>
#include <cmath>
#include <stdint.h>
#include <math.h>
#include <stdio.h>
#include <string.h>

#define DIAG_EXACT_ROUTING 0

__device__ __forceinline__ int tidx() { int t = threadIdx.x; asm volatile("" : "+v"(t)); return t; }

#define REP_LIGHT 1
#define REP_CONV 1
#define REP_GEMM 1
#define REP_ATTN 1
#define REP_MOE1 1
#define REP_MOE2 1

__device__ __forceinline__ unsigned char* fresh_ws(unsigned char* w) { unsigned long long z = 0; asm volatile("" : "+s"(z)); return w + z; }

#define TIME_SEL_A -1
#define TIME_SEL_B -1

#define ATTN_IMPL 0

namespace pg8 {
#define PG8_LAS __attribute__((address_space(3)))
typedef unsigned short bf16_t;
typedef short bf16x8 __attribute__((ext_vector_type(8)));
typedef float f32x4 __attribute__((ext_vector_type(4)));
typedef unsigned u32x4 __attribute__((ext_vector_type(4)));
constexpr int BM = 256, BK = 64, HALF = 128, HTB = HALF * BK * 2  , STAGE_BYTES = 8 * HTB, NXCD = 8, WGM = 8;

__host__ __device__ __forceinline__ int lds_byte(int r, int c) { const int st = (r >> 4) * 2 + (c >> 5), rr = r & 15, cc = c & 31, ob = rr * 64 + cc * 2; return st * 1024 + (ob ^ (((ob >> 9) & 1) << 5)); }
__host__ __device__ __forceinline__ void stage_rc(int b, int& R, int& C) { const int st = b / 1024, sb = b % 1024, swz = sb ^ (((sb >> 9) & 1) << 5); R = (st >> 1) * 16 + swz / 64; C = (st & 1) * 32 + (swz % 64) / 2; }
__host__ __device__ __forceinline__ int perm32(int rho) { const int n = rho >> 4, i = rho & 15; return 8 * (i >> 2) + 4 * n + (i & 3); }

struct Unit { int pm, pn; };
struct Gemm { const bf16_t* A; const bf16_t* Bt; int M, N, K; };

struct StaticOrder {
    int nM, nN, nwg, G, c;
    __host__ __device__ void init(int M, int N, int G_, int c_) { nM = M / BM; nN = N / BM; nwg = nM * nN; G = G_; c = c_; }
    __host__ __device__ bool next(int i, Unit& u) const {
        const long L = (long)i * G + c; if (L >= nwg) return false;
        int wgid = (int)L; { const int q = nwg / NXCD, r = nwg % NXCD, xcd = wgid % NXCD, off = wgid / NXCD; wgid = (xcd < r ? xcd * (q + 1) : r * (q + 1) + (xcd - r) * q) + off; }
        const int nig = WGM * nN, gid = wgid / nig, fm = gid * WGM, gsz = (nM - fm) < WGM ? (nM - fm) : WGM;
        u.pm = fm + ((wgid % nig) % gsz); u.pn = (wgid % nig) / gsz; return true;
    }
    __device__ __forceinline__ void a_ready(const Unit&) const {}
    __device__ __forceinline__ void done(const Unit&) const {}
};
__device__ __forceinline__ unsigned cvt_pk_bf16(float lo, float hi) { unsigned r; asm volatile("v_cvt_pk_bf16_f32 %0, %1, %2" : "=v"(r) : "v"(lo), "v"(hi)); return r; }
template <class Epi, class Sched, bool ALIGN_EPI = false, bool SP2 = false>
__device__ __forceinline__ void gemm_phase(PG8_LAS unsigned char* lds, const Gemm g, const Sched& S, const Epi& E) {
    const int tid = tidx(), wid = __builtin_amdgcn_readfirstlane(tid >> 6), lane = tid & 63, wr = wid >> 2, wc = wid & 3, fr = lane & 15, fq = lane >> 4;
    const int K = g.K, nt = K / BK;
    unsigned voffA[2], voffB[2];
#pragma unroll
    for (int i = 0; i < 2; ++i) { int R, C; stage_rc(tid * 16 + i * 8192, R, C); const int Rb = Epi::PERM ? ((R & ~31) + perm32(R & 31)) : R;
        voffA[i] = (unsigned)(R * K + C) * 2u; voffB[i] = (unsigned)(Rb * K + C) * 2u; }
    const size_t kstep = (size_t)(BK * 2);
    const size_t hstep = (size_t)HALF * K * 2;
    const size_t tstep = 2 * hstep;
    const unsigned ldsw = (unsigned)wid * 1024u;
    const int aoff = lds_byte(wr * 64 + fr, fq * 8), boff = lds_byte(wc * 32 + fr, fq * 8);
#define PG8_SA(b, h) (((b) * 2 + (h)) * HTB)
#define PG8_SB(b, h) ((4 + (b) * 2 + (h)) * HTB)
#define PG8_STAGE(bufoff, gbase, voff) do { _Pragma("unroll") for (int _i = 0; _i < 2; ++_i) \
        __builtin_amdgcn_global_load_lds((const unsigned*)((const char*)(gbase) + (voff)[_i]), (PG8_LAS unsigned*)(lds + (bufoff) + ldsw + _i * 8192), 16, 0, 0); } while (0)
#define PG8_LDA(dst, b, h) do { _Pragma("unroll") for (int m = 0; m < 4; ++m) _Pragma("unroll") for (int k = 0; k < 2; ++k) dst[m][k] = *(const PG8_LAS bf16x8*)(lds + PG8_SA(b, h) + aoff + m * 2048 + k * 1024); } while (0)
#define PG8_LDB(dst, b, h) do { _Pragma("unroll") for (int n = 0; n < 2; ++n) _Pragma("unroll") for (int k = 0; k < 2; ++k) dst[n][k] = *(const PG8_LAS bf16x8*)(lds + PG8_SB(b, h) + boff + n * 2048 + k * 1024); } while (0)
#define PG8_MMA(ai, bj, At, Bt) do { __builtin_amdgcn_s_setprio(1); _Pragma("unroll") for (int m = 0; m < 4; ++m) _Pragma("unroll") for (int n = 0; n < 2; ++n) _Pragma("unroll") for (int k = 0; k < 2; ++k) \
        acc[ai][bj][m][n] = __builtin_amdgcn_mfma_f32_16x16x32_bf16(Bt[n][k], At[m][k], acc[ai][bj][m][n], 0, 0, 0); __builtin_amdgcn_s_setprio(0); } while (0)
#define PG8_WAIT_V(n) asm volatile("s_waitcnt vmcnt(" #n ")" ::: "memory")
#define PG8_WAIT_L(n) asm volatile("s_waitcnt lgkmcnt(" #n ")" ::: "memory")
#define PG8_BAR __builtin_amdgcn_s_barrier()
#define PG8_SCHED __builtin_amdgcn_sched_barrier(0)
    Unit cur, nxt; int ui = 0;
    if (!S.next(0, cur)) return;
    f32x4 acc[2][2][4][2];
#pragma unroll
    for (int a = 0; a < 2; ++a)
#pragma unroll
        for (int b = 0; b < 2; ++b)
#pragma unroll
            for (int m = 0; m < 4; ++m)
#pragma unroll
                for (int n = 0; n < 2; ++n) acc[a][b][m][n] = (f32x4){0.f, 0.f, 0.f, 0.f};
    bf16x8 At[4][2], B0[2][2], B1[2][2];
    const char* cA = (const char*)g.A + (size_t)cur.pm * tstep; const char* cB = (const char*)g.Bt + (size_t)cur.pn * tstep;
    S.a_ready(cur);
    if constexpr (SP2) {
        PG8_STAGE(PG8_SB(0, 0), cB, voffB); PG8_STAGE(PG8_SB(0, 1), cB + hstep, voffB); PG8_STAGE(PG8_SA(0, 0), cA, voffA); PG8_STAGE(PG8_SA(0, 1), cA + hstep, voffA);
        if (wr == 1) PG8_BAR;
        PG8_WAIT_V(2); PG8_BAR;
        PG8_STAGE(PG8_SB(1, 0), cB + kstep, voffB); PG8_STAGE(PG8_SA(1, 0), cA + kstep, voffA); PG8_STAGE(PG8_SB(1, 1), cB + hstep + kstep, voffB);
        PG8_WAIT_V(6); PG8_BAR;
    } else {
        PG8_STAGE(PG8_SB(0, 0), cB, voffB); PG8_STAGE(PG8_SA(0, 0), cA, voffA); PG8_STAGE(PG8_SB(0, 1), cB + hstep, voffB); PG8_STAGE(PG8_SA(0, 1), cA + hstep, voffA);
        if (wr == 1) PG8_BAR;
        PG8_WAIT_V(4); PG8_BAR;
        PG8_STAGE(PG8_SB(1, 0), cB + kstep, voffB); PG8_STAGE(PG8_SA(1, 0), cA + kstep, voffA); PG8_STAGE(PG8_SB(1, 1), cB + hstep + kstep, voffB);
        PG8_WAIT_V(6); PG8_BAR;
    }
    for (;;) {
        const bool has_next = S.next(ui + 1, nxt);
        const char* nA = has_next ? (const char*)g.A + (size_t)nxt.pm * tstep : cA; const char* nB = has_next ? (const char*)g.Bt + (size_t)nxt.pn * tstep : cB;
        for (int t = 0; t < nt; t += 2) {
            const bool last = (t == nt - 2);
            const char* a1 = cA + (size_t)(t + 1) * kstep;
            const char* a2 = last ? nA : cA + (size_t)(t + 2) * kstep; const char* b2 = last ? nB : cB + (size_t)(t + 2) * kstep;
            const char* a3 = a2 + kstep; const char* b3 = b2 + kstep;
            if (last && has_next) S.a_ready(nxt);
            if constexpr (SP2) {
            PG8_LDB(B0, 0, 0); PG8_LDB(B1, 0, 1); PG8_SCHED; PG8_LDA(At, 0, 0); PG8_STAGE(PG8_SA(1, 1), a1 + hstep, voffA);
            PG8_WAIT_V(8); PG8_WAIT_L(0); PG8_BAR; PG8_MMA(0, 0, At, B0); PG8_MMA(0, 1, At, B1); PG8_BAR; PG8_SCHED;
            PG8_LDA(At, 0, 1); PG8_STAGE(PG8_SB(0, 0), b2, voffB); PG8_STAGE(PG8_SB(0, 1), b2 + hstep, voffB); PG8_STAGE(PG8_SA(0, 0), a2, voffA);
            PG8_WAIT_V(8); PG8_WAIT_L(0); PG8_BAR; PG8_MMA(1, 0, At, B0); PG8_MMA(1, 1, At, B1); PG8_BAR; PG8_SCHED;
            PG8_LDB(B0, 1, 0); PG8_LDB(B1, 1, 1); PG8_SCHED; PG8_LDA(At, 1, 0); PG8_STAGE(PG8_SA(0, 1), a2 + hstep, voffA);
            PG8_WAIT_V(8); PG8_WAIT_L(0); PG8_BAR; PG8_MMA(0, 0, At, B0); PG8_MMA(0, 1, At, B1); PG8_BAR; PG8_SCHED;
            PG8_LDA(At, 1, 1); PG8_STAGE(PG8_SB(1, 0), b3, voffB); PG8_STAGE(PG8_SB(1, 1), b3 + hstep, voffB); PG8_STAGE(PG8_SA(1, 0), a3, voffA);
            PG8_WAIT_V(8); PG8_WAIT_L(0); PG8_BAR; PG8_MMA(1, 0, At, B0); PG8_MMA(1, 1, At, B1); PG8_BAR; PG8_SCHED;
            } else {
            PG8_LDB(B0, 0, 0); PG8_SCHED; PG8_LDA(At, 0, 0); PG8_STAGE(PG8_SA(1, 1), a1 + hstep, voffA);
            PG8_WAIT_L(8); PG8_BAR; PG8_WAIT_L(0); PG8_MMA(0, 0, At, B0); PG8_BAR; PG8_SCHED;
            PG8_LDB(B1, 0, 1); PG8_STAGE(PG8_SB(0, 0), b2, voffB);
            PG8_BAR; PG8_WAIT_L(0); PG8_MMA(0, 1, At, B1); PG8_BAR;
            PG8_LDA(At, 0, 1); PG8_STAGE(PG8_SA(0, 0), a2, voffA);
            PG8_BAR; PG8_WAIT_L(0); PG8_MMA(1, 0, At, B0); PG8_BAR; PG8_SCHED;
            PG8_STAGE(PG8_SB(0, 1), b2 + hstep, voffB);
            PG8_WAIT_V(6); PG8_BAR; PG8_MMA(1, 1, At, B1); PG8_BAR;
            PG8_LDB(B0, 1, 0); PG8_SCHED; PG8_LDA(At, 1, 0); PG8_STAGE(PG8_SA(0, 1), a2 + hstep, voffA);
            PG8_WAIT_L(8); PG8_BAR; PG8_WAIT_L(0); PG8_MMA(0, 0, At, B0); PG8_BAR; PG8_SCHED;
            PG8_LDB(B1, 1, 1); PG8_STAGE(PG8_SB(1, 0), b3, voffB);
            PG8_BAR; PG8_WAIT_L(0); PG8_MMA(0, 1, At, B1); PG8_BAR;
            PG8_LDA(At, 1, 1); PG8_STAGE(PG8_SA(1, 0), a3, voffA);
            PG8_BAR; PG8_WAIT_L(0); PG8_MMA(1, 0, At, B0); PG8_BAR; PG8_SCHED;
            PG8_STAGE(PG8_SB(1, 1), b3 + hstep, voffB);
            PG8_WAIT_V(6); PG8_BAR; PG8_MMA(1, 1, At, B1); PG8_BAR;
            }
        }
        if constexpr (ALIGN_EPI) { if (wr == 0) PG8_BAR; }
        if constexpr (!Epi::AFTER_DRAIN) { E(acc, cur, wr, wc, fr, fq); S.done(cur); }
        if (!has_next) break;
#pragma unroll
        for (int a = 0; a < 2; ++a)
#pragma unroll
            for (int b = 0; b < 2; ++b)
#pragma unroll
                for (int m = 0; m < 4; ++m)
#pragma unroll
                    for (int n = 0; n < 2; ++n) acc[a][b][m][n] = (f32x4){0.f, 0.f, 0.f, 0.f};
        cur = nxt; cA = nA; cB = nB; ++ui;
        if constexpr (ALIGN_EPI) { if (wr == 1) PG8_BAR; }
    }
    PG8_WAIT_V(0);
    if constexpr (!ALIGN_EPI) { if (wr == 0) PG8_BAR; }
    PG8_BAR;
    if constexpr (Epi::AFTER_DRAIN) { E.fused(acc, cur, wr, wc, fr, fq, lds, wid, lane); S.done(cur); }
#undef PG8_SA
#undef PG8_SB
#undef PG8_STAGE
#undef PG8_LDA
#undef PG8_LDB
#undef PG8_MMA
#undef PG8_WAIT_V
#undef PG8_WAIT_L
#undef PG8_BAR
#undef PG8_SCHED
}
}

namespace {
using pg8::bf16_t; using pg8::f32x4; using pg8::u32x4; using pg8::Unit;
constexpr int D = 1024, BATCH = 4, SEQ = 4096, T = BATCH * SEQ;
constexpr int DPROJ = 3072;
constexpr int COL_H = 0, COL_B = 512, COL_C = 1024, COL_Q = 1536, COL_K = 2048, COL_V = 2560;
constexpr int NE = 256, TOPK = 8, DE = 256, DSH = 256;
constexpr int NT = 512;
constexpr int NW = NT / 64;
constexpr int LISTCAP = T;
constexpr int CNT_STRIDE = 64;
constexpr float C2 = 0.125f * 1.4426950408889634f;

constexpr size_t MiB = 1u << 20;
constexpr size_t WS_CTL = 0, CTL_BYTES = 1 * MiB;
constexpr size_t WS_ADA = 1 * MiB;
constexpr size_t WS_MISC = 1 * MiB + 128 * 1024;
constexpr size_t WS_COS = 2 * MiB, WS_SIN = 2 * MiB + 512 * 1024;
constexpr size_t WS_IDX = 3 * MiB, WS_WTS = 3 * MiB + 512 * 1024;
constexpr size_t WS_LIST = 4 * MiB;
constexpr size_t WS_LOGITS = 20 * MiB;
constexpr size_t WS_ACTS = 36 * MiB;
constexpr size_t WS_WIN_T = 44 * MiB;
constexpr size_t WS_WOUT_T = 50 * MiB;
constexpr size_t WS_WRS_T = 52 * MiB;
constexpr size_t WS_WDS_T = 54 * MiB;
constexpr size_t WS_X1 = 64 * MiB;
constexpr size_t WS_HNB = 128 * MiB;
constexpr size_t WS_PROJB = 160 * MiB;
constexpr size_t WS_AO = 256 * MiB;
constexpr size_t WS_SLAB = 128 * MiB;
constexpr size_t WS_H = 384 * MiB;
constexpr size_t WS_WE1 = 448 * MiB;
constexpr size_t WS_WE2 = 704 * MiB;
constexpr size_t WS_END = 832 * MiB;

struct P {
  const float* x; const float* c; const int* pos; const float* w_ada; const float* b_ada; const float* g1;
  const float* w_in; const float* conv_w; const float* g_conv; const float* lq1; const float* lk1; const float* lq2; const float* lk2;
  const float* g_subln; const float* w_out; const float* g2; const float* w_router; const float* rbias;
  const float* wg_e; const float* wu_e; const float* wd_e; const float* wg_s; const float* wu_s; const float* wd_s; const float* g_final;
  float* out; unsigned char* ws;
  float inv_freq[8];
};

#define LAS __attribute__((address_space(3)))
__device__ __forceinline__ float wave_sum(float v) {
#pragma unroll
  for (int o = 1; o < 64; o <<= 1) v += __shfl_xor(v, o);
  return v;
}
__device__ __forceinline__ float silu_f(float v) { return v / (1.f + expf(-v)); }
__device__ __forceinline__ unsigned f2bf(float f) { unsigned u = __float_as_uint(f); return (u + 0x7fffu + ((u >> 16) & 1u)) >> 16; }
__device__ __forceinline__ unsigned pk2(float lo, float hi) { typedef float f32x2_ __attribute__((ext_vector_type(2))); typedef __bf16 bf16x2_ __attribute__((ext_vector_type(2))); f32x2_ v = {lo, hi}; return __builtin_bit_cast(unsigned, __builtin_convertvector(v, bf16x2_)); }
__device__ __forceinline__ float bflo(unsigned w) { return __uint_as_float(w << 16); }
__device__ __forceinline__ float bfhi(unsigned w) { return __uint_as_float(w & 0xffff0000u); }
__device__ __forceinline__ float4 ld_bf4(const bf16_t* p) { const uint2 w = *(const uint2*)p; return make_float4(bflo(w.x), bfhi(w.x), bflo(w.y), bfhi(w.y)); }
__device__ __forceinline__ void st_bf4(bf16_t* p, float a, float b, float c, float d) { *(uint2*)p = make_uint2(pk2(a, b), pk2(c, d)); }

struct EpiInproj {
  static constexpr bool PERM = true, AFTER_DRAIN = false;
  bf16_t* O; const float* cosT; const float* sinT;
  __device__ __forceinline__ void operator()(const f32x4 (&acc)[2][2][4][2], const Unit& u, int wr, int wc, int fr, int fq) const {
    const int row0 = u.pm * 256 + wr * 64 + fr, col0 = u.pn * 256 + wc * 32 + 8 * fq;
    const bool qk = (u.pn >= 6 && u.pn < 10), rot = qk && ((wc & 1) == 0) && (fq < 2);
    const float sc = (u.pn == 6 || u.pn == 7) ? C2 : 1.f;
#pragma unroll
    for (int ai = 0; ai < 2; ++ai)
#pragma unroll
      for (int m = 0; m < 4; ++m) {
        const int row = row0 + ai * 128 + m * 16;
        f32x4 cs = {1.f, 1.f, 1.f, 1.f}, sn = {0.f, 0.f, 0.f, 0.f};
        if (rot) { cs = *(const f32x4*)(cosT + (size_t)row * 8 + 4 * fq); sn = *(const f32x4*)(sinT + (size_t)row * 8 + 4 * fq); }
        bf16_t* rowp = O + (size_t)row * DPROJ + col0;
#pragma unroll
        for (int bj = 0; bj < 2; ++bj) {
          const f32x4 a = acc[ai][bj][m][0], b = acc[ai][bj][m][1];
          const f32x4 v0 = (a * cs - b * sn) * sc, v1 = (b * cs + a * sn) * sc;
          u32x4 w; w.x = pk2(v0[0], v0[1]); w.y = pk2(v0[2], v0[3]); w.z = pk2(v1[0], v1[1]); w.w = pk2(v1[2], v1[3]);
          *(u32x4*)(rowp + bj * 128) = w;
        }
      }
  }
};
struct EpiResid {
  static constexpr bool PERM = false, AFTER_DRAIN = false;
  const float* base; float* out; const float* gate;
  __device__ __forceinline__ void operator()(const f32x4 (&acc)[2][2][4][2], const Unit& u, int wr, int wc, int fr, int fq) const {
    const int row0 = u.pm * 256 + wr * 64 + fr, col0 = u.pn * 256 + wc * 32 + 4 * fq;
    const float* gp = gate + (size_t)(u.pm / 16) * 6144;
#pragma unroll
    for (int bj = 0; bj < 2; ++bj)
#pragma unroll
      for (int n = 0; n < 2; ++n) {
        const int c = col0 + bj * 128 + n * 16;
        const f32x4 gv = *(const f32x4*)(gp + c);
#pragma unroll
        for (int ai = 0; ai < 2; ++ai)
#pragma unroll
          for (int m = 0; m < 4; ++m) {
            const size_t o = (size_t)(row0 + ai * 128 + m * 16) * D + c;
            const f32x4 bs = *(const f32x4*)(base + o);
            *(f32x4*)(out + o) = bs + gv * acc[ai][bj][m][n];
          }
      }
  }
};
struct EpiRS {
  static constexpr bool PERM = true, AFTER_DRAIN = false;
  float* LG; bf16_t* AC;
  __device__ __forceinline__ void operator()(const f32x4 (&acc)[2][2][4][2], const Unit& u, int wr, int wc, int fr, int fq) const {
    const int row0 = u.pm * 256 + wr * 64 + fr, cl = wc * 32 + 8 * fq;
#pragma unroll
    for (int ai = 0; ai < 2; ++ai)
#pragma unroll
      for (int m = 0; m < 4; ++m) {
        const int row = row0 + ai * 128 + m * 16;
#pragma unroll
        for (int bj = 0; bj < 2; ++bj) {
          const f32x4 a = acc[ai][bj][m][0], b = acc[ai][bj][m][1];
          if (u.pn == 0) { float* lp = LG + (size_t)row * 256 + cl + bj * 128; *(f32x4*)lp = a; *(f32x4*)(lp + 4) = b; }
          else {
            const int ci = 256 * (u.pn - 1) + cl + bj * 128;
            st_bf4(AC + (size_t)row * DSH + (ci >> 1), silu_f(a[0]) * b[0], silu_f(a[1]) * b[1], silu_f(a[2]) * b[2], silu_f(a[3]) * b[3]);
          }
        }
      }
  }
};

template <class RM>
__device__ __forceinline__ void transpose_item(const float* W, int K, int N, bf16_t* WT, LAS float* scr, int item, int lane, const RM& rowmap) {
  const int nblk = N / 32, kb = item / nblk, nbk = item % nblk, k0 = 64 * kb, n0 = 32 * nbk;
#pragma unroll 8
  for (int i = 0; i < 32; ++i) { const int kk = 2 * i + (lane >> 5); scr[kk * 33 + (lane & 31)] = W[(size_t)(k0 + kk) * N + n0 + (lane & 31)]; }
  asm volatile("s_waitcnt lgkmcnt(0)" ::: "memory");
  const int c = lane & 7;
#pragma unroll
  for (int j = 0; j < 4; ++j) {
    const int n = (lane >> 3) + 8 * j; const LAS float* s = scr + (8 * c) * 33 + n;
    u32x4 o; o.x = pk2(s[0 * 33], s[1 * 33]); o.y = pk2(s[2 * 33], s[3 * 33]); o.z = pk2(s[4 * 33], s[5 * 33]); o.w = pk2(s[6 * 33], s[7 * 33]);
    *(u32x4*)(WT + (size_t)rowmap(n0 + n) * K + k0 + 8 * c) = o;
  }
  asm volatile("s_waitcnt lgkmcnt(0)" ::: "memory");
}
__device__ __forceinline__ int win_rowmap(int n) {
  if (n < COL_Q || n >= COL_V) return n;
  const int pos = n & 63; if (pos >= 16) return n;
  const int g = pos >> 2, g2 = (g == 1) ? 2 : (g == 2) ? 1 : g;
  return (n & ~63) + g2 * 4 + (pos & 3);
}
__device__ __forceinline__ void phase_prologue(const P& p, int bid, int nb, float* lds) {
  unsigned char* const ws_ = fresh_ws(p.ws);
  float* cact = lds;
  float* red = lds + 4096;
  const int tid = tidx();
  float* ada = (float*)(ws_ + WS_ADA);
  for (int i = tid; i < 4096; i += NT) cact[i] = silu_f(p.c[i]);
  __syncthreads();
  for (int cb = bid; cb < 256; cb += nb) {
    const int col = tid % 24, kg = tid / 24;
    if (kg < 21) {
      float a0 = 0.f, a1 = 0.f, a2 = 0.f, a3 = 0.f;
      for (int k = kg; k < 1024; k += 21) {
        const float w = p.w_ada[(size_t)k * 6144 + cb * 24 + col];
        a0 += cact[k] * w; a1 += cact[1024 + k] * w; a2 += cact[2048 + k] * w; a3 += cact[3072 + k] * w;
      }
      float* r = red + (kg * 24 + col) * 4; r[0] = a0; r[1] = a1; r[2] = a2; r[3] = a3;
    }
    __syncthreads();
    if (tid < 96) {
      const int cc = tid >> 2, b = tid & 3; float s = 0.f;
      for (int g = 0; g < 21; ++g) s += red[(g * 24 + cc) * 4 + b];
      ada[b * 6144 + cb * 24 + cc] = s + p.b_ada[cb * 24 + cc];
    }
    __syncthreads();
  }
  if (bid == 0 && tid == 0) {
    float s1 = 0.f, s2 = 0.f;
    for (int i = 0; i < 64; ++i) { s1 += p.lq1[i] * p.lk1[i]; s2 += p.lq2[i] * p.lk2[i]; }
    ((float*)(ws_ + WS_MISC))[0] = expf(s1) - expf(s2) + 0.2f;
  }
  float* ct = (float*)(ws_ + WS_COS); float* st = (float*)(ws_ + WS_SIN);
  for (int i = bid * NT + tid; i < T * 8; i += nb * NT) {
    const int t = i >> 3, f = i & 7;
    const float ifr = f == 0 ? p.inv_freq[0] : f == 1 ? p.inv_freq[1] : f == 2 ? p.inv_freq[2] : f == 3 ? p.inv_freq[3] : f == 4 ? p.inv_freq[4] : f == 5 ? p.inv_freq[5] : f == 6 ? p.inv_freq[6] : p.inv_freq[7];
    const float ang = (float)p.pos[t] * ifr;
    float s, c; sincosf(ang, &s, &c);
    ct[i] = c; st[i] = s;
  }
  const int lane = tid & 63, wave = tid >> 6;
  LAS float* scr = (LAS float*)lds + 8192 + wave * 2176;
  constexpr int I_IN = 16 * 96, I_OUT = 16 * 32, I_R = 16 * 8, I_G = 16 * 8, I_U = 16 * 8, I_D = 4 * 32;
  constexpr int NITEMS = I_IN + I_OUT + I_R + I_G + I_U + I_D;
  bf16_t* WIN = (bf16_t*)(ws_ + WS_WIN_T); bf16_t* WOUT = (bf16_t*)(ws_ + WS_WOUT_T); bf16_t* WRS = (bf16_t*)(ws_ + WS_WRS_T); bf16_t* WDS = (bf16_t*)(ws_ + WS_WDS_T);
  for (int it = bid * NW + wave; it < NITEMS; it += nb * NW) {
    int r = it;
    if (r < I_IN) { transpose_item(p.w_in, D, DPROJ, WIN, scr, r, lane, [](int n) { return win_rowmap(n); }); continue; } r -= I_IN;
    if (r < I_OUT) { transpose_item(p.w_out, D, D, WOUT, scr, r, lane, [](int n) { return n; }); continue; } r -= I_OUT;
    if (r < I_R) { transpose_item(p.w_router, D, 256, WRS, scr, r, lane, [](int n) { return n; }); continue; } r -= I_R;
    if (r < I_G) { transpose_item(p.wg_s, D, 256, WRS, scr, r, lane, [](int n) { return 256 + 8 * (n >> 2) + (n & 3); }); continue; } r -= I_G;
    if (r < I_U) { transpose_item(p.wu_s, D, 256, WRS, scr, r, lane, [](int n) { return 256 + 8 * (n >> 2) + 4 + (n & 3); }); continue; } r -= I_U;
    transpose_item(p.wd_s, DSH, D, WDS, scr, r, lane, [](int n) { return n; });
  }
}

__device__ __forceinline__ void phase_modnorm(const P& p, int bid, int nb, const float* in, const float* g, int sh_off, int sc_off, bf16_t* outp) {
  unsigned char* const ws_ = fresh_ws(p.ws);
  const int tid_ = tidx(), lane = tid_ & 63, wave = tid_ >> 6;
  const float* ada = (const float*)(ws_ + WS_ADA);
  for (int t = bid * NW + wave; t < T; t += nb * NW) {
    const int b = t / SEQ;
    const float4* xr = (const float4*)(in + (size_t)t * D) + lane;
    float4 v[4]; float s = 0.f;
#pragma unroll
    for (int j = 0; j < 4; ++j) { v[j] = xr[64 * j]; s += v[j].x * v[j].x + v[j].y * v[j].y + v[j].z * v[j].z + v[j].w * v[j].w; }
    s = wave_sum(s);
    const float rstd = 1.0f / sqrtf(s * (1.0f / D) + 1e-6f);
#pragma unroll
    for (int j = 0; j < 4; ++j) {
      const int c0 = lane * 4 + 256 * j;
      const float4 gg = *(const float4*)(g + c0);
      const float4 sc = *(const float4*)(ada + b * 6144 + sc_off + c0);
      const float4 sh = *(const float4*)(ada + b * 6144 + sh_off + c0);
      st_bf4(outp + (size_t)t * D + c0, v[j].x * rstd * gg.x * (1.f + sc.x) + sh.x, v[j].y * rstd * gg.y * (1.f + sc.y) + sh.y,
             v[j].z * rstd * gg.z * (1.f + sc.z) + sh.z, v[j].w * rstd * gg.w * (1.f + sc.w) + sh.w);
    }
  }
}

template <bool DUAL, class AF, class EF>
__device__ __forceinline__ void gemm_tile_naive(const AF& af, int mcount, const float* __restrict__ B0, const float* __restrict__ B1, int ldb, int n0, int K, const EF& ef, float* lds) {
  float* As = lds; float* Bs0 = lds + 16 * 132; float* Bs1 = Bs0 + 16 * 64;
  const int tid = tidx(), ty = tid >> 4, tx = tid & 15;
  float acc0[4][4], acc1[4][4];
#pragma unroll
  for (int i = 0; i < 4; ++i)
#pragma unroll
    for (int j = 0; j < 4; ++j) { acc0[i][j] = 0.f; acc1[i][j] = 0.f; }
  const int ar = tid >> 2, akq = (tid & 3) * 4;
  const bool avalid = ar < mcount;
  const int bt = tid & 255, bk = bt >> 4, bc = (bt & 15) * 4;
  const float* bsrc = (tid < 256) ? B0 : B1;
  float* bdst = (tid < 256) ? Bs0 : Bs1;
  for (int k0 = 0; k0 < K; k0 += 16) {
    float4 av = make_float4(0.f, 0.f, 0.f, 0.f);
    if (avalid) av = af(ar, k0 + akq);
    As[(akq + 0) * 132 + ar] = av.x; As[(akq + 1) * 132 + ar] = av.y; As[(akq + 2) * 132 + ar] = av.z; As[(akq + 3) * 132 + ar] = av.w;
    if (DUAL || tid < 256) {
      const float4 bv = *(const float4*)(bsrc + (size_t)(k0 + bk) * ldb + n0 + bc);
      *(float4*)(bdst + bk * 64 + bc) = bv;
    }
    __syncthreads();
#pragma unroll
    for (int kk = 0; kk < 16; ++kk) {
      const float4 a = *(const float4*)(As + kk * 132 + ty * 4);
      const float4 b = *(const float4*)(Bs0 + kk * 64 + tx * 4);
      const float aa[4] = {a.x, a.y, a.z, a.w}; const float bb[4] = {b.x, b.y, b.z, b.w};
#pragma unroll
      for (int i = 0; i < 4; ++i)
#pragma unroll
        for (int j = 0; j < 4; ++j) acc0[i][j] += aa[i] * bb[j];
      if (DUAL) {
        const float4 b1 = *(const float4*)(Bs1 + kk * 64 + tx * 4);
        const float cc[4] = {b1.x, b1.y, b1.z, b1.w};
#pragma unroll
        for (int i = 0; i < 4; ++i)
#pragma unroll
          for (int j = 0; j < 4; ++j) acc1[i][j] += aa[i] * cc[j];
      }
    }
    __syncthreads();
  }
#pragma unroll
  for (int i = 0; i < 4; ++i)
    if (ty * 4 + i < mcount) {
#pragma unroll
      for (int j = 0; j < 4; ++j) ef(ty * 4 + i, n0 + tx * 4 + j, acc0[i][j], acc1[i][j]);
    }
}

__device__ __forceinline__ void phase_mix(const P& p, int bid, int nb) {
  unsigned char* const ws_ = fresh_ws(p.ws);
  const bf16_t* PR = (const bf16_t*)(ws_ + WS_PROJB); const bf16_t* AO = (const bf16_t*)(ws_ + WS_AO); bf16_t* MIX = (bf16_t*)(ws_ + WS_HNB);
  const float lam = ((const float*)(ws_ + WS_MISC))[0];
  const int tid_ = tidx(), lane = tid_ & 63, wave = tid_ >> 6;
  for (int t = bid * NW + wave; t < T; t += nb * NW) {
    const int s = t % SEQ;
    const bf16_t* r0 = PR + (size_t)t * DPROJ;
    float vals[8]; float ss = 0.f;
#pragma unroll
    for (int j = 0; j < 2; ++j) {
      const int ch = lane * 4 + 256 * j;
      const float4 h0 = ld_bf4(r0 + COL_H + ch), c0 = ld_bf4(r0 + COL_C + ch), bg = ld_bf4(r0 + COL_B + ch);
      float4 h1 = make_float4(0, 0, 0, 0), c1 = h1, h2 = h1, c2 = h1;
      if (s >= 1) { h1 = ld_bf4(r0 - DPROJ + COL_H + ch); c1 = ld_bf4(r0 - DPROJ + COL_C + ch); }
      if (s >= 2) { h2 = ld_bf4(r0 - 2 * DPROJ + COL_H + ch); c2 = ld_bf4(r0 - 2 * DPROJ + COL_C + ch); }
      const float4 w0 = *(const float4*)(p.conv_w + ch), w1 = *(const float4*)(p.conv_w + 512 + ch), w2 = *(const float4*)(p.conv_w + 1024 + ch);
      float y;
      y = w0.x * (c2.x * h2.x) + w1.x * (c1.x * h1.x) + w2.x * (c0.x * h0.x); vals[4 * j + 0] = bg.x * y;
      y = w0.y * (c2.y * h2.y) + w1.y * (c1.y * h1.y) + w2.y * (c0.y * h0.y); vals[4 * j + 1] = bg.y * y;
      y = w0.z * (c2.z * h2.z) + w1.z * (c1.z * h1.z) + w2.z * (c0.z * h0.z); vals[4 * j + 2] = bg.z * y;
      y = w0.w * (c2.w * h2.w) + w1.w * (c1.w * h1.w) + w2.w * (c0.w * h0.w); vals[4 * j + 3] = bg.w * y;
#pragma unroll
      for (int i = 0; i < 4; ++i) ss += vals[4 * j + i] * vals[4 * j + i];
    }
    ss = wave_sum(ss);
    const float rstd = 1.0f / sqrtf(ss * (1.0f / 512.f) + 1e-6f);
    bf16_t* mo = MIX + (size_t)t * D;
#pragma unroll
    for (int j = 0; j < 2; ++j) {
      const int ch = lane * 4 + 256 * j;
      const float4 gg = *(const float4*)(p.g_conv + ch);
      st_bf4(mo + ch, vals[4 * j] * rstd * gg.x, vals[4 * j + 1] * rstd * gg.y, vals[4 * j + 2] * rstd * gg.z, vals[4 * j + 3] * rstd * gg.w);
    }
    const bf16_t* ao = AO + (size_t)t * 1024;
#pragma unroll
    for (int j = 0; j < 2; ++j) {
      const int idx = lane * 4 + 256 * j, h = idx >> 7, d = idx & 127;
      const float4 o0 = ld_bf4(ao + (2 * h) * 128 + d), o1 = ld_bf4(ao + (2 * h + 1) * 128 + d);
      float dv[4] = {o0.x - lam * o1.x, o0.y - lam * o1.y, o0.z - lam * o1.z, o0.w - lam * o1.w};
      float q = dv[0] * dv[0] + dv[1] * dv[1] + dv[2] * dv[2] + dv[3] * dv[3];
#pragma unroll
      for (int o = 1; o < 32; o <<= 1) q += __shfl_xor(q, o);
      const float r2 = 1.0f / sqrtf(q * (1.0f / 128.f) + 1e-5f);
      const float4 gg = *(const float4*)(p.g_subln + d);
      st_bf4(mo + 512 + idx, dv[0] * r2 * gg.x * 0.8f, dv[1] * r2 * gg.y * 0.8f, dv[2] * r2 * gg.z * 0.8f, dv[3] * r2 * gg.w * 0.8f);
    }
  }
}

__device__ __forceinline__ void phase_route(const P& p, int bid, int nb, const float* LG) {
  unsigned char* const ws_ = fresh_ws(p.ws);
  int* IDX = (int*)(ws_ + WS_IDX); float* WTS = (float*)(ws_ + WS_WTS); int* LIST = (int*)(ws_ + WS_LIST); int* cnt = (int*)(ws_ + WS_CTL);
  const int tid_ = tidx(), lane = tid_ & 63, wave = tid_ >> 6;
  for (int t = bid * NW + wave; t < T; t += nb * NW) {
    const float4 lg = *(const float4*)(LG + (size_t)t * 256 + lane * 4);
    const float4 bs = *(const float4*)(p.rbias + lane * 4);
    float sc[4], cv[4];
    sc[0] = 1.f / (1.f + expf(-lg.x)); sc[1] = 1.f / (1.f + expf(-lg.y)); sc[2] = 1.f / (1.f + expf(-lg.z)); sc[3] = 1.f / (1.f + expf(-lg.w));
    cv[0] = sc[0] + bs.x; cv[1] = sc[1] + bs.y; cv[2] = sc[2] + bs.z; cv[3] = sc[3] + bs.w;
    float m1 = -INFINITY, m2 = -INFINITY;
#pragma unroll
    for (int i = 0; i < 4; ++i) { const float v = cv[i]; if (v > m1) { m2 = m1; m1 = v; } else if (v > m2) m2 = v; }
#pragma unroll
    for (int off = 1; off < 8; off <<= 1) {
      const float o1 = __shfl_xor(m1, off), o2 = __shfl_xor(m2, off);
      const float n1 = fmaxf(m1, o1), n2 = fmaxf(fminf(m1, o1), fmaxf(m2, o2));
      m1 = n1; m2 = n2;
    }
    const float gs = m1 + m2; const int g = lane >> 3; int rank = 0;
#pragma unroll
    for (int gg = 0; gg < 8; ++gg) { const float og = __shfl(gs, gg * 8); rank += (og > gs || (og == gs && gg < g)) ? 1 : 0; }
    const bool sel = rank < 4;
#pragma unroll
    for (int i = 0; i < 4; ++i) cv[i] = sel ? cv[i] : -INFINITY;
    int my_e = 0; float my_w = 0.f;
#pragma unroll
    for (int k = 0; k < 8; ++k) {
      float bv = cv[0]; int bi = 0;
#pragma unroll
      for (int i = 1; i < 4; ++i) if (cv[i] > bv) { bv = cv[i]; bi = i; }
      int gi = lane * 4 + bi;
#pragma unroll
      for (int off = 32; off >= 1; off >>= 1) {
        const float ov = __shfl_xor(bv, off); const int oi = __shfl_xor(gi, off);
        if (ov > bv || (ov == bv && oi < gi)) { bv = ov; gi = oi; }
      }
      const int sub = gi & 3, own = gi >> 2;
      const float mine = sub == 0 ? sc[0] : sub == 1 ? sc[1] : sub == 2 ? sc[2] : sc[3];
      const float wv = __shfl(mine, own);
      if (lane == own) {
#pragma unroll
        for (int i = 0; i < 4; ++i) if (sub == i) cv[i] = -INFINITY;
      }
      if (lane == k) { my_e = gi; my_w = wv; }
    }
    float sum = (lane < 8) ? my_w : 0.f;
    sum += __shfl_xor(sum, 1); sum += __shfl_xor(sum, 2); sum += __shfl_xor(sum, 4);
    if (lane < 8) {
      const float w = my_w / (sum + 1e-20f) * 2.5f;
      IDX[t * 8 + lane] = my_e; WTS[t * 8 + lane] = w;
      const int pos = atomicAdd(&cnt[my_e * CNT_STRIDE], 1);
      LIST[(size_t)my_e * LISTCAP + pos] = t * 8 + lane;
    }
  }
}

__device__ __forceinline__ void phase_final(const P& p, int bid, int nb) {
  unsigned char* const ws_ = fresh_ws(p.ws);
  const float* X1 = (const float*)(ws_ + WS_X1); const float* SL = (const float*)(ws_ + WS_SLAB); const float* ada = (const float*)(ws_ + WS_ADA);
  const int tid_ = tidx(), lane = tid_ & 63, wave = tid_ >> 6;
  for (int t = bid * NW + wave; t < T; t += nb * NW) {
    const int b = t / SEQ;
    float4 v[4]; float s = 0.f;
#pragma unroll
    for (int j = 0; j < 4; ++j) {
      const int c0 = lane * 4 + 256 * j;
      float4 y = make_float4(0, 0, 0, 0);
#pragma unroll
      for (int k = 0; k < 8; ++k) { const float4 z = *(const float4*)(SL + (size_t)(t * 8 + k) * D + c0); y.x += z.x; y.y += z.y; y.z += z.z; y.w += z.w; }
      const float4 gt = *(const float4*)(ada + b * 6144 + 5120 + c0);
      const float4 bx = *(const float4*)(X1 + (size_t)t * D + c0);
      v[j] = make_float4(bx.x + gt.x * y.x, bx.y + gt.y * y.y, bx.z + gt.z * y.z, bx.w + gt.w * y.w);
      s += v[j].x * v[j].x + v[j].y * v[j].y + v[j].z * v[j].z + v[j].w * v[j].w;
    }
    s = wave_sum(s);
    const float rstd = 1.0f / sqrtf(s * (1.0f / D) + 1e-6f);
#pragma unroll
    for (int j = 0; j < 4; ++j) {
      const int c0 = lane * 4 + 256 * j;
      const float4 gg = *(const float4*)(p.g_final + c0);
      *(float4*)(p.out + (size_t)t * D + c0) = make_float4(v[j].x * rstd * gg.x, v[j].y * rstd * gg.y, v[j].z * rstd * gg.z, v[j].w * rstd * gg.w);
    }
  }
}

#if DIAG_EXACT_ROUTING
namespace diag {
constexpr size_t DW_HN = 64 * MiB, DW_PROJ = 128 * MiB, DW_AO = 320 * MiB, DW_X1 = 384 * MiB, DW_LOGITS = WS_LOGITS;
__device__ __forceinline__ void modnorm(const P& p, int bid, int nb, const float* in, const float* g, int sh_off, int sc_off, float* outp) {
  unsigned char* const ws_ = fresh_ws(p.ws);
  const int tid_ = tidx(), lane = tid_ & 63, wave = tid_ >> 6;
  const float* ada = (const float*)(ws_ + WS_ADA);
  for (int t = bid * NW + wave; t < T; t += nb * NW) {
    const int b = t / SEQ;
    const float4* xr = (const float4*)(in + (size_t)t * D) + lane;
    float4 v[4]; float s = 0.f;
#pragma unroll
    for (int j = 0; j < 4; ++j) { v[j] = xr[64 * j]; s += v[j].x * v[j].x + v[j].y * v[j].y + v[j].z * v[j].z + v[j].w * v[j].w; }
    s = wave_sum(s);
    const float rstd = 1.0f / sqrtf(s * (1.0f / D) + 1e-6f);
    float4* o = (float4*)(outp + (size_t)t * D) + lane;
#pragma unroll
    for (int j = 0; j < 4; ++j) {
      const int c0 = lane * 4 + 256 * j;
      const float4 gg = *(const float4*)(g + c0);
      const float4 sc = *(const float4*)(ada + b * 6144 + sc_off + c0);
      const float4 sh = *(const float4*)(ada + b * 6144 + sh_off + c0);
      float4 r;
      r.x = v[j].x * rstd * gg.x * (1.f + sc.x) + sh.x; r.y = v[j].y * rstd * gg.y * (1.f + sc.y) + sh.y;
      r.z = v[j].z * rstd * gg.z * (1.f + sc.z) + sh.z; r.w = v[j].w * rstd * gg.w * (1.f + sc.w) + sh.w;
      o[64 * j] = r;
    }
  }
}
__device__ __forceinline__ void inproj(const P& p, int bid, int nb, float* lds) {
  unsigned char* const ws_ = fresh_ws(p.ws);
  const float* HN = (const float*)(ws_ + DW_HN); float* PR = (float*)(ws_ + DW_PROJ);
  for (int it = bid; it < (T / 128) * (DPROJ / 64); it += nb) {
    const int mt = it / (DPROJ / 64), nt = it % (DPROJ / 64), m0 = mt * 128;
    auto af = [&](int r, int k) { return *(const float4*)(HN + (size_t)(m0 + r) * D + k); };
    auto ef = [&](int r, int col, float v, float) { PR[(size_t)(m0 + r) * DPROJ + col] = v; };
    gemm_tile_naive<false>(af, 128, p.w_in, nullptr, DPROJ, nt * 64, D, ef, lds);
  }
}
__device__ __forceinline__ void rope(const P& p, int bid, int nb) {
  unsigned char* const ws_ = fresh_ws(p.ws);
  float* PR = (float*)(ws_ + DW_PROJ);
  const float* ct = (const float*)(ws_ + WS_COS); const float* st = (const float*)(ws_ + WS_SIN);
  for (int i = bid * NT + tidx(); i < T * 128; i += nb * NT) {
    const int t = i >> 7, r = i & 127, which = r >> 6, hc = (r >> 3) & 7, f = r & 7;
    float* base = PR + (size_t)t * DPROJ + (which ? COL_K : COL_Q) + hc * 64;
    const float t1 = base[f], t2 = base[8 + f], c = ct[t * 8 + f], s = st[t * 8 + f];
    base[f] = t1 * c - t2 * s; base[8 + f] = t2 * c + t1 * s;
  }
}
__device__ __forceinline__ void attn(const P& p, int bid, int nb) {
  unsigned char* const ws_ = fresh_ws(p.ws);
  const float* PR = (const float*)(ws_ + DW_PROJ); float* AO = (float*)(ws_ + DW_AO);
  const int tid_ = tidx(), lane = tid_ & 63, wave = tid_ >> 6;
  for (int it0 = bid * NW + wave; it0 < 4096; it0 += nb * NW) {
    const int it = __builtin_amdgcn_readfirstlane(it0);
    const int qc = 63 - (it >> 6), rest = it & 63, vh = rest & 1, bh = rest >> 1, b = bh >> 3, hc = bh & 7, h = hc >> 1;
    const int qi = qc * 64 + lane;
    const float* qp = PR + (size_t)(b * SEQ + qi) * DPROJ + COL_Q + hc * 64;
    float q[64], o[64];
#pragma unroll
    for (int d = 0; d < 64; d += 4) { const float4 v = *(const float4*)(qp + d); q[d] = v.x * 0.125f; q[d + 1] = v.y * 0.125f; q[d + 2] = v.z * 0.125f; q[d + 3] = v.w * 0.125f; }
#pragma unroll
    for (int d = 0; d < 64; ++d) o[d] = 0.f;
    float m = -INFINITY, l = 0.f;
    const float* kbase = PR + (size_t)(b * SEQ) * DPROJ + COL_K + hc * 64;
    const float* vbase = PR + (size_t)(b * SEQ) * DPROJ + COL_V + h * 128 + vh * 64;
    const int jmax = qc * 64 + 63;
    for (int j = 0; j <= jmax; ++j) {
      const float* kr = kbase + (size_t)j * DPROJ; const float* vr = vbase + (size_t)j * DPROJ;
      float s = 0.f;
#pragma unroll
      for (int d = 0; d < 64; d += 4) { const float4 kv = *(const float4*)(kr + d); s += q[d] * kv.x; s += q[d + 1] * kv.y; s += q[d + 2] * kv.z; s += q[d + 3] * kv.w; }
      if (j <= qi) {
        const float mn = fmaxf(m, s), a = expf(m - mn), pp = expf(s - mn);
        l = l * a + pp;
#pragma unroll
        for (int d = 0; d < 64; d += 4) { const float4 vv = *(const float4*)(vr + d); o[d] = o[d] * a + pp * vv.x; o[d + 1] = o[d + 1] * a + pp * vv.y; o[d + 2] = o[d + 2] * a + pp * vv.z; o[d + 3] = o[d + 3] * a + pp * vv.w; }
        m = mn;
      }
    }
    const float inv = 1.0f / l;
    float* op = AO + (size_t)(b * SEQ + qi) * 1024 + hc * 128 + vh * 64;
#pragma unroll
    for (int d = 0; d < 64; d += 4) *(float4*)(op + d) = make_float4(o[d] * inv, o[d + 1] * inv, o[d + 2] * inv, o[d + 3] * inv);
  }
}
__device__ __forceinline__ void mix(const P& p, int bid, int nb) {
  unsigned char* const ws_ = fresh_ws(p.ws);
  const float* PR = (const float*)(ws_ + DW_PROJ); const float* AO = (const float*)(ws_ + DW_AO); float* MIX = (float*)(ws_ + DW_HN);
  const float lam = ((const float*)(ws_ + WS_MISC))[0];
  const int tid_ = tidx(), lane = tid_ & 63, wave = tid_ >> 6;
  for (int t = bid * NW + wave; t < T; t += nb * NW) {
    const int s = t % SEQ;
    const float* r0 = PR + (size_t)t * DPROJ;
    float vals[8]; float ss = 0.f;
#pragma unroll
    for (int j = 0; j < 2; ++j) {
      const int ch = lane * 4 + 256 * j;
      const float4 h0 = *(const float4*)(r0 + COL_H + ch), c0 = *(const float4*)(r0 + COL_C + ch), bg = *(const float4*)(r0 + COL_B + ch);
      float4 h1 = make_float4(0, 0, 0, 0), c1 = h1, h2 = h1, c2 = h1;
      if (s >= 1) { h1 = *(const float4*)(r0 - DPROJ + COL_H + ch); c1 = *(const float4*)(r0 - DPROJ + COL_C + ch); }
      if (s >= 2) { h2 = *(const float4*)(r0 - 2 * DPROJ + COL_H + ch); c2 = *(const float4*)(r0 - 2 * DPROJ + COL_C + ch); }
      const float4 w0 = *(const float4*)(p.conv_w + ch), w1 = *(const float4*)(p.conv_w + 512 + ch), w2 = *(const float4*)(p.conv_w + 1024 + ch);
      float y;
      y = w0.x * (c2.x * h2.x) + w1.x * (c1.x * h1.x) + w2.x * (c0.x * h0.x); vals[4 * j + 0] = bg.x * y;
      y = w0.y * (c2.y * h2.y) + w1.y * (c1.y * h1.y) + w2.y * (c0.y * h0.y); vals[4 * j + 1] = bg.y * y;
      y = w0.z * (c2.z * h2.z) + w1.z * (c1.z * h1.z) + w2.z * (c0.z * h0.z); vals[4 * j + 2] = bg.z * y;
      y = w0.w * (c2.w * h2.w) + w1.w * (c1.w * h1.w) + w2.w * (c0.w * h0.w); vals[4 * j + 3] = bg.w * y;
#pragma unroll
      for (int i = 0; i < 4; ++i) ss += vals[4 * j + i] * vals[4 * j + i];
    }
    ss = wave_sum(ss);
    const float rstd = 1.0f / sqrtf(ss * (1.0f / 512.f) + 1e-6f);
    float* mo = MIX + (size_t)t * D;
#pragma unroll
    for (int j = 0; j < 2; ++j) {
      const int ch = lane * 4 + 256 * j;
      const float4 gg = *(const float4*)(p.g_conv + ch);
      *(float4*)(mo + ch) = make_float4(vals[4 * j] * rstd * gg.x, vals[4 * j + 1] * rstd * gg.y, vals[4 * j + 2] * rstd * gg.z, vals[4 * j + 3] * rstd * gg.w);
    }
    const float* ao = AO + (size_t)t * 1024;
#pragma unroll
    for (int j = 0; j < 2; ++j) {
      const int idx = lane * 4 + 256 * j, h = idx >> 7, d = idx & 127;
      const float4 o0 = *(const float4*)(ao + (2 * h) * 128 + d), o1 = *(const float4*)(ao + (2 * h + 1) * 128 + d);
      float dv[4] = {o0.x - lam * o1.x, o0.y - lam * o1.y, o0.z - lam * o1.z, o0.w - lam * o1.w};
      float q = dv[0] * dv[0] + dv[1] * dv[1] + dv[2] * dv[2] + dv[3] * dv[3];
#pragma unroll
      for (int o = 1; o < 32; o <<= 1) q += __shfl_xor(q, o);
      const float r2 = 1.0f / sqrtf(q * (1.0f / 128.f) + 1e-5f);
      const float4 gg = *(const float4*)(p.g_subln + d);
      *(float4*)(mo + 512 + idx) = make_float4(dv[0] * r2 * gg.x * 0.8f, dv[1] * r2 * gg.y * 0.8f, dv[2] * r2 * gg.z * 0.8f, dv[3] * r2 * gg.w * 0.8f);
    }
  }
}
__device__ __forceinline__ void outproj(const P& p, int bid, int nb, float* lds) {
  unsigned char* const ws_ = fresh_ws(p.ws);
  const float* MIX = (const float*)(ws_ + DW_HN); float* X1 = (float*)(ws_ + DW_X1); const float* ada = (const float*)(ws_ + WS_ADA);
  for (int it = bid; it < (T / 128) * (D / 64); it += nb) {
    const int mt = it / (D / 64), nt = it % (D / 64), m0 = mt * 128, b = m0 / SEQ;
    auto af = [&](int r, int k) { return *(const float4*)(MIX + (size_t)(m0 + r) * D + k); };
    auto ef = [&](int r, int col, float v, float) { const size_t o = (size_t)(m0 + r) * D + col; X1[o] = p.x[o] + ada[b * 6144 + 2048 + col] * v; };
    gemm_tile_naive<false>(af, 128, p.w_out, nullptr, D, nt * 64, D, ef, lds);
  }
}
__device__ __forceinline__ void router(const P& p, int bid, int nb, float* lds) {
  unsigned char* const ws_ = fresh_ws(p.ws);
  const float* HN = (const float*)(ws_ + DW_HN); float* LG = (float*)(ws_ + DW_LOGITS);
  for (int it = bid; it < (T / 128) * 4; it += nb) {
    const int mt = it >> 2, r4 = it & 3, m0 = mt * 128;
    auto af = [&](int r, int k) { return *(const float4*)(HN + (size_t)(m0 + r) * D + k); };
    auto ef = [&](int r, int col, float v, float) { LG[(size_t)(m0 + r) * 256 + col] = v; };
    gemm_tile_naive<false>(af, 128, p.w_router, nullptr, 256, r4 * 64, D, ef, lds);
  }
}
}
#endif

__device__ __forceinline__ void convert_slice(const P& p, int part, int nparts, int sl) {
  unsigned char* const ws_ = fresh_ws(p.ws);
  const int tid = tidx();
  bf16_t* WE1 = (bf16_t*)(ws_ + WS_WE1); bf16_t* WE2 = (bf16_t*)(ws_ + WS_WE2);
  constexpr int UN = 8;
  const unsigned stride = (unsigned)nparts * NT;
  const unsigned cbeg = (unsigned)(sl & 3) << 22, cend = cbeg + (1u << 22);
  if (sl < 4) {
    for (unsigned ch0 = cbeg + (unsigned)part * NT + tid; ch0 < cend; ch0 += stride * UN) {
      f32x4 a[UN], b[UN];
#pragma unroll
      for (int u = 0; u < UN; ++u) {
        const unsigned ch = ch0 + u * stride;
        if (ch < cend) {
          const int h8 = (int)(ch & 31), k = (int)((ch >> 5) & 1023), mat = (int)((ch >> 15) & 1), e = (int)(ch >> 16);
          const float* src = (mat ? p.wu_e : p.wg_e) + ((size_t)e * D + k) * DE + 8 * h8;
          a[u] = __builtin_nontemporal_load((const f32x4*)src); b[u] = __builtin_nontemporal_load((const f32x4*)(src + 4));
        }
      }
#pragma unroll
      for (int u = 0; u < UN; ++u) {
        const unsigned ch = ch0 + u * stride;
        if (ch < cend) {
          const int h8 = (int)(ch & 31), k = (int)((ch >> 5) & 1023), mat = (int)((ch >> 15) & 1), e = (int)(ch >> 16);
          const int h = 8 * h8, sub = h >> 7, hl = h & 127, c = 64 * (hl >> 5) + 32 * mat + (hl & 31);
          const size_t blk = ((size_t)(e * 2 + sub) * 32 + (k >> 5)) * 8192;
          const int kk = k & 31, off = (c >> 5) * 1024 + (kk >> 3) * 256 + (kk & 7) * 32 + (c & 31);
          *(u32x4*)(WE1 + blk + off) = (u32x4){pk2(a[u][0], a[u][1]), pk2(a[u][2], a[u][3]), pk2(b[u][0], b[u][1]), pk2(b[u][2], b[u][3])};
        }
      }
    }
  } else {
    const unsigned cb2 = (unsigned)(sl - 4) << 22, ce2 = cb2 + (1u << 22);
    for (unsigned ch0 = cb2 + (unsigned)part * NT + tid; ch0 < ce2; ch0 += stride * UN) {
      f32x4 a[UN], b[UN];
#pragma unroll
      for (int u = 0; u < UN; ++u) {
        const unsigned ch = ch0 + u * stride;
        if (ch < ce2) {
          const int c8 = (int)(ch & 127), k = (int)((ch >> 7) & 255), e = (int)(ch >> 15);
          const float* src = p.wd_e + ((size_t)e * DE + k) * D + 8 * c8;
          a[u] = __builtin_nontemporal_load((const f32x4*)src); b[u] = __builtin_nontemporal_load((const f32x4*)(src + 4));
        }
      }
#pragma unroll
      for (int u = 0; u < UN; ++u) {
        const unsigned ch = ch0 + u * stride;
        if (ch < ce2) {
          const int c8 = (int)(ch & 127), k = (int)((ch >> 7) & 255), e = (int)(ch >> 15);
          const int col = 8 * c8, nt = col >> 8, c = col & 255;
          const size_t blk = ((size_t)(e * 4 + nt) * 8 + (k >> 5)) * 8192;
          const int kk = k & 31, off = (c >> 5) * 1024 + (kk >> 3) * 256 + (kk & 7) * 32 + (c & 31);
          *(u32x4*)(WE2 + blk + off) = (u32x4){pk2(a[u][0], a[u][1]), pk2(a[u][2], a[u][3]), pk2(b[u][0], b[u][1]), pk2(b[u][2], b[u][3])};
        }
      }
    }
  }
}


template <int NC> struct ConvSide {
  unsigned cur, end, stride; f32x4 a[NC], b[NC];
  __device__ __forceinline__ void init(int part, int nparts, unsigned c0, unsigned c1, int tid) { stride = (unsigned)nparts * NT; cur = c0 + (unsigned)part * NT + tid; end = c1; }
  __device__ __forceinline__ bool done() const { return cur >= end; }
  __device__ __forceinline__ void issue(const P& p) {
#pragma unroll
    for (int u = 0; u < NC; ++u) {
      const unsigned ch = cur + u * stride;
      if (ch < end) {
        const float* src;
        if (ch < (1u << 24)) { const int h8 = (int)(ch & 31), k = (int)((ch >> 5) & 1023), mat = (int)((ch >> 15) & 1), e = (int)(ch >> 16); src = (mat ? p.wu_e : p.wg_e) + ((size_t)e * D + k) * DE + 8 * h8; }
        else { const unsigned c2 = ch - (1u << 24); const int c8 = (int)(c2 & 127), k = (int)((c2 >> 7) & 255), e = (int)(c2 >> 15); src = p.wd_e + ((size_t)e * DE + k) * D + 8 * c8; }
        a[u] = __builtin_nontemporal_load((const f32x4*)src); b[u] = __builtin_nontemporal_load((const f32x4*)(src + 4));
      }
    }
  }
  __device__ __forceinline__ void finish(unsigned char* ws_) {
    bf16_t* WE1 = (bf16_t*)(ws_ + WS_WE1); bf16_t* WE2 = (bf16_t*)(ws_ + WS_WE2);
#pragma unroll
    for (int u = 0; u < NC; ++u) {
      const unsigned ch = cur + u * stride;
      if (ch < end) {
        const u32x4 o = (u32x4){pk2(a[u][0], a[u][1]), pk2(a[u][2], a[u][3]), pk2(b[u][0], b[u][1]), pk2(b[u][2], b[u][3])};
        if (ch < (1u << 24)) {
          const int h8 = (int)(ch & 31), k = (int)((ch >> 5) & 1023), mat = (int)((ch >> 15) & 1), e = (int)(ch >> 16);
          const int h = 8 * h8, sub = h >> 7, hl = h & 127, c = 64 * (hl >> 5) + 32 * mat + (hl & 31);
          const size_t blk = ((size_t)(e * 2 + sub) * 32 + (k >> 5)) * 8192; const int kk = k & 31, off = (c >> 5) * 1024 + (kk >> 3) * 256 + (kk & 7) * 32 + (c & 31);
          *(u32x4*)(WE1 + blk + off) = o;
        } else {
          const unsigned c2 = ch - (1u << 24); const int c8 = (int)(c2 & 127), k = (int)((c2 >> 7) & 255), e = (int)(c2 >> 15);
          const int col = 8 * c8, nt = col >> 8, c = col & 255;
          const size_t blk = ((size_t)(e * 4 + nt) * 8 + (k >> 5)) * 8192; const int kk = k & 31, off = (c >> 5) * 1024 + (kk >> 3) * 256 + (kk & 7) * 32 + (c & 31);
          *(u32x4*)(WE2 + blk + off) = o;
        }
      }
    }
    cur += NC * stride;
  }
};

namespace att {
typedef short bf16x8 __attribute__((ext_vector_type(8)));
typedef short s16x4 __attribute__((ext_vector_type(4)));
typedef float f32x16 __attribute__((ext_vector_type(16)));
typedef float f32x2_t __attribute__((ext_vector_type(2)));
typedef __bf16 bf16x2_t __attribute__((ext_vector_type(2)));
constexpr int KSLOT = 8192, VSLOT = 16384;
constexpr int L_K = 0, L_V = 2 * KSLOT, L_WS = L_V + 2 * VSLOT, L_END = L_WS + 8 * 64 * 4;
constexpr float THR = 8.0f;
__device__ __forceinline__ int crow(int r, int hi) { return (r & 3) + 8 * (r >> 2) + 4 * hi; }
__device__ __forceinline__ unsigned cvtpk(float lo, float hi) { f32x2_t v = {lo, hi}; bf16x2_t b = __builtin_convertvector(v, bf16x2_t); return __builtin_bit_cast(unsigned, b); }
__device__ __forceinline__ s16x4 vtr(const LAS unsigned char* p) { typedef short v4i16_t __attribute__((ext_vector_type(4))); return __builtin_bit_cast(s16x4, __builtin_amdgcn_ds_read_tr16_b64_v4i16((LAS v4i16_t*)p)); }
__device__ __forceinline__ bf16x8 pack8(const f32x16& x, int s) {
  u32x4 w; w.x = cvtpk(x[8 * s], x[8 * s + 1]); w.y = cvtpk(x[8 * s + 2], x[8 * s + 3]); w.z = cvtpk(x[8 * s + 4], x[8 * s + 5]); w.w = cvtpk(x[8 * s + 6], x[8 * s + 7]);
  return __builtin_bit_cast(bf16x8, w);
}

template <class SIDE>
__device__ __forceinline__ void attn_unit(const P& p, int b, int hc, int qb, LAS unsigned char* lds, SIDE& side) {
  const int tid = tidx(), lane = tid & 63, r32 = lane & 31, hi = lane >> 5; const int wid = __builtin_amdgcn_readfirstlane(tid >> 6);
  unsigned char* const ws_ = fresh_ws(p.ws);
  const bf16_t* PR = (const bf16_t*)(ws_ + WS_PROJB); bf16_t* AO = (bf16_t*)(ws_ + WS_AO);
  const int h = hc >> 1; const size_t rowbase = (size_t)b * SEQ; const int q0w = qb * 256 + wid * 32;
  bf16x8 qr[4];
  { const bf16_t* Qw = PR + (rowbase + q0w + r32) * DPROJ + COL_Q + hc * 64 + hi * 8;
#pragma unroll
    for (int d0 = 0; d0 < 4; ++d0) qr[d0] = *(const bf16x8*)(Qw + d0 * 16); }
  const bf16_t* ksrc = PR + (rowbase + lane) * DPROJ + COL_K + hc * 64 + wid * 8;
  const bf16_t* vsrc = PR + (rowbase + 16 * (wid & 3) + (lane >> 2)) * DPROJ + COL_V + h * 128 + (wid >> 2) * 32 + (lane & 3) * 8;
  LAS unsigned char* kdst = lds + L_K + wid * 1024 + lane * 16;
  LAS unsigned char* vdst = lds + L_V + wid * 1024 + lane * 16;
  LAS float* wsf = (LAS float*)(lds + L_WS) + wid * 64;
  const int NTL = 4 * qb + 4, tl = 4 * qb + (wid >> 1);
  const size_t tstep = (size_t)64 * DPROJ;
  float mhat = 0.f, l = 0.f; f32x16 o[4], negm;
#pragma unroll
  for (int i = 0; i < 16; ++i) { o[0][i] = 0.f; o[1][i] = 0.f; o[2][i] = 0.f; o[3][i] = 0.f; negm[i] = 0.f; }
  u32x4 kreg = *(const u32x4*)ksrc, v0reg = *(const u32x4*)vsrc, v1reg = *(const u32x4*)(vsrc + 64);
  *(LAS u32x4*)kdst = kreg; *(LAS u32x4*)vdst = v0reg; *(LAS u32x4*)(vdst + 8192) = v1reg;
  __syncthreads();
  const int vlane = ((lane >> 4) & 1) * 32 + (lane & 3) * 8 + (4 * hi + ((lane & 15) >> 2)) * 64;
  for (int t = 0; t < NTL; ++t) {
    const int cur = t & 1;
    side.issue(p);
    if (t + 1 < NTL) { const size_t off = (size_t)(t + 1) * tstep; kreg = *(const u32x4*)(ksrc + off); v0reg = *(const u32x4*)(vsrc + off); v1reg = *(const u32x4*)(vsrc + off + 64); }
    if (t <= tl) {
      const LAS unsigned char* kb = lds + L_K + cur * KSLOT + hi * 1024 + r32 * 16;
      bf16x8 kf[8];
#pragma unroll
      for (int d0 = 0; d0 < 4; ++d0) { kf[2 * d0] = *(const LAS bf16x8*)(kb + d0 * 2048); kf[2 * d0 + 1] = *(const LAS bf16x8*)(kb + d0 * 2048 + 512); }
      f32x16 p0 = negm, p1 = negm;
#pragma unroll
      for (int d0 = 0; d0 < 4; ++d0) {
        p0 = __builtin_amdgcn_mfma_f32_32x32x16_bf16(kf[2 * d0], qr[d0], p0, 0, 0, 0);
        p1 = __builtin_amdgcn_mfma_f32_32x32x16_bf16(kf[2 * d0 + 1], qr[d0], p1, 0, 0, 0);
      }
      const LAS unsigned char* vb = lds + L_V + cur * VSLOT + vlane;
      s16x4 vl[8], vh[8];
#pragma unroll
      for (int i = 0; i < 8; ++i) { vl[i] = vtr(vb + (i >> 2) * 4096 + (i & 3) * 1024); vh[i] = vtr(vb + (i >> 2) * 4096 + (i & 3) * 1024 + 512); }
      if (t == tl) {
        const int lim = 32 * (wid & 1) + r32;
#pragma unroll
        for (int r = 0; r < 16; ++r) { const int kk = crow(r, hi); if (kk > lim) p0[r] = -INFINITY; if (kk + 32 > lim) p1[r] = -INFINITY; }
      }
      float rm = fmaxf(p0[0], p1[0]);
#pragma unroll
      for (int r = 1; r < 16; ++r) rm = fmaxf(rm, fmaxf(p0[r], p1[r]));
      { auto rr = __builtin_amdgcn_permlane32_swap(__float_as_uint(rm), __float_as_uint(rm), false, false); rm = fmaxf(__uint_as_float(rr[0]), __uint_as_float(rr[1])); }
      const bool first = (t == 0);
      if (first || __any(rm > THR)) {
        const float dl = first ? rm : fmaxf(rm, 0.f);
        mhat += dl;
#pragma unroll
        for (int r = 0; r < 16; ++r) { p0[r] -= dl; p1[r] -= dl; negm[r] = -mhat; }
        if (!first) {
          const float f = __builtin_amdgcn_exp2f(-dl);
          l *= f;
          if (hi == 0) wsf[r32] = f;
          asm volatile("s_waitcnt lgkmcnt(0)" ::: "memory");
          float fr[16];
#pragma unroll
          for (int r = 0; r < 16; ++r) fr[r] = wsf[crow(r, hi)];
#pragma unroll
          for (int d0 = 0; d0 < 4; ++d0)
#pragma unroll
            for (int r = 0; r < 16; ++r) o[d0][r] *= fr[r];
          asm volatile("s_waitcnt lgkmcnt(0)" ::: "memory");
        }
      }
      float sacc = 0.f;
#pragma unroll
      for (int r = 0; r < 16; ++r) { p0[r] = __builtin_amdgcn_exp2f(p0[r]); p1[r] = __builtin_amdgcn_exp2f(p1[r]); sacc += p0[r] + p1[r]; }
      l += sacc;
      bf16x8 pa[4]; pa[0] = pack8(p0, 0); pa[1] = pack8(p0, 1); pa[2] = pack8(p1, 0); pa[3] = pack8(p1, 1);
#define ATT_VF(i) (bf16x8){vl[i][0], vl[i][1], vl[i][2], vl[i][3], vh[i][0], vh[i][1], vh[i][2], vh[i][3]}
#pragma unroll
      for (int i = 0; i < 8; ++i) o[i >> 2] = __builtin_amdgcn_mfma_f32_32x32x16_bf16(pa[i & 3], ATT_VF(i), o[i >> 2], 0, 0, 0);
#pragma unroll
      for (int i = 0; i < 8; ++i) { vl[i] = vtr(vb + (2 + (i >> 2)) * 4096 + (i & 3) * 1024); vh[i] = vtr(vb + (2 + (i >> 2)) * 4096 + (i & 3) * 1024 + 512); }
#pragma unroll
      for (int i = 0; i < 8; ++i) o[2 + (i >> 2)] = __builtin_amdgcn_mfma_f32_32x32x16_bf16(pa[i & 3], ATT_VF(i), o[2 + (i >> 2)], 0, 0, 0);
#undef ATT_VF
    }
    side.finish(ws_);
    if (t + 1 < NTL) { const int nx = (cur ^ 1); *(LAS u32x4*)(kdst + nx * KSLOT) = kreg; *(LAS u32x4*)(vdst + nx * VSLOT) = v0reg; *(LAS u32x4*)(vdst + nx * VSLOT + 8192) = v1reg; }
    __syncthreads();
  }
  { auto rr = __builtin_amdgcn_permlane32_swap(__float_as_uint(l), __float_as_uint(l), false, false); l = __uint_as_float(rr[0]) + __uint_as_float(rr[1]); }
  if (hi == 0) wsf[32 + r32] = l;
  asm volatile("s_waitcnt lgkmcnt(0)" ::: "memory");
  bf16_t* Ow = AO + (rowbase + q0w) * 1024 + hc * 128 + r32;
#pragma unroll
  for (int r = 0; r < 16; ++r) {
    const int qq = crow(r, hi); const float rl = 1.0f / wsf[32 + qq];
#pragma unroll
    for (int d0 = 0; d0 < 4; ++d0) Ow[(size_t)qq * 1024 + d0 * 32] = (bf16_t)f2bf(o[d0][r] * rl);
  }
  asm volatile("s_waitcnt lgkmcnt(0)" ::: "memory");
}
}
template <class SIDE>
__device__ __forceinline__ void phase_attn_unit(const P& p, int v, int i, LAS unsigned char* lds, SIDE& side) { const int bh = v >> 3, s = v & 7; att::attn_unit(p, bh >> 3, bh & 7, i == 0 ? 15 - s : s, lds, side); }
namespace attn_body {
using bf16=__hip_bfloat16;
using bf16x8=__attribute__((ext_vector_type(8)))short;
using s16x4=__attribute__((ext_vector_type(4)))short;
using f32x16=__attribute__((ext_vector_type(16)))float;
using u32x4=__attribute__((ext_vector_type(4)))unsigned;
constexpr int BATCH=4,NHEAD=8,SEQ=4096,D=64,PQ=3072,PO=1024;
constexpr int NW=8,QBLK=32,QB=QBLK*NW,KVBLK=64,NQB=SEQ/QB;
constexpr int ATTN_UNIT_ROWS=QB;
__device__ __forceinline__ int crow(int r,int hi){return (r&3)+8*(r>>2)+4*hi;}
#define SBAR() __builtin_amdgcn_sched_barrier(0)
__device__ __forceinline__ void cmask(f32x16&p0,f32x16&p1,int jb,int qrel,int hi){
  const float NEG=-INFINITY; int kb=64*jb+4*hi;
  #pragma unroll
  for(int r=0;r<16;++r){int kv=kb+(r&3)+8*(r>>2); if(kv>qrel)p0[r]=NEG; if(kv+32>qrel)p1[r]=NEG;}
}

constexpr int NSLOT=3, SLOTB=8192;
constexpr int LDS_K=0, LDS_V=NSLOT*SLOTB, LDS_WS=2*NSLOT*SLOTB, LDS_OST=LDS_WS+NW*64*4, LDS_BYTES=LDS_OST+NW*4096;
constexpr float C2=0.125f*1.4426950408889634f;
__device__ __forceinline__ void glds16(const void*gsrc,unsigned lds_dst){unsigned keep;
  asm volatile("s_mov_b32 %0, m0\n\ts_mov_b32 m0, %2\n\ts_nop 0\n\tglobal_load_lds_dwordx4 %1, off\n\ts_mov_b32 m0, %0":"=&s"(keep):"v"(gsrc),"s"(lds_dst):"memory");}
__device__ __forceinline__ float max3f(float a,float b,float c){float r;asm("v_max3_f32 %0, %1, %2, %3":"=v"(r):"v"(a),"v"(b),"v"(c));return r;}
__device__ __forceinline__ float max2f(float a,float b){float r;asm("v_max_f32_e32 %0, %1, %2":"=v"(r):"v"(a),"v"(b));return r;}
__device__ __forceinline__ float fadd_s(float a,float b){float r;asm("v_add_f32_e32 %0, %1, %2":"=v"(r):"v"(a),"v"(b));return r;}
__device__ __forceinline__ float fsub_s(float a,float b){float r;asm("v_sub_f32_e32 %0, %1, %2":"=v"(r):"v"(a),"v"(b));return r;}
typedef float f32x2_t __attribute__((ext_vector_type(2))); typedef __bf16 bf16x2_t __attribute__((ext_vector_type(2)));
__device__ __forceinline__ unsigned cvtpk_s(float lo,float hi){f32x2_t v={lo,hi};bf16x2_t b=__builtin_convertvector(v,bf16x2_t);return __builtin_bit_cast(unsigned,b);}
#define WAIT_BAR(N) asm volatile("s_waitcnt vmcnt(" #N ") lgkmcnt(0)\n\ts_barrier":::"memory")

__device__ __forceinline__ void qkt(f32x16&p0,f32x16&p1,const char*Kslot,const bf16x8*qr,const f32x16&negm,int r32,int hi){
  const char*kb=Kslot+hi*1024+r32*16;
  #pragma unroll
  for(int d0=0;d0<4;++d0){
    const bf16x8 b0=*reinterpret_cast<const bf16x8*>(kb+d0*2048);
    const bf16x8 b1=*reinterpret_cast<const bf16x8*>(kb+d0*2048+512);
    if(d0==0){p0=__builtin_amdgcn_mfma_f32_32x32x16_bf16(b0,qr[0],negm,0,0,0);p1=__builtin_amdgcn_mfma_f32_32x32x16_bf16(b1,qr[0],negm,0,0,0);}
    else{p0=__builtin_amdgcn_mfma_f32_32x32x16_bf16(b0,qr[d0],p0,0,0,0);p1=__builtin_amdgcn_mfma_f32_32x32x16_bf16(b1,qr[d0],p1,0,0,0);}}
}
typedef __attribute__((address_space(3))) const char* lds_cptr;
typedef short v4i16_t __attribute__((ext_vector_type(4)));
__device__ __forceinline__ void kload8(bf16x8*kf,lds_cptr kp){
  kf[0]=*(const __attribute__((address_space(3))) bf16x8*)(kp);      kf[1]=*(const __attribute__((address_space(3))) bf16x8*)(kp+512);
  kf[2]=*(const __attribute__((address_space(3))) bf16x8*)(kp+2048); kf[3]=*(const __attribute__((address_space(3))) bf16x8*)(kp+2560);
  kf[4]=*(const __attribute__((address_space(3))) bf16x8*)(kp+4096); kf[5]=*(const __attribute__((address_space(3))) bf16x8*)(kp+4608);
  kf[6]=*(const __attribute__((address_space(3))) bf16x8*)(kp+6144); kf[7]=*(const __attribute__((address_space(3))) bf16x8*)(kp+6656);
}
__device__ __forceinline__ void kload2(bf16x8*kf,lds_cptr kp,int j){ kf[2*j]=*(const __attribute__((address_space(3))) bf16x8*)(kp+j*2048); kf[2*j+1]=*(const __attribute__((address_space(3))) bf16x8*)(kp+j*2048+512); }
__device__ __forceinline__ s16x4 vtr(lds_cptr p){ return __builtin_bit_cast(s16x4,__builtin_amdgcn_ds_read_tr16_b64_v4i16((__attribute__((address_space(3))) v4i16_t*)p)); }
__device__ __forceinline__ float rowmax(const f32x16&p0,const f32x16&p1){
  float a=max3f(p0[0],p0[1],p1[0]),b=max3f(p0[2],p0[3],p1[1]);a=max3f(a,p1[2],p1[3]);
  #pragma unroll
  for(int r=4;r<16;r+=4){a=max3f(a,p0[r],p0[r+1]);b=max3f(b,p0[r+2],p0[r+3]);a=max3f(a,p1[r],p1[r+1]);b=max3f(b,p1[r+2],p1[r+3]);}
  const float m=max2f(a,b);
  auto rr=__builtin_amdgcn_permlane32_swap(__float_as_uint(m),__float_as_uint(m),false,false);
  return max2f(__uint_as_float(rr[0]),__uint_as_float(rr[1]));
}
__device__ __forceinline__ void pv(f32x16*o,int vb,bf16x8 pa0,bf16x8 pa1,bf16x8 pa2,bf16x8 pa3){
  #pragma unroll
  for(int d0=0;d0<2;++d0){s16x4 lo[4],hi[4];
    #pragma unroll
    for(int ks=0;ks<4;++ks){
      asm volatile("ds_read_b64_tr_b16 %0,%1 offset:%c2":"=&v"(lo[ks]):"v"(vb),"i"(d0*4096+ks*1024):"memory");
      asm volatile("ds_read_b64_tr_b16 %0,%1 offset:%c2":"=&v"(hi[ks]):"v"(vb),"i"(d0*4096+ks*1024+512):"memory");}
    asm volatile("s_waitcnt lgkmcnt(0)":::"memory");SBAR();
    #define PK(k) (bf16x8){lo[k][0],lo[k][1],lo[k][2],lo[k][3],hi[k][0],hi[k][1],hi[k][2],hi[k][3]}
    o[d0]=__builtin_amdgcn_mfma_f32_32x32x16_bf16(pa0,PK(0),o[d0],0,0,0);
    o[d0]=__builtin_amdgcn_mfma_f32_32x32x16_bf16(pa1,PK(1),o[d0],0,0,0);
    o[d0]=__builtin_amdgcn_mfma_f32_32x32x16_bf16(pa2,PK(2),o[d0],0,0,0);
    o[d0]=__builtin_amdgcn_mfma_f32_32x32x16_bf16(pa3,PK(3),o[d0],0,0,0);
    #undef PK
  }
}

#ifndef ATTN_STORE16
#define ATTN_STORE16(p,v) (*(u32x4*)(p)=(v))
#endif
template<int THRL> __device__ __forceinline__ void attn_unit(int b,int h,int hv,int ho,int qb,const bf16*Q,const bf16*__restrict__ K,const bf16*__restrict__ V,bf16*O,char*shm){
  const int tid=tidx(),lane=tid&63,r32=lane&31,hi=lane>>5; const int wid=__builtin_amdgcn_readfirstlane(tid>>6);
  const long rowbase=(long)b*SEQ; const int q0=qb*QB;
  const bf16*Qw=Q+(rowbase+q0+wid*QBLK)*PQ+h*D;
  const bf16*Kh=K+rowbase*PQ+h*D,*Vh=V+rowbase*PQ+hv*D;
  const unsigned lds0=(unsigned)(uintptr_t)shm;
  float*wsf=(float*)(shm+LDS_WS)+wid*64;
  const bf16*ksrc=Kh+(long)lane*PQ+wid*8;
  const bf16*vsrc=Vh+(long)(16*(wid&3)+(lane>>2))*PQ+(wid>>2)*32+(lane&3)*8;
  const unsigned kdst=lds0+LDS_K+wid*1024, vdst=lds0+LDS_V+wid*1024;
  #define DMA_K(t,slot) glds16(ksrc+(long)(t)*KVBLK*PQ,(unsigned)__builtin_amdgcn_readfirstlane(kdst+(slot)))
  #define DMA_V(t,slot) glds16(vsrc+(long)(t)*KVBLK*PQ,(unsigned)__builtin_amdgcn_readfirstlane(vdst+(slot)))
  const int vb0=(int)(lds0+LDS_V)+((lane>>4)&1)*32+(lane&3)*8+(4*hi+((lane&15)>>2))*64;
  const char*Kbase=shm+LDS_K; bf16x8 kf[8];
  const lds_cptr shm3=(lds_cptr)shm; const lds_cptr kp0=shm3+LDS_K+hi*1024+r32*16; const lds_cptr vp0=shm3+LDS_V+((lane>>4)&1)*32+(lane&3)*8+(4*hi+((lane&15)>>2))*64;
  const int NT=(q0+QB)/KVBLK;
  DMA_K(0,0);DMA_V(0,0);DMA_K(1,SLOTB);
  bf16x8 qr[4];
  #pragma unroll
  for(int d0=0;d0<4;++d0)qr[d0]=*reinterpret_cast<const bf16x8*>(&Qw[(long)r32*PQ+d0*16+hi*8]);
  float mhat=0.f,l_reg=0.f;f32x16 o[2];o[0]=f32x16{};o[1]=f32x16{};f32x16 negm=f32x16{};asm volatile("":"+v"(negm));
  const int qrel=wid*QBLK+r32;
  #define CMASK(P0,P1,t) do{int jb_=(t)-(NT-4); if(jb_>=0)cmask(P0,P1,jb_,qrel,hi);}while(0)
  bool resc=false;
  #define START(P0,P1) do{ const float rm=rowmax(P0,P1); resc=false; \
    { const float dl=rm; mhat=fadd_s(mhat,dl); \
      _Pragma("unroll") for(int r=0;r<16;++r){P0[r]=fsub_s(P0[r],dl);P1[r]=fsub_s(P1[r],dl);} \
      _Pragma("unroll") for(int r=0;r<16;++r)negm[r]=-mhat; asm volatile("":"+v"(negm)); } \
    _Pragma("unroll") for(int r=0;r<16;++r)P0[r]=__builtin_amdgcn_exp2f(P0[r]); }while(0)
  #define RESC() do{ if(resc){ asm volatile("s_waitcnt lgkmcnt(0)":::"memory"); \
      _Pragma("unroll") for(int d_=0;d_<2;++d_) _Pragma("unroll") for(int r=0;r<16;++r)o[d_][r]*=wsf[crow(r,hi)]; } }while(0)
  f32x16 pA0,pA1,pB0,pB1;
  int sl_prev=0,sl_cur=0,sl_next=SLOTB;
  #define ROT() do{sl_prev=sl_cur;sl_cur=sl_next;sl_next=(sl_next==(NSLOT-1)*SLOTB)?0:sl_next+SLOTB;}while(0)
  DMA_K(2,2*SLOTB);
  WAIT_BAR(3);
  qkt(pA0,pA1,Kbase,qr,negm,r32,hi);asm volatile("s_nop 15\n\ts_nop 7":"+v"(pA0),"+v"(pA1));CMASK(pA0,pA1,0);
  START(pA0,pA1);
  _Pragma("unroll") for(int r=0;r<16;++r)pA1[r]=__builtin_amdgcn_exp2f(pA1[r]);
  WAIT_BAR(0);
  DMA_K(3,0);DMA_V(1,SLOTB);
  ROT();
  kload8(kf,kp0+sl_cur);
  WAIT_BAR(2);
  s16x4 vlo[8],vhi[8]; u32x4 pw0,pw1,pw2,pw3;
  #define PKW(P,B) cvtpk_s(P[B],P[B+1])
  #define PAF(k) __builtin_bit_cast(bf16x8,pw##k)
  #define VFR(i) (bf16x8){vlo[i][0],vlo[i][1],vlo[i][2],vlo[i][3],vhi[i][0],vhi[i][1],vhi[i][2],vhi[i][3]}
  #define PIN(x) asm volatile("":"+v"(x))
  #define MX3(a,b,c) __builtin_fmaxf(__builtin_fmaxf((a),(b)),(c))
  #define GAPA(MF,A0,A1,A2,A3,W0,W1,PW) do{ MF; sacc+=A0; sacc+=A1; sacc+=A2; sacc+=A3; PIN(sacc); W0; W1; PIN(PW); SBAR(); }while(0)
  #define EX(v) __builtin_amdgcn_exp2f(v)
  #define GAPB(MF,X,B) do{ MF; X[B]=EX(X[B]); X[B+1]=EX(X[B+1]); X[B+2]=EX(X[B+2]); X[B+3]=EX(X[B+3]); PIN(X); SBAR(); }while(0)
  #define VRD(i) do{ vlo[i]=vtr(vp_+(((i)>>2)*4096+((i)&3)*1024)); vhi[i]=vtr(vp_+(((i)>>2)*4096+((i)&3)*1024+512)); }while(0)
  #define KRD(G,j) do{ if(G){ kload2(kf,kp0+sl_next,j); SBAR(); } }while(0)
  #define STEP(C0,C1,P0,P1,t,GK,GV,GL) do{ SBAR(); \
    const lds_cptr vp_=vp0+sl_prev; \
    VRD(0); SBAR(); float sacc=(P0[0]+P0[1]); \
    GAPA(C0=__builtin_amdgcn_mfma_f32_32x32x16_bf16(kf[0],qr[0],negm,0,0,0), P0[2],P0[3],P0[4],P0[5],     pw0[0]=PKW(P0,0), pw0[1]=PKW(P0,2), pw0); \
    VRD(4); SBAR(); GAPA(C1=__builtin_amdgcn_mfma_f32_32x32x16_bf16(kf[1],qr[0],negm,0,0,0), P0[6],P0[7],P0[8],P0[9],     pw0[2]=PKW(P0,4), pw0[3]=PKW(P0,6), pw0); \
    VRD(1); SBAR(); GAPA(C0=__builtin_amdgcn_mfma_f32_32x32x16_bf16(kf[2],qr[1],C0,0,0,0),   P0[10],P0[11],P0[12],P0[13], pw1[0]=PKW(P0,8), pw1[1]=PKW(P0,10), pw1); \
    VRD(5); SBAR(); GAPA(C1=__builtin_amdgcn_mfma_f32_32x32x16_bf16(kf[3],qr[1],C1,0,0,0),   P0[14],P0[15],P1[0],P1[1],   pw1[2]=PKW(P0,12),pw1[3]=PKW(P0,14), pw1); \
    VRD(2); SBAR(); GAPA(C0=__builtin_amdgcn_mfma_f32_32x32x16_bf16(kf[4],qr[2],C0,0,0,0),   P1[2],P1[3],P1[4],P1[5],     pw2[0]=PKW(P1,0), pw2[1]=PKW(P1,2), pw2); \
    VRD(6); SBAR(); GAPA(C1=__builtin_amdgcn_mfma_f32_32x32x16_bf16(kf[5],qr[2],C1,0,0,0),   P1[6],P1[7],P1[8],P1[9],     pw2[2]=PKW(P1,4), pw2[3]=PKW(P1,6), pw2); \
    VRD(3); SBAR(); GAPA(C0=__builtin_amdgcn_mfma_f32_32x32x16_bf16(kf[6],qr[3],C0,0,0,0),   P1[10],P1[11],P1[12],P1[13], pw3[0]=PKW(P1,8), pw3[1]=PKW(P1,10), pw3); \
    VRD(7); SBAR(); GAPA(C1=__builtin_amdgcn_mfma_f32_32x32x16_bf16(kf[7],qr[3],C1,0,0,0),   P1[14],P1[15],0.f,0.f,       pw3[2]=PKW(P1,12),pw3[3]=PKW(P1,14), pw3); \
    l_reg+=sacc; \
    if(GK){DMA_K((t)+3,sl_cur);} if(GV){DMA_V((t)+1,sl_next);} \
    CMASK(C0,C1,t); \
    { float a=MX3(C0[0],C0[1],C1[0]),b=MX3(C0[2],C0[3],C1[1]); a=MX3(a,C1[2],C1[3]); \
      _Pragma("unroll") for(int r=4;r<16;r+=4){a=MX3(a,C0[r],C0[r+1]);b=MX3(b,C0[r+2],C0[r+3]);a=MX3(a,C1[r],C1[r+1]);b=MX3(b,C1[r+2],C1[r+3]);} \
      float rm=__builtin_fmaxf(a,b); { auto rr=__builtin_amdgcn_permlane32_swap(__float_as_uint(rm),__float_as_uint(rm),false,false); rm=__builtin_fmaxf(__uint_as_float(rr[0]),__uint_as_float(rr[1])); } \
      resc=false; \
      if(__builtin_expect(__any(rm>(float)THRL),0)){ const float dl=__builtin_fmaxf(rm,0.f); mhat+=dl; \
        _Pragma("unroll") for(int r=0;r<16;++r){C0[r]-=dl;C1[r]-=dl;} \
        _Pragma("unroll") for(int r=0;r<16;++r)negm[r]=-mhat; asm volatile("":"+v"(negm)); \
        const float f=__builtin_amdgcn_exp2f(-dl); l_reg*=f; if(hi==0)wsf[r32]=f; resc=true; } } \
    SBAR(); \
    GAPB(o[0]=__builtin_amdgcn_mfma_f32_32x32x16_bf16(PAF(0),VFR(0),o[0],0,0,0), C0,0); \
    GAPB(o[1]=__builtin_amdgcn_mfma_f32_32x32x16_bf16(PAF(0),VFR(4),o[1],0,0,0), C0,4); \
    KRD(GL,0); GAPB(o[0]=__builtin_amdgcn_mfma_f32_32x32x16_bf16(PAF(1),VFR(1),o[0],0,0,0), C0,8); \
    KRD(GL,1); GAPB(o[1]=__builtin_amdgcn_mfma_f32_32x32x16_bf16(PAF(1),VFR(5),o[1],0,0,0), C0,12); \
    KRD(GL,2); GAPB(o[0]=__builtin_amdgcn_mfma_f32_32x32x16_bf16(PAF(2),VFR(2),o[0],0,0,0), C1,0); \
    KRD(GL,3); GAPB(o[1]=__builtin_amdgcn_mfma_f32_32x32x16_bf16(PAF(2),VFR(6),o[1],0,0,0), C1,4); \
    GAPB(o[0]=__builtin_amdgcn_mfma_f32_32x32x16_bf16(PAF(3),VFR(3),o[0],0,0,0), C1,8); \
    GAPB(o[1]=__builtin_amdgcn_mfma_f32_32x32x16_bf16(PAF(3),VFR(7),o[1],0,0,0), C1,12); \
    }while(0)
  int t=1;
  #undef CMASK
  #define CMASK(P0,P1,t) do{}while(0)
  for(;t+5<NT;t+=2){
    STEP(pB0,pB1,pA0,pA1,t,true,true,true);     WAIT_BAR(2); RESC(); ROT();
    STEP(pA0,pA1,pB0,pB1,t+1,true,true,true);   WAIT_BAR(2); RESC(); ROT();
  }
  #undef CMASK
  #define CMASK(P0,P1,t) do{int jb_=(t)-(NT-4); if(jb_>=0)cmask(P0,P1,jb_,qrel,hi);}while(0)
  #define ENDW(tt) do{ if((tt)+3<NT){WAIT_BAR(2);} else if((tt)+2<NT){WAIT_BAR(1);} else {WAIT_BAR(0);} }while(0)
  for(;t+1<NT;t+=2){
    STEP(pB0,pB1,pA0,pA1,t,(t+3<NT),(t+1<NT),(t+1<NT));       ENDW(t);   RESC(); ROT();
    STEP(pA0,pA1,pB0,pB1,t+1,(t+4<NT),(t+2<NT),(t+2<NT));     ENDW(t+1); RESC(); ROT();
  }
  STEP(pB0,pB1,pA0,pA1,NT-1,false,false,false); RESC();
  { float sacc=pB0[0]+pB0[1]; _Pragma("unroll") for(int r=2;r<16;++r)sacc+=pB0[r]; _Pragma("unroll") for(int r=0;r<16;++r)sacc+=pB1[r]; l_reg+=sacc;
    pw0=(u32x4){PKW(pB0,0),PKW(pB0,2),PKW(pB0,4),PKW(pB0,6)};pw1=(u32x4){PKW(pB0,8),PKW(pB0,10),PKW(pB0,12),PKW(pB0,14)};pw2=(u32x4){PKW(pB1,0),PKW(pB1,2),PKW(pB1,4),PKW(pB1,6)};pw3=(u32x4){PKW(pB1,8),PKW(pB1,10),PKW(pB1,12),PKW(pB1,14)};
    SBAR(); pv(o,vb0+sl_cur,PAF(0),PAF(1),PAF(2),PAF(3)); }
  #undef PKW
  #undef PAF
  #undef VFR
  #undef PIN
  #undef MX3
  #undef GAPA
  #undef GAPB
  #undef EX
  #undef VRD
  #undef KRD
  #undef STEP
  #undef ENDW
  {auto rr=__builtin_amdgcn_permlane32_swap(__float_as_uint(l_reg),__float_as_uint(l_reg),false,false);l_reg=__uint_as_float(rr[0])+__uint_as_float(rr[1]);}
  if(hi==0)wsf[32+r32]=l_reg;asm volatile("s_waitcnt lgkmcnt(0)":::"memory");
  float rli[16];
  #pragma unroll
  for(int r=0;r<16;++r)rli[r]=__builtin_amdgcn_rcpf(wsf[32+crow(r,hi)]);
  bf16*Ow=O+(rowbase+q0+wid*QBLK)*PO+ho*D;
  { bf16*stg=(bf16*)(shm+LDS_OST)+wid*2048;
    #pragma unroll
    for(int r=0;r<16;++r){const int orow=crow(r,hi);
      #pragma unroll
      for(int d0=0;d0<2;++d0)stg[orow*64+d0*32+r32]=__float2bfloat16(o[d0][r]*rli[r]);}
    asm volatile("s_waitcnt lgkmcnt(0)":::"memory");
    #pragma unroll
    for(int i=0;i<4;++i){const int row=i*8+(lane>>3),ch=lane&7; const u32x4 v=*(const u32x4*)(stg+row*64+ch*8); ATTN_STORE16(Ow+(long)row*PO+ch*8,v);} }
  asm volatile("s_waitcnt lgkmcnt(0)\n\ts_barrier":::"memory");
  #undef DMA_K
  #undef DMA_V
  #undef CMASK
  #undef START
  #undef RESC
  #undef ROT
}
constexpr int ATTN_LDS_BYTES=LDS_BYTES;
struct AttnTensors { const bf16* Q; const bf16* K; const bf16* V; bf16* O; };
template<int THRL=8> __device__ __forceinline__ void attn_phase_unit(char*lds,const AttnTensors&T,int vcu,int i){
  const int bh=vcu>>3,s=vcu&7,b=bh>>3,hc=bh&7;
  const int qb=(i<2)?15-s:s, half=i&1; attn_unit<THRL>(b,hc,(hc>>1)*2+half,2*hc+half,qb,T.Q,T.K,T.V,T.O,lds);
}
#undef SBAR
#undef WAIT_BAR
}

namespace moe {
typedef short bf16x8 __attribute__((ext_vector_type(8)));
typedef short s16x4 __attribute__((ext_vector_type(4)));
typedef float f32x16 __attribute__((ext_vector_type(16)));
typedef unsigned u32x2 __attribute__((ext_vector_type(2)));
constexpr int SLOT = 32768, L_ROWS = 131072, L_TS = 133120, L_CL = 134400;

template <int STAGE>
__device__ __forceinline__ void run(const P& p, int bid, int nb, LAS unsigned char* lds) {
  unsigned char* const ws_ = fresh_ws(p.ws);
  constexpr int NSUB = (STAGE == 1) ? 2 : 4, KTOT = (STAGE == 1) ? D : DE, NK = KTOT / 32;
  const int tid = tidx(), lane = tid & 63, r32 = lane & 31, hi = lane >> 5; const int wid = __builtin_amdgcn_readfirstlane(tid >> 6), wm = wid >> 2, wn = wid & 3;
  const int* cnt = (const int*)(ws_ + WS_CTL); const int* LIST = (const int*)(ws_ + WS_LIST);
  LAS int* ts = (LAS int*)(lds + L_TS); LAS int* cl = (LAS int*)(lds + L_CL);
  __syncthreads();
  if (tid < 256) cl[tid] = cnt[tid * CNT_STRIDE];
  __syncthreads();
  if (tid <= 256) { int a = 0; for (int i = 0; i < tid; ++i) a += (cl[i] + 255) >> 8; ts[tid] = a; }
  __syncthreads();
  const int nitems = ts[256] * NSUB;
  const int vcu = (nb % 8 == 0) ? (bid % 8) * (nb / 8) + bid / 8 : bid;
  const bf16_t* Asrc = (STAGE == 1) ? (const bf16_t*)(ws_ + WS_HNB) : (const bf16_t*)(ws_ + WS_H);
  const bf16_t* Bimg = (STAGE == 1) ? (const bf16_t*)(ws_ + WS_WE1) : (const bf16_t*)(ws_ + WS_WE2);
  const int cgk = ((lane & 3) ^ ((lane >> 4) & 3)) * 8;
  int abase[2];
#pragma unroll
  for (int k16 = 0; k16 < 2; ++k16) abase[k16] = (128 * wm + r32) * 64 + (((2 * k16 + hi) ^ ((r32 >> 2) & 3)) * 16);
  const int bbase = 16384 + (2 * wn) * 2048 + hi * 512 + ((lane & 15) >> 2) * 64 + ((lane >> 4) & 1) * 32 + (lane & 3) * 8;

#define MOE_DESC(it, E_, MT_, MC_, SUB_) do { const int tile_ = (it) / NSUB; SUB_ = (it) % NSUB; int lo_ = 0, hi_ = 256; \
    while (hi_ - lo_ > 1) { const int mid_ = (lo_ + hi_) >> 1; if (ts[mid_] <= tile_) lo_ = mid_; else hi_ = mid_; } \
    E_ = __builtin_amdgcn_readfirstlane(lo_); MT_ = __builtin_amdgcn_readfirstlane(tile_ - ts[lo_]); MC_ = __builtin_amdgcn_readfirstlane(min(256, cl[lo_] - MT_ * 256)); } while (0)
#define MOE_ROWS_DMA(E_, MT_, par) do { if (wid == 0) __builtin_amdgcn_global_load_lds((const unsigned*)(LIST + (size_t)(E_) * LISTCAP + (MT_) * 256 + lane * 4), (LAS unsigned*)(lds + L_ROWS + (par) * 1024), 16, 0, 0); } while (0)
#define MOE_ASRC(dst, par, MC_) do { _Pragma("unroll") for (int i = 0; i < 2; ++i) { const int aidr = ((LAS int*)(lds + L_ROWS + (par) * 1024))[min(16 * (2 * wid + i) + (lane >> 2), (MC_) - 1)]; \
      dst[i] = Asrc + ((STAGE == 1) ? (size_t)(aidr >> 3) * D : (size_t)aidr * DE) + cgk; } } while (0)
#define MOE_ISSUE_SL(AS, BS, s, SL) do { LAS unsigned char* sl_ = lds + (SL) * SLOT + (2 * wid) * 1024; \
      __builtin_amdgcn_global_load_lds((const unsigned*)(AS[0] + (s) * 32), (LAS unsigned*)(sl_), 16, 0, 0); \
      __builtin_amdgcn_global_load_lds((const unsigned*)(AS[1] + (s) * 32), (LAS unsigned*)(sl_ + 1024), 16, 0, 0); \
      __builtin_amdgcn_global_load_lds((const unsigned*)(BS + (size_t)(s) * 8192), (LAS unsigned*)(sl_ + 16384), 16, 0, 0); \
      __builtin_amdgcn_global_load_lds((const unsigned*)(BS + (size_t)(s) * 8192 + 512), (LAS unsigned*)(sl_ + 16384 + 1024), 16, 0, 0); } while (0)

  int item = vcu, par = 0;
  int e = 0, mt = 0, mcount = 1, sub = 0;
  const bf16_t* asrc[2]; const bf16_t* bsrc;
  if (item < nitems) {
    MOE_DESC(item, e, mt, mcount, sub);
    MOE_ROWS_DMA(e, mt, 0);
    asm volatile("s_waitcnt vmcnt(0)" ::: "memory"); __syncthreads();
    MOE_ASRC(asrc, 0, mcount);
    bsrc = Bimg + (size_t)(e * NSUB + sub) * NK * 8192 + (2 * wid) * 512 + lane * 8;
    MOE_ISSUE_SL(asrc, bsrc, 0, 0); MOE_ISSUE_SL(asrc, bsrc, 1, 1); MOE_ISSUE_SL(asrc, bsrc, 2, 2);
  }
  while (item < nitems) {
    const int nitem = item + nb; const bool has_next = nitem < nitems;
    int ne = 0, nmt = 0, nmc = 1, nsub = 0;
    const bf16_t* nasrc[2] = {Asrc, Asrc}; const bf16_t* nbsrc = Bimg;
    if (has_next) { MOE_DESC(nitem, ne, nmt, nmc, nsub); nbsrc = Bimg + (size_t)(ne * NSUB + nsub) * NK * 8192 + (2 * wid) * 512 + lane * 8; }
    f32x16 acc[4][2];
#pragma unroll
    for (int m = 0; m < 4; ++m)
#pragma unroll
      for (int n = 0; n < 2; ++n)
#pragma unroll
        for (int r = 0; r < 16; ++r) acc[m][n][r] = 0.f;
#define MOE_STEP(s, SL) do { \
      if ((s) + 2 < NK || has_next) asm volatile("s_waitcnt vmcnt(8)" ::: "memory"); \
      else if ((s) + 1 < NK) asm volatile("s_waitcnt vmcnt(4)" ::: "memory"); \
      else asm volatile("s_waitcnt vmcnt(0)" ::: "memory"); \
      __builtin_amdgcn_s_barrier(); \
      asm volatile("" ::: "memory"); \
      if ((s) + 3 < NK) MOE_ISSUE_SL(asrc, bsrc, (s) + 3, ((SL) + 3) & 3); \
      else if (has_next) { if ((s) + 3 == NK) MOE_ASRC(nasrc, par ^ 1, nmc); MOE_ISSUE_SL(nasrc, nbsrc, (s) + 3 - NK, ((SL) + 3) & 3); } \
      if ((s) == 0 && has_next) MOE_ROWS_DMA(ne, nmt, par ^ 1); \
      const LAS unsigned char* Ab = lds + (SL) * SLOT; const unsigned Bbv = (unsigned)(uintptr_t)(lds + (SL) * SLOT + bbase); \
      bf16x8 af[2][4], bfr[2][2]; s16x4 tq[8]; const unsigned Abv0 = (unsigned)(uintptr_t)(Ab + abase[0]), Abv1 = (unsigned)(uintptr_t)(Ab + abase[1]); \
      asm volatile("ds_read_b64_tr_b16 %0, %1 offset:0" : "=&v"(tq[0]) : "v"(Bbv) : "memory"); \
      asm volatile("ds_read_b64_tr_b16 %0, %1 offset:256" : "=&v"(tq[1]) : "v"(Bbv) : "memory"); \
      asm volatile("ds_read_b64_tr_b16 %0, %1 offset:2048" : "=&v"(tq[2]) : "v"(Bbv) : "memory"); \
      asm volatile("ds_read_b64_tr_b16 %0, %1 offset:2304" : "=&v"(tq[3]) : "v"(Bbv) : "memory"); \
      asm volatile("ds_read_b128 %0, %1 offset:0" : "=&v"(af[0][0]) : "v"(Abv0) : "memory"); \
      asm volatile("ds_read_b128 %0, %1 offset:2048" : "=&v"(af[0][1]) : "v"(Abv0) : "memory"); \
      asm volatile("ds_read_b128 %0, %1 offset:4096" : "=&v"(af[0][2]) : "v"(Abv0) : "memory"); \
      asm volatile("ds_read_b128 %0, %1 offset:6144" : "=&v"(af[0][3]) : "v"(Abv0) : "memory"); \
      asm volatile("ds_read_b64_tr_b16 %0, %1 offset:1024" : "=&v"(tq[4]) : "v"(Bbv) : "memory"); \
      asm volatile("ds_read_b64_tr_b16 %0, %1 offset:1280" : "=&v"(tq[5]) : "v"(Bbv) : "memory"); \
      asm volatile("ds_read_b64_tr_b16 %0, %1 offset:3072" : "=&v"(tq[6]) : "v"(Bbv) : "memory"); \
      asm volatile("ds_read_b64_tr_b16 %0, %1 offset:3328" : "=&v"(tq[7]) : "v"(Bbv) : "memory"); \
      asm volatile("ds_read_b128 %0, %1 offset:0" : "=&v"(af[1][0]) : "v"(Abv1) : "memory"); \
      asm volatile("ds_read_b128 %0, %1 offset:2048" : "=&v"(af[1][1]) : "v"(Abv1) : "memory"); \
      asm volatile("ds_read_b128 %0, %1 offset:4096" : "=&v"(af[1][2]) : "v"(Abv1) : "memory"); \
      asm volatile("ds_read_b128 %0, %1 offset:6144" : "=&v"(af[1][3]) : "v"(Abv1) : "memory"); \
      asm volatile("s_waitcnt lgkmcnt(8)" : "+v"(tq[0]), "+v"(tq[1]), "+v"(tq[2]), "+v"(tq[3]), "+v"(af[0][0]), "+v"(af[0][1]), "+v"(af[0][2]), "+v"(af[0][3]) :: "memory"); __builtin_amdgcn_sched_barrier(0); \
      _Pragma("unroll") for (int n = 0; n < 2; ++n) { const s16x4 l0 = tq[2 * n], h0 = tq[2 * n + 1]; bfr[0][n] = (bf16x8){l0[0], l0[1], l0[2], l0[3], h0[0], h0[1], h0[2], h0[3]}; } \
      __builtin_amdgcn_s_setprio(1); \
      _Pragma("unroll") for (int m = 0; m < 4; ++m) \
        _Pragma("unroll") for (int n = 0; n < 2; ++n) acc[m][n] = __builtin_amdgcn_mfma_f32_32x32x16_bf16(bfr[0][n], af[0][m], acc[m][n], 0, 0, 0); \
      __builtin_amdgcn_sched_barrier(0); \
      asm volatile("s_waitcnt lgkmcnt(0)" : "+v"(tq[4]), "+v"(tq[5]), "+v"(tq[6]), "+v"(tq[7]), "+v"(af[1][0]), "+v"(af[1][1]), "+v"(af[1][2]), "+v"(af[1][3]) :: "memory"); __builtin_amdgcn_sched_barrier(0); \
      _Pragma("unroll") for (int n = 0; n < 2; ++n) { const s16x4 l0 = tq[4 + 2 * n], h0 = tq[4 + 2 * n + 1]; bfr[1][n] = (bf16x8){l0[0], l0[1], l0[2], l0[3], h0[0], h0[1], h0[2], h0[3]}; } \
      _Pragma("unroll") for (int m = 0; m < 4; ++m) \
        _Pragma("unroll") for (int n = 0; n < 2; ++n) acc[m][n] = __builtin_amdgcn_mfma_f32_32x32x16_bf16(bfr[1][n], af[1][m], acc[m][n], 0, 0, 0); \
      __builtin_amdgcn_s_setprio(0); \
      asm volatile("s_waitcnt lgkmcnt(0)" ::: "memory"); } while (0)
    for (int s = 0; s < NK; s += 4) { MOE_STEP(s, 0); MOE_STEP(s + 1, 1); MOE_STEP(s + 2, 2); MOE_STEP(s + 3, 3); }
#undef MOE_STEP
    {
      const LAS int* rw = (const LAS int*)(lds + L_ROWS + par * 1024);
#pragma unroll
      for (int m = 0; m < 4; ++m) {
        const int row = 128 * wm + 32 * m + r32; const bool valid = row < mcount;
        const int aid = rw[min(row, mcount - 1)];
        if (STAGE == 1) {
          bf16_t* hp = (bf16_t*)(ws_ + WS_H) + (size_t)aid * DE + 128 * sub + 32 * wn + 8 * hi;
#pragma unroll
          for (int g = 0; g < 4; g += 2) {
            unsigned a0 = pk2(silu_f(acc[m][0][4 * g]) * acc[m][1][4 * g], silu_f(acc[m][0][4 * g + 1]) * acc[m][1][4 * g + 1]), a1 = pk2(silu_f(acc[m][0][4 * g + 2]) * acc[m][1][4 * g + 2], silu_f(acc[m][0][4 * g + 3]) * acc[m][1][4 * g + 3]);
            unsigned b0 = pk2(silu_f(acc[m][0][4 * g + 4]) * acc[m][1][4 * g + 4], silu_f(acc[m][0][4 * g + 5]) * acc[m][1][4 * g + 5]), b1 = pk2(silu_f(acc[m][0][4 * g + 6]) * acc[m][1][4 * g + 6], silu_f(acc[m][0][4 * g + 7]) * acc[m][1][4 * g + 7]);
            { auto r = __builtin_amdgcn_permlane32_swap(a0, b0, false, false); a0 = r[0]; b0 = r[1]; }
            { auto r = __builtin_amdgcn_permlane32_swap(a1, b1, false, false); a1 = r[0]; b1 = r[1]; }
            if (valid) *(u32x4*)(hp + 8 * g) = (u32x4){a0, a1, b0, b1};
          }
        } else {
          const float w = ((const float*)(ws_ + WS_WTS))[aid];
          bf16_t* sp = (bf16_t*)(ws_ + WS_SLAB) + (size_t)aid * D + 256 * sub + 64 * wn + 8 * hi;
#pragma unroll
          for (int n = 0; n < 2; ++n)
#pragma unroll
            for (int g = 0; g < 4; g += 2) {
              unsigned a0 = pk2(acc[m][n][4 * g] * w, acc[m][n][4 * g + 1] * w), a1 = pk2(acc[m][n][4 * g + 2] * w, acc[m][n][4 * g + 3] * w);
              unsigned b0 = pk2(acc[m][n][4 * g + 4] * w, acc[m][n][4 * g + 5] * w), b1 = pk2(acc[m][n][4 * g + 6] * w, acc[m][n][4 * g + 7] * w);
              { auto r = __builtin_amdgcn_permlane32_swap(a0, b0, false, false); a0 = r[0]; b0 = r[1]; }
              { auto r = __builtin_amdgcn_permlane32_swap(a1, b1, false, false); a1 = r[0]; b1 = r[1]; }
              if (valid) *(u32x4*)(sp + 32 * n + 8 * g) = (u32x4){a0, a1, b0, b1};
            }
        }
      }
    }
    item = nitem; par ^= 1; e = ne; mt = nmt; mcount = nmc; sub = nsub; asrc[0] = nasrc[0]; asrc[1] = nasrc[1]; bsrc = nbsrc;
  }
#undef MOE_DESC
#undef MOE_ROWS_DMA
#undef MOE_ASRC
#undef MOE_ISSUE_SL
  asm volatile("s_waitcnt vmcnt(0)" ::: "memory");
  __syncthreads();
}
}

__device__ __forceinline__ void phase_final_bf(const P& p, int bid, int nb) {
  unsigned char* const ws_ = fresh_ws(p.ws);
  const float* X1 = (const float*)(ws_ + WS_X1); const bf16_t* SL = (const bf16_t*)(ws_ + WS_SLAB); const float* ada = (const float*)(ws_ + WS_ADA);
  const int tid_ = tidx(), lane = tid_ & 63, wave = tid_ >> 6;
  for (int t = bid * NW + wave; t < T; t += nb * NW) {
    const int b = t / SEQ;
    float4 v[4]; float s = 0.f;
#pragma unroll
    for (int j = 0; j < 4; ++j) {
      const int c0 = lane * 4 + 256 * j;
      float4 y = make_float4(0, 0, 0, 0);
#pragma unroll
      for (int k = 0; k < 8; ++k) { const float4 z = ld_bf4(SL + (size_t)(t * 8 + k) * D + c0); y.x += z.x; y.y += z.y; y.z += z.z; y.w += z.w; }
      const float4 gt = *(const float4*)(ada + b * 6144 + 5120 + c0);
      const float4 bx = *(const float4*)(X1 + (size_t)t * D + c0);
      v[j] = make_float4(bx.x + gt.x * y.x, bx.y + gt.y * y.y, bx.z + gt.z * y.z, bx.w + gt.w * y.w);
      s += v[j].x * v[j].x + v[j].y * v[j].y + v[j].z * v[j].z + v[j].w * v[j].w;
    }
    s = wave_sum(s);
    const float rstd = 1.0f / sqrtf(s * (1.0f / D) + 1e-6f);
#pragma unroll
    for (int j = 0; j < 4; ++j) {
      const int c0 = lane * 4 + 256 * j;
      const float4 gg = *(const float4*)(p.g_final + c0);
      *(float4*)(p.out + (size_t)t * D + c0) = make_float4(v[j].x * rstd * gg.x, v[j].y * rstd * gg.y, v[j].z * rstd * gg.z, v[j].w * rstd * gg.w);
    }
  }
}

#define XB_TMO      128
#define XB_XCNT(j)  (256  + 64 * (j))
#define XB_XSUB(j)  (1280 + 64 * (j))
#define XB_XGEN(j)  (2304 + 64 * (j))
#define XB_TOP      3328
#define XB_TOPGEN   3392
#define XCD_BAR_WORDS 3456
#define XB_SPIN_CAP (1u << 22)
__device__ __forceinline__ unsigned xb_ld(unsigned* p)              { return __hip_atomic_load(p, __ATOMIC_RELAXED, __HIP_MEMORY_SCOPE_AGENT); }
__device__ __forceinline__ unsigned xb_add(unsigned* p, unsigned v) { return __hip_atomic_fetch_add(p, v, __ATOMIC_RELAXED, __HIP_MEMORY_SCOPE_AGENT); }
__device__ __forceinline__ unsigned xb_xcc_id() { return (unsigned)__builtin_amdgcn_s_getreg((3 << 11) | 20) & 0xFu; }
#define XB_SPIN(cond, bar) do { unsigned _sp = 0; while (cond) { __builtin_amdgcn_s_sleep(1); \
    if ((++_sp & 255u) == 0u) { if (xb_ld(&(bar)[XB_TMO])) break; if (_sp > XB_SPIN_CAP) { atomicAdd(&(bar)[XB_TMO], 1u); break; } } } } while (0)
struct XcdBarrier { unsigned* bar; unsigned x; volatile LAS unsigned* st; };
__device__ __forceinline__ XcdBarrier xcd_barrier_post(unsigned* bar, volatile LAS unsigned* st) {
    XcdBarrier b; b.bar = bar; b.x = xb_xcc_id(); b.st = st;
    if (threadIdx.x == 0) (void)xb_add(&bar[XB_XCNT(b.x)], 1u);
    return b;
}
__device__ __forceinline__ void xcd_barrier_complete(unsigned* bar, unsigned x, unsigned& nloc, unsigned& nx) {
    const unsigned G = gridDim.x * gridDim.y * gridDim.z;
    unsigned sum, cnt, mine, sp = 0u;
    for (;;) {
        sum = 0u; cnt = 0u; mine = 0u;
#pragma unroll
        for (unsigned j = 0; j < 16; ++j) { const unsigned c = xb_ld(&bar[XB_XCNT(j)]); sum += c; cnt += (c > 0u) ? 1u : 0u; mine = (j == x) ? c : mine; }
        if (sum == G) break;
        __builtin_amdgcn_s_sleep(1);
        if ((++sp & 255u) == 0u) { if (xb_ld(&bar[XB_TMO])) break; if (sp > XB_SPIN_CAP) { atomicAdd(&bar[XB_TMO], 1u); break; } }
    }
    nloc = mine > 0u ? mine : 1u; nx = cnt > 0u ? cnt : 1u;
}
__device__ __forceinline__ void xcd_barrier(const XcdBarrier& b) {
    asm volatile("s_waitcnt vmcnt(0)" ::: "memory");
    __syncthreads();
    if (threadIdx.x == 0) {
        unsigned long long bz = 0; unsigned bx = b.x;
        asm volatile("" : "+s"(bz), "+s"(bx));
        unsigned* bar = b.bar + bz;
        __builtin_amdgcn_s_waitcnt(0);
        unsigned nloc = b.st[0], nx = b.st[1];
        if (nloc == 0u) { xcd_barrier_complete(bar, bx, nloc, nx); b.st[0] = nloc; b.st[1] = nx; }
        const unsigned old = xb_add(&bar[XB_XSUB(bx)], 1u);
        const unsigned gen = old / nloc;
        if (old + 1u == (gen + 1u) * nloc) {
            __builtin_amdgcn_fence(__ATOMIC_RELEASE, "agent");
            asm volatile("s_waitcnt vmcnt(0)" ::: "memory");
            const unsigned og = xb_add(&bar[XB_TOP], 1u);
            const unsigned tg = og / nx;
            if (og + 1u == (tg + 1u) * nx) xb_add(&bar[XB_TOPGEN], 1u);
            else XB_SPIN(xb_ld(&bar[XB_TOPGEN]) == tg, bar);
            __builtin_amdgcn_fence(__ATOMIC_ACQUIRE, "agent");
            xb_add(&bar[XB_XGEN(bx)], 1u);
            asm volatile("s_waitcnt vmcnt(0)" ::: "memory");
        } else {
            XB_SPIN(xb_ld(&bar[XB_XGEN(bx)]) == gen, bar);
            __builtin_amdgcn_fence(__ATOMIC_ACQUIRE, "agent");
            asm volatile("s_waitcnt vmcnt(0)" ::: "memory");
        }
    }
    __syncthreads();
}

constexpr int CW_BAR = 32768;
constexpr int LDS_BYTES = 147456;
constexpr int MISC_OFF = 140 * 1024;

__global__ void __launch_bounds__(NT, 2) mega(P p) {
  extern __shared__ __attribute__((aligned(16))) unsigned char smem[];
  float* lds = (float*)smem;
  LAS unsigned char* ldsb = (LAS unsigned char*)smem;
  volatile LAS unsigned* st = (volatile LAS unsigned*)(ldsb + MISC_OFF);
  if (threadIdx.x < 4) st[threadIdx.x] = 0u;
  __syncthreads();
  XcdBarrier bar = xcd_barrier_post((unsigned*)(p.ws + WS_CTL) + CW_BAR, st);
  const int bid = blockIdx.x, nb = gridDim.x;
  volatile LAS unsigned* tl = st + 16; int nstamp = 0;
#define STAMP() do { if (TIME_SEL_A >= 0 && threadIdx.x == 0) tl[nstamp] = (unsigned)__builtin_amdgcn_s_memrealtime(); ++nstamp; } while (0)
  STAMP();
#define FRESH(q) const P& q = p; unsigned char* const q##w = fresh_ws(p.ws)
#define HNB_(q) ((bf16_t*)(q##w + WS_HNB))
#define PROJB_(q) ((bf16_t*)(q##w + WS_PROJB))
#define X1_(q) ((float*)(q##w + WS_X1))
#define ADA_(q) ((const float*)(q##w + WS_ADA))

  for (int rep = 0; rep < REP_CONV; ++rep) { FRESH(q); phase_prologue(q, bid, nb, lds); xcd_barrier(bar); STAMP(); }
#if DIAG_EXACT_ROUTING
  { FRESH(q); diag::modnorm(q, bid, nb, q.x, q.g1, 0, 1024, (float*)(qw + diag::DW_HN));       xcd_barrier(bar); STAMP(); }
  { FRESH(q); diag::inproj(q, bid, nb, lds);                                                     xcd_barrier(bar); STAMP(); }
  { FRESH(q); diag::rope(q, bid, nb);                                                            xcd_barrier(bar); STAMP(); }
  { FRESH(q); diag::attn(q, bid, nb);                                                            xcd_barrier(bar); STAMP(); }
  { FRESH(q); diag::mix(q, bid, nb);                                                             xcd_barrier(bar); STAMP(); }
  { FRESH(q); diag::outproj(q, bid, nb, lds);                                                    xcd_barrier(bar); STAMP(); }
  { FRESH(q); diag::modnorm(q, bid, nb, (const float*)(qw + diag::DW_X1), q.g2, 3072, 4096, (float*)(qw + diag::DW_HN)); xcd_barrier(bar); STAMP(); }
  { FRESH(q); diag::router(q, bid, nb, lds);                                                     xcd_barrier(bar); STAMP(); }
  { FRESH(q); phase_route(q, bid, nb, (const float*)(qw + diag::DW_LOGITS));                   xcd_barrier(bar); STAMP(); }
#endif
  for (int rep = 0; rep < REP_LIGHT; ++rep) { FRESH(q); phase_modnorm(q, bid, nb, q.x, q.g1, 0, 1024, HNB_(q)); xcd_barrier(bar); STAMP(); }
  const bool xpar = ((bid % 8) & 1) != 0;
  { FRESH(q);
    if (xpar) { convert_slice(q, bid, nb, 0); convert_slice(q, bid, nb, 1); }
    pg8::Gemm g{HNB_(q), (const bf16_t*)(qw + WS_WIN_T), T, DPROJ, D}; pg8::StaticOrder S; S.init(T, DPROJ, nb, bid);
    EpiInproj E{PROJB_(q), (const float*)(qw + WS_COS), (const float*)(qw + WS_SIN)};
    pg8::gemm_phase<EpiInproj, pg8::StaticOrder, true, true>(ldsb, g, S, E);
    if (!xpar) { convert_slice(q, bid, nb, 0); convert_slice(q, bid, nb, 1); }
    xcd_barrier(bar); STAMP(); }
  {
    FRESH(q);
    const attn_body::AttnTensors AT{(const attn_body::bf16*)(PROJB_(q) + COL_Q), (const attn_body::bf16*)(PROJB_(q) + COL_K), (const attn_body::bf16*)(PROJB_(q) + COL_V), (attn_body::bf16*)(qw + WS_AO)};
    const int vcu = (nb % 8 == 0) ? (bid % 8) * (nb / 8) + bid / 8 : bid;
#if ATTN_IMPL == 0
    {
      ConvSide<2> side; side.init(bid, nb, 1u << 23, 3u << 23, tidx());
#pragma unroll 1
      for (int i = 0; i < 2; ++i)
        for (int v = vcu; v < 256; v += nb) phase_attn_unit(q, v, i, ldsb, side);
      while (!side.done()) { side.issue(q); side.finish(qw); }
    }
#else
#pragma unroll 1
    for (int i = 0; i < 4; ++i) {
      if (xpar) convert_slice(q, bid, nb, 2 + i);
      for (int v = vcu; v < 256; v += nb) attn_body::attn_phase_unit<8>((char*)smem, AT, v, i);
      if (!xpar) convert_slice(q, bid, nb, 2 + i);
    }
#endif
    xcd_barrier(bar); STAMP(); }
  for (int rep = 0; rep < REP_LIGHT; ++rep) { FRESH(q); phase_mix(q, bid, nb);                    xcd_barrier(bar); STAMP(); }
  for (int rep = 0; rep < REP_GEMM; ++rep)
  { FRESH(q); pg8::Gemm g{HNB_(q), (const bf16_t*)(qw + WS_WOUT_T), T, D, D}; pg8::StaticOrder S; S.init(T, D, nb, bid);
    EpiResid E{q.x, X1_(q), ADA_(q) + 2048};
    pg8::gemm_phase<EpiResid, pg8::StaticOrder, true, true>(ldsb, g, S, E);            xcd_barrier(bar); STAMP(); }
  for (int rep = 0; rep < REP_LIGHT; ++rep) { FRESH(q); phase_modnorm(q, bid, nb, X1_(q), q.g2, 3072, 4096, HNB_(q)); xcd_barrier(bar); STAMP(); }
  for (int rep = 0; rep < REP_GEMM; ++rep)
  { FRESH(q); pg8::Gemm g{HNB_(q), (const bf16_t*)(qw + WS_WRS_T), T, 768, D}; pg8::StaticOrder S; S.init(T, 768, nb, bid);
    EpiRS E{(float*)(qw + WS_LOGITS), (bf16_t*)(qw + WS_ACTS)};
    pg8::gemm_phase<EpiRS, pg8::StaticOrder, true, true>(ldsb, g, S, E);               xcd_barrier(bar); STAMP(); }
#if !DIAG_EXACT_ROUTING
  { FRESH(q); phase_route(q, bid, nb, (const float*)(qw + WS_LOGITS)); }
#endif
  { FRESH(q); pg8::Gemm g{(const bf16_t*)(qw + WS_ACTS), (const bf16_t*)(qw + WS_WDS_T), T, D, DSH}; pg8::StaticOrder S; S.init(T, D, nb, bid);
    EpiResid E{X1_(q), X1_(q), ADA_(q) + 5120};
    pg8::gemm_phase<EpiResid, pg8::StaticOrder, true, true>(ldsb, g, S, E);           xcd_barrier(bar); STAMP(); }
  for (int rep = 0; rep < REP_MOE1; ++rep) { FRESH(q); moe::run<1>(q, bid, nb, ldsb);             xcd_barrier(bar); STAMP(); }
  for (int rep = 0; rep < REP_MOE2; ++rep) { FRESH(q); moe::run<2>(q, bid, nb, ldsb);             xcd_barrier(bar); STAMP(); }
  for (int rep = 0; rep < REP_LIGHT; ++rep) { FRESH(q); phase_final_bf(q, bid, nb); }
  STAMP();
#if TIME_SEL_A >= 0
  if (bid == 0) {
    asm volatile("s_waitcnt vmcnt(0)" ::: "memory"); __syncthreads();
    const float usA = floorf((float)(tl[TIME_SEL_A + 1] - tl[TIME_SEL_A]) * 0.01f * (1.f / 16.f) + 0.5f) * 16.f;
    const float delta = sqrtf(usA * 1e-5f * 16.8e6f / 1024.f);
    if (threadIdx.x < 256) { float4* o = (float4*)p.out + threadIdx.x; float4 v = *o; v.x += delta; v.y += delta; v.z += delta; v.w += delta; *o = v; }
#if TIME_SEL_B >= 0
    if (threadIdx.x == 0) { const float usB = floorf((float)(tl[TIME_SEL_B + 1] - tl[TIME_SEL_B]) * 0.01f * (1.f / 16.f) + 0.5f) * 16.f; p.out[1024] = 10.f + usB * 0.1f; }
#endif
  }
#endif
}
}

extern "C" void kernel_launch(void* const* d_in, const int* in_sizes, int n_in, void* d_out, int out_size, void* d_ws, size_t ws_size, hipStream_t stream) {
  if (n_in != 25 || ws_size < WS_END) { fprintf(stderr, "kernel_launch: unexpected n_in %d or ws_size %zu\n", n_in, ws_size); return; }
  P p; memset(&p, 0, sizeof(p));
  p.x = (const float*)d_in[0]; p.c = (const float*)d_in[1]; p.pos = (const int*)d_in[2]; p.w_ada = (const float*)d_in[3]; p.b_ada = (const float*)d_in[4];
  p.g1 = (const float*)d_in[5]; p.w_in = (const float*)d_in[6]; p.conv_w = (const float*)d_in[7]; p.g_conv = (const float*)d_in[8];
  p.lq1 = (const float*)d_in[9]; p.lk1 = (const float*)d_in[10]; p.lq2 = (const float*)d_in[11]; p.lk2 = (const float*)d_in[12];
  p.g_subln = (const float*)d_in[13]; p.w_out = (const float*)d_in[14]; p.g2 = (const float*)d_in[15]; p.w_router = (const float*)d_in[16]; p.rbias = (const float*)d_in[17];
  p.wg_e = (const float*)d_in[18]; p.wu_e = (const float*)d_in[19]; p.wd_e = (const float*)d_in[20];
  p.wg_s = (const float*)d_in[21]; p.wu_s = (const float*)d_in[22]; p.wd_s = (const float*)d_in[23]; p.g_final = (const float*)d_in[24];
  p.out = (float*)d_out; p.ws = (unsigned char*)d_ws;
  for (int i = 0; i < 8; ++i) p.inv_freq[i] = (float)pow(500000.0, -(double)i / 8.0);
  (void)hipMemsetAsync((char*)d_ws + WS_CTL, 0, CTL_BYTES, stream);
  static int grid = 0;
  if (grid == 0) {
    int dev = 0, cus = 0, per_cu = 0;
    (void)hipGetDevice(&dev); (void)hipDeviceGetAttribute(&cus, hipDeviceAttributeMultiprocessorCount, dev);
    (void)hipFuncSetAttribute((const void*)mega, hipFuncAttributeMaxDynamicSharedMemorySize, LDS_BYTES);
    (void)hipOccupancyMaxActiveBlocksPerMultiprocessor(&per_cu, (const void*)mega, NT, LDS_BYTES);
    if (per_cu < 1) { fprintf(stderr, "kernel_launch: occupancy query says %d blocks/CU\n", per_cu); grid = -1; }
    else grid = cus;
  }
  if (grid < 0) return;
  void* args[] = {&p};
  hipError_t e = hipLaunchCooperativeKernel((const void*)mega, dim3(grid), dim3(NT), args, LDS_BYTES, stream);
  if (e != hipSuccess) fprintf(stderr, "cooperative launch failed: %s (grid %d)\n", hipGetErrorString(e), grid);
}
```

```cpp
#include <hip/hip_runtime.h>
#include <hip/hip_bf16.h>
#include <cmath>
#include <stdint.h>
#include <math.h>
#include <stdio.h>
#include <string.h>

#define DIAG_EXACT_ROUTING 0

__device__ __forceinline__ int tidx() { int t = threadIdx.x; asm volatile("" : "+v"(t)); return t; }

#define REP_LIGHT 1
#define REP_CONV 1
#define REP_GEMM 1
#define REP_ATTN 1
#define REP_MOE1 1
#define REP_MOE2 1

__device__ __forceinline__ unsigned char* fresh_ws(unsigned char* w) { unsigned long long z = 0; asm volatile("" : "+s"(z)); return w + z; }

#define TIME_SEL_A -1
#define TIME_SEL_B -1

#define ATTN_IMPL 0

namespace pg8 {
#define PG8_LAS __attribute__((address_space(3)))
typedef unsigned short bf16_t;
typedef short bf16x8 __attribute__((ext_vector_type(8)));
typedef float f32x4 __attribute__((ext_vector_type(4)));
typedef unsigned u32x4 __attribute__((ext_vector_type(4)));
constexpr int BM = 256, BK = 64, HALF = 128, HTB = HALF * BK * 2  , STAGE_BYTES = 8 * HTB, NXCD = 8, WGM = 8;

__host__ __device__ __forceinline__ int lds_byte(int r, int c) { const int st = (r >> 4) * 2 + (c >> 5), rr = r & 15, cc = c & 31, ob = rr * 64 + cc * 2; return st * 1024 + (ob ^ (((ob >> 9) & 1) << 5)); }
__host__ __device__ __forceinline__ void stage_rc(int b, int& R, int& C) { const int st = b / 1024, sb = b % 1024, swz = sb ^ (((sb >> 9) & 1) << 5); R = (st >> 1) * 16 + swz / 64; C = (st & 1) * 32 + (swz % 64) / 2; }
__host__ __device__ __forceinline__ int perm32(int rho) { const int n = rho >> 4, i = rho & 15; return 8 * (i >> 2) + 4 * n + (i & 3); }

struct Unit { int pm, pn; };
struct Gemm { const bf16_t* A; const bf16_t* Bt; int M, N, K; };

struct StaticOrder {
    int nM, nN, nwg, G, c;
    __host__ __device__ void init(int M, int N, int G_, int c_) { nM = M / BM; nN = N / BM; nwg = nM * nN; G = G_; c = c_; }
    __host__ __device__ bool next(int i, Unit& u) const {
        const long L = (long)i * G + c; if (L >= nwg) return false;
        int wgid = (int)L; { const int q = nwg / NXCD, r = nwg % NXCD, xcd = wgid % NXCD, off = wgid / NXCD; wgid = (xcd < r ? xcd * (q + 1) : r * (q + 1) + (xcd - r) * q) + off; }
        const int nig = WGM * nN, gid = wgid / nig, fm = gid * WGM, gsz = (nM - fm) < WGM ? (nM - fm) : WGM;
        u.pm = fm + ((wgid % nig) % gsz); u.pn = (wgid % nig) / gsz; return true;
    }
    __device__ __forceinline__ void a_ready(const Unit&) const {}
    __device__ __forceinline__ void done(const Unit&) const {}
};
__device__ __forceinline__ unsigned cvt_pk_bf16(float lo, float hi) { unsigned r; asm volatile("v_cvt_pk_bf16_f32 %0, %1, %2" : "=v"(r) : "v"(lo), "v"(hi)); return r; }
template <class Epi, class Sched, bool ALIGN_EPI = false, bool SP2 = false>
__device__ __forceinline__ void gemm_phase(PG8_LAS unsigned char* lds, const Gemm g, const Sched& S, const Epi& E) {
    const int tid = tidx(), wid = __builtin_amdgcn_readfirstlane(tid >> 6), lane = tid & 63, wr = wid >> 2, wc = wid & 3, fr = lane & 15, fq = lane >> 4;
    const int K = g.K, nt = K / BK;
    unsigned voffA[2], voffB[2];
#pragma unroll
    for (int i = 0; i < 2; ++i) { int R, C; stage_rc(tid * 16 + i * 8192, R, C); const int Rb = Epi::PERM ? ((R & ~31) + perm32(R & 31)) : R;
        voffA[i] = (unsigned)(R * K + C) * 2u; voffB[i] = (unsigned)(Rb * K + C) * 2u; }
    const size_t kstep = (size_t)(BK * 2);
    const size_t hstep = (size_t)HALF * K * 2;
    const size_t tstep = 2 * hstep;
    const unsigned ldsw = (unsigned)wid * 1024u;
    const int aoff = lds_byte(wr * 64 + fr, fq * 8), boff = lds_byte(wc * 32 + fr, fq * 8);
#define PG8_SA(b, h) (((b) * 2 + (h)) * HTB)
#define PG8_SB(b, h) ((4 + (b) * 2 + (h)) * HTB)
#define PG8_STAGE(bufoff, gbase, voff) do { _Pragma("unroll") for (int _i = 0; _i < 2; ++_i) \
        __builtin_amdgcn_global_load_lds((const unsigned*)((const char*)(gbase) + (voff)[_i]), (PG8_LAS unsigned*)(lds + (bufoff) + ldsw + _i * 8192), 16, 0, 0); } while (0)
#define PG8_LDA(dst, b, h) do { _Pragma("unroll") for (int m = 0; m < 4; ++m) _Pragma("unroll") for (int k = 0; k < 2; ++k) dst[m][k] = *(const PG8_LAS bf16x8*)(lds + PG8_SA(b, h) + aoff + m * 2048 + k * 1024); } while (0)
#define PG8_LDB(dst, b, h) do { _Pragma("unroll") for (int n = 0; n < 2; ++n) _Pragma("unroll") for (int k = 0; k < 2; ++k) dst[n][k] = *(const PG8_LAS bf16x8*)(lds + PG8_SB(b, h) + boff + n * 2048 + k * 1024); } while (0)
#define PG8_MMA(ai, bj, At, Bt) do { __builtin_amdgcn_s_setprio(1); _Pragma("unroll") for (int m = 0; m < 4; ++m) _Pragma("unroll") for (int n = 0; n < 2; ++n) _Pragma("unroll") for (int k = 0; k < 2; ++k) \
        acc[ai][bj][m][n] = __builtin_amdgcn_mfma_f32_16x16x32_bf16(Bt[n][k], At[m][k], acc[ai][bj][m][n], 0, 0, 0); __builtin_amdgcn_s_setprio(0); } while (0)
#define PG8_WAIT_V(n) asm volatile("s_waitcnt vmcnt(" #n ")" ::: "memory")
#define PG8_WAIT_L(n) asm volatile("s_waitcnt lgkmcnt(" #n ")" ::: "memory")
#define PG8_BAR __builtin_amdgcn_s_barrier()
#define PG8_SCHED __builtin_amdgcn_sched_barrier(0)
    Unit cur, nxt; int ui = 0;
    if (!S.next(0, cur)) return;
    f32x4 acc[2][2][4][2];
#pragma unroll
    for (int a = 0; a < 2; ++a)
#pragma unroll
        for (int b = 0; b < 2; ++b)
#pragma unroll
            for (int m = 0; m < 4; ++m)
#pragma unroll
                for (int n = 0; n < 2; ++n) acc[a][b][m][n] = (f32x4){0.f, 0.f, 0.f, 0.f};
    bf16x8 At[4][2], B0[2][2], B1[2][2];
    const char* cA = (const char*)g.A + (size_t)cur.pm * tstep; const char* cB = (const char*)g.Bt + (size_t)cur.pn * tstep;
    S.a_ready(cur);
    if constexpr (SP2) {
        PG8_STAGE(PG8_SB(0, 0), cB, voffB); PG8_STAGE(PG8_SB(0, 1), cB + hstep, voffB); PG8_STAGE(PG8_SA(0, 0), cA, voffA); PG8_STAGE(PG8_SA(0, 1), cA + hstep, voffA);
        if (wr == 1) PG8_BAR;
        PG8_WAIT_V(2); PG8_BAR;
        PG8_STAGE(PG8_SB(1, 0), cB + kstep, voffB); PG8_STAGE(PG8_SA(1, 0), cA + kstep, voffA); PG8_STAGE(PG8_SB(1, 1), cB + hstep + kstep, voffB);
        PG8_WAIT_V(6); PG8_BAR;
    } else {
        PG8_STAGE(PG8_SB(0, 0), cB, voffB); PG8_STAGE(PG8_SA(0, 0), cA, voffA); PG8_STAGE(PG8_SB(0, 1), cB + hstep, voffB); PG8_STAGE(PG8_SA(0, 1), cA + hstep, voffA);
        if (wr == 1) PG8_BAR;
        PG8_WAIT_V(4); PG8_BAR;
        PG8_STAGE(PG8_SB(1, 0), cB + kstep, voffB); PG8_STAGE(PG8_SA(1, 0), cA + kstep, voffA); PG8_STAGE(PG8_SB(1, 1), cB + hstep + kstep, voffB);
        PG8_WAIT_V(6); PG8_BAR;
    }
    for (;;) {
        const bool has_next = S.next(ui + 1, nxt);
        const char* nA = has_next ? (const char*)g.A + (size_t)nxt.pm * tstep : cA; const char* nB = has_next ? (const char*)g.Bt + (size_t)nxt.pn * tstep : cB;
        for (int t = 0; t < nt; t += 2) {
            const bool last = (t == nt - 2);
            const char* a1 = cA + (size_t)(t + 1) * kstep;
            const char* a2 = last ? nA : cA + (size_t)(t + 2) * kstep; const char* b2 = last ? nB : cB + (size_t)(t + 2) * kstep;
            const char* a3 = a2 + kstep; const char* b3 = b2 + kstep;
            if (last && has_next) S.a_ready(nxt);
            if constexpr (SP2) {
            PG8_LDB(B0, 0, 0); PG8_LDB(B1, 0, 1); PG8_SCHED; PG8_LDA(At, 0, 0); PG8_STAGE(PG8_SA(1, 1), a1 + hstep, voffA);
            PG8_WAIT_V(8); PG8_WAIT_L(0); PG8_BAR; PG8_MMA(0, 0, At, B0); PG8_MMA(0, 1, At, B1); PG8_BAR; PG8_SCHED;
            PG8_LDA(At, 0, 1); PG8_STAGE(PG8_SB(0, 0), b2, voffB); PG8_STAGE(PG8_SB(0, 1), b2 + hstep, voffB); PG8_STAGE(PG8_SA(0, 0), a2, voffA);
            PG8_WAIT_V(8); PG8_WAIT_L(0); PG8_BAR; PG8_MMA(1, 0, At, B0); PG8_MMA(1, 1, At, B1); PG8_BAR; PG8_SCHED;
            PG8_LDB(B0, 1, 0); PG8_LDB(B1, 1, 1); PG8_SCHED; PG8_LDA(At, 1, 0); PG8_STAGE(PG8_SA(0, 1), a2 + hstep, voffA);
            PG8_WAIT_V(8); PG8_WAIT_L(0); PG8_BAR; PG8_MMA(0, 0, At, B0); PG8_MMA(0, 1, At, B1); PG8_BAR; PG8_SCHED;
            PG8_LDA(At, 1, 1); PG8_STAGE(PG8_SB(1, 0), b3, voffB); PG8_STAGE(PG8_SB(1, 1), b3 + hstep, voffB); PG8_STAGE(PG8_SA(1, 0), a3, voffA);
            PG8_WAIT_V(8); PG8_WAIT_L(0); PG8_BAR; PG8_MMA(1, 0, At, B0); PG8_MMA(1, 1, At, B1); PG8_BAR; PG8_SCHED;
            } else {
            PG8_LDB(B0, 0, 0); PG8_SCHED; PG8_LDA(At, 0, 0); PG8_STAGE(PG8_SA(1, 1), a1 + hstep, voffA);
            PG8_WAIT_L(8); PG8_BAR; PG8_WAIT_L(0); PG8_MMA(0, 0, At, B0); PG8_BAR; PG8_SCHED;
            PG8_LDB(B1, 0, 1); PG8_STAGE(PG8_SB(0, 0), b2, voffB);
            PG8_BAR; PG8_WAIT_L(0); PG8_MMA(0, 1, At, B1); PG8_BAR;
            PG8_LDA(At, 0, 1); PG8_STAGE(PG8_SA(0, 0), a2, voffA);
            PG8_BAR; PG8_WAIT_L(0); PG8_MMA(1, 0, At, B0); PG8_BAR; PG8_SCHED;
            PG8_STAGE(PG8_SB(0, 1), b2 + hstep, voffB);
            PG8_WAIT_V(6); PG8_BAR; PG8_MMA(1, 1, At, B1); PG8_BAR;
            PG8_LDB(B0, 1, 0); PG8_SCHED; PG8_LDA(At, 1, 0); PG8_STAGE(PG8_SA(0, 1), a2 + hstep, voffA);
            PG8_WAIT_L(8); PG8_BAR; PG8_WAIT_L(0); PG8_MMA(0, 0, At, B0); PG8_BAR; PG8_SCHED;
            PG8_LDB(B1, 1, 1); PG8_STAGE(PG8_SB(1, 0), b3, voffB);
            PG8_BAR; PG8_WAIT_L(0); PG8_MMA(0, 1, At, B1); PG8_BAR;
            PG8_LDA(At, 1, 1); PG8_STAGE(PG8_SA(1, 0), a3, voffA);
            PG8_BAR; PG8_WAIT_L(0); PG8_MMA(1, 0, At, B0); PG8_BAR; PG8_SCHED;
            PG8_STAGE(PG8_SB(1, 1), b3 + hstep, voffB);
            PG8_WAIT_V(6); PG8_BAR; PG8_MMA(1, 1, At, B1); PG8_BAR;
            }
        }
        if constexpr (ALIGN_EPI) { if (wr == 0) PG8_BAR; }
        if constexpr (!Epi::AFTER_DRAIN) { E(acc, cur, wr, wc, fr, fq); S.done(cur); }
        if (!has_next) break;
#pragma unroll
        for (int a = 0; a < 2; ++a)
#pragma unroll
            for (int b = 0; b < 2; ++b)
#pragma unroll
                for (int m = 0; m < 4; ++m)
#pragma unroll
                    for (int n = 0; n < 2; ++n) acc[a][b][m][n] = (f32x4){0.f, 0.f, 0.f, 0.f};
        cur = nxt; cA = nA; cB = nB; ++ui;
        if constexpr (ALIGN_EPI) { if (wr == 1) PG8_BAR; }
    }
    PG8_WAIT_V(0);
    if constexpr (!ALIGN_EPI) { if (wr == 0) PG8_BAR; }
    PG8_BAR;
    if constexpr (Epi::AFTER_DRAIN) { E.fused(acc, cur, wr, wc, fr, fq, lds, wid, lane); S.done(cur); }
#undef PG8_SA
#undef PG8_SB
#undef PG8_STAGE
#undef PG8_LDA
#undef PG8_LDB
#undef PG8_MMA
#undef PG8_WAIT_V
#undef PG8_WAIT_L
#undef PG8_BAR
#undef PG8_SCHED
}
}

namespace {
using pg8::bf16_t; using pg8::f32x4; using pg8::u32x4; using pg8::Unit;
constexpr int D = 1024, BATCH = 4, SEQ = 4096, T = BATCH * SEQ;
constexpr int DPROJ = 3072;
constexpr int COL_H = 0, COL_B = 512, COL_C = 1024, COL_Q = 1536, COL_K = 2048, COL_V = 2560;
constexpr int NE = 256, TOPK = 8, DE = 256, DSH = 256;
constexpr int NT = 512;
constexpr int NW = NT / 64;
constexpr int LISTCAP = T;
constexpr int CNT_STRIDE = 64;
constexpr float C2 = 0.125f * 1.4426950408889634f;

constexpr size_t MiB = 1u << 20;
constexpr size_t WS_CTL = 0, CTL_BYTES = 1 * MiB;
constexpr size_t WS_ADA = 1 * MiB;
constexpr size_t WS_MISC = 1 * MiB + 128 * 1024;
constexpr size_t WS_COS = 2 * MiB, WS_SIN = 2 * MiB + 512 * 1024;
constexpr size_t WS_IDX = 3 * MiB, WS_WTS = 3 * MiB + 512 * 1024;
constexpr size_t WS_LIST = 4 * MiB;
constexpr size_t WS_LOGITS = 20 * MiB;
constexpr size_t WS_ACTS = 36 * MiB;
constexpr size_t WS_WIN_T = 44 * MiB;
constexpr size_t WS_WOUT_T = 50 * MiB;
constexpr size_t WS_WRS_T = 52 * MiB;
constexpr size_t WS_WDS_T = 54 * MiB;
constexpr size_t WS_X1 = 64 * MiB;
constexpr size_t WS_HNB = 128 * MiB;
constexpr size_t WS_PROJB = 160 * MiB;
constexpr size_t WS_AO = 256 * MiB;
constexpr size_t WS_SLAB = 128 * MiB;
constexpr size_t WS_H = 384 * MiB;
constexpr size_t WS_WE1 = 448 * MiB;
constexpr size_t WS_WE2 = 704 * MiB;
constexpr size_t WS_END = 832 * MiB;

struct P {
  const float* x; const float* c; const int* pos; const float* w_ada; const float* b_ada; const float* g1;
  const float* w_in; const float* conv_w; const float* g_conv; const float* lq1; const float* lk1; const float* lq2; const float* lk2;
  const float* g_subln; const float* w_out; const float* g2; const float* w_router; const float* rbias;
  const float* wg_e; const float* wu_e; const float* wd_e; const float* wg_s; const float* wu_s; const float* wd_s; const float* g_final;
  float* out; unsigned char* ws;
  float inv_freq[8];
};

#define LAS __attribute__((address_space(3)))
__device__ __forceinline__ float wave_sum(float v) {
#pragma unroll
  for (int o = 1; o < 64; o <<= 1) v += __shfl_xor(v, o);
  return v;
}
__device__ __forceinline__ float silu_f(float v) { return v / (1.f + expf(-v)); }
__device__ __forceinline__ unsigned f2bf(float f) { unsigned u = __float_as_uint(f); return (u + 0x7fffu + ((u >> 16) & 1u)) >> 16; }
__device__ __forceinline__ unsigned pk2(float lo, float hi) { typedef float f32x2_ __attribute__((ext_vector_type(2))); typedef __bf16 bf16x2_ __attribute__((ext_vector_type(2))); f32x2_ v = {lo, hi}; return __builtin_bit_cast(unsigned, __builtin_convertvector(v, bf16x2_)); }
__device__ __forceinline__ float bflo(unsigned w) { return __uint_as_float(w << 16); }
__device__ __forceinline__ float bfhi(unsigned w) { return __uint_as_float(w & 0xffff0000u); }
__device__ __forceinline__ float4 ld_bf4(const bf16_t* p) { const uint2 w = *(const uint2*)p; return make_float4(bflo(w.x), bfhi(w.x), bflo(w.y), bfhi(w.y)); }
__device__ __forceinline__ void st_bf4(bf16_t* p, float a, float b, float c, float d) { *(uint2*)p = make_uint2(pk2(a, b), pk2(c, d)); }

struct EpiInproj {
  static constexpr bool PERM = true, AFTER_DRAIN = false;
  bf16_t* O; const float* cosT; const float* sinT;
  __device__ __forceinline__ void operator()(const f32x4 (&acc)[2][2][4][2], const Unit& u, int wr, int wc, int fr, int fq) const {
    const int row0 = u.pm * 256 + wr * 64 + fr, col0 = u.pn * 256 + wc * 32 + 8 * fq;
    const bool qk = (u.pn >= 6 && u.pn < 10), rot = qk && ((wc & 1) == 0) && (fq < 2);
    const float sc = (u.pn == 6 || u.pn == 7) ? C2 : 1.f;
#pragma unroll
    for (int ai = 0; ai < 2; ++ai)
#pragma unroll
      for (int m = 0; m < 4; ++m) {
        const int row = row0 + ai * 128 + m * 16;
        f32x4 cs = {1.f, 1.f, 1.f, 1.f}, sn = {0.f, 0.f, 0.f, 0.f};
        if (rot) { cs = *(const f32x4*)(cosT + (size_t)row * 8 + 4 * fq); sn = *(const f32x4*)(sinT + (size_t)row * 8 + 4 * fq); }
        bf16_t* rowp = O + (size_t)row * DPROJ + col0;
#pragma unroll
        for (int bj = 0; bj < 2; ++bj) {
          const f32x4 a = acc[ai][bj][m][0], b = acc[ai][bj][m][1];
          const f32x4 v0 = (a * cs - b * sn) * sc, v1 = (b * cs + a * sn) * sc;
          u32x4 w; w.x = pk2(v0[0], v0[1]); w.y = pk2(v0[2], v0[3]); w.z = pk2(v1[0], v1[1]); w.w = pk2(v1[2], v1[3]);
          *(u32x4*)(rowp + bj * 128) = w;
        }
      }
  }
};
struct EpiResid {
  static constexpr bool PERM = false, AFTER_DRAIN = false;
  const float* base; float* out; const float* gate;
  __device__ __forceinline__ void operator()(const f32x4 (&acc)[2][2][4][2], const Unit& u, int wr, int wc, int fr, int fq) const {
    const int row0 = u.pm * 256 + wr * 64 + fr, col0 = u.pn * 256 + wc * 32 + 4 * fq;
    const float* gp = gate + (size_t)(u.pm / 16) * 6144;
#pragma unroll
    for (int bj = 0; bj < 2; ++bj)
#pragma unroll
      for (int n = 0; n < 2; ++n) {
        const int c = col0 + bj * 128 + n * 16;
        const f32x4 gv = *(const f32x4*)(gp + c);
#pragma unroll
        for (int ai = 0; ai < 2; ++ai)
#pragma unroll
          for (int m = 0; m < 4; ++m) {
            const size_t o = (size_t)(row0 + ai * 128 + m * 16) * D + c;
            const f32x4 bs = *(const f32x4*)(base + o);
            *(f32x4*)(out + o) = bs + gv * acc[ai][bj][m][n];
          }
      }
  }
};
struct EpiRS {
  static constexpr bool PERM = true, AFTER_DRAIN = false;
  float* LG; bf16_t* AC;
  __device__ __forceinline__ void operator()(const f32x4 (&acc)[2][2][4][2], const Unit& u, int wr, int wc, int fr, int fq) const {
    const int row0 = u.pm * 256 + wr * 64 + fr, cl = wc * 32 + 8 * fq;
#pragma unroll
    for (int ai = 0; ai < 2; ++ai)
#pragma unroll
      for (int m = 0; m < 4; ++m) {
        const int row = row0 + ai * 128 + m * 16;
#pragma unroll
        for (int bj = 0; bj < 2; ++bj) {
          const f32x4 a = acc[ai][bj][m][0], b = acc[ai][bj][m][1];
          if (u.pn == 0) { float* lp = LG + (size_t)row * 256 + cl + bj * 128; *(f32x4*)lp = a; *(f32x4*)(lp + 4) = b; }
          else {
            const int ci = 256 * (u.pn - 1) + cl + bj * 128;
            st_bf4(AC + (size_t)row * DSH + (ci >> 1), silu_f(a[0]) * b[0], silu_f(a[1]) * b[1], silu_f(a[2]) * b[2], silu_f(a[3]) * b[3]);
          }
        }
      }
  }
};

template <class RM>
__device__ __forceinline__ void transpose_item(const float* W, int K, int N, bf16_t* WT, LAS float* scr, int item, int lane, const RM& rowmap) {
  const int nblk = N / 32, kb = item / nblk, nbk = item % nblk, k0 = 64 * kb, n0 = 32 * nbk;
#pragma unroll 8
  for (int i = 0; i < 32; ++i) { const int kk = 2 * i + (lane >> 5); scr[kk * 33 + (lane & 31)] = W[(size_t)(k0 + kk) * N + n0 + (lane & 31)]; }
  asm volatile("s_waitcnt lgkmcnt(0)" ::: "memory");
  const int c = lane & 7;
#pragma unroll
  for (int j = 0; j < 4; ++j) {
    const int n = (lane >> 3) + 8 * j; const LAS float* s = scr + (8 * c) * 33 + n;
    u32x4 o; o.x = pk2(s[0 * 33], s[1 * 33]); o.y = pk2(s[2 * 33], s[3 * 33]); o.z = pk2(s[4 * 33], s[5 * 33]); o.w = pk2(s[6 * 33], s[7 * 33]);
    *(u32x4*)(WT + (size_t)rowmap(n0 + n) * K + k0 + 8 * c) = o;
  }
  asm volatile("s_waitcnt lgkmcnt(0)" ::: "memory");
}
__device__ __forceinline__ int win_rowmap(int n) {
  if (n < COL_Q || n >= COL_V) return n;
  const int pos = n & 63; if (pos >= 16) return n;
  const int g = pos >> 2, g2 = (g == 1) ? 2 : (g == 2) ? 1 : g;
  return (n & ~63) + g2 * 4 + (pos & 3);
}
__device__ __forceinline__ void phase_prologue(const P& p, int bid, int nb, float* lds) {
  unsigned char* const ws_ = fresh_ws(p.ws);
  float* cact = lds;
  float* red = lds + 4096;
  const int tid = tidx();
  float* ada = (float*)(ws_ + WS_ADA);
  for (int i = tid; i < 4096; i += NT) cact[i] = silu_f(p.c[i]);
  __syncthreads();
  for (int cb = bid; cb < 256; cb += nb) {
    const int col = tid % 24, kg = tid / 24;
    if (kg < 21) {
      float a0 = 0.f, a1 = 0.f, a2 = 0.f, a3 = 0.f;
      for (int k = kg; k < 1024; k += 21) {
        const float w = p.w_ada[(size_t)k * 6144 + cb * 24 + col];
        a0 += cact[k] * w; a1 += cact[1024 + k] * w; a2 += cact[2048 + k] * w; a3 += cact[3072 + k] * w;
      }
      float* r = red + (kg * 24 + col) * 4; r[0] = a0; r[1] = a1; r[2] = a2; r[3] = a3;
    }
    __syncthreads();
    if (tid < 96) {
      const int cc = tid >> 2, b = tid & 3; float s = 0.f;
      for (int g = 0; g < 21; ++g) s += red[(g * 24 + cc) * 4 + b];
      ada[b * 6144 + cb * 24 + cc] = s + p.b_ada[cb * 24 + cc];
    }
    __syncthreads();
  }
  if (bid == 0 && tid == 0) {
    float s1 = 0.f, s2 = 0.f;
    for (int i = 0; i < 64; ++i) { s1 += p.lq1[i] * p.lk1[i]; s2 += p.lq2[i] * p.lk2[i]; }
    ((float*)(ws_ + WS_MISC))[0] = expf(s1) - expf(s2) + 0.2f;
  }
  float* ct = (float*)(ws_ + WS_COS); float* st = (float*)(ws_ + WS_SIN);
  for (int i = bid * NT + tid; i < T * 8; i += nb * NT) {
    const int t = i >> 3, f = i & 7;
    const float ifr = f == 0 ? p.inv_freq[0] : f == 1 ? p.inv_freq[1] : f == 2 ? p.inv_freq[2] : f == 3 ? p.inv_freq[3] : f == 4 ? p.inv_freq[4] : f == 5 ? p.inv_freq[5] : f == 6 ? p.inv_freq[6] : p.inv_freq[7];
    const float ang = (float)p.pos[t] * ifr;
    float s, c; sincosf(ang, &s, &c);
    ct[i] = c; st[i] = s;
  }
  const int lane = tid & 63, wave = tid >> 6;
  LAS float* scr = (LAS float*)lds + 8192 + wave * 2176;
  constexpr int I_IN = 16 * 96, I_OUT = 16 * 32, I_R = 16 * 8, I_G = 16 * 8, I_U = 16 * 8, I_D = 4 * 32;
  constexpr int NITEMS = I_IN + I_OUT + I_R + I_G + I_U + I_D;
  bf16_t* WIN = (bf16_t*)(ws_ + WS_WIN_T); bf16_t* WOUT = (bf16_t*)(ws_ + WS_WOUT_T); bf16_t* WRS = (bf16_t*)(ws_ + WS_WRS_T); bf16_t* WDS = (bf16_t*)(ws_ + WS_WDS_T);
  for (int it = bid * NW + wave; it < NITEMS; it += nb * NW) {
    int r = it;
    if (r < I_IN) { transpose_item(p.w_in, D, DPROJ, WIN, scr, r, lane, [](int n) { return win_rowmap(n); }); continue; } r -= I_IN;
    if (r < I_OUT) { transpose_item(p.w_out, D, D, WOUT, scr, r, lane, [](int n) { return n; }); continue; } r -= I_OUT;
    if (r < I_R) { transpose_item(p.w_router, D, 256, WRS, scr, r, lane, [](int n) { return n; }); continue; } r -= I_R;
    if (r < I_G) { transpose_item(p.wg_s, D, 256, WRS, scr, r, lane, [](int n) { return 256 + 8 * (n >> 2) + (n & 3); }); continue; } r -= I_G;
    if (r < I_U) { transpose_item(p.wu_s, D, 256, WRS, scr, r, lane, [](int n) { return 256 + 8 * (n >> 2) + 4 + (n & 3); }); continue; } r -= I_U;
    transpose_item(p.wd_s, DSH, D, WDS, scr, r, lane, [](int n) { return n; });
  }
}

__device__ __forceinline__ void phase_modnorm(const P& p, int bid, int nb, const float* in, const float* g, int sh_off, int sc_off, bf16_t* outp) {
  unsigned char* const ws_ = fresh_ws(p.ws);
  const int tid_ = tidx(), lane = tid_ & 63, wave = tid_ >> 6;
  const float* ada = (const float*)(ws_ + WS_ADA);
  for (int t = bid * NW + wave; t < T; t += nb * NW) {
    const int b = t / SEQ;
    const float4* xr = (const float4*)(in + (size_t)t * D) + lane;
    float4 v[4]; float s = 0.f;
#pragma unroll
    for (int j = 0; j < 4; ++j) { v[j] = xr[64 * j]; s += v[j].x * v[j].x + v[j].y * v[j].y + v[j].z * v[j].z + v[j].w * v[j].w; }
    s = wave_sum(s);
    const float rstd = 1.0f / sqrtf(s * (1.0f / D) + 1e-6f);
#pragma unroll
    for (int j = 0; j < 4; ++j) {
      const int c0 = lane * 4 + 256 * j;
      const float4 gg = *(const float4*)(g + c0);
      const float4 sc = *(const float4*)(ada + b * 6144 + sc_off + c0);
      const float4 sh = *(const float4*)(ada + b * 6144 + sh_off + c0);
      st_bf4(outp + (size_t)t * D + c0, v[j].x * rstd * gg.x * (1.f + sc.x) + sh.x, v[j].y * rstd * gg.y * (1.f + sc.y) + sh.y,
             v[j].z * rstd * gg.z * (1.f + sc.z) + sh.z, v[j].w * rstd * gg.w * (1.f + sc.w) + sh.w);
    }
  }
}

template <bool DUAL, class AF, class EF>
__device__ __forceinline__ void gemm_tile_naive(const AF& af, int mcount, const float* __restrict__ B0, const float* __restrict__ B1, int ldb, int n0, int K, const EF& ef, float* lds) {
  float* As = lds; float* Bs0 = lds + 16 * 132; float* Bs1 = Bs0 + 16 * 64;
  const int tid = tidx(), ty = tid >> 4, tx = tid & 15;
  float acc0[4][4], acc1[4][4];
#pragma unroll
  for (int i = 0; i < 4; ++i)
#pragma unroll
    for (int j = 0; j < 4; ++j) { acc0[i][j] = 0.f; acc1[i][j] = 0.f; }
  const int ar = tid >> 2, akq = (tid & 3) * 4;
  const bool avalid = ar < mcount;
  const int bt = tid & 255, bk = bt >> 4, bc = (bt & 15) * 4;
  const float* bsrc = (tid < 256) ? B0 : B1;
  float* bdst = (tid < 256) ? Bs0 : Bs1;
  for (int k0 = 0; k0 < K; k0 += 16) {
    float4 av = make_float4(0.f, 0.f, 0.f, 0.f);
    if (avalid) av = af(ar, k0 + akq);
    As[(akq + 0) * 132 + ar] = av.x; As[(akq + 1) * 132 + ar] = av.y; As[(akq + 2) * 132 + ar] = av.z; As[(akq + 3) * 132 + ar] = av.w;
    if (DUAL || tid < 256) {
      const float4 bv = *(const float4*)(bsrc + (size_t)(k0 + bk) * ldb + n0 + bc);
      *(float4*)(bdst + bk * 64 + bc) = bv;
    }
    __syncthreads();
#pragma unroll
    for (int kk = 0; kk < 16; ++kk) {
      const float4 a = *(const float4*)(As + kk * 132 + ty * 4);
      const float4 b = *(const float4*)(Bs0 + kk * 64 + tx * 4);
      const float aa[4] = {a.x, a.y, a.z, a.w}; const float bb[4] = {b.x, b.y, b.z, b.w};
#pragma unroll
      for (int i = 0; i < 4; ++i)
#pragma unroll
        for (int j = 0; j < 4; ++j) acc0[i][j] += aa[i] * bb[j];
      if (DUAL) {
        const float4 b1 = *(const float4*)(Bs1 + kk * 64 + tx * 4);
        const float cc[4] = {b1.x, b1.y, b1.z, b1.w};
#pragma unroll
        for (int i = 0; i < 4; ++i)
#pragma unroll
          for (int j = 0; j < 4; ++j) acc1[i][j] += aa[i] * cc[j];
      }
    }
    __syncthreads();
  }
#pragma unroll
  for (int i = 0; i < 4; ++i)
    if (ty * 4 + i < mcount) {
#pragma unroll
      for (int j = 0; j < 4; ++j) ef(ty * 4 + i, n0 + tx * 4 + j, acc0[i][j], acc1[i][j]);
    }
}

__device__ __forceinline__ void ld_bf8(const bf16_t* p, float (&v)[8]) { const u32x4 w = *(const u32x4*)p; v[0] = bflo(w.x); v[1] = bfhi(w.x); v[2] = bflo(w.y); v[3] = bfhi(w.y); v[4] = bflo(w.z); v[5] = bfhi(w.z); v[6] = bflo(w.w); v[7] = bfhi(w.w); }
__device__ __forceinline__ void ld_f8(const float* p, float (&v)[8]) { const float4 a = *(const float4*)p, b = *(const float4*)(p + 4); v[0] = a.x; v[1] = a.y; v[2] = a.z; v[3] = a.w; v[4] = b.x; v[5] = b.y; v[6] = b.z; v[7] = b.w; }
template <int CTRL> __device__ __forceinline__ float dppf_(float x) { return __int_as_float(__builtin_amdgcn_update_dpp(0, __float_as_int(x), CTRL, 0xF, 0xF, false)); }
__device__ __forceinline__ float row16_sum(float x) { x += dppf_<0xB1>(x); x += dppf_<0x4E>(x); x += dppf_<0x141>(x); x += dppf_<0x140>(x); return x; }
__device__ __forceinline__ void phase_mix(const P& p, int bid, int nb) {
  unsigned char* const ws_ = fresh_ws(p.ws);
  const bf16_t* PR = (const bf16_t*)(ws_ + WS_PROJB); const bf16_t* AO = (const bf16_t*)(ws_ + WS_AO); bf16_t* MIX = (bf16_t*)(ws_ + WS_HNB);
  const float lam = ((const float*)(ws_ + WS_MISC))[0];
  const int tid_ = tidx(), lane = tid_ & 63, wave = tid_ >> 6, ch = lane * 8;
  float w0[8], w1[8], w2[8], gc[8], gsn[8];
  ld_f8(p.conv_w + ch, w0); ld_f8(p.conv_w + 512 + ch, w1); ld_f8(p.conv_w + 1024 + ch, w2); ld_f8(p.g_conv + ch, gc); ld_f8(p.g_subln + (ch & 127), gsn);
  for (int t0 = (bid * NW + wave) * 8; t0 < T; t0 += nb * NW * 8) {
    const int s0 = t0 % SEQ;
    float u1[8], u2[8];
#pragma unroll
    for (int i = 0; i < 8; ++i) { u1[i] = 0.f; u2[i] = 0.f; }
    if (s0 >= 2) {
      float h[8], c[8];
      ld_bf8(PR + (size_t)(t0 - 1) * DPROJ + COL_H + ch, h); ld_bf8(PR + (size_t)(t0 - 1) * DPROJ + COL_C + ch, c);
#pragma unroll
      for (int i = 0; i < 8; ++i) u1[i] = c[i] * h[i];
      ld_bf8(PR + (size_t)(t0 - 2) * DPROJ + COL_H + ch, h); ld_bf8(PR + (size_t)(t0 - 2) * DPROJ + COL_C + ch, c);
#pragma unroll
      for (int i = 0; i < 8; ++i) u2[i] = c[i] * h[i];
    }
#pragma unroll 2
    for (int k = 0; k < 8; ++k) {
      const int t = t0 + k;
      const bf16_t* r0 = PR + (size_t)t * DPROJ;
      float h[8], c[8], bg[8], o0[8], o1[8], vals[8];
      ld_bf8(r0 + COL_H + ch, h); ld_bf8(r0 + COL_C + ch, c); ld_bf8(r0 + COL_B + ch, bg);
      const int hd = lane >> 4, d = (lane & 15) * 8;
      ld_bf8(AO + (size_t)t * 1024 + (2 * hd) * 128 + d, o0); ld_bf8(AO + (size_t)t * 1024 + (2 * hd + 1) * 128 + d, o1);
      float ss = 0.f;
#pragma unroll
      for (int i = 0; i < 8; ++i) { const float u0 = c[i] * h[i]; const float y = w0[i] * u2[i] + w1[i] * u1[i] + w2[i] * u0; vals[i] = bg[i] * y; ss += vals[i] * vals[i]; u2[i] = u1[i]; u1[i] = u0; }
      ss = row16_sum(ss);
      ss = __int_as_float(__builtin_amdgcn_readlane(__float_as_int(ss), 0)) + __int_as_float(__builtin_amdgcn_readlane(__float_as_int(ss), 16)) +
           __int_as_float(__builtin_amdgcn_readlane(__float_as_int(ss), 32)) + __int_as_float(__builtin_amdgcn_readlane(__float_as_int(ss), 48));
      const float rstd = 1.0f / sqrtf(ss * (1.0f / 512.f) + 1e-6f);
      bf16_t* mo = MIX + (size_t)t * D;
      *(u32x4*)(mo + ch) = (u32x4){pk2(vals[0] * rstd * gc[0], vals[1] * rstd * gc[1]), pk2(vals[2] * rstd * gc[2], vals[3] * rstd * gc[3]),
                                   pk2(vals[4] * rstd * gc[4], vals[5] * rstd * gc[5]), pk2(vals[6] * rstd * gc[6], vals[7] * rstd * gc[7])};
      float dv[8], q = 0.f;
#pragma unroll
      for (int i = 0; i < 8; ++i) { dv[i] = o0[i] - lam * o1[i]; q += dv[i] * dv[i]; }
      q = row16_sum(q);
      const float r2 = 1.0f / sqrtf(q * (1.0f / 128.f) + 1e-5f);
      *(u32x4*)(mo + 512 + ch) = (u32x4){pk2(dv[0] * r2 * gsn[0] * 0.8f, dv[1] * r2 * gsn[1] * 0.8f), pk2(dv[2] * r2 * gsn[2] * 0.8f, dv[3] * r2 * gsn[3] * 0.8f),
                                         pk2(dv[4] * r2 * gsn[4] * 0.8f, dv[5] * r2 * gsn[5] * 0.8f), pk2(dv[6] * r2 * gsn[6] * 0.8f, dv[7] * r2 * gsn[7] * 0.8f)};
    }
  }
}

template <int CTRL> __device__ __forceinline__ float dppf(float x) { return __int_as_float(__builtin_amdgcn_update_dpp(0, __float_as_int(x), CTRL, 0xF, 0xF, false)); }
__device__ __forceinline__ void phase_route(const P& p, int bid, int nb, const float* LG) {
  unsigned char* const ws_ = fresh_ws(p.ws);
  int* IDX = (int*)(ws_ + WS_IDX); float* WTS = (float*)(ws_ + WS_WTS); int* LIST = (int*)(ws_ + WS_LIST); int* cnt = (int*)(ws_ + WS_CTL);
  const int tid_ = tidx(), lane = tid_ & 63, wave = tid_ >> 6;
  const float4 bs = *(const float4*)(p.rbias + lane * 4);
  for (int t = bid * NW + wave; t < T; t += nb * NW) {
    const float4 lg = *(const float4*)(LG + (size_t)t * 256 + lane * 4);
    float sc[4], cv[4];
    sc[0] = 1.f / (1.f + expf(-lg.x)); sc[1] = 1.f / (1.f + expf(-lg.y)); sc[2] = 1.f / (1.f + expf(-lg.z)); sc[3] = 1.f / (1.f + expf(-lg.w));
    cv[0] = sc[0] + bs.x; cv[1] = sc[1] + bs.y; cv[2] = sc[2] + bs.z; cv[3] = sc[3] + bs.w;
    float m1 = -INFINITY, m2 = -INFINITY;
#pragma unroll
    for (int i = 0; i < 4; ++i) { const float v = cv[i]; if (v > m1) { m2 = m1; m1 = v; } else if (v > m2) m2 = v; }
#define RT_MERGE(CTRL) do { const float o1 = dppf<CTRL>(m1), o2 = dppf<CTRL>(m2); const float n1 = fmaxf(m1, o1), n2 = fmaxf(fminf(m1, o1), fmaxf(m2, o2)); m1 = n1; m2 = n2; } while (0)
    RT_MERGE(0xB1); RT_MERGE(0x4E); RT_MERGE(0x141);
#undef RT_MERGE
    const float gs = m1 + m2; const int g = lane >> 3; int rank = 0;
#pragma unroll
    for (int gg = 0; gg < 8; ++gg) { const float og = __int_as_float(__builtin_amdgcn_readlane(__float_as_int(gs), gg * 8)); rank += (og > gs || (og == gs && gg < g)) ? 1 : 0; }
    const bool sel = rank < 4;
#pragma unroll
    for (int i = 0; i < 4; ++i) cv[i] = sel ? cv[i] : -INFINITY;
    int my_e = 0; float my_w = 0.f, wsum = 0.f;
#pragma unroll
    for (int k = 0; k < 8; ++k) {
      float bv = cv[0]; int bi = 0;
#pragma unroll
      for (int i = 1; i < 4; ++i) if (cv[i] > bv) { bv = cv[i]; bi = i; }
      float rmx = fmaxf(bv, dppf<0xB1>(bv)); rmx = fmaxf(rmx, dppf<0x4E>(rmx)); rmx = fmaxf(rmx, dppf<0x141>(rmx)); rmx = fmaxf(rmx, dppf<0x140>(rmx));
      const float M = fmaxf(fmaxf(__int_as_float(__builtin_amdgcn_readlane(__float_as_int(rmx), 0)), __int_as_float(__builtin_amdgcn_readlane(__float_as_int(rmx), 16))),
                            fmaxf(__int_as_float(__builtin_amdgcn_readlane(__float_as_int(rmx), 32)), __int_as_float(__builtin_amdgcn_readlane(__float_as_int(rmx), 48))));
      const unsigned long long bal = __ballot(bv == M);
      const int wl = __builtin_ctzll(bal);
      const int sub = __builtin_amdgcn_readlane(bi, wl);
      const float mine = bi == 0 ? sc[0] : bi == 1 ? sc[1] : bi == 2 ? sc[2] : sc[3];
      const float wv = __int_as_float(__builtin_amdgcn_readlane(__float_as_int(mine), wl));
      if (lane == wl) {
#pragma unroll
        for (int i = 0; i < 4; ++i) if (sub == i) cv[i] = -INFINITY;
      }
      wsum += wv;
      if (lane == k) { my_e = wl * 4 + sub; my_w = wv; }
    }
    if (lane < 8) {
      const float w = my_w / (wsum + 1e-20f) * 2.5f;
      IDX[t * 8 + lane] = my_e; WTS[t * 8 + lane] = w;
      const int pos = atomicAdd(&cnt[my_e * CNT_STRIDE], 1);
      LIST[(size_t)my_e * LISTCAP + pos] = t * 8 + lane;
    }
  }
}

__device__ __forceinline__ void phase_final(const P& p, int bid, int nb) {
  unsigned char* const ws_ = fresh_ws(p.ws);
  const float* X1 = (const float*)(ws_ + WS_X1); const float* SL = (const float*)(ws_ + WS_SLAB); const float* ada = (const float*)(ws_ + WS_ADA);
  const int tid_ = tidx(), lane = tid_ & 63, wave = tid_ >> 6;
  for (int t = bid * NW + wave; t < T; t += nb * NW) {
    const int b = t / SEQ;
    float4 v[4]; float s = 0.f;
#pragma unroll
    for (int j = 0; j < 4; ++j) {
      const int c0 = lane * 4 + 256 * j;
      float4 y = make_float4(0, 0, 0, 0);
#pragma unroll
      for (int k = 0; k < 8; ++k) { const float4 z = *(const float4*)(SL + (size_t)(t * 8 + k) * D + c0); y.x += z.x; y.y += z.y; y.z += z.z; y.w += z.w; }
      const float4 gt = *(const float4*)(ada + b * 6144 + 5120 + c0);
      const float4 bx = *(const float4*)(X1 + (size_t)t * D + c0);
      v[j] = make_float4(bx.x + gt.x * y.x, bx.y + gt.y * y.y, bx.z + gt.z * y.z, bx.w + gt.w * y.w);
      s += v[j].x * v[j].x + v[j].y * v[j].y + v[j].z * v[j].z + v[j].w * v[j].w;
    }
    s = wave_sum(s);
    const float rstd = 1.0f / sqrtf(s * (1.0f / D) + 1e-6f);
#pragma unroll
    for (int j = 0; j < 4; ++j) {
      const int c0 = lane * 4 + 256 * j;
      const float4 gg = *(const float4*)(p.g_final + c0);
      *(float4*)(p.out + (size_t)t * D + c0) = make_float4(v[j].x * rstd * gg.x, v[j].y * rstd * gg.y, v[j].z * rstd * gg.z, v[j].w * rstd * gg.w);
    }
  }
}

#if DIAG_EXACT_ROUTING
namespace diag {
constexpr size_t DW_HN = 64 * MiB, DW_PROJ = 128 * MiB, DW_AO = 320 * MiB, DW_X1 = 384 * MiB, DW_LOGITS = WS_LOGITS;
__device__ __forceinline__ void modnorm(const P& p, int bid, int nb, const float* in, const float* g, int sh_off, int sc_off, float* outp) {
  unsigned char* const ws_ = fresh_ws(p.ws);
  const int tid_ = tidx(), lane = tid_ & 63, wave = tid_ >> 6;
  const float* ada = (const float*)(ws_ + WS_ADA);
  for (int t = bid * NW + wave; t < T; t += nb * NW) {
    const int b = t / SEQ;
    const float4* xr = (const float4*)(in + (size_t)t * D) + lane;
    float4 v[4]; float s = 0.f;
#pragma unroll
    for (int j = 0; j < 4; ++j) { v[j] = xr[64 * j]; s += v[j].x * v[j].x + v[j].y * v[j].y + v[j].z * v[j].z + v[j].w * v[j].w; }
    s = wave_sum(s);
    const float rstd = 1.0f / sqrtf(s * (1.0f / D) + 1e-6f);
    float4* o = (float4*)(outp + (size_t)t * D) + lane;
#pragma unroll
    for (int j = 0; j < 4; ++j) {
      const int c0 = lane * 4 + 256 * j;
      const float4 gg = *(const float4*)(g + c0);
      const float4 sc = *(const float4*)(ada + b * 6144 + sc_off + c0);
      const float4 sh = *(const float4*)(ada + b * 6144 + sh_off + c0);
      float4 r;
      r.x = v[j].x * rstd * gg.x * (1.f + sc.x) + sh.x; r.y = v[j].y * rstd * gg.y * (1.f + sc.y) + sh.y;
      r.z = v[j].z * rstd * gg.z * (1.f + sc.z) + sh.z; r.w = v[j].w * rstd * gg.w * (1.f + sc.w) + sh.w;
      o[64 * j] = r;
    }
  }
}
__device__ __forceinline__ void inproj(const P& p, int bid, int nb, float* lds) {
  unsigned char* const ws_ = fresh_ws(p.ws);
  const float* HN = (const float*)(ws_ + DW_HN); float* PR = (float*)(ws_ + DW_PROJ);
  for (int it = bid; it < (T / 128) * (DPROJ / 64); it += nb) {
    const int mt = it / (DPROJ / 64), nt = it % (DPROJ / 64), m0 = mt * 128;
    auto af = [&](int r, int k) { return *(const float4*)(HN + (size_t)(m0 + r) * D + k); };
    auto ef = [&](int r, int col, float v, float) { PR[(size_t)(m0 + r) * DPROJ + col] = v; };
    gemm_tile_naive<false>(af, 128, p.w_in, nullptr, DPROJ, nt * 64, D, ef, lds);
  }
}
__device__ __forceinline__ void rope(const P& p, int bid, int nb) {
  unsigned char* const ws_ = fresh_ws(p.ws);
  float* PR = (float*)(ws_ + DW_PROJ);
  const float* ct = (const float*)(ws_ + WS_COS); const float* st = (const float*)(ws_ + WS_SIN);
  for (int i = bid * NT + tidx(); i < T * 128; i += nb * NT) {
    const int t = i >> 7, r = i & 127, which = r >> 6, hc = (r >> 3) & 7, f = r & 7;
    float* base = PR + (size_t)t * DPROJ + (which ? COL_K : COL_Q) + hc * 64;
    const float t1 = base[f], t2 = base[8 + f], c = ct[t * 8 + f], s = st[t * 8 + f];
    base[f] = t1 * c - t2 * s; base[8 + f] = t2 * c + t1 * s;
  }
}
__device__ __forceinline__ void attn(const P& p, int bid, int nb) {
  unsigned char* const ws_ = fresh_ws(p.ws);
  const float* PR = (const float*)(ws_ + DW_PROJ); float* AO = (float*)(ws_ + DW_AO);
  const int tid_ = tidx(), lane = tid_ & 63, wave = tid_ >> 6;
  for (int it0 = bid * NW + wave; it0 < 4096; it0 += nb * NW) {
    const int it = __builtin_amdgcn_readfirstlane(it0);
    const int qc = 63 - (it >> 6), rest = it & 63, vh = rest & 1, bh = rest >> 1, b = bh >> 3, hc = bh & 7, h = hc >> 1;
    const int qi = qc * 64 + lane;
    const float* qp = PR + (size_t)(b * SEQ + qi) * DPROJ + COL_Q + hc * 64;
    float q[64], o[64];
#pragma unroll
    for (int d = 0; d < 64; d += 4) { const float4 v = *(const float4*)(qp + d); q[d] = v.x * 0.125f; q[d + 1] = v.y * 0.125f; q[d + 2] = v.z * 0.125f; q[d + 3] = v.w * 0.125f; }
#pragma unroll
    for (int d = 0; d < 64; ++d) o[d] = 0.f;
    float m = -INFINITY, l = 0.f;
    const float* kbase = PR + (size_t)(b * SEQ) * DPROJ + COL_K + hc * 64;
    const float* vbase = PR + (size_t)(b * SEQ) * DPROJ + COL_V + h * 128 + vh * 64;
    const int jmax = qc * 64 + 63;
    for (int j = 0; j <= jmax; ++j) {
      const float* kr = kbase + (size_t)j * DPROJ; const float* vr = vbase + (size_t)j * DPROJ;
      float s = 0.f;
#pragma unroll
      for (int d = 0; d < 64; d += 4) { const float4 kv = *(const float4*)(kr + d); s += q[d] * kv.x; s += q[d + 1] * kv.y; s += q[d + 2] * kv.z; s += q[d + 3] * kv.w; }
      if (j <= qi) {
        const float mn = fmaxf(m, s), a = expf(m - mn), pp = expf(s - mn);
        l = l * a + pp;
#pragma unroll
        for (int d = 0; d < 64; d += 4) { const float4 vv = *(const float4*)(vr + d); o[d] = o[d] * a + pp * vv.x; o[d + 1] = o[d + 1] * a + pp * vv.y; o[d + 2] = o[d + 2] * a + pp * vv.z; o[d + 3] = o[d + 3] * a + pp * vv.w; }
        m = mn;
      }
    }
    const float inv = 1.0f / l;
    float* op = AO + (size_t)(b * SEQ + qi) * 1024 + hc * 128 + vh * 64;
#pragma unroll
    for (int d = 0; d < 64; d += 4) *(float4*)(op + d) = make_float4(o[d] * inv, o[d + 1] * inv, o[d + 2] * inv, o[d + 3] * inv);
  }
}
__device__ __forceinline__ void mix(const P& p, int bid, int nb) {
  unsigned char* const ws_ = fresh_ws(p.ws);
  const float* PR = (const float*)(ws_ + DW_PROJ); const float* AO = (const float*)(ws_ + DW_AO); float* MIX = (float*)(ws_ + DW_HN);
  const float lam = ((const float*)(ws_ + WS_MISC))[0];
  const int tid_ = tidx(), lane = tid_ & 63, wave = tid_ >> 6;
  for (int t = bid * NW + wave; t < T; t += nb * NW) {
    const int s = t % SEQ;
    const float* r0 = PR + (size_t)t * DPROJ;
    float vals[8]; float ss = 0.f;
#pragma unroll
    for (int j = 0; j < 2; ++j) {
      const int ch = lane * 4 + 256 * j;
      const float4 h0 = *(const float4*)(r0 + COL_H + ch), c0 = *(const float4*)(r0 + COL_C + ch), bg = *(const float4*)(r0 + COL_B + ch);
      float4 h1 = make_float4(0, 0, 0, 0), c1 = h1, h2 = h1, c2 = h1;
      if (s >= 1) { h1 = *(const float4*)(r0 - DPROJ + COL_H + ch); c1 = *(const float4*)(r0 - DPROJ + COL_C + ch); }
      if (s >= 2) { h2 = *(const float4*)(r0 - 2 * DPROJ + COL_H + ch); c2 = *(const float4*)(r0 - 2 * DPROJ + COL_C + ch); }
      const float4 w0 = *(const float4*)(p.conv_w + ch), w1 = *(const float4*)(p.conv_w + 512 + ch), w2 = *(const float4*)(p.conv_w + 1024 + ch);
      float y;
      y = w0.x * (c2.x * h2.x) + w1.x * (c1.x * h1.x) + w2.x * (c0.x * h0.x); vals[4 * j + 0] = bg.x * y;
      y = w0.y * (c2.y * h2.y) + w1.y * (c1.y * h1.y) + w2.y * (c0.y * h0.y); vals[4 * j + 1] = bg.y * y;
      y = w0.z * (c2.z * h2.z) + w1.z * (c1.z * h1.z) + w2.z * (c0.z * h0.z); vals[4 * j + 2] = bg.z * y;
      y = w0.w * (c2.w * h2.w) + w1.w * (c1.w * h1.w) + w2.w * (c0.w * h0.w); vals[4 * j + 3] = bg.w * y;
#pragma unroll
      for (int i = 0; i < 4; ++i) ss += vals[4 * j + i] * vals[4 * j + i];
    }
    ss = wave_sum(ss);
    const float rstd = 1.0f / sqrtf(ss * (1.0f / 512.f) + 1e-6f);
    float* mo = MIX + (size_t)t * D;
#pragma unroll
    for (int j = 0; j < 2; ++j) {
      const int ch = lane * 4 + 256 * j;
      const float4 gg = *(const float4*)(p.g_conv + ch);
      *(float4*)(mo + ch) = make_float4(vals[4 * j] * rstd * gg.x, vals[4 * j + 1] * rstd * gg.y, vals[4 * j + 2] * rstd * gg.z, vals[4 * j + 3] * rstd * gg.w);
    }
    const float* ao = AO + (size_t)t * 1024;
#pragma unroll
    for (int j = 0; j < 2; ++j) {
      const int idx = lane * 4 + 256 * j, h = idx >> 7, d = idx & 127;
      const float4 o0 = *(const float4*)(ao + (2 * h) * 128 + d), o1 = *(const float4*)(ao + (2 * h + 1) * 128 + d);
      float dv[4] = {o0.x - lam * o1.x, o0.y - lam * o1.y, o0.z - lam * o1.z, o0.w - lam * o1.w};
      float q = dv[0] * dv[0] + dv[1] * dv[1] + dv[2] * dv[2] + dv[3] * dv[3];
#pragma unroll
      for (int o = 1; o < 32; o <<= 1) q += __shfl_xor(q, o);
      const float r2 = 1.0f / sqrtf(q * (1.0f / 128.f) + 1e-5f);
      const float4 gg = *(const float4*)(p.g_subln + d);
      *(float4*)(mo + 512 + idx) = make_float4(dv[0] * r2 * gg.x * 0.8f, dv[1] * r2 * gg.y * 0.8f, dv[2] * r2 * gg.z * 0.8f, dv[3] * r2 * gg.w * 0.8f);
    }
  }
}
__device__ __forceinline__ void outproj(const P& p, int bid, int nb, float* lds) {
  unsigned char* const ws_ = fresh_ws(p.ws);
  const float* MIX = (const float*)(ws_ + DW_HN); float* X1 = (float*)(ws_ + DW_X1); const float* ada = (const float*)(ws_ + WS_ADA);
  for (int it = bid; it < (T / 128) * (D / 64); it += nb) {
    const int mt = it / (D / 64), nt = it % (D / 64), m0 = mt * 128, b = m0 / SEQ;
    auto af = [&](int r, int k) { return *(const float4*)(MIX + (size_t)(m0 + r) * D + k); };
    auto ef = [&](int r, int col, float v, float) { const size_t o = (size_t)(m0 + r) * D + col; X1[o] = p.x[o] + ada[b * 6144 + 2048 + col] * v; };
    gemm_tile_naive<false>(af, 128, p.w_out, nullptr, D, nt * 64, D, ef, lds);
  }
}
__device__ __forceinline__ void router(const P& p, int bid, int nb, float* lds) {
  unsigned char* const ws_ = fresh_ws(p.ws);
  const float* HN = (const float*)(ws_ + DW_HN); float* LG = (float*)(ws_ + DW_LOGITS);
  for (int it = bid; it < (T / 128) * 4; it += nb) {
    const int mt = it >> 2, r4 = it & 3, m0 = mt * 128;
    auto af = [&](int r, int k) { return *(const float4*)(HN + (size_t)(m0 + r) * D + k); };
    auto ef = [&](int r, int col, float v, float) { LG[(size_t)(m0 + r) * 256 + col] = v; };
    gemm_tile_naive<false>(af, 128, p.w_router, nullptr, 256, r4 * 64, D, ef, lds);
  }
}
}
#endif

__device__ __forceinline__ void convert_slice(const P& p, int part, int nparts, int sl) {
  unsigned char* const ws_ = fresh_ws(p.ws);
  const int tid = tidx();
  bf16_t* WE1 = (bf16_t*)(ws_ + WS_WE1); bf16_t* WE2 = (bf16_t*)(ws_ + WS_WE2);
  constexpr int UN = 8;
  const unsigned stride = (unsigned)nparts * NT;
  const unsigned cbeg = (unsigned)(sl & 3) << 22, cend = cbeg + (1u << 22);
  if (sl < 4) {
    for (unsigned ch0 = cbeg + (unsigned)part * NT + tid; ch0 < cend; ch0 += stride * UN) {
      f32x4 a[UN], b[UN];
#pragma unroll
      for (int u = 0; u < UN; ++u) {
        const unsigned ch = ch0 + u * stride;
        if (ch < cend) {
          const int h8 = (int)(ch & 31), k = (int)((ch >> 5) & 1023), mat = (int)((ch >> 15) & 1), e = (int)(ch >> 16);
          const float* src = (mat ? p.wu_e : p.wg_e) + ((size_t)e * D + k) * DE + 8 * h8;
          a[u] = __builtin_nontemporal_load((const f32x4*)src); b[u] = __builtin_nontemporal_load((const f32x4*)(src + 4));
        }
      }
#pragma unroll
      for (int u = 0; u < UN; ++u) {
        const unsigned ch = ch0 + u * stride;
        if (ch < cend) {
          const int h8 = (int)(ch & 31), k = (int)((ch >> 5) & 1023), mat = (int)((ch >> 15) & 1), e = (int)(ch >> 16);
          const int h = 8 * h8, sub = h >> 7, hl = h & 127, c = 64 * (hl >> 5) + 32 * mat + (hl & 31);
          const size_t blk = ((size_t)(e * 2 + sub) * 32 + (k >> 5)) * 8192;
          const int kk = k & 31, off = (c >> 5) * 1024 + (kk >> 3) * 256 + (kk & 7) * 32 + (c & 31);
          *(u32x4*)(WE1 + blk + off) = (u32x4){pk2(a[u][0], a[u][1]), pk2(a[u][2], a[u][3]), pk2(b[u][0], b[u][1]), pk2(b[u][2], b[u][3])};
        }
      }
    }
  } else {
    const unsigned cb2 = (unsigned)(sl - 4) << 22, ce2 = cb2 + (1u << 22);
    for (unsigned ch0 = cb2 + (unsigned)part * NT + tid; ch0 < ce2; ch0 += stride * UN) {
      f32x4 a[UN], b[UN];
#pragma unroll
      for (int u = 0; u < UN; ++u) {
        const unsigned ch = ch0 + u * stride;
        if (ch < ce2) {
          const int c8 = (int)(ch & 127), k = (int)((ch >> 7) & 255), e = (int)(ch >> 15);
          const float* src = p.wd_e + ((size_t)e * DE + k) * D + 8 * c8;
          a[u] = __builtin_nontemporal_load((const f32x4*)src); b[u] = __builtin_nontemporal_load((const f32x4*)(src + 4));
        }
      }
#pragma unroll
      for (int u = 0; u < UN; ++u) {
        const unsigned ch = ch0 + u * stride;
        if (ch < ce2) {
          const int c8 = (int)(ch & 127), k = (int)((ch >> 7) & 255), e = (int)(ch >> 15);
          const int col = 8 * c8, nt = col >> 8, c = col & 255;
          const size_t blk = ((size_t)(e * 4 + nt) * 8 + (k >> 5)) * 8192;
          const int kk = k & 31, off = (c >> 5) * 1024 + (kk >> 3) * 256 + (kk & 7) * 32 + (c & 31);
          *(u32x4*)(WE2 + blk + off) = (u32x4){pk2(a[u][0], a[u][1]), pk2(a[u][2], a[u][3]), pk2(b[u][0], b[u][1]), pk2(b[u][2], b[u][3])};
        }
      }
    }
  }
}


template <int NC> struct ConvSide {
  unsigned cur, end, stride; f32x4 a[NC], b[NC];
  __device__ __forceinline__ void init(int part, int nparts, unsigned c0, unsigned c1, int tid) { stride = (unsigned)nparts * NT; cur = c0 + (unsigned)part * NT + tid; end = c1; }
  __device__ __forceinline__ bool done() const { return cur >= end; }
  __device__ __forceinline__ void issue(const P& p) {
#pragma unroll
    for (int u = 0; u < NC; ++u) {
      const unsigned ch = cur + u * stride;
      if (ch < end) {
        const float* src;
        if (ch < (1u << 24)) { const int h8 = (int)(ch & 31), k = (int)((ch >> 5) & 1023), mat = (int)((ch >> 15) & 1), e = (int)(ch >> 16); src = (mat ? p.wu_e : p.wg_e) + ((size_t)e * D + k) * DE + 8 * h8; }
        else { const unsigned c2 = ch - (1u << 24); const int c8 = (int)(c2 & 127), k = (int)((c2 >> 7) & 255), e = (int)(c2 >> 15); src = p.wd_e + ((size_t)e * DE + k) * D + 8 * c8; }
        a[u] = __builtin_nontemporal_load((const f32x4*)src); b[u] = __builtin_nontemporal_load((const f32x4*)(src + 4));
      }
    }
  }
  __device__ __forceinline__ void finish(unsigned char* ws_) {
    bf16_t* WE1 = (bf16_t*)(ws_ + WS_WE1); bf16_t* WE2 = (bf16_t*)(ws_ + WS_WE2);
#pragma unroll
    for (int u = 0; u < NC; ++u) {
      const unsigned ch = cur + u * stride;
      if (ch < end) {
        const u32x4 o = (u32x4){pk2(a[u][0], a[u][1]), pk2(a[u][2], a[u][3]), pk2(b[u][0], b[u][1]), pk2(b[u][2], b[u][3])};
        if (ch < (1u << 24)) {
          const int h8 = (int)(ch & 31), k = (int)((ch >> 5) & 1023), mat = (int)((ch >> 15) & 1), e = (int)(ch >> 16);
          const int h = 8 * h8, sub = h >> 7, hl = h & 127, c = 64 * (hl >> 5) + 32 * mat + (hl & 31);
          const size_t blk = ((size_t)(e * 2 + sub) * 32 + (k >> 5)) * 8192; const int kk = k & 31, off = (c >> 5) * 1024 + (kk >> 3) * 256 + (kk & 7) * 32 + (c & 31);
          *(u32x4*)(WE1 + blk + off) = o;
        } else {
          const unsigned c2 = ch - (1u << 24); const int c8 = (int)(c2 & 127), k = (int)((c2 >> 7) & 255), e = (int)(c2 >> 15);
          const int col = 8 * c8, nt = col >> 8, c = col & 255;
          const size_t blk = ((size_t)(e * 4 + nt) * 8 + (k >> 5)) * 8192; const int kk = k & 31, off = (c >> 5) * 1024 + (kk >> 3) * 256 + (kk & 7) * 32 + (c & 31);
          *(u32x4*)(WE2 + blk + off) = o;
        }
      }
    }
    cur += NC * stride;
  }
};


struct ConvSideLds {
  unsigned cur, end, stride; LAS unsigned char* buf;
  __device__ __forceinline__ void init(int part, int nparts, unsigned c0, unsigned c1, int tid, LAS unsigned char* b) { stride = (unsigned)nparts * NT; cur = c0 + (unsigned)part * NT + tid; end = c1; buf = b; }
  __device__ __forceinline__ bool done() const { return cur >= end; }
  __device__ __forceinline__ const float* src_of(const P& p, unsigned ch) const {
    const unsigned c2 = ch - (1u << 24); const int c8 = (int)(c2 & 127), k = (int)((c2 >> 7) & 255), e = (int)(c2 >> 15); return p.wd_e + ((size_t)e * DE + k) * D + 8 * c8; }
  __device__ __forceinline__ void issue(const P& p) {
    if (cur < end) { const float* src = src_of(p, cur);
      __builtin_amdgcn_global_load_lds((const unsigned*)src, (LAS unsigned*)buf, 16, 0, 0);
      __builtin_amdgcn_global_load_lds((const unsigned*)(src + 4), (LAS unsigned*)(buf + 1024), 16, 0, 0); }
  }
  template <int VMC> __device__ __forceinline__ void finish(unsigned char* ws_, int lane) {
    if (cur < end) {
      if (VMC == 8) asm volatile("s_waitcnt vmcnt(8)" ::: "memory"); else asm volatile("s_waitcnt vmcnt(0)" ::: "memory");
      const f32x4 a = *(const LAS f32x4*)(buf + lane * 16), b = *(const LAS f32x4*)(buf + 1024 + lane * 16);
      const unsigned c2 = cur - (1u << 24); const int c8 = (int)(c2 & 127), k = (int)((c2 >> 7) & 255), e = (int)(c2 >> 15);
      const int col = 8 * c8, nt = col >> 8, c = col & 255;
      const size_t blk = ((size_t)(e * 4 + nt) * 8 + (k >> 5)) * 8192; const int kk = k & 31, off = (c >> 5) * 1024 + (kk >> 3) * 256 + (kk & 7) * 32 + (c & 31);
      *(u32x4*)((bf16_t*)(ws_ + WS_WE2) + blk + off) = (u32x4){pk2(a[0], a[1]), pk2(a[2], a[3]), pk2(b[0], b[1]), pk2(b[2], b[3])};
      asm volatile("s_waitcnt lgkmcnt(0)" ::: "memory");
    }
    cur += stride;
  }
};

namespace att {
typedef short bf16x8 __attribute__((ext_vector_type(8)));
typedef short s16x4 __attribute__((ext_vector_type(4)));
typedef float f32x16 __attribute__((ext_vector_type(16)));
typedef float f32x2_t __attribute__((ext_vector_type(2)));
typedef __bf16 bf16x2_t __attribute__((ext_vector_type(2)));
constexpr int KSLOT = 8192, VSLOT = 16384;
constexpr int L_K = 0, L_V = 2 * KSLOT, L_WS = L_V + 2 * VSLOT, L_END = L_WS + 8 * 64 * 4;
constexpr float THR = 8.0f;
__device__ __forceinline__ int crow(int r, int hi) { return (r & 3) + 8 * (r >> 2) + 4 * hi; }
__device__ __forceinline__ unsigned cvtpk(float lo, float hi) { f32x2_t v = {lo, hi}; bf16x2_t b = __builtin_convertvector(v, bf16x2_t); return __builtin_bit_cast(unsigned, b); }
__device__ __forceinline__ s16x4 vtr(const LAS unsigned char* p) { typedef short v4i16_t __attribute__((ext_vector_type(4))); return __builtin_bit_cast(s16x4, __builtin_amdgcn_ds_read_tr16_b64_v4i16((LAS v4i16_t*)p)); }
__device__ __forceinline__ bf16x8 pack8(const f32x16& x, int s) {
  u32x4 w; w.x = cvtpk(x[8 * s], x[8 * s + 1]); w.y = cvtpk(x[8 * s + 2], x[8 * s + 3]); w.z = cvtpk(x[8 * s + 4], x[8 * s + 5]); w.w = cvtpk(x[8 * s + 6], x[8 * s + 7]);
  return __builtin_bit_cast(bf16x8, w);
}

template <class SIDE>
__device__ __forceinline__ void attn_unit(const P& p, int b, int hc, int qb, LAS unsigned char* lds, SIDE& side) {
  const int tid = tidx(), lane = tid & 63, r32 = lane & 31, hi = lane >> 5; const int wid = __builtin_amdgcn_readfirstlane(tid >> 6);
  unsigned char* const ws_ = fresh_ws(p.ws);
  const bf16_t* PR = (const bf16_t*)(ws_ + WS_PROJB); bf16_t* AO = (bf16_t*)(ws_ + WS_AO);
  const int h = hc >> 1; const size_t rowbase = (size_t)b * SEQ; const int q0w = qb * 256 + wid * 32;
  bf16x8 qr[4];
  { const bf16_t* Qw = PR + (rowbase + q0w + r32) * DPROJ + COL_Q + hc * 64 + hi * 8;
#pragma unroll
    for (int d0 = 0; d0 < 4; ++d0) qr[d0] = *(const bf16x8*)(Qw + d0 * 16); }
  const bf16_t* ksrc = PR + (rowbase + lane) * DPROJ + COL_K + hc * 64 + wid * 8;
  const bf16_t* vsrc = PR + (rowbase + 16 * (wid & 3) + (lane >> 2)) * DPROJ + COL_V + h * 128 + (wid >> 2) * 32 + (lane & 3) * 8;
  LAS unsigned char* kdst = lds + L_K + wid * 1024 + lane * 16;
  LAS unsigned char* vdst = lds + L_V + wid * 1024 + lane * 16;
  LAS float* wsf = (LAS float*)(lds + L_WS) + wid * 64;
  const int NTL = 4 * qb + 4, tl = 4 * qb + (wid >> 1);
  const size_t tstep = (size_t)64 * DPROJ;
  float mhat = 0.f, l = 0.f; f32x16 o[4], negm;
#pragma unroll
  for (int i = 0; i < 16; ++i) { o[0][i] = 0.f; o[1][i] = 0.f; o[2][i] = 0.f; o[3][i] = 0.f; negm[i] = 0.f; }
  u32x4 kreg = *(const u32x4*)ksrc, v0reg = *(const u32x4*)vsrc, v1reg = *(const u32x4*)(vsrc + 64);
  *(LAS u32x4*)kdst = kreg; *(LAS u32x4*)vdst = v0reg; *(LAS u32x4*)(vdst + 8192) = v1reg;
  __syncthreads();
  const int vlane = ((lane >> 4) & 1) * 32 + (lane & 3) * 8 + (4 * hi + ((lane & 15) >> 2)) * 64;
  for (int t = 0; t < NTL; ++t) {
    const int cur = t & 1;
    side.issue(p);
    if (t + 1 < NTL) { const size_t off = (size_t)(t + 1) * tstep; kreg = *(const u32x4*)(ksrc + off); v0reg = *(const u32x4*)(vsrc + off); v1reg = *(const u32x4*)(vsrc + off + 64); }
    if (t <= tl) {
      const LAS unsigned char* kb = lds + L_K + cur * KSLOT + hi * 1024 + r32 * 16;
      bf16x8 kf[8];
#pragma unroll
      for (int d0 = 0; d0 < 4; ++d0) { kf[2 * d0] = *(const LAS bf16x8*)(kb + d0 * 2048); kf[2 * d0 + 1] = *(const LAS bf16x8*)(kb + d0 * 2048 + 512); }
      f32x16 p0 = negm, p1 = negm;
#pragma unroll
      for (int d0 = 0; d0 < 4; ++d0) {
        p0 = __builtin_amdgcn_mfma_f32_32x32x16_bf16(kf[2 * d0], qr[d0], p0, 0, 0, 0);
        p1 = __builtin_amdgcn_mfma_f32_32x32x16_bf16(kf[2 * d0 + 1], qr[d0], p1, 0, 0, 0);
      }
      const LAS unsigned char* vb = lds + L_V + cur * VSLOT + vlane;
      s16x4 vl[8], vh[8];
#pragma unroll
      for (int i = 0; i < 8; ++i) { vl[i] = vtr(vb + (i >> 2) * 4096 + (i & 3) * 1024); vh[i] = vtr(vb + (i >> 2) * 4096 + (i & 3) * 1024 + 512); }
      if (t == tl) {
        const int lim = 32 * (wid & 1) + r32;
#pragma unroll
        for (int r = 0; r < 16; ++r) { const int kk = crow(r, hi); if (kk > lim) p0[r] = -INFINITY; if (kk + 32 > lim) p1[r] = -INFINITY; }
      }
      float rm = fmaxf(p0[0], p1[0]);
#pragma unroll
      for (int r = 1; r < 16; ++r) rm = fmaxf(rm, fmaxf(p0[r], p1[r]));
      { auto rr = __builtin_amdgcn_permlane32_swap(__float_as_uint(rm), __float_as_uint(rm), false, false); rm = fmaxf(__uint_as_float(rr[0]), __uint_as_float(rr[1])); }
      const bool first = (t == 0);
      if (first || __any(rm > THR)) {
        const float dl = first ? rm : fmaxf(rm, 0.f);
        mhat += dl;
#pragma unroll
        for (int r = 0; r < 16; ++r) { p0[r] -= dl; p1[r] -= dl; negm[r] = -mhat; }
        if (!first) {
          const float f = __builtin_amdgcn_exp2f(-dl);
          l *= f;
          if (hi == 0) wsf[r32] = f;
          asm volatile("s_waitcnt lgkmcnt(0)" ::: "memory");
          float fr[16];
#pragma unroll
          for (int r = 0; r < 16; ++r) fr[r] = wsf[crow(r, hi)];
#pragma unroll
          for (int d0 = 0; d0 < 4; ++d0)
#pragma unroll
            for (int r = 0; r < 16; ++r) o[d0][r] *= fr[r];
          asm volatile("s_waitcnt lgkmcnt(0)" ::: "memory");
        }
      }
      float sacc = 0.f;
#pragma unroll
      for (int r = 0; r < 16; ++r) { p0[r] = __builtin_amdgcn_exp2f(p0[r]); p1[r] = __builtin_amdgcn_exp2f(p1[r]); sacc += p0[r] + p1[r]; }
      l += sacc;
      bf16x8 pa[4]; pa[0] = pack8(p0, 0); pa[1] = pack8(p0, 1); pa[2] = pack8(p1, 0); pa[3] = pack8(p1, 1);
#define ATT_VF(i) (bf16x8){vl[i][0], vl[i][1], vl[i][2], vl[i][3], vh[i][0], vh[i][1], vh[i][2], vh[i][3]}
#pragma unroll
      for (int i = 0; i < 8; ++i) o[i >> 2] = __builtin_amdgcn_mfma_f32_32x32x16_bf16(pa[i & 3], ATT_VF(i), o[i >> 2], 0, 0, 0);
#pragma unroll
      for (int i = 0; i < 8; ++i) { vl[i] = vtr(vb + (2 + (i >> 2)) * 4096 + (i & 3) * 1024); vh[i] = vtr(vb + (2 + (i >> 2)) * 4096 + (i & 3) * 1024 + 512); }
#pragma unroll
      for (int i = 0; i < 8; ++i) o[2 + (i >> 2)] = __builtin_amdgcn_mfma_f32_32x32x16_bf16(pa[i & 3], ATT_VF(i), o[2 + (i >> 2)], 0, 0, 0);
#undef ATT_VF
    }
    side.finish(ws_);
    if (t + 1 < NTL) { const int nx = (cur ^ 1); *(LAS u32x4*)(kdst + nx * KSLOT) = kreg; *(LAS u32x4*)(vdst + nx * VSLOT) = v0reg; *(LAS u32x4*)(vdst + nx * VSLOT + 8192) = v1reg; }
    __syncthreads();
  }
  { auto rr = __builtin_amdgcn_permlane32_swap(__float_as_uint(l), __float_as_uint(l), false, false); l = __uint_as_float(rr[0]) + __uint_as_float(rr[1]); }
  if (hi == 0) wsf[32 + r32] = l;
  asm volatile("s_waitcnt lgkmcnt(0)" ::: "memory");
  bf16_t* Ow = AO + (rowbase + q0w) * 1024 + hc * 128 + r32;
#pragma unroll
  for (int r = 0; r < 16; ++r) {
    const int qq = crow(r, hi); const float rl = 1.0f / wsf[32 + qq];
#pragma unroll
    for (int d0 = 0; d0 < 4; ++d0) Ow[(size_t)qq * 1024 + d0 * 32] = (bf16_t)f2bf(o[d0][r] * rl);
  }
  asm volatile("s_waitcnt lgkmcnt(0)" ::: "memory");
}
}
template <class SIDE>
__device__ __forceinline__ void phase_attn_unit(const P& p, int v, int i, LAS unsigned char* lds, SIDE& side) { const int bh = v >> 3, s = v & 7; att::attn_unit(p, bh >> 3, bh & 7, i == 0 ? 15 - s : s, lds, side); }
namespace attn_body {
using bf16=__hip_bfloat16;
using bf16x8=__attribute__((ext_vector_type(8)))short;
using s16x4=__attribute__((ext_vector_type(4)))short;
using f32x16=__attribute__((ext_vector_type(16)))float;
using u32x4=__attribute__((ext_vector_type(4)))unsigned;
constexpr int BATCH=4,NHEAD=8,SEQ=4096,D=64,PQ=3072,PO=1024;
constexpr int NW=8,QBLK=32,QB=QBLK*NW,KVBLK=64,NQB=SEQ/QB;
constexpr int ATTN_UNIT_ROWS=QB;
__device__ __forceinline__ int crow(int r,int hi){return (r&3)+8*(r>>2)+4*hi;}
#define SBAR() __builtin_amdgcn_sched_barrier(0)
__device__ __forceinline__ void cmask(f32x16&p0,f32x16&p1,int jb,int qrel,int hi){
  const float NEG=-INFINITY; int kb=64*jb+4*hi;
  #pragma unroll
  for(int r=0;r<16;++r){int kv=kb+(r&3)+8*(r>>2); if(kv>qrel)p0[r]=NEG; if(kv+32>qrel)p1[r]=NEG;}
}

constexpr int NSLOT=3, SLOTB=8192;
constexpr int LDS_K=0, LDS_V=NSLOT*SLOTB, LDS_WS=2*NSLOT*SLOTB, LDS_OST=LDS_WS+NW*64*4, LDS_BYTES=LDS_OST+NW*4096;
constexpr float C2=0.125f*1.4426950408889634f;
__device__ __forceinline__ void glds16(const void*gsrc,unsigned lds_dst){unsigned keep;
  asm volatile("s_mov_b32 %0, m0\n\ts_mov_b32 m0, %2\n\ts_nop 0\n\tglobal_load_lds_dwordx4 %1, off\n\ts_mov_b32 m0, %0":"=&s"(keep):"v"(gsrc),"s"(lds_dst):"memory");}
__device__ __forceinline__ float max3f(float a,float b,float c){float r;asm("v_max3_f32 %0, %1, %2, %3":"=v"(r):"v"(a),"v"(b),"v"(c));return r;}
__device__ __forceinline__ float max2f(float a,float b){float r;asm("v_max_f32_e32 %0, %1, %2":"=v"(r):"v"(a),"v"(b));return r;}
__device__ __forceinline__ float fadd_s(float a,float b){float r;asm("v_add_f32_e32 %0, %1, %2":"=v"(r):"v"(a),"v"(b));return r;}
__device__ __forceinline__ float fsub_s(float a,float b){float r;asm("v_sub_f32_e32 %0, %1, %2":"=v"(r):"v"(a),"v"(b));return r;}
typedef float f32x2_t __attribute__((ext_vector_type(2))); typedef __bf16 bf16x2_t __attribute__((ext_vector_type(2)));
__device__ __forceinline__ unsigned cvtpk_s(float lo,float hi){f32x2_t v={lo,hi};bf16x2_t b=__builtin_convertvector(v,bf16x2_t);return __builtin_bit_cast(unsigned,b);}
#define WAIT_BAR(N) asm volatile("s_waitcnt vmcnt(" #N ") lgkmcnt(0)\n\ts_barrier":::"memory")

__device__ __forceinline__ void qkt(f32x16&p0,f32x16&p1,const char*Kslot,const bf16x8*qr,const f32x16&negm,int r32,int hi){
  const char*kb=Kslot+hi*1024+r32*16;
  #pragma unroll
  for(int d0=0;d0<4;++d0){
    const bf16x8 b0=*reinterpret_cast<const bf16x8*>(kb+d0*2048);
    const bf16x8 b1=*reinterpret_cast<const bf16x8*>(kb+d0*2048+512);
    if(d0==0){p0=__builtin_amdgcn_mfma_f32_32x32x16_bf16(b0,qr[0],negm,0,0,0);p1=__builtin_amdgcn_mfma_f32_32x32x16_bf16(b1,qr[0],negm,0,0,0);}
    else{p0=__builtin_amdgcn_mfma_f32_32x32x16_bf16(b0,qr[d0],p0,0,0,0);p1=__builtin_amdgcn_mfma_f32_32x32x16_bf16(b1,qr[d0],p1,0,0,0);}}
}
typedef __attribute__((address_space(3))) const char* lds_cptr;
typedef short v4i16_t __attribute__((ext_vector_type(4)));
__device__ __forceinline__ void kload8(bf16x8*kf,lds_cptr kp){
  kf[0]=*(const __attribute__((address_space(3))) bf16x8*)(kp);      kf[1]=*(const __attribute__((address_space(3))) bf16x8*)(kp+512);
  kf[2]=*(const __attribute__((address_space(3))) bf16x8*)(kp+2048); kf[3]=*(const __attribute__((address_space(3))) bf16x8*)(kp+2560);
  kf[4]=*(const __attribute__((address_space(3))) bf16x8*)(kp+4096); kf[5]=*(const __attribute__((address_space(3))) bf16x8*)(kp+4608);
  kf[6]=*(const __attribute__((address_space(3))) bf16x8*)(kp+6144); kf[7]=*(const __attribute__((address_space(3))) bf16x8*)(kp+6656);
}
__device__ __forceinline__ void kload2(bf16x8*kf,lds_cptr kp,int j){ kf[2*j]=*(const __attribute__((address_space(3))) bf16x8*)(kp+j*2048); kf[2*j+1]=*(const __attribute__((address_space(3))) bf16x8*)(kp+j*2048+512); }
__device__ __forceinline__ s16x4 vtr(lds_cptr p){ return __builtin_bit_cast(s16x4,__builtin_amdgcn_ds_read_tr16_b64_v4i16((__attribute__((address_space(3))) v4i16_t*)p)); }
__device__ __forceinline__ float rowmax(const f32x16&p0,const f32x16&p1){
  float a=max3f(p0[0],p0[1],p1[0]),b=max3f(p0[2],p0[3],p1[1]);a=max3f(a,p1[2],p1[3]);
  #pragma unroll
  for(int r=4;r<16;r+=4){a=max3f(a,p0[r],p0[r+1]);b=max3f(b,p0[r+2],p0[r+3]);a=max3f(a,p1[r],p1[r+1]);b=max3f(b,p1[r+2],p1[r+3]);}
  const float m=max2f(a,b);
  auto rr=__builtin_amdgcn_permlane32_swap(__float_as_uint(m),__float_as_uint(m),false,false);
  return max2f(__uint_as_float(rr[0]),__uint_as_float(rr[1]));
}
__device__ __forceinline__ void pv(f32x16*o,int vb,bf16x8 pa0,bf16x8 pa1,bf16x8 pa2,bf16x8 pa3){
  #pragma unroll
  for(int d0=0;d0<2;++d0){s16x4 lo[4],hi[4];
    #pragma unroll
    for(int ks=0;ks<4;++ks){
      asm volatile("ds_read_b64_tr_b16 %0,%1 offset:%c2":"=&v"(lo[ks]):"v"(vb),"i"(d0*4096+ks*1024):"memory");
      asm volatile("ds_read_b64_tr_b16 %0,%1 offset:%c2":"=&v"(hi[ks]):"v"(vb),"i"(d0*4096+ks*1024+512):"memory");}
    asm volatile("s_waitcnt lgkmcnt(0)":::"memory");SBAR();
    #define PK(k) (bf16x8){lo[k][0],lo[k][1],lo[k][2],lo[k][3],hi[k][0],hi[k][1],hi[k][2],hi[k][3]}
    o[d0]=__builtin_amdgcn_mfma_f32_32x32x16_bf16(pa0,PK(0),o[d0],0,0,0);
    o[d0]=__builtin_amdgcn_mfma_f32_32x32x16_bf16(pa1,PK(1),o[d0],0,0,0);
    o[d0]=__builtin_amdgcn_mfma_f32_32x32x16_bf16(pa2,PK(2),o[d0],0,0,0);
    o[d0]=__builtin_amdgcn_mfma_f32_32x32x16_bf16(pa3,PK(3),o[d0],0,0,0);
    #undef PK
  }
}

#ifndef ATTN_STORE16
#define ATTN_STORE16(p,v) (*(u32x4*)(p)=(v))
#endif
template<int THRL> __device__ __forceinline__ void attn_unit(int b,int h,int hv,int ho,int qb,const bf16*Q,const bf16*__restrict__ K,const bf16*__restrict__ V,bf16*O,char*shm){
  const int tid=tidx(),lane=tid&63,r32=lane&31,hi=lane>>5; const int wid=__builtin_amdgcn_readfirstlane(tid>>6);
  const long rowbase=(long)b*SEQ; const int q0=qb*QB;
  const bf16*Qw=Q+(rowbase+q0+wid*QBLK)*PQ+h*D;
  const bf16*Kh=K+rowbase*PQ+h*D,*Vh=V+rowbase*PQ+hv*D;
  const unsigned lds0=(unsigned)(uintptr_t)shm;
  float*wsf=(float*)(shm+LDS_WS)+wid*64;
  const bf16*ksrc=Kh+(long)lane*PQ+wid*8;
  const bf16*vsrc=Vh+(long)(16*(wid&3)+(lane>>2))*PQ+(wid>>2)*32+(lane&3)*8;
  const unsigned kdst=lds0+LDS_K+wid*1024, vdst=lds0+LDS_V+wid*1024;
  #define DMA_K(t,slot) glds16(ksrc+(long)(t)*KVBLK*PQ,(unsigned)__builtin_amdgcn_readfirstlane(kdst+(slot)))
  #define DMA_V(t,slot) glds16(vsrc+(long)(t)*KVBLK*PQ,(unsigned)__builtin_amdgcn_readfirstlane(vdst+(slot)))
  const int vb0=(int)(lds0+LDS_V)+((lane>>4)&1)*32+(lane&3)*8+(4*hi+((lane&15)>>2))*64;
  const char*Kbase=shm+LDS_K; bf16x8 kf[8];
  const lds_cptr shm3=(lds_cptr)shm; const lds_cptr kp0=shm3+LDS_K+hi*1024+r32*16; const lds_cptr vp0=shm3+LDS_V+((lane>>4)&1)*32+(lane&3)*8+(4*hi+((lane&15)>>2))*64;
  const int NT=(q0+QB)/KVBLK;
  DMA_K(0,0);DMA_V(0,0);DMA_K(1,SLOTB);
  bf16x8 qr[4];
  #pragma unroll
  for(int d0=0;d0<4;++d0)qr[d0]=*reinterpret_cast<const bf16x8*>(&Qw[(long)r32*PQ+d0*16+hi*8]);
  float mhat=0.f,l_reg=0.f;f32x16 o[2];o[0]=f32x16{};o[1]=f32x16{};f32x16 negm=f32x16{};asm volatile("":"+v"(negm));
  const int qrel=wid*QBLK+r32;
  #define CMASK(P0,P1,t) do{int jb_=(t)-(NT-4); if(jb_>=0)cmask(P0,P1,jb_,qrel,hi);}while(0)
  bool resc=false;
  #define START(P0,P1) do{ const float rm=rowmax(P0,P1); resc=false; \
    { const float dl=rm; mhat=fadd_s(mhat,dl); \
      _Pragma("unroll") for(int r=0;r<16;++r){P0[r]=fsub_s(P0[r],dl);P1[r]=fsub_s(P1[r],dl);} \
      _Pragma("unroll") for(int r=0;r<16;++r)negm[r]=-mhat; asm volatile("":"+v"(negm)); } \
    _Pragma("unroll") for(int r=0;r<16;++r)P0[r]=__builtin_amdgcn_exp2f(P0[r]); }while(0)
  #define RESC() do{ if(resc){ asm volatile("s_waitcnt lgkmcnt(0)":::"memory"); \
      _Pragma("unroll") for(int d_=0;d_<2;++d_) _Pragma("unroll") for(int r=0;r<16;++r)o[d_][r]*=wsf[crow(r,hi)]; } }while(0)
  f32x16 pA0,pA1,pB0,pB1;
  int sl_prev=0,sl_cur=0,sl_next=SLOTB;
  #define ROT() do{sl_prev=sl_cur;sl_cur=sl_next;sl_next=(sl_next==(NSLOT-1)*SLOTB)?0:sl_next+SLOTB;}while(0)
  DMA_K(2,2*SLOTB);
  WAIT_BAR(3);
  qkt(pA0,pA1,Kbase,qr,negm,r32,hi);asm volatile("s_nop 15\n\ts_nop 7":"+v"(pA0),"+v"(pA1));CMASK(pA0,pA1,0);
  START(pA0,pA1);
  _Pragma("unroll") for(int r=0;r<16;++r)pA1[r]=__builtin_amdgcn_exp2f(pA1[r]);
  WAIT_BAR(0);
  DMA_K(3,0);DMA_V(1,SLOTB);
  ROT();
  kload8(kf,kp0+sl_cur);
  WAIT_BAR(2);
  s16x4 vlo[8],vhi[8]; u32x4 pw0,pw1,pw2,pw3;
  #define PKW(P,B) cvtpk_s(P[B],P[B+1])
  #define PAF(k) __builtin_bit_cast(bf16x8,pw##k)
  #define VFR(i) (bf16x8){vlo[i][0],vlo[i][1],vlo[i][2],vlo[i][3],vhi[i][0],vhi[i][1],vhi[i][2],vhi[i][3]}
  #define PIN(x) asm volatile("":"+v"(x))
  #define MX3(a,b,c) __builtin_fmaxf(__builtin_fmaxf((a),(b)),(c))
  #define GAPA(MF,A0,A1,A2,A3,W0,W1,PW) do{ MF; sacc+=A0; sacc+=A1; sacc+=A2; sacc+=A3; PIN(sacc); W0; W1; PIN(PW); SBAR(); }while(0)
  #define EX(v) __builtin_amdgcn_exp2f(v)
  #define GAPB(MF,X,B) do{ MF; X[B]=EX(X[B]); X[B+1]=EX(X[B+1]); X[B+2]=EX(X[B+2]); X[B+3]=EX(X[B+3]); PIN(X); SBAR(); }while(0)
  #define VRD(i) do{ vlo[i]=vtr(vp_+(((i)>>2)*4096+((i)&3)*1024)); vhi[i]=vtr(vp_+(((i)>>2)*4096+((i)&3)*1024+512)); }while(0)
  #define KRD(G,j) do{ if(G){ kload2(kf,kp0+sl_next,j); SBAR(); } }while(0)
  #define STEP(C0,C1,P0,P1,t,GK,GV,GL) do{ SBAR(); \
    const lds_cptr vp_=vp0+sl_prev; \
    VRD(0); SBAR(); float sacc=(P0[0]+P0[1]); \
    GAPA(C0=__builtin_amdgcn_mfma_f32_32x32x16_bf16(kf[0],qr[0],negm,0,0,0), P0[2],P0[3],P0[4],P0[5],     pw0[0]=PKW(P0,0), pw0[1]=PKW(P0,2), pw0); \
    VRD(4); SBAR(); GAPA(C1=__builtin_amdgcn_mfma_f32_32x32x16_bf16(kf[1],qr[0],negm,0,0,0), P0[6],P0[7],P0[8],P0[9],     pw0[2]=PKW(P0,4), pw0[3]=PKW(P0,6), pw0); \
    VRD(1); SBAR(); GAPA(C0=__builtin_amdgcn_mfma_f32_32x32x16_bf16(kf[2],qr[1],C0,0,0,0),   P0[10],P0[11],P0[12],P0[13], pw1[0]=PKW(P0,8), pw1[1]=PKW(P0,10), pw1); \
    VRD(5); SBAR(); GAPA(C1=__builtin_amdgcn_mfma_f32_32x32x16_bf16(kf[3],qr[1],C1,0,0,0),   P0[14],P0[15],P1[0],P1[1],   pw1[2]=PKW(P0,12),pw1[3]=PKW(P0,14), pw1); \
    VRD(2); SBAR(); GAPA(C0=__builtin_amdgcn_mfma_f32_32x32x16_bf16(kf[4],qr[2],C0,0,0,0),   P1[2],P1[3],P1[4],P1[5],     pw2[0]=PKW(P1,0), pw2[1]=PKW(P1,2), pw2); \
    VRD(6); SBAR(); GAPA(C1=__builtin_amdgcn_mfma_f32_32x32x16_bf16(kf[5],qr[2],C1,0,0,0),   P1[6],P1[7],P1[8],P1[9],     pw2[2]=PKW(P1,4), pw2[3]=PKW(P1,6), pw2); \
    VRD(3); SBAR(); GAPA(C0=__builtin_amdgcn_mfma_f32_32x32x16_bf16(kf[6],qr[3],C0,0,0,0),   P1[10],P1[11],P1[12],P1[13], pw3[0]=PKW(P1,8), pw3[1]=PKW(P1,10), pw3); \
    VRD(7); SBAR(); GAPA(C1=__builtin_amdgcn_mfma_f32_32x32x16_bf16(kf[7],qr[3],C1,0,0,0),   P1[14],P1[15],0.f,0.f,       pw3[2]=PKW(P1,12),pw3[3]=PKW(P1,14), pw3); \
    l_reg+=sacc; \
    if(GK){DMA_K((t)+3,sl_cur);} if(GV){DMA_V((t)+1,sl_next);} \
    CMASK(C0,C1,t); \
    { float a=MX3(C0[0],C0[1],C1[0]),b=MX3(C0[2],C0[3],C1[1]); a=MX3(a,C1[2],C1[3]); \
      _Pragma("unroll") for(int r=4;r<16;r+=4){a=MX3(a,C0[r],C0[r+1]);b=MX3(b,C0[r+2],C0[r+3]);a=MX3(a,C1[r],C1[r+1]);b=MX3(b,C1[r+2],C1[r+3]);} \
      float rm=__builtin_fmaxf(a,b); { auto rr=__builtin_amdgcn_permlane32_swap(__float_as_uint(rm),__float_as_uint(rm),false,false); rm=__builtin_fmaxf(__uint_as_float(rr[0]),__uint_as_float(rr[1])); } \
      resc=false; \
      if(__builtin_expect(__any(rm>(float)THRL),0)){ const float dl=__builtin_fmaxf(rm,0.f); mhat+=dl; \
        _Pragma("unroll") for(int r=0;r<16;++r){C0[r]-=dl;C1[r]-=dl;} \
        _Pragma("unroll") for(int r=0;r<16;++r)negm[r]=-mhat; asm volatile("":"+v"(negm)); \
        const float f=__builtin_amdgcn_exp2f(-dl); l_reg*=f; if(hi==0)wsf[r32]=f; resc=true; } } \
    SBAR(); \
    GAPB(o[0]=__builtin_amdgcn_mfma_f32_32x32x16_bf16(PAF(0),VFR(0),o[0],0,0,0), C0,0); \
    GAPB(o[1]=__builtin_amdgcn_mfma_f32_32x32x16_bf16(PAF(0),VFR(4),o[1],0,0,0), C0,4); \
    KRD(GL,0); GAPB(o[0]=__builtin_amdgcn_mfma_f32_32x32x16_bf16(PAF(1),VFR(1),o[0],0,0,0), C0,8); \
    KRD(GL,1); GAPB(o[1]=__builtin_amdgcn_mfma_f32_32x32x16_bf16(PAF(1),VFR(5),o[1],0,0,0), C0,12); \
    KRD(GL,2); GAPB(o[0]=__builtin_amdgcn_mfma_f32_32x32x16_bf16(PAF(2),VFR(2),o[0],0,0,0), C1,0); \
    KRD(GL,3); GAPB(o[1]=__builtin_amdgcn_mfma_f32_32x32x16_bf16(PAF(2),VFR(6),o[1],0,0,0), C1,4); \
    GAPB(o[0]=__builtin_amdgcn_mfma_f32_32x32x16_bf16(PAF(3),VFR(3),o[0],0,0,0), C1,8); \
    GAPB(o[1]=__builtin_amdgcn_mfma_f32_32x32x16_bf16(PAF(3),VFR(7),o[1],0,0,0), C1,12); \
    }while(0)
  int t=1;
  #undef CMASK
  #define CMASK(P0,P1,t) do{}while(0)
  for(;t+5<NT;t+=2){
    STEP(pB0,pB1,pA0,pA1,t,true,true,true);     WAIT_BAR(2); RESC(); ROT();
    STEP(pA0,pA1,pB0,pB1,t+1,true,true,true);   WAIT_BAR(2); RESC(); ROT();
  }
  #undef CMASK
  #define CMASK(P0,P1,t) do{int jb_=(t)-(NT-4); if(jb_>=0)cmask(P0,P1,jb_,qrel,hi);}while(0)
  #define ENDW(tt) do{ if((tt)+3<NT){WAIT_BAR(2);} else if((tt)+2<NT){WAIT_BAR(1);} else {WAIT_BAR(0);} }while(0)
  for(;t+1<NT;t+=2){
    STEP(pB0,pB1,pA0,pA1,t,(t+3<NT),(t+1<NT),(t+1<NT));       ENDW(t);   RESC(); ROT();
    STEP(pA0,pA1,pB0,pB1,t+1,(t+4<NT),(t+2<NT),(t+2<NT));     ENDW(t+1); RESC(); ROT();
  }
  STEP(pB0,pB1,pA0,pA1,NT-1,false,false,false); RESC();
  { float sacc=pB0[0]+pB0[1]; _Pragma("unroll") for(int r=2;r<16;++r)sacc+=pB0[r]; _Pragma("unroll") for(int r=0;r<16;++r)sacc+=pB1[r]; l_reg+=sacc;
    pw0=(u32x4){PKW(pB0,0),PKW(pB0,2),PKW(pB0,4),PKW(pB0,6)};pw1=(u32x4){PKW(pB0,8),PKW(pB0,10),PKW(pB0,12),PKW(pB0,14)};pw2=(u32x4){PKW(pB1,0),PKW(pB1,2),PKW(pB1,4),PKW(pB1,6)};pw3=(u32x4){PKW(pB1,8),PKW(pB1,10),PKW(pB1,12),PKW(pB1,14)};
    SBAR(); pv(o,vb0+sl_cur,PAF(0),PAF(1),PAF(2),PAF(3)); }
  #undef PKW
  #undef PAF
  #undef VFR
  #undef PIN
  #undef MX3
  #undef GAPA
  #undef GAPB
  #undef EX
  #undef VRD
  #undef KRD
  #undef STEP
  #undef ENDW
  {auto rr=__builtin_amdgcn_permlane32_swap(__float_as_uint(l_reg),__float_as_uint(l_reg),false,false);l_reg=__uint_as_float(rr[0])+__uint_as_float(rr[1]);}
  if(hi==0)wsf[32+r32]=l_reg;asm volatile("s_waitcnt lgkmcnt(0)":::"memory");
  float rli[16];
  #pragma unroll
  for(int r=0;r<16;++r)rli[r]=__builtin_amdgcn_rcpf(wsf[32+crow(r,hi)]);
  bf16*Ow=O+(rowbase+q0+wid*QBLK)*PO+ho*D;
  { bf16*stg=(bf16*)(shm+LDS_OST)+wid*2048;
    #pragma unroll
    for(int r=0;r<16;++r){const int orow=crow(r,hi);
      #pragma unroll
      for(int d0=0;d0<2;++d0)stg[orow*64+d0*32+r32]=__float2bfloat16(o[d0][r]*rli[r]);}
    asm volatile("s_waitcnt lgkmcnt(0)":::"memory");
    #pragma unroll
    for(int i=0;i<4;++i){const int row=i*8+(lane>>3),ch=lane&7; const u32x4 v=*(const u32x4*)(stg+row*64+ch*8); ATTN_STORE16(Ow+(long)row*PO+ch*8,v);} }
  asm volatile("s_waitcnt lgkmcnt(0)\n\ts_barrier":::"memory");
  #undef DMA_K
  #undef DMA_V
  #undef CMASK
  #undef START
  #undef RESC
  #undef ROT
}
constexpr int ATTN_LDS_BYTES=LDS_BYTES;
struct AttnTensors { const bf16* Q; const bf16* K; const bf16* V; bf16* O; };
template<int THRL=8> __device__ __forceinline__ void attn_phase_unit(char*lds,const AttnTensors&T,int vcu,int i){
  const int bh=vcu>>3,s=vcu&7,b=bh>>3,hc=bh&7;
  const int qb=(i<2)?15-s:s, half=i&1; attn_unit<THRL>(b,hc,(hc>>1)*2+half,2*hc+half,qb,T.Q,T.K,T.V,T.O,lds);
}
#undef SBAR
#undef WAIT_BAR
}

namespace moe {
typedef short bf16x8 __attribute__((ext_vector_type(8)));
typedef short s16x4 __attribute__((ext_vector_type(4)));
typedef float f32x16 __attribute__((ext_vector_type(16)));
typedef unsigned u32x2 __attribute__((ext_vector_type(2)));
constexpr int SLOT = 32768, L_ROWS = 131072, L_TS = 133120, L_CL = 134400, L_SIDE = 139264;

template <int STAGE>
__device__ __forceinline__ void run(const P& p, int bid, int nb, LAS unsigned char* lds) {
  unsigned char* const ws_ = fresh_ws(p.ws);
  constexpr int NSUB = (STAGE == 1) ? 2 : 4, KTOT = (STAGE == 1) ? D : DE, NK = KTOT / 32;
  const int tid = tidx(), lane = tid & 63, r32 = lane & 31, hi = lane >> 5; const int wid = __builtin_amdgcn_readfirstlane(tid >> 6), wm = wid >> 2, wn = wid & 3;
  const int* cnt = (const int*)(ws_ + WS_CTL); const int* LIST = (const int*)(ws_ + WS_LIST);
  LAS int* ts = (LAS int*)(lds + L_TS); LAS int* cl = (LAS int*)(lds + L_CL);
  __syncthreads();
  if (tid < 256) cl[tid] = cnt[tid * CNT_STRIDE];
  __syncthreads();
  if (tid <= 256) { int a = 0; for (int i = 0; i < tid; ++i) a += (cl[i] + 255) >> 8; ts[tid] = a; }
  __syncthreads();
  const int nitems = ts[256] * NSUB;
  const int vcu = (nb % 8 == 0) ? (bid % 8) * (nb / 8) + bid / 8 : bid;
  const bf16_t* Asrc = (STAGE == 1) ? (const bf16_t*)(ws_ + WS_HNB) : (const bf16_t*)(ws_ + WS_H);
  const bf16_t* Bimg = (STAGE == 1) ? (const bf16_t*)(ws_ + WS_WE1) : (const bf16_t*)(ws_ + WS_WE2);
  const int cgk = ((lane & 3) ^ ((lane >> 4) & 3)) * 8;
  int abase[2];
#pragma unroll
  for (int k16 = 0; k16 < 2; ++k16) abase[k16] = (128 * wm + r32) * 64 + (((2 * k16 + hi) ^ ((r32 >> 2) & 3)) * 16);
  const int bbase = 16384 + (2 * wn) * 2048 + hi * 512 + ((lane & 15) >> 2) * 64 + ((lane >> 4) & 1) * 32 + (lane & 3) * 8;

#define MOE_DESC(it, E_, MT_, MC_, SUB_) do { const int tile_ = (it) / NSUB; SUB_ = (it) % NSUB; int lo_ = 0, hi_ = 256; \
    while (hi_ - lo_ > 1) { const int mid_ = (lo_ + hi_) >> 1; if (ts[mid_] <= tile_) lo_ = mid_; else hi_ = mid_; } \
    E_ = __builtin_amdgcn_readfirstlane(lo_); MT_ = __builtin_amdgcn_readfirstlane(tile_ - ts[lo_]); MC_ = __builtin_amdgcn_readfirstlane(min(256, cl[lo_] - MT_ * 256)); } while (0)
#define MOE_ROWS_DMA(E_, MT_, par) do { if (wid == 0) __builtin_amdgcn_global_load_lds((const unsigned*)(LIST + (size_t)(E_) * LISTCAP + (MT_) * 256 + lane * 4), (LAS unsigned*)(lds + L_ROWS + (par) * 1024), 16, 0, 0); } while (0)
#define MOE_ASRC(dst, par, MC_) do { _Pragma("unroll") for (int i = 0; i < 2; ++i) { const int aidr = ((LAS int*)(lds + L_ROWS + (par) * 1024))[min(16 * (2 * wid + i) + (lane >> 2), (MC_) - 1)]; \
      dst[i] = Asrc + ((STAGE == 1) ? (size_t)(aidr >> 3) * D : (size_t)aidr * DE) + cgk; } } while (0)
#define MOE_ISSUE_SL(AS, BS, s, SL) do { LAS unsigned char* sl_ = lds + (SL) * SLOT + (2 * wid) * 1024; \
      __builtin_amdgcn_global_load_lds((const unsigned*)(AS[0] + (s) * 32), (LAS unsigned*)(sl_), 16, 0, 0); \
      __builtin_amdgcn_global_load_lds((const unsigned*)(AS[1] + (s) * 32), (LAS unsigned*)(sl_ + 1024), 16, 0, 0); \
      __builtin_amdgcn_global_load_lds((const unsigned*)(BS + (size_t)(s) * 8192), (LAS unsigned*)(sl_ + 16384), 16, 0, 0); \
      __builtin_amdgcn_global_load_lds((const unsigned*)(BS + (size_t)(s) * 8192 + 512), (LAS unsigned*)(sl_ + 16384 + 1024), 16, 0, 0); } while (0)

  ConvSideLds side; side.init(bid, nb, (STAGE == 1) ? (1u << 24) : 0u, (STAGE == 1) ? (3u << 23) : 0u, tid, lds + L_SIDE + wid * 2048);
  int item = vcu, par = 0;
  int e = 0, mt = 0, mcount = 1, sub = 0;
  const bf16_t* asrc[2]; const bf16_t* bsrc;
  if (item < nitems) {
    MOE_DESC(item, e, mt, mcount, sub);
    MOE_ROWS_DMA(e, mt, 0);
    asm volatile("s_waitcnt vmcnt(0)" ::: "memory"); __syncthreads();
    MOE_ASRC(asrc, 0, mcount);
    bsrc = Bimg + (size_t)(e * NSUB + sub) * NK * 8192 + (2 * wid) * 512 + lane * 8;
    MOE_ISSUE_SL(asrc, bsrc, 0, 0); MOE_ISSUE_SL(asrc, bsrc, 1, 1); MOE_ISSUE_SL(asrc, bsrc, 2, 2);
  }
  while (item < nitems) {
    const int nitem = item + nb; const bool has_next = nitem < nitems;
    int ne = 0, nmt = 0, nmc = 1, nsub = 0;
    const bf16_t* nasrc[2] = {Asrc, Asrc}; const bf16_t* nbsrc = Bimg;
    if (has_next) { MOE_DESC(nitem, ne, nmt, nmc, nsub); nbsrc = Bimg + (size_t)(ne * NSUB + nsub) * NK * 8192 + (2 * wid) * 512 + lane * 8; }
    f32x16 acc[4][2];
#pragma unroll
    for (int m = 0; m < 4; ++m)
#pragma unroll
      for (int n = 0; n < 2; ++n)
#pragma unroll
        for (int r = 0; r < 16; ++r) acc[m][n][r] = 0.f;
#define MOE_STEP(s, SL) do { \
      if ((s) + 2 < NK || has_next) asm volatile("s_waitcnt vmcnt(8)" ::: "memory"); \
      else if ((s) + 1 < NK) asm volatile("s_waitcnt vmcnt(4)" ::: "memory"); \
      else asm volatile("s_waitcnt vmcnt(0)" ::: "memory"); \
      __builtin_amdgcn_s_barrier(); \
      asm volatile("" ::: "memory"); \
      if ((s) + 3 < NK) MOE_ISSUE_SL(asrc, bsrc, (s) + 3, ((SL) + 3) & 3); \
      else if (has_next) { if ((s) + 3 == NK) MOE_ASRC(nasrc, par ^ 1, nmc); MOE_ISSUE_SL(nasrc, nbsrc, (s) + 3 - NK, ((SL) + 3) & 3); } \
      if ((s) == 0 && has_next) MOE_ROWS_DMA(ne, nmt, par ^ 1); \
      const LAS unsigned char* Ab = lds + (SL) * SLOT; const unsigned Bbv = (unsigned)(uintptr_t)(lds + (SL) * SLOT + bbase); \
      bf16x8 af[2][4], bfr[2][2]; s16x4 tq[8]; const unsigned Abv0 = (unsigned)(uintptr_t)(Ab + abase[0]), Abv1 = (unsigned)(uintptr_t)(Ab + abase[1]); \
      asm volatile("ds_read_b64_tr_b16 %0, %1 offset:0" : "=&v"(tq[0]) : "v"(Bbv) : "memory"); \
      asm volatile("ds_read_b64_tr_b16 %0, %1 offset:256" : "=&v"(tq[1]) : "v"(Bbv) : "memory"); \
      asm volatile("ds_read_b64_tr_b16 %0, %1 offset:2048" : "=&v"(tq[2]) : "v"(Bbv) : "memory"); \
      asm volatile("ds_read_b64_tr_b16 %0, %1 offset:2304" : "=&v"(tq[3]) : "v"(Bbv) : "memory"); \
      asm volatile("ds_read_b128 %0, %1 offset:0" : "=&v"(af[0][0]) : "v"(Abv0) : "memory"); \
      asm volatile("ds_read_b128 %0, %1 offset:2048" : "=&v"(af[0][1]) : "v"(Abv0) : "memory"); \
      asm volatile("ds_read_b128 %0, %1 offset:4096" : "=&v"(af[0][2]) : "v"(Abv0) : "memory"); \
      asm volatile("ds_read_b128 %0, %1 offset:6144" : "=&v"(af[0][3]) : "v"(Abv0) : "memory"); \
      asm volatile("ds_read_b64_tr_b16 %0, %1 offset:1024" : "=&v"(tq[4]) : "v"(Bbv) : "memory"); \
      asm volatile("ds_read_b64_tr_b16 %0, %1 offset:1280" : "=&v"(tq[5]) : "v"(Bbv) : "memory"); \
      asm volatile("ds_read_b64_tr_b16 %0, %1 offset:3072" : "=&v"(tq[6]) : "v"(Bbv) : "memory"); \
      asm volatile("ds_read_b64_tr_b16 %0, %1 offset:3328" : "=&v"(tq[7]) : "v"(Bbv) : "memory"); \
      asm volatile("ds_read_b128 %0, %1 offset:0" : "=&v"(af[1][0]) : "v"(Abv1) : "memory"); \
      asm volatile("ds_read_b128 %0, %1 offset:2048" : "=&v"(af[1][1]) : "v"(Abv1) : "memory"); \
      asm volatile("ds_read_b128 %0, %1 offset:4096" : "=&v"(af[1][2]) : "v"(Abv1) : "memory"); \
      asm volatile("ds_read_b128 %0, %1 offset:6144" : "=&v"(af[1][3]) : "v"(Abv1) : "memory"); \
      asm volatile("s_waitcnt lgkmcnt(8)" : "+v"(tq[0]), "+v"(tq[1]), "+v"(tq[2]), "+v"(tq[3]), "+v"(af[0][0]), "+v"(af[0][1]), "+v"(af[0][2]), "+v"(af[0][3]) :: "memory"); __builtin_amdgcn_sched_barrier(0); \
      _Pragma("unroll") for (int n = 0; n < 2; ++n) { const s16x4 l0 = tq[2 * n], h0 = tq[2 * n + 1]; bfr[0][n] = (bf16x8){l0[0], l0[1], l0[2], l0[3], h0[0], h0[1], h0[2], h0[3]}; } \
      __builtin_amdgcn_s_setprio(1); \
      _Pragma("unroll") for (int m = 0; m < 4; ++m) \
        _Pragma("unroll") for (int n = 0; n < 2; ++n) acc[m][n] = __builtin_amdgcn_mfma_f32_32x32x16_bf16(bfr[0][n], af[0][m], acc[m][n], 0, 0, 0); \
      __builtin_amdgcn_sched_barrier(0); \
      asm volatile("s_waitcnt lgkmcnt(0)" : "+v"(tq[4]), "+v"(tq[5]), "+v"(tq[6]), "+v"(tq[7]), "+v"(af[1][0]), "+v"(af[1][1]), "+v"(af[1][2]), "+v"(af[1][3]) :: "memory"); __builtin_amdgcn_sched_barrier(0); \
      _Pragma("unroll") for (int n = 0; n < 2; ++n) { const s16x4 l0 = tq[4 + 2 * n], h0 = tq[4 + 2 * n + 1]; bfr[1][n] = (bf16x8){l0[0], l0[1], l0[2], l0[3], h0[0], h0[1], h0[2], h0[3]}; } \
      _Pragma("unroll") for (int m = 0; m < 4; ++m) \
        _Pragma("unroll") for (int n = 0; n < 2; ++n) acc[m][n] = __builtin_amdgcn_mfma_f32_32x32x16_bf16(bfr[1][n], af[1][m], acc[m][n], 0, 0, 0); \
      __builtin_amdgcn_s_setprio(0); \
      asm volatile("s_waitcnt lgkmcnt(0)" ::: "memory"); } while (0)
    for (int s = 0; s < NK; s += 4) {
      if (STAGE == 1) side.issue(p);
      MOE_STEP(s, 0); MOE_STEP(s + 1, 1);
      if (STAGE == 1) { if (s + 4 < NK || has_next) side.template finish<8>(ws_, lane); else side.template finish<0>(ws_, lane); side.issue(p); }
      MOE_STEP(s + 2, 2); MOE_STEP(s + 3, 3);
      if (STAGE == 1) { if (s + 6 < NK || has_next) side.template finish<8>(ws_, lane); else side.template finish<0>(ws_, lane); }
    }
#undef MOE_STEP
    {
      const LAS int* rw = (const LAS int*)(lds + L_ROWS + par * 1024);
#pragma unroll
      for (int m = 0; m < 4; ++m) {
        const int row = 128 * wm + 32 * m + r32; const bool valid = row < mcount;
        const int aid = rw[min(row, mcount - 1)];
        if (STAGE == 1) {
          bf16_t* hp = (bf16_t*)(ws_ + WS_H) + (size_t)aid * DE + 128 * sub + 32 * wn + 8 * hi;
#pragma unroll
          for (int g = 0; g < 4; g += 2) {
            unsigned a0 = pk2(silu_f(acc[m][0][4 * g]) * acc[m][1][4 * g], silu_f(acc[m][0][4 * g + 1]) * acc[m][1][4 * g + 1]), a1 = pk2(silu_f(acc[m][0][4 * g + 2]) * acc[m][1][4 * g + 2], silu_f(acc[m][0][4 * g + 3]) * acc[m][1][4 * g + 3]);
            unsigned b0 = pk2(silu_f(acc[m][0][4 * g + 4]) * acc[m][1][4 * g + 4], silu_f(acc[m][0][4 * g + 5]) * acc[m][1][4 * g + 5]), b1 = pk2(silu_f(acc[m][0][4 * g + 6]) * acc[m][1][4 * g + 6], silu_f(acc[m][0][4 * g + 7]) * acc[m][1][4 * g + 7]);
            { auto r = __builtin_amdgcn_permlane32_swap(a0, b0, false, false); a0 = r[0]; b0 = r[1]; }
            { auto r = __builtin_amdgcn_permlane32_swap(a1, b1, false, false); a1 = r[0]; b1 = r[1]; }
            if (valid) *(u32x4*)(hp + 8 * g) = (u32x4){a0, a1, b0, b1};
          }
        } else {
          const float w = ((const float*)(ws_ + WS_WTS))[aid];
          bf16_t* sp = (bf16_t*)(ws_ + WS_SLAB) + (size_t)aid * D + 256 * sub + 64 * wn + 8 * hi;
#pragma unroll
          for (int n = 0; n < 2; ++n)
#pragma unroll
            for (int g = 0; g < 4; g += 2) {
              unsigned a0 = pk2(acc[m][n][4 * g] * w, acc[m][n][4 * g + 1] * w), a1 = pk2(acc[m][n][4 * g + 2] * w, acc[m][n][4 * g + 3] * w);
              unsigned b0 = pk2(acc[m][n][4 * g + 4] * w, acc[m][n][4 * g + 5] * w), b1 = pk2(acc[m][n][4 * g + 6] * w, acc[m][n][4 * g + 7] * w);
              { auto r = __builtin_amdgcn_permlane32_swap(a0, b0, false, false); a0 = r[0]; b0 = r[1]; }
              { auto r = __builtin_amdgcn_permlane32_swap(a1, b1, false, false); a1 = r[0]; b1 = r[1]; }
              if (valid) *(u32x4*)(sp + 32 * n + 8 * g) = (u32x4){a0, a1, b0, b1};
            }
        }
      }
    }
    item = nitem; par ^= 1; e = ne; mt = nmt; mcount = nmc; sub = nsub; asrc[0] = nasrc[0]; asrc[1] = nasrc[1]; bsrc = nbsrc;
  }
#undef MOE_DESC
#undef MOE_ROWS_DMA
#undef MOE_ASRC
#undef MOE_ISSUE_SL
  asm volatile("s_waitcnt vmcnt(0)" ::: "memory");
  if (STAGE == 1) while (!side.done()) { side.issue(p); side.template finish<0>(ws_, lane); }
  __syncthreads();
}
}

__device__ __forceinline__ void phase_final_bf(const P& p, int bid, int nb) {
  unsigned char* const ws_ = fresh_ws(p.ws);
  const float* X1 = (const float*)(ws_ + WS_X1); const bf16_t* SL = (const bf16_t*)(ws_ + WS_SLAB); const float* ada = (const float*)(ws_ + WS_ADA);
  const int tid_ = tidx(), lane = tid_ & 63, wave = tid_ >> 6;
  for (int t = bid * NW + wave; t < T; t += nb * NW) {
    const int b = t / SEQ;
    float4 v[4]; float s = 0.f;
#pragma unroll
    for (int j = 0; j < 4; ++j) {
      const int c0 = lane * 4 + 256 * j;
      float4 y = make_float4(0, 0, 0, 0);
#pragma unroll
      for (int k = 0; k < 8; ++k) { const float4 z = ld_bf4(SL + (size_t)(t * 8 + k) * D + c0); y.x += z.x; y.y += z.y; y.z += z.z; y.w += z.w; }
      const float4 gt = *(const float4*)(ada + b * 6144 + 5120 + c0);
      const float4 bx = *(const float4*)(X1 + (size_t)t * D + c0);
      v[j] = make_float4(bx.x + gt.x * y.x, bx.y + gt.y * y.y, bx.z + gt.z * y.z, bx.w + gt.w * y.w);
      s += v[j].x * v[j].x + v[j].y * v[j].y + v[j].z * v[j].z + v[j].w * v[j].w;
    }
    s = wave_sum(s);
    const float rstd = 1.0f / sqrtf(s * (1.0f / D) + 1e-6f);
#pragma unroll
    for (int j = 0; j < 4; ++j) {
      const int c0 = lane * 4 + 256 * j;
      const float4 gg = *(const float4*)(p.g_final + c0);
      *(float4*)(p.out + (size_t)t * D + c0) = make_float4(v[j].x * rstd * gg.x, v[j].y * rstd * gg.y, v[j].z * rstd * gg.z, v[j].w * rstd * gg.w);
    }
  }
}

#define XB_TMO      128
#define XB_XCNT(j)  (256  + 64 * (j))
#define XB_XSUB(j)  (1280 + 64 * (j))
#define XB_XGEN(j)  (2304 + 64 * (j))
#define XB_TOP      3328
#define XB_TOPGEN   3392
#define XCD_BAR_WORDS 3456
#define XB_SPIN_CAP (1u << 22)
__device__ __forceinline__ unsigned xb_ld(unsigned* p)              { return __hip_atomic_load(p, __ATOMIC_RELAXED, __HIP_MEMORY_SCOPE_AGENT); }
__device__ __forceinline__ unsigned xb_add(unsigned* p, unsigned v) { return __hip_atomic_fetch_add(p, v, __ATOMIC_RELAXED, __HIP_MEMORY_SCOPE_AGENT); }
__device__ __forceinline__ unsigned xb_xcc_id() { return (unsigned)__builtin_amdgcn_s_getreg((3 << 11) | 20) & 0xFu; }
#define XB_SPIN(cond, bar) do { unsigned _sp = 0; while (cond) { __builtin_amdgcn_s_sleep(1); \
    if ((++_sp & 255u) == 0u) { if (xb_ld(&(bar)[XB_TMO])) break; if (_sp > XB_SPIN_CAP) { atomicAdd(&(bar)[XB_TMO], 1u); break; } } } } while (0)
struct XcdBarrier { unsigned* bar; unsigned x; volatile LAS unsigned* st; };
__device__ __forceinline__ XcdBarrier xcd_barrier_post(unsigned* bar, volatile LAS unsigned* st) {
    XcdBarrier b; b.bar = bar; b.x = xb_xcc_id(); b.st = st;
    if (threadIdx.x == 0) (void)xb_add(&bar[XB_XCNT(b.x)], 1u);
    return b;
}
__device__ __forceinline__ void xcd_barrier_complete(unsigned* bar, unsigned x, unsigned& nloc, unsigned& nx) {
    const unsigned G = gridDim.x * gridDim.y * gridDim.z;
    unsigned sum, cnt, mine, sp = 0u;
    for (;;) {
        sum = 0u; cnt = 0u; mine = 0u;
#pragma unroll
        for (unsigned j = 0; j < 16; ++j) { const unsigned c = xb_ld(&bar[XB_XCNT(j)]); sum += c; cnt += (c > 0u) ? 1u : 0u; mine = (j == x) ? c : mine; }
        if (sum == G) break;
        __builtin_amdgcn_s_sleep(1);
        if ((++sp & 255u) == 0u) { if (xb_ld(&bar[XB_TMO])) break; if (sp > XB_SPIN_CAP) { atomicAdd(&bar[XB_TMO], 1u); break; } }
    }
    nloc = mine > 0u ? mine : 1u; nx = cnt > 0u ? cnt : 1u;
}
__device__ __forceinline__ void xcd_barrier(const XcdBarrier& b) {
    asm volatile("s_waitcnt vmcnt(0)" ::: "memory");
    __syncthreads();
    if (threadIdx.x == 0) {
        unsigned long long bz = 0; unsigned bx = b.x;
        asm volatile("" : "+s"(bz), "+s"(bx));
        unsigned* bar = b.bar + bz;
        __builtin_amdgcn_s_waitcnt(0);
        unsigned nloc = b.st[0], nx = b.st[1];
        if (nloc == 0u) { xcd_barrier_complete(bar, bx, nloc, nx); b.st[0] = nloc; b.st[1] = nx; }
        const unsigned old = xb_add(&bar[XB_XSUB(bx)], 1u);
        const unsigned gen = old / nloc;
        if (old + 1u == (gen + 1u) * nloc) {
            __builtin_amdgcn_fence(__ATOMIC_RELEASE, "agent");
            asm volatile("s_waitcnt vmcnt(0)" ::: "memory");
            const unsigned og = xb_add(&bar[XB_TOP], 1u);
            const unsigned tg = og / nx;
            if (og + 1u == (tg + 1u) * nx) xb_add(&bar[XB_TOPGEN], 1u);
            else XB_SPIN(xb_ld(&bar[XB_TOPGEN]) == tg, bar);
            __builtin_amdgcn_fence(__ATOMIC_ACQUIRE, "agent");
            xb_add(&bar[XB_XGEN(bx)], 1u);
            asm volatile("s_waitcnt vmcnt(0)" ::: "memory");
        } else {
            XB_SPIN(xb_ld(&bar[XB_XGEN(bx)]) == gen, bar);
            __builtin_amdgcn_fence(__ATOMIC_ACQUIRE, "agent");
            asm volatile("s_waitcnt vmcnt(0)" ::: "memory");
        }
    }
    __syncthreads();
}

constexpr int CW_BAR = 32768;
constexpr int LDS_BYTES = 163840;
constexpr int MISC_OFF = 159 * 1024;

__global__ void __launch_bounds__(NT, 2) mega(P p) {
  extern __shared__ __attribute__((aligned(16))) unsigned char smem[];
  float* lds = (float*)smem;
  LAS unsigned char* ldsb = (LAS unsigned char*)smem;
  volatile LAS unsigned* st = (volatile LAS unsigned*)(ldsb + MISC_OFF);
  if (threadIdx.x < 4) st[threadIdx.x] = 0u;
  __syncthreads();
  XcdBarrier bar = xcd_barrier_post((unsigned*)(p.ws + WS_CTL) + CW_BAR, st);
  const int bid = blockIdx.x, nb = gridDim.x;
  volatile LAS unsigned* tl = st + 16; int nstamp = 0;
#define STAMP() do { if (TIME_SEL_A >= 0 && threadIdx.x == 0) tl[nstamp] = (unsigned)__builtin_amdgcn_s_memrealtime(); ++nstamp; } while (0)
  STAMP();
#define FRESH(q) const P& q = p; unsigned char* const q##w = fresh_ws(p.ws)
#define HNB_(q) ((bf16_t*)(q##w + WS_HNB))
#define PROJB_(q) ((bf16_t*)(q##w + WS_PROJB))
#define X1_(q) ((float*)(q##w + WS_X1))
#define ADA_(q) ((const float*)(q##w + WS_ADA))

  for (int rep = 0; rep < REP_CONV; ++rep) { FRESH(q); phase_prologue(q, bid, nb, lds); xcd_barrier(bar); STAMP(); }
#if DIAG_EXACT_ROUTING
  { FRESH(q); diag::modnorm(q, bid, nb, q.x, q.g1, 0, 1024, (float*)(qw + diag::DW_HN));       xcd_barrier(bar); STAMP(); }
  { FRESH(q); diag::inproj(q, bid, nb, lds);                                                     xcd_barrier(bar); STAMP(); }
  { FRESH(q); diag::rope(q, bid, nb);                                                            xcd_barrier(bar); STAMP(); }
  { FRESH(q); diag::attn(q, bid, nb);                                                            xcd_barrier(bar); STAMP(); }
  { FRESH(q); diag::mix(q, bid, nb);                                                             xcd_barrier(bar); STAMP(); }
  { FRESH(q); diag::outproj(q, bid, nb, lds);                                                    xcd_barrier(bar); STAMP(); }
  { FRESH(q); diag::modnorm(q, bid, nb, (const float*)(qw + diag::DW_X1), q.g2, 3072, 4096, (float*)(qw + diag::DW_HN)); xcd_barrier(bar); STAMP(); }
  { FRESH(q); diag::router(q, bid, nb, lds);                                                     xcd_barrier(bar); STAMP(); }
  { FRESH(q); phase_route(q, bid, nb, (const float*)(qw + diag::DW_LOGITS));                   xcd_barrier(bar); STAMP(); }
#endif
  for (int rep = 0; rep < REP_LIGHT; ++rep) { FRESH(q); phase_modnorm(q, bid, nb, q.x, q.g1, 0, 1024, HNB_(q)); xcd_barrier(bar); STAMP(); }
  const bool xpar = ((bid % 8) & 1) != 0;
  { FRESH(q);
    pg8::Gemm g{HNB_(q), (const bf16_t*)(qw + WS_WIN_T), T, DPROJ, D}; pg8::StaticOrder S; S.init(T, DPROJ, nb, bid);
    EpiInproj E{PROJB_(q), (const float*)(qw + WS_COS), (const float*)(qw + WS_SIN)};
    pg8::gemm_phase<EpiInproj, pg8::StaticOrder, true, true>(ldsb, g, S, E);
    xcd_barrier(bar); STAMP(); }
  {
    FRESH(q);
    const attn_body::AttnTensors AT{(const attn_body::bf16*)(PROJB_(q) + COL_Q), (const attn_body::bf16*)(PROJB_(q) + COL_K), (const attn_body::bf16*)(PROJB_(q) + COL_V), (attn_body::bf16*)(qw + WS_AO)};
    const int vcu = (nb % 8 == 0) ? (bid % 8) * (nb / 8) + bid / 8 : bid;
#if ATTN_IMPL == 0
    {
      ConvSide<2> side; side.init(bid, nb, 0u, 1u << 24, tidx());
#pragma unroll 1
      for (int i = 0; i < 2; ++i)
        for (int v = vcu; v < 256; v += nb) phase_attn_unit(q, v, i, ldsb, side);
      while (!side.done()) { side.issue(q); side.finish(qw); }
    }
#else
#pragma unroll 1
    for (int i = 0; i < 4; ++i) {
      if (xpar) convert_slice(q, bid, nb, 2 + i);
      for (int v = vcu; v < 256; v += nb) attn_body::attn_phase_unit<8>((char*)smem, AT, v, i);
      if (!xpar) convert_slice(q, bid, nb, 2 + i);
    }
#endif
    xcd_barrier(bar); STAMP(); }
  for (int rep = 0; rep < REP_LIGHT; ++rep) { FRESH(q); phase_mix(q, bid, nb);                    xcd_barrier(bar); STAMP(); }
  for (int rep = 0; rep < REP_GEMM; ++rep)
  { FRESH(q); pg8::Gemm g{HNB_(q), (const bf16_t*)(qw + WS_WOUT_T), T, D, D}; pg8::StaticOrder S; S.init(T, D, nb, bid);
    EpiResid E{q.x, X1_(q), ADA_(q) + 2048};
    pg8::gemm_phase<EpiResid, pg8::StaticOrder, true, true>(ldsb, g, S, E);            xcd_barrier(bar); STAMP(); }
  for (int rep = 0; rep < REP_LIGHT; ++rep) { FRESH(q); phase_modnorm(q, bid, nb, X1_(q), q.g2, 3072, 4096, HNB_(q)); xcd_barrier(bar); STAMP(); }
  for (int rep = 0; rep < REP_GEMM; ++rep)
  { FRESH(q); pg8::Gemm g{HNB_(q), (const bf16_t*)(qw + WS_WRS_T), T, 768, D}; pg8::StaticOrder S; S.init(T, 768, nb, bid);
    EpiRS E{(float*)(qw + WS_LOGITS), (bf16_t*)(qw + WS_ACTS)};
    pg8::gemm_phase<EpiRS, pg8::StaticOrder, true, true>(ldsb, g, S, E);               xcd_barrier(bar); STAMP(); }
#if !DIAG_EXACT_ROUTING
  { FRESH(q); phase_route(q, bid, nb, (const float*)(qw + WS_LOGITS)); }
#endif
  { FRESH(q); pg8::Gemm g{(const bf16_t*)(qw + WS_ACTS), (const bf16_t*)(qw + WS_WDS_T), T, D, DSH}; pg8::StaticOrder S; S.init(T, D, nb, bid);
    EpiResid E{X1_(q), X1_(q), ADA_(q) + 5120};
    pg8::gemm_phase<EpiResid, pg8::StaticOrder, true, true>(ldsb, g, S, E);           xcd_barrier(bar); STAMP(); }
  for (int rep = 0; rep < REP_MOE1; ++rep) { FRESH(q); moe::run<1>(q, bid, nb, ldsb);             xcd_barrier(bar); STAMP(); }
  for (int rep = 0; rep < REP_MOE2; ++rep) { FRESH(q); moe::run<2>(q, bid, nb, ldsb);             xcd_barrier(bar); STAMP(); }
  for (int rep = 0; rep < REP_LIGHT; ++rep) { FRESH(q); phase_final_bf(q, bid, nb); }
  STAMP();
#if TIME_SEL_A >= 0
  if (bid == 0) {
    asm volatile("s_waitcnt vmcnt(0)" ::: "memory"); __syncthreads();
    const float usA = floorf((float)(tl[TIME_SEL_A + 1] - tl[TIME_SEL_A]) * 0.01f * (1.f / 16.f) + 0.5f) * 16.f;
    const float delta = sqrtf(usA * 1e-5f * 16.8e6f / 1024.f);
    if (threadIdx.x < 256) { float4* o = (float4*)p.out + threadIdx.x; float4 v = *o; v.x += delta; v.y += delta; v.z += delta; v.w += delta; *o = v; }
#if TIME_SEL_B >= 0
    if (threadIdx.x == 0) { const float usB = floorf((float)(tl[TIME_SEL_B + 1] - tl[TIME_SEL_B]) * 0.01f * (1.f / 16.f) + 0.5f) * 16.f; p.out[1024] = 10.f + usB * 0.1f; }
#endif
  }
#endif
}
}

extern "C" void kernel_launch(void* const* d_in, const int* in_sizes, int n_in, void* d_out, int out_size, void* d_ws, size_t ws_size, hipStream_t stream) {
  if (n_in != 25 || ws_size < WS_END) { fprintf(stderr, "kernel_launch: unexpected n_in %d or ws_size %zu\n", n_in, ws_size); return; }
  P p; memset(&p, 0, sizeof(p));
  p.x = (const float*)d_in[0]; p.c = (const float*)d_in[1]; p.pos = (const int*)d_in[2]; p.w_ada = (const float*)d_in[3]; p.b_ada = (const float*)d_in[4];
  p.g1 = (const float*)d_in[5]; p.w_in = (const float*)d_in[6]; p.conv_w = (const float*)d_in[7]; p.g_conv = (const float*)d_in[8];
  p.lq1 = (const float*)d_in[9]; p.lk1 = (const float*)d_in[10]; p.lq2 = (const float*)d_in[11]; p.lk2 = (const float*)d_in[12];
  p.g_subln = (const float*)d_in[13]; p.w_out = (const float*)d_in[14]; p.g2 = (const float*)d_in[15]; p.w_router = (const float*)d_in[16]; p.rbias = (const float*)d_in[17];
  p.wg_e = (const float*)d_in[18]; p.wu_e = (const float*)d_in[19]; p.wd_e = (const float*)d_in[20];
  p.wg_s = (const float*)d_in[21]; p.wu_s = (const float*)d_in[22]; p.wd_s = (const float*)d_in[23]; p.g_final = (const float*)d_in[24];
  p.out = (float*)d_out; p.ws = (unsigned char*)d_ws;
  for (int i = 0; i < 8; ++i) p.inv_freq[i] = (float)pow(500000.0, -(double)i / 8.0);
  (void)hipMemsetAsync((char*)d_ws + WS_CTL, 0, CTL_BYTES, stream);
  static int grid = 0;
  if (grid == 0) {
    int dev = 0, cus = 0, per_cu = 0;
    (void)hipGetDevice(&dev); (void)hipDeviceGetAttribute(&cus, hipDeviceAttributeMultiprocessorCount, dev);
    (void)hipFuncSetAttribute((const void*)mega, hipFuncAttributeMaxDynamicSharedMemorySize, LDS_BYTES);
    (void)hipOccupancyMaxActiveBlocksPerMultiprocessor(&per_cu, (const void*)mega, NT, LDS_BYTES);
    if (per_cu < 1) { fprintf(stderr, "kernel_launch: occupancy query says %d blocks/CU\n", per_cu); grid = -1; }
    else grid = cus;
  }
  if (grid < 0) return;
  void* args[] = {&p};
  hipError_t e = hipLaunchCooperativeKernel((const void*)mega, dim3(grid), dim3(NT), args, LDS_BYTES, stream);
  if (e != hipSuccess) fprintf(stderr, "cooperative launch failed: %s (grid %d)\n", hipGetErrorString(e), grid);
}
```

```cpp
#include <hip/hip_runtime.h>
#include <hip/hip_bf16.h>
#include <cmath>
#include <stdint.h>
#include <math.h>
#include <stdio.h>
#include <string.h>

#define DIAG_EXACT_ROUTING 0

__device__ __forceinline__ int tidx() { int t = threadIdx.x; asm volatile("" : "+v"(t)); return t; }

#define REP_LIGHT 1
#define REP_CONV 1
#define REP_GEMM 1
#define REP_ATTN 1
#define REP_MOE1 1
#define REP_MOE2 1

__device__ __forceinline__ unsigned char* fresh_ws(unsigned char* w) { unsigned long long z = 0; asm volatile("" : "+s"(z)); return w + z; }

#define TIME_SEL_A -1
#define TIME_SEL_B -1

#define ATTN_IMPL 0

namespace pg8 {
#define PG8_LAS __attribute__((address_space(3)))
typedef unsigned short bf16_t;
typedef short bf16x8 __attribute__((ext_vector_type(8)));
typedef float f32x4 __attribute__((ext_vector_type(4)));
typedef unsigned u32x4 __attribute__((ext_vector_type(4)));
constexpr int BM = 256, BK = 64, HALF = 128, HTB = HALF * BK * 2  , STAGE_BYTES = 8 * HTB, NXCD = 8, WGM = 8;

__host__ __device__ __forceinline__ int lds_byte(int r, int c) { const int st = (r >> 4) * 2 + (c >> 5), rr = r & 15, cc = c & 31, ob = rr * 64 + cc * 2; return st * 1024 + (ob ^ (((ob >> 9) & 1) << 5)); }
__host__ __device__ __forceinline__ void stage_rc(int b, int& R, int& C) { const int st = b / 1024, sb = b % 1024, swz = sb ^ (((sb >> 9) & 1) << 5); R = (st >> 1) * 16 + swz / 64; C = (st & 1) * 32 + (swz % 64) / 2; }
__host__ __device__ __forceinline__ int perm32(int rho) { const int n = rho >> 4, i = rho & 15; return 8 * (i >> 2) + 4 * n + (i & 3); }

struct Unit { int pm, pn; };
struct Gemm { const bf16_t* A; const bf16_t* Bt; int M, N, K; };

struct StaticOrder {
    int nM, nN, nwg, G, c;
    __host__ __device__ void init(int M, int N, int G_, int c_) { nM = M / BM; nN = N / BM; nwg = nM * nN; G = G_; c = c_; }
    __host__ __device__ bool next(int i, Unit& u) const {
        const long L = (long)i * G + c; if (L >= nwg) return false;
        int wgid = (int)L; { const int q = nwg / NXCD, r = nwg % NXCD, xcd = wgid % NXCD, off = wgid / NXCD; wgid = (xcd < r ? xcd * (q + 1) : r * (q + 1) + (xcd - r) * q) + off; }
        const int nig = WGM * nN, gid = wgid / nig, fm = gid * WGM, gsz = (nM - fm) < WGM ? (nM - fm) : WGM;
        u.pm = fm + ((wgid % nig) % gsz); u.pn = (wgid % nig) / gsz; return true;
    }
    __device__ __forceinline__ void a_ready(const Unit&) const {}
    __device__ __forceinline__ void done(const Unit&) const {}
};
__device__ __forceinline__ unsigned cvt_pk_bf16(float lo, float hi) { unsigned r; asm volatile("v_cvt_pk_bf16_f32 %0, %1, %2" : "=v"(r) : "v"(lo), "v"(hi)); return r; }
template <class Epi, class Sched, bool ALIGN_EPI = false, bool SP2 = false>
__device__ __forceinline__ void gemm_phase(PG8_LAS unsigned char* lds, const Gemm g, const Sched& S, const Epi& E) {
    const int tid = tidx(), wid = __builtin_amdgcn_readfirstlane(tid >> 6), lane = tid & 63, wr = wid >> 2, wc = wid & 3, fr = lane & 15, fq = lane >> 4;
    const int K = g.K, nt = K / BK;
    unsigned voffA[2], voffB[2];
#pragma unroll
    for (int i = 0; i < 2; ++i) { int R, C; stage_rc(tid * 16 + i * 8192, R, C); const int Rb = Epi::PERM ? ((R & ~31) + perm32(R & 31)) : R;
        voffA[i] = (unsigned)(R * K + C) * 2u; voffB[i] = (unsigned)(Rb * K + C) * 2u; }
    const size_t kstep = (size_t)(BK * 2);
    const size_t hstep = (size_t)HALF * K * 2;
    const size_t tstep = 2 * hstep;
    const unsigned ldsw = (unsigned)wid * 1024u;
    const int aoff = lds_byte(wr * 64 + fr, fq * 8), boff = lds_byte(wc * 32 + fr, fq * 8);
#define PG8_SA(b, h) (((b) * 2 + (h)) * HTB)
#define PG8_SB(b, h) ((4 + (b) * 2 + (h)) * HTB)
#define PG8_STAGE(bufoff, gbase, voff) do { _Pragma("unroll") for (int _i = 0; _i < 2; ++_i) \
        __builtin_amdgcn_global_load_lds((const unsigned*)((const char*)(gbase) + (voff)[_i]), (PG8_LAS unsigned*)(lds + (bufoff) + ldsw + _i * 8192), 16, 0, 0); } while (0)
#define PG8_LDA(dst, b, h) do { _Pragma("unroll") for (int m = 0; m < 4; ++m) _Pragma("unroll") for (int k = 0; k < 2; ++k) dst[m][k] = *(const PG8_LAS bf16x8*)(lds + PG8_SA(b, h) + aoff + m * 2048 + k * 1024); } while (0)
#define PG8_LDB(dst, b, h) do { _Pragma("unroll") for (int n = 0; n < 2; ++n) _Pragma("unroll") for (int k = 0; k < 2; ++k) dst[n][k] = *(const PG8_LAS bf16x8*)(lds + PG8_SB(b, h) + boff + n * 2048 + k * 1024); } while (0)
#define PG8_MMA(ai, bj, At, Bt) do { __builtin_amdgcn_s_setprio(1); _Pragma("unroll") for (int m = 0; m < 4; ++m) _Pragma("unroll") for (int n = 0; n < 2; ++n) _Pragma("unroll") for (int k = 0; k < 2; ++k) \
        acc[ai][bj][m][n] = __builtin_amdgcn_mfma_f32_16x16x32_bf16(Bt[n][k], At[m][k], acc[ai][bj][m][n], 0, 0, 0); __builtin_amdgcn_s_setprio(0); } while (0)
#define PG8_WAIT_V(n) asm volatile("s_waitcnt vmcnt(" #n ")" ::: "memory")
#define PG8_WAIT_L(n) asm volatile("s_waitcnt lgkmcnt(" #n ")" ::: "memory")
#define PG8_BAR __builtin_amdgcn_s_barrier()
#define PG8_SCHED __builtin_amdgcn_sched_barrier(0)
    Unit cur, nxt; int ui = 0;
    if (!S.next(0, cur)) return;
    f32x4 acc[2][2][4][2];
#pragma unroll
    for (int a = 0; a < 2; ++a)
#pragma unroll
        for (int b = 0; b < 2; ++b)
#pragma unroll
            for (int m = 0; m < 4; ++m)
#pragma unroll
                for (int n = 0; n < 2; ++n) acc[a][b][m][n] = (f32x4){0.f, 0.f, 0.f, 0.f};
    bf16x8 At[4][2], B0[2][2], B1[2][2];
    const char* cA = (const char*)g.A + (size_t)cur.pm * tstep; const char* cB = (const char*)g.Bt + (size_t)cur.pn * tstep;
    S.a_ready(cur);
    if constexpr (SP2) {
        PG8_STAGE(PG8_SB(0, 0), cB, voffB); PG8_STAGE(PG8_SB(0, 1), cB + hstep, voffB); PG8_STAGE(PG8_SA(0, 0), cA, voffA); PG8_STAGE(PG8_SA(0, 1), cA + hstep, voffA);
        if (wr == 1) PG8_BAR;
        PG8_WAIT_V(2); PG8_BAR;
        PG8_STAGE(PG8_SB(1, 0), cB + kstep, voffB); PG8_STAGE(PG8_SA(1, 0), cA + kstep, voffA); PG8_STAGE(PG8_SB(1, 1), cB + hstep + kstep, voffB);
        PG8_WAIT_V(6); PG8_BAR;
    } else {
        PG8_STAGE(PG8_SB(0, 0), cB, voffB); PG8_STAGE(PG8_SA(0, 0), cA, voffA); PG8_STAGE(PG8_SB(0, 1), cB + hstep, voffB); PG8_STAGE(PG8_SA(0, 1), cA + hstep, voffA);
        if (wr == 1) PG8_BAR;
        PG8_WAIT_V(4); PG8_BAR;
        PG8_STAGE(PG8_SB(1, 0), cB + kstep, voffB); PG8_STAGE(PG8_SA(1, 0), cA + kstep, voffA); PG8_STAGE(PG8_SB(1, 1), cB + hstep + kstep, voffB);
        PG8_WAIT_V(6); PG8_BAR;
    }
    for (;;) {
        const bool has_next = S.next(ui + 1, nxt);
        const char* nA = has_next ? (const char*)g.A + (size_t)nxt.pm * tstep : cA; const char* nB = has_next ? (const char*)g.Bt + (size_t)nxt.pn * tstep : cB;
        for (int t = 0; t < nt; t += 2) {
            const bool last = (t == nt - 2);
            const char* a1 = cA + (size_t)(t + 1) * kstep;
            const char* a2 = last ? nA : cA + (size_t)(t + 2) * kstep; const char* b2 = last ? nB : cB + (size_t)(t + 2) * kstep;
            const char* a3 = a2 + kstep; const char* b3 = b2 + kstep;
            if (last && has_next) S.a_ready(nxt);
            if constexpr (SP2) {
            PG8_LDB(B0, 0, 0); PG8_LDB(B1, 0, 1); PG8_SCHED; PG8_LDA(At, 0, 0); PG8_STAGE(PG8_SA(1, 1), a1 + hstep, voffA);
            PG8_WAIT_V(8); PG8_WAIT_L(0); PG8_BAR; PG8_MMA(0, 0, At, B0); PG8_MMA(0, 1, At, B1); PG8_BAR; PG8_SCHED;
            PG8_LDA(At, 0, 1); PG8_STAGE(PG8_SB(0, 0), b2, voffB); PG8_STAGE(PG8_SB(0, 1), b2 + hstep, voffB); PG8_STAGE(PG8_SA(0, 0), a2, voffA);
            PG8_WAIT_V(8); PG8_WAIT_L(0); PG8_BAR; PG8_MMA(1, 0, At, B0); PG8_MMA(1, 1, At, B1); PG8_BAR; PG8_SCHED;
            PG8_LDB(B0, 1, 0); PG8_LDB(B1, 1, 1); PG8_SCHED; PG8_LDA(At, 1, 0); PG8_STAGE(PG8_SA(0, 1), a2 + hstep, voffA);
            PG8_WAIT_V(8); PG8_WAIT_L(0); PG8_BAR; PG8_MMA(0, 0, At, B0); PG8_MMA(0, 1, At, B1); PG8_BAR; PG8_SCHED;
            PG8_LDA(At, 1, 1); PG8_STAGE(PG8_SB(1, 0), b3, voffB); PG8_STAGE(PG8_SB(1, 1), b3 + hstep, voffB); PG8_STAGE(PG8_SA(1, 0), a3, voffA);
            PG8_WAIT_V(8); PG8_WAIT_L(0); PG8_BAR; PG8_MMA(1, 0, At, B0); PG8_MMA(1, 1, At, B1); PG8_BAR; PG8_SCHED;
            } else {
            PG8_LDB(B0, 0, 0); PG8_SCHED; PG8_LDA(At, 0, 0); PG8_STAGE(PG8_SA(1, 1), a1 + hstep, voffA);
            PG8_WAIT_L(8); PG8_BAR; PG8_WAIT_L(0); PG8_MMA(0, 0, At, B0); PG8_BAR; PG8_SCHED;
            PG8_LDB(B1, 0, 1); PG8_STAGE(PG8_SB(0, 0), b2, voffB);
            PG8_BAR; PG8_WAIT_L(0); PG8_MMA(0, 1, At, B1); PG8_BAR;
            PG8_LDA(At, 0, 1); PG8_STAGE(PG8_SA(0, 0), a2, voffA);
            PG8_BAR; PG8_WAIT_L(0); PG8_MMA(1, 0, At, B0); PG8_BAR; PG8_SCHED;
            PG8_STAGE(PG8_SB(0, 1), b2 + hstep, voffB);
            PG8_WAIT_V(6); PG8_BAR; PG8_MMA(1, 1, At, B1); PG8_BAR;
            PG8_LDB(B0, 1, 0); PG8_SCHED; PG8_LDA(At, 1, 0); PG8_STAGE(PG8_SA(0, 1), a2 + hstep, voffA);
            PG8_WAIT_L(8); PG8_BAR; PG8_WAIT_L(0); PG8_MMA(0, 0, At, B0); PG8_BAR; PG8_SCHED;
            PG8_LDB(B1, 1, 1); PG8_STAGE(PG8_SB(1, 0), b3, voffB);
            PG8_BAR; PG8_WAIT_L(0); PG8_MMA(0, 1, At, B1); PG8_BAR;
            PG8_LDA(At, 1, 1); PG8_STAGE(PG8_SA(1, 0), a3, voffA);
            PG8_BAR; PG8_WAIT_L(0); PG8_MMA(1, 0, At, B0); PG8_BAR; PG8_SCHED;
            PG8_STAGE(PG8_SB(1, 1), b3 + hstep, voffB);
            PG8_WAIT_V(6); PG8_BAR; PG8_MMA(1, 1, At, B1); PG8_BAR;
            }
        }
        if constexpr (ALIGN_EPI) { if (wr == 0) PG8_BAR; }
        if constexpr (!Epi::AFTER_DRAIN) { E(acc, cur, wr, wc, fr, fq); S.done(cur); }
        if (!has_next) break;
#pragma unroll
        for (int a = 0; a < 2; ++a)
#pragma unroll
            for (int b = 0; b < 2; ++b)
#pragma unroll
                for (int m = 0; m < 4; ++m)
#pragma unroll
                    for (int n = 0; n < 2; ++n) acc[a][b][m][n] = (f32x4){0.f, 0.f, 0.f, 0.f};
        cur = nxt; cA = nA; cB = nB; ++ui;
        if constexpr (ALIGN_EPI) { if (wr == 1) PG8_BAR; }
    }
    PG8_WAIT_V(0);
    if constexpr (!ALIGN_EPI) { if (wr == 0) PG8_BAR; }
    PG8_BAR;
    if constexpr (Epi::AFTER_DRAIN) { E.fused(acc, cur, wr, wc, fr, fq, lds, wid, lane); S.done(cur); }
#undef PG8_SA
#undef PG8_SB
#undef PG8_STAGE
#undef PG8_LDA
#undef PG8_LDB
#undef PG8_MMA
#undef PG8_WAIT_V
#undef PG8_WAIT_L
#undef PG8_BAR
#undef PG8_SCHED
}
}

namespace {
using pg8::bf16_t; using pg8::f32x4; using pg8::u32x4; using pg8::Unit;
constexpr int D = 1024, BATCH = 4, SEQ = 4096, T = BATCH * SEQ;
constexpr int DPROJ = 3072;
constexpr int COL_H = 0, COL_B = 512, COL_C = 1024, COL_Q = 1536, COL_K = 2048, COL_V = 2560;
constexpr int NE = 256, TOPK = 8, DE = 256, DSH = 256;
constexpr int NT = 512;
constexpr int NW = NT / 64;
constexpr int LISTCAP = T;
constexpr int CNT_STRIDE = 64;
constexpr float C2 = 0.125f * 1.4426950408889634f;

constexpr size_t MiB = 1u << 20;
constexpr size_t WS_CTL = 0, CTL_BYTES = 1 * MiB;
constexpr size_t WS_ADA = 1 * MiB;
constexpr size_t WS_MISC = 1 * MiB + 128 * 1024;
constexpr size_t WS_COS = 2 * MiB, WS_SIN = 2 * MiB + 512 * 1024;
constexpr size_t WS_IDX = 3 * MiB, WS_WTS = 3 * MiB + 512 * 1024;
constexpr size_t WS_LIST = 4 * MiB;
constexpr size_t WS_LOGITS = 20 * MiB;
constexpr size_t WS_ACTS = 36 * MiB;
constexpr size_t WS_WIN_T = 44 * MiB;
constexpr size_t WS_WOUT_T = 50 * MiB;
constexpr size_t WS_WRS_T = 52 * MiB;
constexpr size_t WS_WDS_T = 54 * MiB;
constexpr size_t WS_X1 = 64 * MiB;
constexpr size_t WS_HNB = 128 * MiB;
constexpr size_t WS_PROJB = 160 * MiB;
constexpr size_t WS_AO = 256 * MiB;
constexpr size_t WS_SLAB = 128 * MiB;
constexpr size_t WS_H = 384 * MiB;
constexpr size_t WS_WE1 = 448 * MiB;
constexpr size_t WS_WE2 = 704 * MiB;
constexpr size_t WS_END = 832 * MiB;

struct P {
  const float* x; const float* c; const int* pos; const float* w_ada; const float* b_ada; const float* g1;
  const float* w_in; const float* conv_w; const float* g_conv; const float* lq1; const float* lk1; const float* lq2; const float* lk2;
  const float* g_subln; const float* w_out; const float* g2; const float* w_router; const float* rbias;
  const float* wg_e; const float* wu_e; const float* wd_e; const float* wg_s; const float* wu_s; const float* wd_s; const float* g_final;
  float* out; unsigned char* ws;
  float inv_freq[8];
};

#define LAS __attribute__((address_space(3)))
__device__ __forceinline__ float wave_sum(float v) {
#pragma unroll
  for (int o = 1; o < 64; o <<= 1) v += __shfl_xor(v, o);
  return v;
}
__device__ __forceinline__ float silu_f(float v) { return v / (1.f + expf(-v)); }
__device__ __forceinline__ unsigned f2bf(float f) { unsigned u = __float_as_uint(f); return (u + 0x7fffu + ((u >> 16) & 1u)) >> 16; }
__device__ __forceinline__ unsigned pk2(float lo, float hi) { typedef float f32x2_ __attribute__((ext_vector_type(2))); typedef __bf16 bf16x2_ __attribute__((ext_vector_type(2))); f32x2_ v = {lo, hi}; return __builtin_bit_cast(unsigned, __builtin_convertvector(v, bf16x2_)); }
__device__ __forceinline__ float bflo(unsigned w) { return __uint_as_float(w << 16); }
__device__ __forceinline__ float bfhi(unsigned w) { return __uint_as_float(w & 0xffff0000u); }
__device__ __forceinline__ float4 ld_bf4(const bf16_t* p) { const uint2 w = *(const uint2*)p; return make_float4(bflo(w.x), bfhi(w.x), bflo(w.y), bfhi(w.y)); }
__device__ __forceinline__ void st_bf4(bf16_t* p, float a, float b, float c, float d) { *(uint2*)p = make_uint2(pk2(a, b), pk2(c, d)); }

struct EpiInproj {
  static constexpr bool PERM = true, AFTER_DRAIN = false;
  bf16_t* O; const float* cosT; const float* sinT;
  __device__ __forceinline__ void operator()(const f32x4 (&acc)[2][2][4][2], const Unit& u, int wr, int wc, int fr, int fq) const {
    const int row0 = u.pm * 256 + wr * 64 + fr, col0 = u.pn * 256 + wc * 32 + 8 * fq;
    const bool qk = (u.pn >= 6 && u.pn < 10), rot = qk && ((wc & 1) == 0) && (fq < 2);
    const float sc = (u.pn == 6 || u.pn == 7) ? C2 : 1.f;
#pragma unroll
    for (int ai = 0; ai < 2; ++ai)
#pragma unroll
      for (int m = 0; m < 4; ++m) {
        const int row = row0 + ai * 128 + m * 16;
        f32x4 cs = {1.f, 1.f, 1.f, 1.f}, sn = {0.f, 0.f, 0.f, 0.f};
        if (rot) { cs = *(const f32x4*)(cosT + (size_t)row * 8 + 4 * fq); sn = *(const f32x4*)(sinT + (size_t)row * 8 + 4 * fq); }
        bf16_t* rowp = O + (size_t)row * DPROJ + col0;
#pragma unroll
        for (int bj = 0; bj < 2; ++bj) {
          const f32x4 a = acc[ai][bj][m][0], b = acc[ai][bj][m][1];
          const f32x4 v0 = (a * cs - b * sn) * sc, v1 = (b * cs + a * sn) * sc;
          u32x4 w; w.x = pk2(v0[0], v0[1]); w.y = pk2(v0[2], v0[3]); w.z = pk2(v1[0], v1[1]); w.w = pk2(v1[2], v1[3]);
          *(u32x4*)(rowp + bj * 128) = w;
        }
      }
  }
};
struct EpiResid {
  static constexpr bool PERM = false, AFTER_DRAIN = false;
  const float* base; float* out; const float* gate;
  __device__ __forceinline__ void operator()(const f32x4 (&acc)[2][2][4][2], const Unit& u, int wr, int wc, int fr, int fq) const {
    const int row0 = u.pm * 256 + wr * 64 + fr, col0 = u.pn * 256 + wc * 32 + 4 * fq;
    const float* gp = gate + (size_t)(u.pm / 16) * 6144;
#pragma unroll
    for (int bj = 0; bj < 2; ++bj)
#pragma unroll
      for (int n = 0; n < 2; ++n) {
        const int c = col0 + bj * 128 + n * 16;
        const f32x4 gv = *(const f32x4*)(gp + c);
#pragma unroll
        for (int ai = 0; ai < 2; ++ai)
#pragma unroll
          for (int m = 0; m < 4; ++m) {
            const size_t o = (size_t)(row0 + ai * 128 + m * 16) * D + c;
            const f32x4 bs = *(const f32x4*)(base + o);
            *(f32x4*)(out + o) = bs + gv * acc[ai][bj][m][n];
          }
      }
  }
};
struct EpiRS {
  static constexpr bool PERM = true, AFTER_DRAIN = false;
  float* LG; bf16_t* AC;
  __device__ __forceinline__ void operator()(const f32x4 (&acc)[2][2][4][2], const Unit& u, int wr, int wc, int fr, int fq) const {
    const int row0 = u.pm * 256 + wr * 64 + fr, cl = wc * 32 + 8 * fq;
#pragma unroll
    for (int ai = 0; ai < 2; ++ai)
#pragma unroll
      for (int m = 0; m < 4; ++m) {
        const int row = row0 + ai * 128 + m * 16;
#pragma unroll
        for (int bj = 0; bj < 2; ++bj) {
          const f32x4 a = acc[ai][bj][m][0], b = acc[ai][bj][m][1];
          if (u.pn == 0) { float* lp = LG + (size_t)row * 256 + cl + bj * 128; *(f32x4*)lp = a; *(f32x4*)(lp + 4) = b; }
          else {
            const int ci = 256 * (u.pn - 1) + cl + bj * 128;
            st_bf4(AC + (size_t)row * DSH + (ci >> 1), silu_f(a[0]) * b[0], silu_f(a[1]) * b[1], silu_f(a[2]) * b[2], silu_f(a[3]) * b[3]);
          }
        }
      }
  }
};

template <class RM>
__device__ __forceinline__ void transpose_item(const float* W, int K, int N, bf16_t* WT, LAS float* scr, int item, int lane, const RM& rowmap) {
  const int nblk = N / 32, kb = item / nblk, nbk = item % nblk, k0 = 64 * kb, n0 = 32 * nbk;
#pragma unroll 8
  for (int i = 0; i < 32; ++i) { const int kk = 2 * i + (lane >> 5); scr[kk * 33 + (lane & 31)] = W[(size_t)(k0 + kk) * N + n0 + (lane & 31)]; }
  asm volatile("s_waitcnt lgkmcnt(0)" ::: "memory");
  const int c = lane & 7;
#pragma unroll
  for (int j = 0; j < 4; ++j) {
    const int n = (lane >> 3) + 8 * j; const LAS float* s = scr + (8 * c) * 33 + n;
    u32x4 o; o.x = pk2(s[0 * 33], s[1 * 33]); o.y = pk2(s[2 * 33], s[3 * 33]); o.z = pk2(s[4 * 33], s[5 * 33]); o.w = pk2(s[6 * 33], s[7 * 33]);
    *(u32x4*)(WT + (size_t)rowmap(n0 + n) * K + k0 + 8 * c) = o;
  }
  asm volatile("s_waitcnt lgkmcnt(0)" ::: "memory");
}
__device__ __forceinline__ int win_rowmap(int n) {
  if (n < COL_Q || n >= COL_V) return n;
  const int pos = n & 63; if (pos >= 16) return n;
  const int g = pos >> 2, g2 = (g == 1) ? 2 : (g == 2) ? 1 : g;
  return (n & ~63) + g2 * 4 + (pos & 3);
}
__device__ __forceinline__ void phase_prologue(const P& p, int bid, int nb, float* lds) {
  unsigned char* const ws_ = fresh_ws(p.ws);
  float* cact = lds;
  float* red = lds + 4096;
  const int tid = tidx();
  float* ada = (float*)(ws_ + WS_ADA);
  for (int i = tid; i < 4096; i += NT) cact[i] = silu_f(p.c[i]);
  __syncthreads();
  for (int cb = bid; cb < 256; cb += nb) {
    const int col = tid % 24, kg = tid / 24;
    if (kg < 21) {
      float a0 = 0.f, a1 = 0.f, a2 = 0.f, a3 = 0.f;
      for (int k0 = kg; k0 < 1024; k0 += 21 * 7) {
        float w[7];
#pragma unroll
        for (int u = 0; u < 7; ++u) { const int k = k0 + 21 * u; w[u] = (k < 1024) ? p.w_ada[(size_t)k * 6144 + cb * 24 + col] : 0.f; }
#pragma unroll
        for (int u = 0; u < 7; ++u) { const int k = (k0 + 21 * u) & 1023; a0 += cact[k] * w[u]; a1 += cact[1024 + k] * w[u]; a2 += cact[2048 + k] * w[u]; a3 += cact[3072 + k] * w[u]; }
      }
      float* r = red + (kg * 24 + col) * 4; r[0] = a0; r[1] = a1; r[2] = a2; r[3] = a3;
    }
    __syncthreads();
    if (tid < 96) {
      const int cc = tid >> 2, b = tid & 3; float s = 0.f;
      for (int g = 0; g < 21; ++g) s += red[(g * 24 + cc) * 4 + b];
      ada[b * 6144 + cb * 24 + cc] = s + p.b_ada[cb * 24 + cc];
    }
    __syncthreads();
  }
  if (bid == 0 && tid == 0) {
    float s1 = 0.f, s2 = 0.f;
    for (int i = 0; i < 64; ++i) { s1 += p.lq1[i] * p.lk1[i]; s2 += p.lq2[i] * p.lk2[i]; }
    ((float*)(ws_ + WS_MISC))[0] = expf(s1) - expf(s2) + 0.2f;
  }
  float* ct = (float*)(ws_ + WS_COS); float* st = (float*)(ws_ + WS_SIN);
  for (int i = bid * NT + tid; i < T * 8; i += nb * NT) {
    const int t = i >> 3, f = i & 7;
    const float ifr = f == 0 ? p.inv_freq[0] : f == 1 ? p.inv_freq[1] : f == 2 ? p.inv_freq[2] : f == 3 ? p.inv_freq[3] : f == 4 ? p.inv_freq[4] : f == 5 ? p.inv_freq[5] : f == 6 ? p.inv_freq[6] : p.inv_freq[7];
    const float ang = (float)p.pos[t] * ifr;
    float s, c; sincosf(ang, &s, &c);
    ct[i] = c; st[i] = s;
  }
  const int lane = tid & 63, wave = tid >> 6;
  LAS float* scr = (LAS float*)lds + 8192 + wave * 2176;
  constexpr int I_IN = 16 * 96, I_OUT = 16 * 32, I_R = 16 * 8, I_G = 16 * 8, I_U = 16 * 8, I_D = 4 * 32;
  constexpr int NITEMS = I_IN + I_OUT + I_R + I_G + I_U + I_D;
  bf16_t* WIN = (bf16_t*)(ws_ + WS_WIN_T); bf16_t* WOUT = (bf16_t*)(ws_ + WS_WOUT_T); bf16_t* WRS = (bf16_t*)(ws_ + WS_WRS_T); bf16_t* WDS = (bf16_t*)(ws_ + WS_WDS_T);
  for (int it = bid * NW + wave; it < NITEMS; it += nb * NW) {
    int r = it;
    if (r < I_IN) { transpose_item(p.w_in, D, DPROJ, WIN, scr, r, lane, [](int n) { return win_rowmap(n); }); continue; } r -= I_IN;
    if (r < I_OUT) { transpose_item(p.w_out, D, D, WOUT, scr, r, lane, [](int n) { return n; }); continue; } r -= I_OUT;
    if (r < I_R) { transpose_item(p.w_router, D, 256, WRS, scr, r, lane, [](int n) { return n; }); continue; } r -= I_R;
    if (r < I_G) { transpose_item(p.wg_s, D, 256, WRS, scr, r, lane, [](int n) { return 256 + 8 * (n >> 2) + (n & 3); }); continue; } r -= I_G;
    if (r < I_U) { transpose_item(p.wu_s, D, 256, WRS, scr, r, lane, [](int n) { return 256 + 8 * (n >> 2) + 4 + (n & 3); }); continue; } r -= I_U;
    transpose_item(p.wd_s, DSH, D, WDS, scr, r, lane, [](int n) { return n; });
  }
}

__device__ __forceinline__ void phase_modnorm(const P& p, int bid, int nb, const float* in, const float* g, int sh_off, int sc_off, bf16_t* outp) {
  unsigned char* const ws_ = fresh_ws(p.ws);
  const int tid_ = tidx(), lane = tid_ & 63, wave = tid_ >> 6;
  const float* ada = (const float*)(ws_ + WS_ADA);
  for (int t = bid * NW + wave; t < T; t += nb * NW) {
    const int b = t / SEQ;
    const float4* xr = (const float4*)(in + (size_t)t * D) + lane;
    float4 v[4]; float s = 0.f;
#pragma unroll
    for (int j = 0; j < 4; ++j) { v[j] = xr[64 * j]; s += v[j].x * v[j].x + v[j].y * v[j].y + v[j].z * v[j].z + v[j].w * v[j].w; }
    s = wave_sum(s);
    const float rstd = 1.0f / sqrtf(s * (1.0f / D) + 1e-6f);
#pragma unroll
    for (int j = 0; j < 4; ++j) {
      const int c0 = lane * 4 + 256 * j;
      const float4 gg = *(const float4*)(g + c0);
      const float4 sc = *(const float4*)(ada + b * 6144 + sc_off + c0);
      const float4 sh = *(const float4*)(ada + b * 6144 + sh_off + c0);
      st_bf4(outp + (size_t)t * D + c0, v[j].x * rstd * gg.x * (1.f + sc.x) + sh.x, v[j].y * rstd * gg.y * (1.f + sc.y) + sh.y,
             v[j].z * rstd * gg.z * (1.f + sc.z) + sh.z, v[j].w * rstd * gg.w * (1.f + sc.w) + sh.w);
    }
  }
}

template <bool DUAL, class AF, class EF>
__device__ __forceinline__ void gemm_tile_naive(const AF& af, int mcount, const float* __restrict__ B0, const float* __restrict__ B1, int ldb, int n0, int K, const EF& ef, float* lds) {
  float* As = lds; float* Bs0 = lds + 16 * 132; float* Bs1 = Bs0 + 16 * 64;
  const int tid = tidx(), ty = tid >> 4, tx = tid & 15;
  float acc0[4][4], acc1[4][4];
#pragma unroll
  for (int i = 0; i < 4; ++i)
#pragma unroll
    for (int j = 0; j < 4; ++j) { acc0[i][j] = 0.f; acc1[i][j] = 0.f; }
  const int ar = tid >> 2, akq = (tid & 3) * 4;
  const bool avalid = ar < mcount;
  const int bt = tid & 255, bk = bt >> 4, bc = (bt & 15) * 4;
  const float* bsrc = (tid < 256) ? B0 : B1;
  float* bdst = (tid < 256) ? Bs0 : Bs1;
  for (int k0 = 0; k0 < K; k0 += 16) {
    float4 av = make_float4(0.f, 0.f, 0.f, 0.f);
    if (avalid) av = af(ar, k0 + akq);
    As[(akq + 0) * 132 + ar] = av.x; As[(akq + 1) * 132 + ar] = av.y; As[(akq + 2) * 132 + ar] = av.z; As[(akq + 3) * 132 + ar] = av.w;
    if (DUAL || tid < 256) {
      const float4 bv = *(const float4*)(bsrc + (size_t)(k0 + bk) * ldb + n0 + bc);
      *(float4*)(bdst + bk * 64 + bc) = bv;
    }
    __syncthreads();
#pragma unroll
    for (int kk = 0; kk < 16; ++kk) {
      const float4 a = *(const float4*)(As + kk * 132 + ty * 4);
      const float4 b = *(const float4*)(Bs0 + kk * 64 + tx * 4);
      const float aa[4] = {a.x, a.y, a.z, a.w}; const float bb[4] = {b.x, b.y, b.z, b.w};
#pragma unroll
      for (int i = 0; i < 4; ++i)
#pragma unroll
        for (int j = 0; j < 4; ++j) acc0[i][j] += aa[i] * bb[j];
      if (DUAL) {
        const float4 b1 = *(const float4*)(Bs1 + kk * 64 + tx * 4);
        const float cc[4] = {b1.x, b1.y, b1.z, b1.w};
#pragma unroll
        for (int i = 0; i < 4; ++i)
#pragma unroll
          for (int j = 0; j < 4; ++j) acc1[i][j] += aa[i] * cc[j];
      }
    }
    __syncthreads();
  }
#pragma unroll
  for (int i = 0; i < 4; ++i)
    if (ty * 4 + i < mcount) {
#pragma unroll
      for (int j = 0; j < 4; ++j) ef(ty * 4 + i, n0 + tx * 4 + j, acc0[i][j], acc1[i][j]);
    }
}

__device__ __forceinline__ void ld_bf8(const bf16_t* p, float (&v)[8]) { const u32x4 w = *(const u32x4*)p; v[0] = bflo(w.x); v[1] = bfhi(w.x); v[2] = bflo(w.y); v[3] = bfhi(w.y); v[4] = bflo(w.z); v[5] = bfhi(w.z); v[6] = bflo(w.w); v[7] = bfhi(w.w); }
__device__ __forceinline__ void ld_f8(const float* p, float (&v)[8]) { const float4 a = *(const float4*)p, b = *(const float4*)(p + 4); v[0] = a.x; v[1] = a.y; v[2] = a.z; v[3] = a.w; v[4] = b.x; v[5] = b.y; v[6] = b.z; v[7] = b.w; }
template <int CTRL> __device__ __forceinline__ float dppf_(float x) { return __int_as_float(__builtin_amdgcn_update_dpp(0, __float_as_int(x), CTRL, 0xF, 0xF, false)); }
__device__ __forceinline__ float row16_sum(float x) { x += dppf_<0xB1>(x); x += dppf_<0x4E>(x); x += dppf_<0x141>(x); x += dppf_<0x140>(x); return x; }
__device__ __forceinline__ void phase_mix(const P& p, int bid, int nb) {
  unsigned char* const ws_ = fresh_ws(p.ws);
  const bf16_t* PR = (const bf16_t*)(ws_ + WS_PROJB); const bf16_t* AO = (const bf16_t*)(ws_ + WS_AO); bf16_t* MIX = (bf16_t*)(ws_ + WS_HNB);
  const float lam = ((const float*)(ws_ + WS_MISC))[0];
  const int tid_ = tidx(), lane = tid_ & 63, wave = tid_ >> 6, ch = lane * 8;
  float w0[8], w1[8], w2[8], gc[8], gsn[8];
  ld_f8(p.conv_w + ch, w0); ld_f8(p.conv_w + 512 + ch, w1); ld_f8(p.conv_w + 1024 + ch, w2); ld_f8(p.g_conv + ch, gc); ld_f8(p.g_subln + (ch & 127), gsn);
  for (int t0 = (bid * NW + wave) * 8; t0 < T; t0 += nb * NW * 8) {
    const int s0 = t0 % SEQ;
    float u1[8], u2[8];
#pragma unroll
    for (int i = 0; i < 8; ++i) { u1[i] = 0.f; u2[i] = 0.f; }
    if (s0 >= 2) {
      float h[8], c[8];
      ld_bf8(PR + (size_t)(t0 - 1) * DPROJ + COL_H + ch, h); ld_bf8(PR + (size_t)(t0 - 1) * DPROJ + COL_C + ch, c);
#pragma unroll
      for (int i = 0; i < 8; ++i) u1[i] = c[i] * h[i];
      ld_bf8(PR + (size_t)(t0 - 2) * DPROJ + COL_H + ch, h); ld_bf8(PR + (size_t)(t0 - 2) * DPROJ + COL_C + ch, c);
#pragma unroll
      for (int i = 0; i < 8; ++i) u2[i] = c[i] * h[i];
    }
#pragma unroll 2
    for (int k = 0; k < 8; ++k) {
      const int t = t0 + k;
      const bf16_t* r0 = PR + (size_t)t * DPROJ;
      float h[8], c[8], bg[8], o0[8], o1[8], vals[8];
      ld_bf8(r0 + COL_H + ch, h); ld_bf8(r0 + COL_C + ch, c); ld_bf8(r0 + COL_B + ch, bg);
      const int hd = lane >> 4, d = (lane & 15) * 8;
      ld_bf8(AO + (size_t)t * 1024 + (2 * hd) * 128 + d, o0); ld_bf8(AO + (size_t)t * 1024 + (2 * hd + 1) * 128 + d, o1);
      float ss = 0.f;
#pragma unroll
      for (int i = 0; i < 8; ++i) { const float u0 = c[i] * h[i]; const float y = w0[i] * u2[i] + w1[i] * u1[i] + w2[i] * u0; vals[i] = bg[i] * y; ss += vals[i] * vals[i]; u2[i] = u1[i]; u1[i] = u0; }
      ss = row16_sum(ss);
      ss = __int_as_float(__builtin_amdgcn_readlane(__float_as_int(ss), 0)) + __int_as_float(__builtin_amdgcn_readlane(__float_as_int(ss), 16)) +
           __int_as_float(__builtin_amdgcn_readlane(__float_as_int(ss), 32)) + __int_as_float(__builtin_amdgcn_readlane(__float_as_int(ss), 48));
      const float rstd = 1.0f / sqrtf(ss * (1.0f / 512.f) + 1e-6f);
      bf16_t* mo = MIX + (size_t)t * D;
      *(u32x4*)(mo + ch) = (u32x4){pk2(vals[0] * rstd * gc[0], vals[1] * rstd * gc[1]), pk2(vals[2] * rstd * gc[2], vals[3] * rstd * gc[3]),
                                   pk2(vals[4] * rstd * gc[4], vals[5] * rstd * gc[5]), pk2(vals[6] * rstd * gc[6], vals[7] * rstd * gc[7])};
      float dv[8], q = 0.f;
#pragma unroll
      for (int i = 0; i < 8; ++i) { dv[i] = o0[i] - lam * o1[i]; q += dv[i] * dv[i]; }
      q = row16_sum(q);
      const float r2 = 1.0f / sqrtf(q * (1.0f / 128.f) + 1e-5f);
      *(u32x4*)(mo + 512 + ch) = (u32x4){pk2(dv[0] * r2 * gsn[0] * 0.8f, dv[1] * r2 * gsn[1] * 0.8f), pk2(dv[2] * r2 * gsn[2] * 0.8f, dv[3] * r2 * gsn[3] * 0.8f),
                                         pk2(dv[4] * r2 * gsn[4] * 0.8f, dv[5] * r2 * gsn[5] * 0.8f), pk2(dv[6] * r2 * gsn[6] * 0.8f, dv[7] * r2 * gsn[7] * 0.8f)};
    }
  }
}

template <int CTRL> __device__ __forceinline__ float dppf(float x) { return __int_as_float(__builtin_amdgcn_update_dpp(0, __float_as_int(x), CTRL, 0xF, 0xF, false)); }
__device__ __forceinline__ void phase_route(const P& p, int bid, int nb, const float* LG) {
  unsigned char* const ws_ = fresh_ws(p.ws);
  int* IDX = (int*)(ws_ + WS_IDX); float* WTS = (float*)(ws_ + WS_WTS); int* LIST = (int*)(ws_ + WS_LIST); int* cnt = (int*)(ws_ + WS_CTL);
  const int tid_ = tidx(), lane = tid_ & 63, wave = tid_ >> 6;
  const float4 bs = *(const float4*)(p.rbias + lane * 4);
  for (int t = bid * NW + wave; t < T; t += nb * NW) {
    const float4 lg = *(const float4*)(LG + (size_t)t * 256 + lane * 4);
    float sc[4], cv[4];
    sc[0] = 1.f / (1.f + expf(-lg.x)); sc[1] = 1.f / (1.f + expf(-lg.y)); sc[2] = 1.f / (1.f + expf(-lg.z)); sc[3] = 1.f / (1.f + expf(-lg.w));
    cv[0] = sc[0] + bs.x; cv[1] = sc[1] + bs.y; cv[2] = sc[2] + bs.z; cv[3] = sc[3] + bs.w;
    float m1 = -INFINITY, m2 = -INFINITY;
#pragma unroll
    for (int i = 0; i < 4; ++i) { const float v = cv[i]; if (v > m1) { m2 = m1; m1 = v; } else if (v > m2) m2 = v; }
#define RT_MERGE(CTRL) do { const float o1 = dppf<CTRL>(m1), o2 = dppf<CTRL>(m2); const float n1 = fmaxf(m1, o1), n2 = fmaxf(fminf(m1, o1), fmaxf(m2, o2)); m1 = n1; m2 = n2; } while (0)
    RT_MERGE(0xB1); RT_MERGE(0x4E); RT_MERGE(0x141);
#undef RT_MERGE
    const float gs = m1 + m2; const int g = lane >> 3; int rank = 0;
#pragma unroll
    for (int gg = 0; gg < 8; ++gg) { const float og = __int_as_float(__builtin_amdgcn_readlane(__float_as_int(gs), gg * 8)); rank += (og > gs || (og == gs && gg < g)) ? 1 : 0; }
    const bool sel = rank < 4;
#pragma unroll
    for (int i = 0; i < 4; ++i) cv[i] = sel ? cv[i] : -INFINITY;
    int my_e = 0; float my_w = 0.f, wsum = 0.f;
#pragma unroll
    for (int k = 0; k < 8; ++k) {
      float bv = cv[0]; int bi = 0;
#pragma unroll
      for (int i = 1; i < 4; ++i) if (cv[i] > bv) { bv = cv[i]; bi = i; }
      float rmx = fmaxf(bv, dppf<0xB1>(bv)); rmx = fmaxf(rmx, dppf<0x4E>(rmx)); rmx = fmaxf(rmx, dppf<0x141>(rmx)); rmx = fmaxf(rmx, dppf<0x140>(rmx));
      const float M = fmaxf(fmaxf(__int_as_float(__builtin_amdgcn_readlane(__float_as_int(rmx), 0)), __int_as_float(__builtin_amdgcn_readlane(__float_as_int(rmx), 16))),
                            fmaxf(__int_as_float(__builtin_amdgcn_readlane(__float_as_int(rmx), 32)), __int_as_float(__builtin_amdgcn_readlane(__float_as_int(rmx), 48))));
      const unsigned long long bal = __ballot(bv == M);
      const int wl = __builtin_ctzll(bal);
      const int sub = __builtin_amdgcn_readlane(bi, wl);
      const float mine = bi == 0 ? sc[0] : bi == 1 ? sc[1] : bi == 2 ? sc[2] : sc[3];
      const float wv = __int_as_float(__builtin_amdgcn_readlane(__float_as_int(mine), wl));
      if (lane == wl) {
#pragma unroll
        for (int i = 0; i < 4; ++i) if (sub == i) cv[i] = -INFINITY;
      }
      wsum += wv;
      if (lane == k) { my_e = wl * 4 + sub; my_w = wv; }
    }
    if (lane < 8) {
      const float w = my_w / (wsum + 1e-20f) * 2.5f;
      IDX[t * 8 + lane] = my_e; WTS[t * 8 + lane] = w;
      const int pos = atomicAdd(&cnt[my_e * CNT_STRIDE], 1);
      LIST[(size_t)my_e * LISTCAP + pos] = t * 8 + lane;
    }
  }
}

__device__ __forceinline__ void phase_final(const P& p, int bid, int nb) {
  unsigned char* const ws_ = fresh_ws(p.ws);
  const float* X1 = (const float*)(ws_ + WS_X1); const float* SL = (const float*)(ws_ + WS_SLAB); const float* ada = (const float*)(ws_ + WS_ADA);
  const int tid_ = tidx(), lane = tid_ & 63, wave = tid_ >> 6;
  for (int t = bid * NW + wave; t < T; t += nb * NW) {
    const int b = t / SEQ;
    float4 v[4]; float s = 0.f;
#pragma unroll
    for (int j = 0; j < 4; ++j) {
      const int c0 = lane * 4 + 256 * j;
      float4 y = make_float4(0, 0, 0, 0);
#pragma unroll
      for (int k = 0; k < 8; ++k) { const float4 z = *(const float4*)(SL + (size_t)(t * 8 + k) * D + c0); y.x += z.x; y.y += z.y; y.z += z.z; y.w += z.w; }
      const float4 gt = *(const float4*)(ada + b * 6144 + 5120 + c0);
      const float4 bx = *(const float4*)(X1 + (size_t)t * D + c0);
      v[j] = make_float4(bx.x + gt.x * y.x, bx.y + gt.y * y.y, bx.z + gt.z * y.z, bx.w + gt.w * y.w);
      s += v[j].x * v[j].x + v[j].y * v[j].y + v[j].z * v[j].z + v[j].w * v[j].w;
    }
    s = wave_sum(s);
    const float rstd = 1.0f / sqrtf(s * (1.0f / D) + 1e-6f);
#pragma unroll
    for (int j = 0; j < 4; ++j) {
      const int c0 = lane * 4 + 256 * j;
      const float4 gg = *(const float4*)(p.g_final + c0);
      *(float4*)(p.out + (size_t)t * D + c0) = make_float4(v[j].x * rstd * gg.x, v[j].y * rstd * gg.y, v[j].z * rstd * gg.z, v[j].w * rstd * gg.w);
    }
  }
}

#if DIAG_EXACT_ROUTING
namespace diag {
constexpr size_t DW_HN = 64 * MiB, DW_PROJ = 128 * MiB, DW_AO = 320 * MiB, DW_X1 = 384 * MiB, DW_LOGITS = WS_LOGITS;
__device__ __forceinline__ void modnorm(const P& p, int bid, int nb, const float* in, const float* g, int sh_off, int sc_off, float* outp) {
  unsigned char* const ws_ = fresh_ws(p.ws);
  const int tid_ = tidx(), lane = tid_ & 63, wave = tid_ >> 6;
  const float* ada = (const float*)(ws_ + WS_ADA);
  for (int t = bid * NW + wave; t < T; t += nb * NW) {
    const int b = t / SEQ;
    const float4* xr = (const float4*)(in + (size_t)t * D) + lane;
    float4 v[4]; float s = 0.f;
#pragma unroll
    for (int j = 0; j < 4; ++j) { v[j] = xr[64 * j]; s += v[j].x * v[j].x + v[j].y * v[j].y + v[j].z * v[j].z + v[j].w * v[j].w; }
    s = wave_sum(s);
    const float rstd = 1.0f / sqrtf(s * (1.0f / D) + 1e-6f);
    float4* o = (float4*)(outp + (size_t)t * D) + lane;
#pragma unroll
    for (int j = 0; j < 4; ++j) {
      const int c0 = lane * 4 + 256 * j;
      const float4 gg = *(const float4*)(g + c0);
      const float4 sc = *(const float4*)(ada + b * 6144 + sc_off + c0);
      const float4 sh = *(const float4*)(ada + b * 6144 + sh_off + c0);
      float4 r;
      r.x = v[j].x * rstd * gg.x * (1.f + sc.x) + sh.x; r.y = v[j].y * rstd * gg.y * (1.f + sc.y) + sh.y;
      r.z = v[j].z * rstd * gg.z * (1.f + sc.z) + sh.z; r.w = v[j].w * rstd * gg.w * (1.f + sc.w) + sh.w;
      o[64 * j] = r;
    }
  }
}
__device__ __forceinline__ void inproj(const P& p, int bid, int nb, float* lds) {
  unsigned char* const ws_ = fresh_ws(p.ws);
  const float* HN = (const float*)(ws_ + DW_HN); float* PR = (float*)(ws_ + DW_PROJ);
  for (int it = bid; it < (T / 128) * (DPROJ / 64); it += nb) {
    const int mt = it / (DPROJ / 64), nt = it % (DPROJ / 64), m0 = mt * 128;
    auto af = [&](int r, int k) { return *(const float4*)(HN + (size_t)(m0 + r) * D + k); };
    auto ef = [&](int r, int col, float v, float) { PR[(size_t)(m0 + r) * DPROJ + col] = v; };
    gemm_tile_naive<false>(af, 128, p.w_in, nullptr, DPROJ, nt * 64, D, ef, lds);
  }
}
__device__ __forceinline__ void rope(const P& p, int bid, int nb) {
  unsigned char* const ws_ = fresh_ws(p.ws);
  float* PR = (float*)(ws_ + DW_PROJ);
  const float* ct = (const float*)(ws_ + WS_COS); const float* st = (const float*)(ws_ + WS_SIN);
  for (int i = bid * NT + tidx(); i < T * 128; i += nb * NT) {
    const int t = i >> 7, r = i & 127, which = r >> 6, hc = (r >> 3) & 7, f = r & 7;
    float* base = PR + (size_t)t * DPROJ + (which ? COL_K : COL_Q) + hc * 64;
    const float t1 = base[f], t2 = base[8 + f], c = ct[t * 8 + f], s = st[t * 8 + f];
    base[f] = t1 * c - t2 * s; base[8 + f] = t2 * c + t1 * s;
  }
}
__device__ __forceinline__ void attn(const P& p, int bid, int nb) {
  unsigned char* const ws_ = fresh_ws(p.ws);
  const float* PR = (const float*)(ws_ + DW_PROJ); float* AO = (float*)(ws_ + DW_AO);
  const int tid_ = tidx(), lane = tid_ & 63, wave = tid_ >> 6;
  for (int it0 = bid * NW + wave; it0 < 4096; it0 += nb * NW) {
    const int it = __builtin_amdgcn_readfirstlane(it0);
    const int qc = 63 - (it >> 6), rest = it & 63, vh = rest & 1, bh = rest >> 1, b = bh >> 3, hc = bh & 7, h = hc >> 1;
    const int qi = qc * 64 + lane;
    const float* qp = PR + (size_t)(b * SEQ + qi) * DPROJ + COL_Q + hc * 64;
    float q[64], o[64];
#pragma unroll
    for (int d = 0; d < 64; d += 4) { const float4 v = *(const float4*)(qp + d); q[d] = v.x * 0.125f; q[d + 1] = v.y * 0.125f; q[d + 2] = v.z * 0.125f; q[d + 3] = v.w * 0.125f; }
#pragma unroll
    for (int d = 0; d < 64; ++d) o[d] = 0.f;
    float m = -INFINITY, l = 0.f;
    const float* kbase = PR + (size_t)(b * SEQ) * DPROJ + COL_K + hc * 64;
    const float* vbase = PR + (size_t)(b * SEQ) * DPROJ + COL_V + h * 128 + vh * 64;
    const int jmax = qc * 64 + 63;
    for (int j = 0; j <= jmax; ++j) {
      const float* kr = kbase + (size_t)j * DPROJ; const float* vr = vbase + (size_t)j * DPROJ;
      float s = 0.f;
#pragma unroll
      for (int d = 0; d < 64; d += 4) { const float4 kv = *(const float4*)(kr + d); s += q[d] * kv.x; s += q[d + 1] * kv.y; s += q[d + 2] * kv.z; s += q[d + 3] * kv.w; }
      if (j <= qi) {
        const float mn = fmaxf(m, s), a = expf(m - mn), pp = expf(s - mn);
        l = l * a + pp;
#pragma unroll
        for (int d = 0; d < 64; d += 4) { const float4 vv = *(const float4*)(vr + d); o[d] = o[d] * a + pp * vv.x; o[d + 1] = o[d + 1] * a + pp * vv.y; o[d + 2] = o[d + 2] * a + pp * vv.z; o[d + 3] = o[d + 3] * a + pp * vv.w; }
        m = mn;
      }
    }
    const float inv = 1.0f / l;
    float* op = AO + (size_t)(b * SEQ + qi) * 1024 + hc * 128 + vh * 64;
#pragma unroll
    for (int d = 0; d < 64; d += 4) *(float4*)(op + d) = make_float4(o[d] * inv, o[d + 1] * inv, o[d + 2] * inv, o[d + 3] * inv);
  }
}
__device__ __forceinline__ void mix(const P& p, int bid, int nb) {
  unsigned char* const ws_ = fresh_ws(p.ws);
  const float* PR = (const float*)(ws_ + DW_PROJ); const float* AO = (const float*)(ws_ + DW_AO); float* MIX = (float*)(ws_ + DW_HN);
  const float lam = ((const float*)(ws_ + WS_MISC))[0];
  const int tid_ = tidx(), lane = tid_ & 63, wave = tid_ >> 6;
  for (int t = bid * NW + wave; t < T; t += nb * NW) {
    const int s = t % SEQ;
    const float* r0 = PR + (size_t)t * DPROJ;
    float vals[8]; float ss = 0.f;
#pragma unroll
    for (int j = 0; j < 2; ++j) {
      const int ch = lane * 4 + 256 * j;
      const float4 h0 = *(const float4*)(r0 + COL_H + ch), c0 = *(const float4*)(r0 + COL_C + ch), bg = *(const float4*)(r0 + COL_B + ch);
      float4 h1 = make_float4(0, 0, 0, 0), c1 = h1, h2 = h1, c2 = h1;
      if (s >= 1) { h1 = *(const float4*)(r0 - DPROJ + COL_H + ch); c1 = *(const float4*)(r0 - DPROJ + COL_C + ch); }
      if (s >= 2) { h2 = *(const float4*)(r0 - 2 * DPROJ + COL_H + ch); c2 = *(const float4*)(r0 - 2 * DPROJ + COL_C + ch); }
      const float4 w0 = *(const float4*)(p.conv_w + ch), w1 = *(const float4*)(p.conv_w + 512 + ch), w2 = *(const float4*)(p.conv_w + 1024 + ch);
      float y;
      y = w0.x * (c2.x * h2.x) + w1.x * (c1.x * h1.x) + w2.x * (c0.x * h0.x); vals[4 * j + 0] = bg.x * y;
      y = w0.y * (c2.y * h2.y) + w1.y * (c1.y * h1.y) + w2.y * (c0.y * h0.y); vals[4 * j + 1] = bg.y * y;
      y = w0.z * (c2.z * h2.z) + w1.z * (c1.z * h1.z) + w2.z * (c0.z * h0.z); vals[4 * j + 2] = bg.z * y;
      y = w0.w * (c2.w * h2.w) + w1.w * (c1.w * h1.w) + w2.w * (c0.w * h0.w); vals[4 * j + 3] = bg.w * y;
#pragma unroll
      for (int i = 0; i < 4; ++i) ss += vals[4 * j + i] * vals[4 * j + i];
    }
    ss = wave_sum(ss);
    const float rstd = 1.0f / sqrtf(ss * (1.0f / 512.f) + 1e-6f);
    float* mo = MIX + (size_t)t * D;
#pragma unroll
    for (int j = 0; j < 2; ++j) {
      const int ch = lane * 4 + 256 * j;
      const float4 gg = *(const float4*)(p.g_conv + ch);
      *(float4*)(mo + ch) = make_float4(vals[4 * j] * rstd * gg.x, vals[4 * j + 1] * rstd * gg.y, vals[4 * j + 2] * rstd * gg.z, vals[4 * j + 3] * rstd * gg.w);
    }
    const float* ao = AO + (size_t)t * 1024;
#pragma unroll
    for (int j = 0; j < 2; ++j) {
      const int idx = lane * 4 + 256 * j, h = idx >> 7, d = idx & 127;
      const float4 o0 = *(const float4*)(ao + (2 * h) * 128 + d), o1 = *(const float4*)(ao + (2 * h + 1) * 128 + d);
      float dv[4] = {o0.x - lam * o1.x, o0.y - lam * o1.y, o0.z - lam * o1.z, o0.w - lam * o1.w};
      float q = dv[0] * dv[0] + dv[1] * dv[1] + dv[2] * dv[2] + dv[3] * dv[3];
#pragma unroll
      for (int o = 1; o < 32; o <<= 1) q += __shfl_xor(q, o);
      const float r2 = 1.0f / sqrtf(q * (1.0f / 128.f) + 1e-5f);
      const float4 gg = *(const float4*)(p.g_subln + d);
      *(float4*)(mo + 512 + idx) = make_float4(dv[0] * r2 * gg.x * 0.8f, dv[1] * r2 * gg.y * 0.8f, dv[2] * r2 * gg.z * 0.8f, dv[3] * r2 * gg.w * 0.8f);
    }
  }
}
__device__ __forceinline__ void outproj(const P& p, int bid, int nb, float* lds) {
  unsigned char* const ws_ = fresh_ws(p.ws);
  const float* MIX = (const float*)(ws_ + DW_HN); float* X1 = (float*)(ws_ + DW_X1); const float* ada = (const float*)(ws_ + WS_ADA);
  for (int it = bid; it < (T / 128) * (D / 64); it += nb) {
    const int mt = it / (D / 64), nt = it % (D / 64), m0 = mt * 128, b = m0 / SEQ;
    auto af = [&](int r, int k) { return *(const float4*)(MIX + (size_t)(m0 + r) * D + k); };
    auto ef = [&](int r, int col, float v, float) { const size_t o = (size_t)(m0 + r) * D + col; X1[o] = p.x[o] + ada[b * 6144 + 2048 + col] * v; };
    gemm_tile_naive<false>(af, 128, p.w_out, nullptr, D, nt * 64, D, ef, lds);
  }
}
__device__ __forceinline__ void router(const P& p, int bid, int nb, float* lds) {
  unsigned char* const ws_ = fresh_ws(p.ws);
  const float* HN = (const float*)(ws_ + DW_HN); float* LG = (float*)(ws_ + DW_LOGITS);
  for (int it = bid; it < (T / 128) * 4; it += nb) {
    const int mt = it >> 2, r4 = it & 3, m0 = mt * 128;
    auto af = [&](int r, int k) { return *(const float4*)(HN + (size_t)(m0 + r) * D + k); };
    auto ef = [&](int r, int col, float v, float) { LG[(size_t)(m0 + r) * 256 + col] = v; };
    gemm_tile_naive<false>(af, 128, p.w_router, nullptr, 256, r4 * 64, D, ef, lds);
  }
}
}
#endif

__device__ __forceinline__ void convert_slice(const P& p, int part, int nparts, int sl) {
  unsigned char* const ws_ = fresh_ws(p.ws);
  const int tid = tidx();
  bf16_t* WE1 = (bf16_t*)(ws_ + WS_WE1); bf16_t* WE2 = (bf16_t*)(ws_ + WS_WE2);
  constexpr int UN = 8;
  const unsigned stride = (unsigned)nparts * NT;
  const unsigned cbeg = (unsigned)(sl & 3) << 22, cend = cbeg + (1u << 22);
  if (sl < 4) {
    for (unsigned ch0 = cbeg + (unsigned)part * NT + tid; ch0 < cend; ch0 += stride * UN) {
      f32x4 a[UN], b[UN];
#pragma unroll
      for (int u = 0; u < UN; ++u) {
        const unsigned ch = ch0 + u * stride;
        if (ch < cend) {
          const int h8 = (int)(ch & 31), k = (int)((ch >> 5) & 1023), mat = (int)((ch >> 15) & 1), e = (int)(ch >> 16);
          const float* src = (mat ? p.wu_e : p.wg_e) + ((size_t)e * D + k) * DE + 8 * h8;
          a[u] = __builtin_nontemporal_load((const f32x4*)src); b[u] = __builtin_nontemporal_load((const f32x4*)(src + 4));
        }
      }
#pragma unroll
      for (int u = 0; u < UN; ++u) {
        const unsigned ch = ch0 + u * stride;
        if (ch < cend) {
          const int h8 = (int)(ch & 31), k = (int)((ch >> 5) & 1023), mat = (int)((ch >> 15) & 1), e = (int)(ch >> 16);
          const int h = 8 * h8, sub = h >> 7, hl = h & 127, c = 64 * (hl >> 5) + 32 * mat + (hl & 31);
          const size_t blk = ((size_t)(e * 2 + sub) * 32 + (k >> 5)) * 8192;
          const int kk = k & 31, off = (c >> 5) * 1024 + (kk >> 3) * 256 + (kk & 7) * 32 + (c & 31);
          *(u32x4*)(WE1 + blk + off) = (u32x4){pk2(a[u][0], a[u][1]), pk2(a[u][2], a[u][3]), pk2(b[u][0], b[u][1]), pk2(b[u][2], b[u][3])};
        }
      }
    }
  } else {
    const unsigned cb2 = (unsigned)(sl - 4) << 22, ce2 = cb2 + (1u << 22);
    for (unsigned ch0 = cb2 + (unsigned)part * NT + tid; ch0 < ce2; ch0 += stride * UN) {
      f32x4 a[UN], b[UN];
#pragma unroll
      for (int u = 0; u < UN; ++u) {
        const unsigned ch = ch0 + u * stride;
        if (ch < ce2) {
          const int c8 = (int)(ch & 127), k = (int)((ch >> 7) & 255), e = (int)(ch >> 15);
          const float* src = p.wd_e + ((size_t)e * DE + k) * D + 8 * c8;
          a[u] = __builtin_nontemporal_load((const f32x4*)src); b[u] = __builtin_nontemporal_load((const f32x4*)(src + 4));
        }
      }
#pragma unroll
      for (int u = 0; u < UN; ++u) {
        const unsigned ch = ch0 + u * stride;
        if (ch < ce2) {
          const int c8 = (int)(ch & 127), k = (int)((ch >> 7) & 255), e = (int)(ch >> 15);
          const int col = 8 * c8, nt = col >> 8, c = col & 255;
          const size_t blk = ((size_t)(e * 4 + nt) * 8 + (k >> 5)) * 8192;
          const int kk = k & 31, off = (c >> 5) * 1024 + (kk >> 3) * 256 + (kk & 7) * 32 + (c & 31);
          *(u32x4*)(WE2 + blk + off) = (u32x4){pk2(a[u][0], a[u][1]), pk2(a[u][2], a[u][3]), pk2(b[u][0], b[u][1]), pk2(b[u][2], b[u][3])};
        }
      }
    }
  }
}


template <int NC> struct ConvSide {
  unsigned cur, end, stride; f32x4 a[NC], b[NC];
  __device__ __forceinline__ void init(int part, int nparts, unsigned c0, unsigned c1, int tid) { stride = (unsigned)nparts * NT; cur = c0 + (unsigned)part * NT + tid; end = c1; }
  __device__ __forceinline__ bool done() const { return cur >= end; }
  __device__ __forceinline__ void issue(const P& p) {
#pragma unroll
    for (int u = 0; u < NC; ++u) {
      const unsigned ch = cur + u * stride;
      if (ch < end) {
        const float* src;
        if (ch < (1u << 24)) { const int h8 = (int)(ch & 31), k = (int)((ch >> 5) & 1023), mat = (int)((ch >> 15) & 1), e = (int)(ch >> 16); src = (mat ? p.wu_e : p.wg_e) + ((size_t)e * D + k) * DE + 8 * h8; }
        else { const unsigned c2 = ch - (1u << 24); const int c8 = (int)(c2 & 127), k = (int)((c2 >> 7) & 255), e = (int)(c2 >> 15); src = p.wd_e + ((size_t)e * DE + k) * D + 8 * c8; }
        a[u] = __builtin_nontemporal_load((const f32x4*)src); b[u] = __builtin_nontemporal_load((const f32x4*)(src + 4));
      }
    }
  }
  __device__ __forceinline__ void finish(unsigned char* ws_) {
    bf16_t* WE1 = (bf16_t*)(ws_ + WS_WE1); bf16_t* WE2 = (bf16_t*)(ws_ + WS_WE2);
#pragma unroll
    for (int u = 0; u < NC; ++u) {
      const unsigned ch = cur + u * stride;
      if (ch < end) {
        const u32x4 o = (u32x4){pk2(a[u][0], a[u][1]), pk2(a[u][2], a[u][3]), pk2(b[u][0], b[u][1]), pk2(b[u][2], b[u][3])};
        if (ch < (1u << 24)) {
          const int h8 = (int)(ch & 31), k = (int)((ch >> 5) & 1023), mat = (int)((ch >> 15) & 1), e = (int)(ch >> 16);
          const int h = 8 * h8, sub = h >> 7, hl = h & 127, c = 64 * (hl >> 5) + 32 * mat + (hl & 31);
          const size_t blk = ((size_t)(e * 2 + sub) * 32 + (k >> 5)) * 8192; const int kk = k & 31, off = (c >> 5) * 1024 + (kk >> 3) * 256 + (kk & 7) * 32 + (c & 31);
          *(u32x4*)(WE1 + blk + off) = o;
        } else {
          const unsigned c2 = ch - (1u << 24); const int c8 = (int)(c2 & 127), k = (int)((c2 >> 7) & 255), e = (int)(c2 >> 15);
          const int col = 8 * c8, nt = col >> 8, c = col & 255;
          const size_t blk = ((size_t)(e * 4 + nt) * 8 + (k >> 5)) * 8192; const int kk = k & 31, off = (c >> 5) * 1024 + (kk >> 3) * 256 + (kk & 7) * 32 + (c & 31);
          *(u32x4*)(WE2 + blk + off) = o;
        }
      }
    }
    cur += NC * stride;
  }
};


struct ConvSideLds {
  unsigned cur, end, stride; LAS unsigned char* buf;
  __device__ __forceinline__ void init(int part, int nparts, unsigned c0, unsigned c1, int tid, LAS unsigned char* b) { stride = (unsigned)nparts * NT; cur = c0 + (unsigned)part * NT + tid; end = c1; buf = b; }
  __device__ __forceinline__ bool done() const { return cur >= end; }
  __device__ __forceinline__ const float* src_of(const P& p, unsigned ch) const {
    const unsigned c2 = ch - (1u << 24); const int c8 = (int)(c2 & 127), k = (int)((c2 >> 7) & 255), e = (int)(c2 >> 15); return p.wd_e + ((size_t)e * DE + k) * D + 8 * c8; }
  __device__ __forceinline__ void issue(const P& p) {
    if (cur < end) { const float* src = src_of(p, cur);
      __builtin_amdgcn_global_load_lds((const unsigned*)src, (LAS unsigned*)buf, 16, 0, 0);
      __builtin_amdgcn_global_load_lds((const unsigned*)(src + 4), (LAS unsigned*)(buf + 1024), 16, 0, 0); }
  }
  template <int VMC> __device__ __forceinline__ void finish(unsigned char* ws_, int lane) {
    if (cur < end) {
      if (VMC == 8) asm volatile("s_waitcnt vmcnt(8)" ::: "memory"); else asm volatile("s_waitcnt vmcnt(0)" ::: "memory");
      const f32x4 a = *(const LAS f32x4*)(buf + lane * 16), b = *(const LAS f32x4*)(buf + 1024 + lane * 16);
      const unsigned c2 = cur - (1u << 24); const int c8 = (int)(c2 & 127), k = (int)((c2 >> 7) & 255), e = (int)(c2 >> 15);
      const int col = 8 * c8, nt = col >> 8, c = col & 255;
      const size_t blk = ((size_t)(e * 4 + nt) * 8 + (k >> 5)) * 8192; const int kk = k & 31, off = (c >> 5) * 1024 + (kk >> 3) * 256 + (kk & 7) * 32 + (c & 31);
      *(u32x4*)((bf16_t*)(ws_ + WS_WE2) + blk + off) = (u32x4){pk2(a[0], a[1]), pk2(a[2], a[3]), pk2(b[0], b[1]), pk2(b[2], b[3])};
      asm volatile("s_waitcnt lgkmcnt(0)" ::: "memory");
    }
    cur += stride;
  }
};

namespace att {
typedef short bf16x8 __attribute__((ext_vector_type(8)));
typedef short s16x4 __attribute__((ext_vector_type(4)));
typedef float f32x16 __attribute__((ext_vector_type(16)));
typedef float f32x2_t __attribute__((ext_vector_type(2)));
typedef __bf16 bf16x2_t __attribute__((ext_vector_type(2)));
constexpr int KSLOT = 8192, VSLOT = 16384;
constexpr int L_K = 0, L_V = 2 * KSLOT, L_WS = L_V + 2 * VSLOT, L_END = L_WS + 8 * 64 * 4;
constexpr float THR = 8.0f;
__device__ __forceinline__ int crow(int r, int hi) { return (r & 3) + 8 * (r >> 2) + 4 * hi; }
__device__ __forceinline__ unsigned cvtpk(float lo, float hi) { f32x2_t v = {lo, hi}; bf16x2_t b = __builtin_convertvector(v, bf16x2_t); return __builtin_bit_cast(unsigned, b); }
__device__ __forceinline__ s16x4 vtr(const LAS unsigned char* p) { typedef short v4i16_t __attribute__((ext_vector_type(4))); return __builtin_bit_cast(s16x4, __builtin_amdgcn_ds_read_tr16_b64_v4i16((LAS v4i16_t*)p)); }
__device__ __forceinline__ bf16x8 pack8(const f32x16& x, int s) {
  u32x4 w; w.x = cvtpk(x[8 * s], x[8 * s + 1]); w.y = cvtpk(x[8 * s + 2], x[8 * s + 3]); w.z = cvtpk(x[8 * s + 4], x[8 * s + 5]); w.w = cvtpk(x[8 * s + 6], x[8 * s + 7]);
  return __builtin_bit_cast(bf16x8, w);
}

template <class SIDE>
__device__ __forceinline__ void attn_unit(const P& p, int b, int hc, int qb, LAS unsigned char* lds, SIDE& side) {
  const int tid = tidx(), lane = tid & 63, r32 = lane & 31, hi = lane >> 5; const int wid = __builtin_amdgcn_readfirstlane(tid >> 6);
  unsigned char* const ws_ = fresh_ws(p.ws);
  const bf16_t* PR = (const bf16_t*)(ws_ + WS_PROJB); bf16_t* AO = (bf16_t*)(ws_ + WS_AO);
  const int h = hc >> 1; const size_t rowbase = (size_t)b * SEQ; const int q0w = qb * 256 + wid * 32;
  bf16x8 qr[4];
  { const bf16_t* Qw = PR + (rowbase + q0w + r32) * DPROJ + COL_Q + hc * 64 + hi * 8;
#pragma unroll
    for (int d0 = 0; d0 < 4; ++d0) qr[d0] = *(const bf16x8*)(Qw + d0 * 16); }
  const bf16_t* ksrc = PR + (rowbase + lane) * DPROJ + COL_K + hc * 64 + wid * 8;
  const bf16_t* vsrc = PR + (rowbase + 16 * (wid & 3) + (lane >> 2)) * DPROJ + COL_V + h * 128 + (wid >> 2) * 32 + (lane & 3) * 8;
  LAS unsigned char* kdst = lds + L_K + wid * 1024 + lane * 16;
  LAS unsigned char* vdst = lds + L_V + wid * 1024 + lane * 16;
  LAS float* wsf = (LAS float*)(lds + L_WS) + wid * 64;
  const int NTL = 4 * qb + 4, tl = 4 * qb + (wid >> 1);
  const size_t tstep = (size_t)64 * DPROJ;
  float mhat = 0.f, l = 0.f; f32x16 o[4], negm;
#pragma unroll
  for (int i = 0; i < 16; ++i) { o[0][i] = 0.f; o[1][i] = 0.f; o[2][i] = 0.f; o[3][i] = 0.f; negm[i] = 0.f; }
  u32x4 kreg = *(const u32x4*)ksrc, v0reg = *(const u32x4*)vsrc, v1reg = *(const u32x4*)(vsrc + 64);
  *(LAS u32x4*)kdst = kreg; *(LAS u32x4*)vdst = v0reg; *(LAS u32x4*)(vdst + 8192) = v1reg;
  __syncthreads();
  const int vlane = ((lane >> 4) & 1) * 32 + (lane & 3) * 8 + (4 * hi + ((lane & 15) >> 2)) * 64;
  for (int t = 0; t < NTL; ++t) {
    const int cur = t & 1;
    side.issue(p);
    if (t + 1 < NTL) { const size_t off = (size_t)(t + 1) * tstep; kreg = *(const u32x4*)(ksrc + off); v0reg = *(const u32x4*)(vsrc + off); v1reg = *(const u32x4*)(vsrc + off + 64); }
    if (t <= tl) {
      const LAS unsigned char* kb = lds + L_K + cur * KSLOT + hi * 1024 + r32 * 16;
      bf16x8 kf[8];
#pragma unroll
      for (int d0 = 0; d0 < 4; ++d0) { kf[2 * d0] = *(const LAS bf16x8*)(kb + d0 * 2048); kf[2 * d0 + 1] = *(const LAS bf16x8*)(kb + d0 * 2048 + 512); }
      f32x16 p0 = negm, p1 = negm;
#pragma unroll
      for (int d0 = 0; d0 < 4; ++d0) {
        p0 = __builtin_amdgcn_mfma_f32_32x32x16_bf16(kf[2 * d0], qr[d0], p0, 0, 0, 0);
        p1 = __builtin_amdgcn_mfma_f32_32x32x16_bf16(kf[2 * d0 + 1], qr[d0], p1, 0, 0, 0);
      }
      const LAS unsigned char* vb = lds + L_V + cur * VSLOT + vlane;
      s16x4 vl[8], vh[8];
#pragma unroll
      for (int i = 0; i < 8; ++i) { vl[i] = vtr(vb + (i >> 2) * 4096 + (i & 3) * 1024); vh[i] = vtr(vb + (i >> 2) * 4096 + (i & 3) * 1024 + 512); }
      if (t == tl) {
        const int lim = 32 * (wid & 1) + r32;
#pragma unroll
        for (int r = 0; r < 16; ++r) { const int kk = crow(r, hi); if (kk > lim) p0[r] = -INFINITY; if (kk + 32 > lim) p1[r] = -INFINITY; }
      }
      float rm = fmaxf(p0[0], p1[0]);
#pragma unroll
      for (int r = 1; r < 16; ++r) rm = fmaxf(rm, fmaxf(p0[r], p1[r]));
      { auto rr = __builtin_amdgcn_permlane32_swap(__float_as_uint(rm), __float_as_uint(rm), false, false); rm = fmaxf(__uint_as_float(rr[0]), __uint_as_float(rr[1])); }
      const bool first = (t == 0);
      if (first || __any(rm > THR)) {
        const float dl = first ? rm : fmaxf(rm, 0.f);
        mhat += dl;
#pragma unroll
        for (int r = 0; r < 16; ++r) { p0[r] -= dl; p1[r] -= dl; negm[r] = -mhat; }
        if (!first) {
          const float f = __builtin_amdgcn_exp2f(-dl);
          l *= f;
          if (hi == 0) wsf[r32] = f;
          asm volatile("s_waitcnt lgkmcnt(0)" ::: "memory");
          float fr[16];
#pragma unroll
          for (int r = 0; r < 16; ++r) fr[r] = wsf[crow(r, hi)];
#pragma unroll
          for (int d0 = 0; d0 < 4; ++d0)
#pragma unroll
            for (int r = 0; r < 16; ++r) o[d0][r] *= fr[r];
          asm volatile("s_waitcnt lgkmcnt(0)" ::: "memory");
        }
      }
      float sacc = 0.f;
#pragma unroll
      for (int r = 0; r < 16; ++r) { p0[r] = __builtin_amdgcn_exp2f(p0[r]); p1[r] = __builtin_amdgcn_exp2f(p1[r]); sacc += p0[r] + p1[r]; }
      l += sacc;
      bf16x8 pa[4]; pa[0] = pack8(p0, 0); pa[1] = pack8(p0, 1); pa[2] = pack8(p1, 0); pa[3] = pack8(p1, 1);
#define ATT_VF(i) (bf16x8){vl[i][0], vl[i][1], vl[i][2], vl[i][3], vh[i][0], vh[i][1], vh[i][2], vh[i][3]}
#pragma unroll
      for (int i = 0; i < 8; ++i) o[i >> 2] = __builtin_amdgcn_mfma_f32_32x32x16_bf16(pa[i & 3], ATT_VF(i), o[i >> 2], 0, 0, 0);
#pragma unroll
      for (int i = 0; i < 8; ++i) { vl[i] = vtr(vb + (2 + (i >> 2)) * 4096 + (i & 3) * 1024); vh[i] = vtr(vb + (2 + (i >> 2)) * 4096 + (i & 3) * 1024 + 512); }
#pragma unroll
      for (int i = 0; i < 8; ++i) o[2 + (i >> 2)] = __builtin_amdgcn_mfma_f32_32x32x16_bf16(pa[i & 3], ATT_VF(i), o[2 + (i >> 2)], 0, 0, 0);
#undef ATT_VF
    }
    side.finish(ws_);
    if (t + 1 < NTL) { const int nx = (cur ^ 1); *(LAS u32x4*)(kdst + nx * KSLOT) = kreg; *(LAS u32x4*)(vdst + nx * VSLOT) = v0reg; *(LAS u32x4*)(vdst + nx * VSLOT + 8192) = v1reg; }
    __syncthreads();
  }
  { auto rr = __builtin_amdgcn_permlane32_swap(__float_as_uint(l), __float_as_uint(l), false, false); l = __uint_as_float(rr[0]) + __uint_as_float(rr[1]); }
  if (hi == 0) wsf[32 + r32] = l;
  asm volatile("s_waitcnt lgkmcnt(0)" ::: "memory");
  bf16_t* Ow = AO + (rowbase + q0w) * 1024 + hc * 128 + r32;
#pragma unroll
  for (int r = 0; r < 16; ++r) {
    const int qq = crow(r, hi); const float rl = 1.0f / wsf[32 + qq];
#pragma unroll
    for (int d0 = 0; d0 < 4; ++d0) Ow[(size_t)qq * 1024 + d0 * 32] = (bf16_t)f2bf(o[d0][r] * rl);
  }
  asm volatile("s_waitcnt lgkmcnt(0)" ::: "memory");
}
}
template <class SIDE>
__device__ __forceinline__ void phase_attn_unit(const P& p, int v, int i, LAS unsigned char* lds, SIDE& side) { const int bh = v >> 3, s = v & 7; att::attn_unit(p, bh >> 3, bh & 7, i == 0 ? 15 - s : s, lds, side); }
namespace attn_body {
using bf16=__hip_bfloat16;
using bf16x8=__attribute__((ext_vector_type(8)))short;
using s16x4=__attribute__((ext_vector_type(4)))short;
using f32x16=__attribute__((ext_vector_type(16)))float;
using u32x4=__attribute__((ext_vector_type(4)))unsigned;
constexpr int BATCH=4,NHEAD=8,SEQ=4096,D=64,PQ=3072,PO=1024;
constexpr int NW=8,QBLK=32,QB=QBLK*NW,KVBLK=64,NQB=SEQ/QB;
constexpr int ATTN_UNIT_ROWS=QB;
__device__ __forceinline__ int crow(int r,int hi){return (r&3)+8*(r>>2)+4*hi;}
#define SBAR() __builtin_amdgcn_sched_barrier(0)
__device__ __forceinline__ void cmask(f32x16&p0,f32x16&p1,int jb,int qrel,int hi){
  const float NEG=-INFINITY; int kb=64*jb+4*hi;
  #pragma unroll
  for(int r=0;r<16;++r){int kv=kb+(r&3)+8*(r>>2); if(kv>qrel)p0[r]=NEG; if(kv+32>qrel)p1[r]=NEG;}
}

constexpr int NSLOT=3, SLOTB=8192;
constexpr int LDS_K=0, LDS_V=NSLOT*SLOTB, LDS_WS=2*NSLOT*SLOTB, LDS_OST=LDS_WS+NW*64*4, LDS_BYTES=LDS_OST+NW*4096;
constexpr float C2=0.125f*1.4426950408889634f;
__device__ __forceinline__ void glds16(const void*gsrc,unsigned lds_dst){unsigned keep;
  asm volatile("s_mov_b32 %0, m0\n\ts_mov_b32 m0, %2\n\ts_nop 0\n\tglobal_load_lds_dwordx4 %1, off\n\ts_mov_b32 m0, %0":"=&s"(keep):"v"(gsrc),"s"(lds_dst):"memory");}
__device__ __forceinline__ float max3f(float a,float b,float c){float r;asm("v_max3_f32 %0, %1, %2, %3":"=v"(r):"v"(a),"v"(b),"v"(c));return r;}
__device__ __forceinline__ float max2f(float a,float b){float r;asm("v_max_f32_e32 %0, %1, %2":"=v"(r):"v"(a),"v"(b));return r;}
__device__ __forceinline__ float fadd_s(float a,float b){float r;asm("v_add_f32_e32 %0, %1, %2":"=v"(r):"v"(a),"v"(b));return r;}
__device__ __forceinline__ float fsub_s(float a,float b){float r;asm("v_sub_f32_e32 %0, %1, %2":"=v"(r):"v"(a),"v"(b));return r;}
typedef float f32x2_t __attribute__((ext_vector_type(2))); typedef __bf16 bf16x2_t __attribute__((ext_vector_type(2)));
__device__ __forceinline__ unsigned cvtpk_s(float lo,float hi){f32x2_t v={lo,hi};bf16x2_t b=__builtin_convertvector(v,bf16x2_t);return __builtin_bit_cast(unsigned,b);}
#define WAIT_BAR(N) asm volatile("s_waitcnt vmcnt(" #N ") lgkmcnt(0)\n\ts_barrier":::"memory")

__device__ __forceinline__ void qkt(f32x16&p0,f32x16&p1,const char*Kslot,const bf16x8*qr,const f32x16&negm,int r32,int hi){
  const char*kb=Kslot+hi*1024+r32*16;
  #pragma unroll
  for(int d0=0;d0<4;++d0){
    const bf16x8 b0=*reinterpret_cast<const bf16x8*>(kb+d0*2048);
    const bf16x8 b1=*reinterpret_cast<const bf16x8*>(kb+d0*2048+512);
    if(d0==0){p0=__builtin_amdgcn_mfma_f32_32x32x16_bf16(b0,qr[0],negm,0,0,0);p1=__builtin_amdgcn_mfma_f32_32x32x16_bf16(b1,qr[0],negm,0,0,0);}
    else{p0=__builtin_amdgcn_mfma_f32_32x32x16_bf16(b0,qr[d0],p0,0,0,0);p1=__builtin_amdgcn_mfma_f32_32x32x16_bf16(b1,qr[d0],p1,0,0,0);}}
}
typedef __attribute__((address_space(3))) const char* lds_cptr;
typedef short v4i16_t __attribute__((ext_vector_type(4)));
__device__ __forceinline__ void kload8(bf16x8*kf,lds_cptr kp){
  kf[0]=*(const __attribute__((address_space(3))) bf16x8*)(kp);      kf[1]=*(const __attribute__((address_space(3))) bf16x8*)(kp+512);
  kf[2]=*(const __attribute__((address_space(3))) bf16x8*)(kp+2048); kf[3]=*(const __attribute__((address_space(3))) bf16x8*)(kp+2560);
  kf[4]=*(const __attribute__((address_space(3))) bf16x8*)(kp+4096); kf[5]=*(const __attribute__((address_space(3))) bf16x8*)(kp+4608);
  kf[6]=*(const __attribute__((address_space(3))) bf16x8*)(kp+6144); kf[7]=*(const __attribute__((address_space(3))) bf16x8*)(kp+6656);
}
__device__ __forceinline__ void kload2(bf16x8*kf,lds_cptr kp,int j){ kf[2*j]=*(const __attribute__((address_space(3))) bf16x8*)(kp+j*2048); kf[2*j+1]=*(const __attribute__((address_space(3))) bf16x8*)(kp+j*2048+512); }
__device__ __forceinline__ s16x4 vtr(lds_cptr p){ return __builtin_bit_cast(s16x4,__builtin_amdgcn_ds_read_tr16_b64_v4i16((__attribute__((address_space(3))) v4i16_t*)p)); }
__device__ __forceinline__ float rowmax(const f32x16&p0,const f32x16&p1){
  float a=max3f(p0[0],p0[1],p1[0]),b=max3f(p0[2],p0[3],p1[1]);a=max3f(a,p1[2],p1[3]);
  #pragma unroll
  for(int r=4;r<16;r+=4){a=max3f(a,p0[r],p0[r+1]);b=max3f(b,p0[r+2],p0[r+3]);a=max3f(a,p1[r],p1[r+1]);b=max3f(b,p1[r+2],p1[r+3]);}
  const float m=max2f(a,b);
  auto rr=__builtin_amdgcn_permlane32_swap(__float_as_uint(m),__float_as_uint(m),false,false);
  return max2f(__uint_as_float(rr[0]),__uint_as_float(rr[1]));
}
__device__ __forceinline__ void pv(f32x16*o,int vb,bf16x8 pa0,bf16x8 pa1,bf16x8 pa2,bf16x8 pa3){
  #pragma unroll
  for(int d0=0;d0<2;++d0){s16x4 lo[4],hi[4];
    #pragma unroll
    for(int ks=0;ks<4;++ks){
      asm volatile("ds_read_b64_tr_b16 %0,%1 offset:%c2":"=&v"(lo[ks]):"v"(vb),"i"(d0*4096+ks*1024):"memory");
      asm volatile("ds_read_b64_tr_b16 %0,%1 offset:%c2":"=&v"(hi[ks]):"v"(vb),"i"(d0*4096+ks*1024+512):"memory");}
    asm volatile("s_waitcnt lgkmcnt(0)":::"memory");SBAR();
    #define PK(k) (bf16x8){lo[k][0],lo[k][1],lo[k][2],lo[k][3],hi[k][0],hi[k][1],hi[k][2],hi[k][3]}
    o[d0]=__builtin_amdgcn_mfma_f32_32x32x16_bf16(pa0,PK(0),o[d0],0,0,0);
    o[d0]=__builtin_amdgcn_mfma_f32_32x32x16_bf16(pa1,PK(1),o[d0],0,0,0);
    o[d0]=__builtin_amdgcn_mfma_f32_32x32x16_bf16(pa2,PK(2),o[d0],0,0,0);
    o[d0]=__builtin_amdgcn_mfma_f32_32x32x16_bf16(pa3,PK(3),o[d0],0,0,0);
    #undef PK
  }
}

#ifndef ATTN_STORE16
#define ATTN_STORE16(p,v) (*(u32x4*)(p)=(v))
#endif
template<int THRL> __device__ __forceinline__ void attn_unit(int b,int h,int hv,int ho,int qb,const bf16*Q,const bf16*__restrict__ K,const bf16*__restrict__ V,bf16*O,char*shm){
  const int tid=tidx(),lane=tid&63,r32=lane&31,hi=lane>>5; const int wid=__builtin_amdgcn_readfirstlane(tid>>6);
  const long rowbase=(long)b*SEQ; const int q0=qb*QB;
  const bf16*Qw=Q+(rowbase+q0+wid*QBLK)*PQ+h*D;
  const bf16*Kh=K+rowbase*PQ+h*D,*Vh=V+rowbase*PQ+hv*D;
  const unsigned lds0=(unsigned)(uintptr_t)shm;
  float*wsf=(float*)(shm+LDS_WS)+wid*64;
  const bf16*ksrc=Kh+(long)lane*PQ+wid*8;
  const bf16*vsrc=Vh+(long)(16*(wid&3)+(lane>>2))*PQ+(wid>>2)*32+(lane&3)*8;
  const unsigned kdst=lds0+LDS_K+wid*1024, vdst=lds0+LDS_V+wid*1024;
  #define DMA_K(t,slot) glds16(ksrc+(long)(t)*KVBLK*PQ,(unsigned)__builtin_amdgcn_readfirstlane(kdst+(slot)))
  #define DMA_V(t,slot) glds16(vsrc+(long)(t)*KVBLK*PQ,(unsigned)__builtin_amdgcn_readfirstlane(vdst+(slot)))
  const int vb0=(int)(lds0+LDS_V)+((lane>>4)&1)*32+(lane&3)*8+(4*hi+((lane&15)>>2))*64;
  const char*Kbase=shm+LDS_K; bf16x8 kf[8];
  const lds_cptr shm3=(lds_cptr)shm; const lds_cptr kp0=shm3+LDS_K+hi*1024+r32*16; const lds_cptr vp0=shm3+LDS_V+((lane>>4)&1)*32+(lane&3)*8+(4*hi+((lane&15)>>2))*64;
  const int NT=(q0+QB)/KVBLK;
  DMA_K(0,0);DMA_V(0,0);DMA_K(1,SLOTB);
  bf16x8 qr[4];
  #pragma unroll
  for(int d0=0;d0<4;++d0)qr[d0]=*reinterpret_cast<const bf16x8*>(&Qw[(long)r32*PQ+d0*16+hi*8]);
  float mhat=0.f,l_reg=0.f;f32x16 o[2];o[0]=f32x16{};o[1]=f32x16{};f32x16 negm=f32x16{};asm volatile("":"+v"(negm));
  const int qrel=wid*QBLK+r32;
  #define CMASK(P0,P1,t) do{int jb_=(t)-(NT-4); if(jb_>=0)cmask(P0,P1,jb_,qrel,hi);}while(0)
  bool resc=false;
  #define START(P0,P1) do{ const float rm=rowmax(P0,P1); resc=false; \
    { const float dl=rm; mhat=fadd_s(mhat,dl); \
      _Pragma("unroll") for(int r=0;r<16;++r){P0[r]=fsub_s(P0[r],dl);P1[r]=fsub_s(P1[r],dl);} \
      _Pragma("unroll") for(int r=0;r<16;++r)negm[r]=-mhat; asm volatile("":"+v"(negm)); } \
    _Pragma("unroll") for(int r=0;r<16;++r)P0[r]=__builtin_amdgcn_exp2f(P0[r]); }while(0)
  #define RESC() do{ if(resc){ asm volatile("s_waitcnt lgkmcnt(0)":::"memory"); \
      _Pragma("unroll") for(int d_=0;d_<2;++d_) _Pragma("unroll") for(int r=0;r<16;++r)o[d_][r]*=wsf[crow(r,hi)]; } }while(0)
  f32x16 pA0,pA1,pB0,pB1;
  int sl_prev=0,sl_cur=0,sl_next=SLOTB;
  #define ROT() do{sl_prev=sl_cur;sl_cur=sl_next;sl_next=(sl_next==(NSLOT-1)*SLOTB)?0:sl_next+SLOTB;}while(0)
  DMA_K(2,2*SLOTB);
  WAIT_BAR(3);
  qkt(pA0,pA1,Kbase,qr,negm,r32,hi);asm volatile("s_nop 15\n\ts_nop 7":"+v"(pA0),"+v"(pA1));CMASK(pA0,pA1,0);
  START(pA0,pA1);
  _Pragma("unroll") for(int r=0;r<16;++r)pA1[r]=__builtin_amdgcn_exp2f(pA1[r]);
  WAIT_BAR(0);
  DMA_K(3,0);DMA_V(1,SLOTB);
  ROT();
  kload8(kf,kp0+sl_cur);
  WAIT_BAR(2);
  s16x4 vlo[8],vhi[8]; u32x4 pw0,pw1,pw2,pw3;
  #define PKW(P,B) cvtpk_s(P[B],P[B+1])
  #define PAF(k) __builtin_bit_cast(bf16x8,pw##k)
  #define VFR(i) (bf16x8){vlo[i][0],vlo[i][1],vlo[i][2],vlo[i][3],vhi[i][0],vhi[i][1],vhi[i][2],vhi[i][3]}
  #define PIN(x) asm volatile("":"+v"(x))
  #define MX3(a,b,c) __builtin_fmaxf(__builtin_fmaxf((a),(b)),(c))
  #define GAPA(MF,A0,A1,A2,A3,W0,W1,PW) do{ MF; sacc+=A0; sacc+=A1; sacc+=A2; sacc+=A3; PIN(sacc); W0; W1; PIN(PW); SBAR(); }while(0)
  #define EX(v) __builtin_amdgcn_exp2f(v)
  #define GAPB(MF,X,B) do{ MF; X[B]=EX(X[B]); X[B+1]=EX(X[B+1]); X[B+2]=EX(X[B+2]); X[B+3]=EX(X[B+3]); PIN(X); SBAR(); }while(0)
  #define VRD(i) do{ vlo[i]=vtr(vp_+(((i)>>2)*4096+((i)&3)*1024)); vhi[i]=vtr(vp_+(((i)>>2)*4096+((i)&3)*1024+512)); }while(0)
  #define KRD(G,j) do{ if(G){ kload2(kf,kp0+sl_next,j); SBAR(); } }while(0)
  #define STEP(C0,C1,P0,P1,t,GK,GV,GL) do{ SBAR(); \
    const lds_cptr vp_=vp0+sl_prev; \
    VRD(0); SBAR(); float sacc=(P0[0]+P0[1]); \
    GAPA(C0=__builtin_amdgcn_mfma_f32_32x32x16_bf16(kf[0],qr[0],negm,0,0,0), P0[2],P0[3],P0[4],P0[5],     pw0[0]=PKW(P0,0), pw0[1]=PKW(P0,2), pw0); \
    VRD(4); SBAR(); GAPA(C1=__builtin_amdgcn_mfma_f32_32x32x16_bf16(kf[1],qr[0],negm,0,0,0), P0[6],P0[7],P0[8],P0[9],     pw0[2]=PKW(P0,4), pw0[3]=PKW(P0,6), pw0); \
    VRD(1); SBAR(); GAPA(C0=__builtin_amdgcn_mfma_f32_32x32x16_bf16(kf[2],qr[1],C0,0,0,0),   P0[10],P0[11],P0[12],P0[13], pw1[0]=PKW(P0,8), pw1[1]=PKW(P0,10), pw1); \
    VRD(5); SBAR(); GAPA(C1=__builtin_amdgcn_mfma_f32_32x32x16_bf16(kf[3],qr[1],C1,0,0,0),   P0[14],P0[15],P1[0],P1[1],   pw1[2]=PKW(P0,12),pw1[3]=PKW(P0,14), pw1); \
    VRD(2); SBAR(); GAPA(C0=__builtin_amdgcn_mfma_f32_32x32x16_bf16(kf[4],qr[2],C0,0,0,0),   P1[2],P1[3],P1[4],P1[5],     pw2[0]=PKW(P1,0), pw2[1]=PKW(P1,2), pw2); \
    VRD(6); SBAR(); GAPA(C1=__builtin_amdgcn_mfma_f32_32x32x16_bf16(kf[5],qr[2],C1,0,0,0),   P1[6],P1[7],P1[8],P1[9],     pw2[2]=PKW(P1,4), pw2[3]=PKW(P1,6), pw2); \
    VRD(3); SBAR(); GAPA(C0=__builtin_amdgcn_mfma_f32_32x32x16_bf16(kf[6],qr[3],C0,0,0,0),   P1[10],P1[11],P1[12],P1[13], pw3[0]=PKW(P1,8), pw3[1]=PKW(P1,10), pw3); \
    VRD(7); SBAR(); GAPA(C1=__builtin_amdgcn_mfma_f32_32x32x16_bf16(kf[7],qr[3],C1,0,0,0),   P1[14],P1[15],0.f,0.f,       pw3[2]=PKW(P1,12),pw3[3]=PKW(P1,14), pw3); \
    l_reg+=sacc; \
    if(GK){DMA_K((t)+3,sl_cur);} if(GV){DMA_V((t)+1,sl_next);} \
    CMASK(C0,C1,t); \
    { float a=MX3(C0[0],C0[1],C1[0]),b=MX3(C0[2],C0[3],C1[1]); a=MX3(a,C1[2],C1[3]); \
      _Pragma("unroll") for(int r=4;r<16;r+=4){a=MX3(a,C0[r],C0[r+1]);b=MX3(b,C0[r+2],C0[r+3]);a=MX3(a,C1[r],C1[r+1]);b=MX3(b,C1[r+2],C1[r+3]);} \
      float rm=__builtin_fmaxf(a,b); { auto rr=__builtin_amdgcn_permlane32_swap(__float_as_uint(rm),__float_as_uint(rm),false,false); rm=__builtin_fmaxf(__uint_as_float(rr[0]),__uint_as_float(rr[1])); } \
      resc=false; \
      if(__builtin_expect(__any(rm>(float)THRL),0)){ const float dl=__builtin_fmaxf(rm,0.f); mhat+=dl; \
        _Pragma("unroll") for(int r=0;r<16;++r){C0[r]-=dl;C1[r]-=dl;} \
        _Pragma("unroll") for(int r=0;r<16;++r)negm[r]=-mhat; asm volatile("":"+v"(negm)); \
        const float f=__builtin_amdgcn_exp2f(-dl); l_reg*=f; if(hi==0)wsf[r32]=f; resc=true; } } \
    SBAR(); \
    GAPB(o[0]=__builtin_amdgcn_mfma_f32_32x32x16_bf16(PAF(0),VFR(0),o[0],0,0,0), C0,0); \
    GAPB(o[1]=__builtin_amdgcn_mfma_f32_32x32x16_bf16(PAF(0),VFR(4),o[1],0,0,0), C0,4); \
    KRD(GL,0); GAPB(o[0]=__builtin_amdgcn_mfma_f32_32x32x16_bf16(PAF(1),VFR(1),o[0],0,0,0), C0,8); \
    KRD(GL,1); GAPB(o[1]=__builtin_amdgcn_mfma_f32_32x32x16_bf16(PAF(1),VFR(5),o[1],0,0,0), C0,12); \
    KRD(GL,2); GAPB(o[0]=__builtin_amdgcn_mfma_f32_32x32x16_bf16(PAF(2),VFR(2),o[0],0,0,0), C1,0); \
    KRD(GL,3); GAPB(o[1]=__builtin_amdgcn_mfma_f32_32x32x16_bf16(PAF(2),VFR(6),o[1],0,0,0), C1,4); \
    GAPB(o[0]=__builtin_amdgcn_mfma_f32_32x32x16_bf16(PAF(3),VFR(3),o[0],0,0,0), C1,8); \
    GAPB(o[1]=__builtin_amdgcn_mfma_f32_32x32x16_bf16(PAF(3),VFR(7),o[1],0,0,0), C1,12); \
    }while(0)
  int t=1;
  #undef CMASK
  #define CMASK(P0,P1,t) do{}while(0)
  for(;t+5<NT;t+=2){
    STEP(pB0,pB1,pA0,pA1,t,true,true,true);     WAIT_BAR(2); RESC(); ROT();
    STEP(pA0,pA1,pB0,pB1,t+1,true,true,true);   WAIT_BAR(2); RESC(); ROT();
  }
  #undef CMASK
  #define CMASK(P0,P1,t) do{int jb_=(t)-(NT-4); if(jb_>=0)cmask(P0,P1,jb_,qrel,hi);}while(0)
  #define ENDW(tt) do{ if((tt)+3<NT){WAIT_BAR(2);} else if((tt)+2<NT){WAIT_BAR(1);} else {WAIT_BAR(0);} }while(0)
  for(;t+1<NT;t+=2){
    STEP(pB0,pB1,pA0,pA1,t,(t+3<NT),(t+1<NT),(t+1<NT));       ENDW(t);   RESC(); ROT();
    STEP(pA0,pA1,pB0,pB1,t+1,(t+4<NT),(t+2<NT),(t+2<NT));     ENDW(t+1); RESC(); ROT();
  }
  STEP(pB0,pB1,pA0,pA1,NT-1,false,false,false); RESC();
  { float sacc=pB0[0]+pB0[1]; _Pragma("unroll") for(int r=2;r<16;++r)sacc+=pB0[r]; _Pragma("unroll") for(int r=0;r<16;++r)sacc+=pB1[r]; l_reg+=sacc;
    pw0=(u32x4){PKW(pB0,0),PKW(pB0,2),PKW(pB0,4),PKW(pB0,6)};pw1=(u32x4){PKW(pB0,8),PKW(pB0,10),PKW(pB0,12),PKW(pB0,14)};pw2=(u32x4){PKW(pB1,0),PKW(pB1,2),PKW(pB1,4),PKW(pB1,6)};pw3=(u32x4){PKW(pB1,8),PKW(pB1,10),PKW(pB1,12),PKW(pB1,14)};
    SBAR(); pv(o,vb0+sl_cur,PAF(0),PAF(1),PAF(2),PAF(3)); }
  #undef PKW
  #undef PAF
  #undef VFR
  #undef PIN
  #undef MX3
  #undef GAPA
  #undef GAPB
  #undef EX
  #undef VRD
  #undef KRD
  #undef STEP
  #undef ENDW
  {auto rr=__builtin_amdgcn_permlane32_swap(__float_as_uint(l_reg),__float_as_uint(l_reg),false,false);l_reg=__uint_as_float(rr[0])+__uint_as_float(rr[1]);}
  if(hi==0)wsf[32+r32]=l_reg;asm volatile("s_waitcnt lgkmcnt(0)":::"memory");
  float rli[16];
  #pragma unroll
  for(int r=0;r<16;++r)rli[r]=__builtin_amdgcn_rcpf(wsf[32+crow(r,hi)]);
  bf16*Ow=O+(rowbase+q0+wid*QBLK)*PO+ho*D;
  { bf16*stg=(bf16*)(shm+LDS_OST)+wid*2048;
    #pragma unroll
    for(int r=0;r<16;++r){const int orow=crow(r,hi);
      #pragma unroll
      for(int d0=0;d0<2;++d0)stg[orow*64+d0*32+r32]=__float2bfloat16(o[d0][r]*rli[r]);}
    asm volatile("s_waitcnt lgkmcnt(0)":::"memory");
    #pragma unroll
    for(int i=0;i<4;++i){const int row=i*8+(lane>>3),ch=lane&7; const u32x4 v=*(const u32x4*)(stg+row*64+ch*8); ATTN_STORE16(Ow+(long)row*PO+ch*8,v);} }
  asm volatile("s_waitcnt lgkmcnt(0)\n\ts_barrier":::"memory");
  #undef DMA_K
  #undef DMA_V
  #undef CMASK
  #undef START
  #undef RESC
  #undef ROT
}
constexpr int ATTN_LDS_BYTES=LDS_BYTES;
struct AttnTensors { const bf16* Q; const bf16* K; const bf16* V; bf16* O; };
template<int THRL=8> __device__ __forceinline__ void attn_phase_unit(char*lds,const AttnTensors&T,int vcu,int i){
  const int bh=vcu>>3,s=vcu&7,b=bh>>3,hc=bh&7;
  const int qb=(i<2)?15-s:s, half=i&1; attn_unit<THRL>(b,hc,(hc>>1)*2+half,2*hc+half,qb,T.Q,T.K,T.V,T.O,lds);
}
#undef SBAR
#undef WAIT_BAR
}

namespace moe {
typedef short bf16x8 __attribute__((ext_vector_type(8)));
typedef short s16x4 __attribute__((ext_vector_type(4)));
typedef float f32x16 __attribute__((ext_vector_type(16)));
typedef unsigned u32x2 __attribute__((ext_vector_type(2)));
constexpr int SLOT = 32768, L_ROWS = 131072, L_TS = 133120, L_CL = 134400, L_SIDE = 139264;

template <int STAGE>
__device__ __forceinline__ void run(const P& p, int bid, int nb, LAS unsigned char* lds) {
  unsigned char* const ws_ = fresh_ws(p.ws);
  constexpr int NSUB = (STAGE == 1) ? 2 : 4, KTOT = (STAGE == 1) ? D : DE, NK = KTOT / 32;
  const int tid = tidx(), lane = tid & 63, r32 = lane & 31, hi = lane >> 5; const int wid = __builtin_amdgcn_readfirstlane(tid >> 6), wm = wid >> 2, wn = wid & 3;
  const int* cnt = (const int*)(ws_ + WS_CTL); const int* LIST = (const int*)(ws_ + WS_LIST);
  LAS int* ts = (LAS int*)(lds + L_TS); LAS int* cl = (LAS int*)(lds + L_CL);
  __syncthreads();
  if (tid < 256) cl[tid] = cnt[tid * CNT_STRIDE];
  __syncthreads();
  if (tid <= 256) { int a = 0; for (int i = 0; i < tid; ++i) a += (cl[i] + 255) >> 8; ts[tid] = a; }
  __syncthreads();
  const int nitems = ts[256] * NSUB;
  const int vcu = (nb % 8 == 0) ? (bid % 8) * (nb / 8) + bid / 8 : bid;
  const bf16_t* Asrc = (STAGE == 1) ? (const bf16_t*)(ws_ + WS_HNB) : (const bf16_t*)(ws_ + WS_H);
  const bf16_t* Bimg = (STAGE == 1) ? (const bf16_t*)(ws_ + WS_WE1) : (const bf16_t*)(ws_ + WS_WE2);
  const int cgk = ((lane & 3) ^ ((lane >> 4) & 3)) * 8;
  int abase[2];
#pragma unroll
  for (int k16 = 0; k16 < 2; ++k16) abase[k16] = (128 * wm + r32) * 64 + (((2 * k16 + hi) ^ ((r32 >> 2) & 3)) * 16);
  const int bbase = 16384 + (2 * wn) * 2048 + hi * 512 + ((lane & 15) >> 2) * 64 + ((lane >> 4) & 1) * 32 + (lane & 3) * 8;

#define MOE_DESC(it, E_, MT_, MC_, SUB_) do { const int tile_ = (it) / NSUB; SUB_ = (it) % NSUB; int lo_ = 0, hi_ = 256; \
    while (hi_ - lo_ > 1) { const int mid_ = (lo_ + hi_) >> 1; if (ts[mid_] <= tile_) lo_ = mid_; else hi_ = mid_; } \
    E_ = __builtin_amdgcn_readfirstlane(lo_); MT_ = __builtin_amdgcn_readfirstlane(tile_ - ts[lo_]); MC_ = __builtin_amdgcn_readfirstlane(min(256, cl[lo_] - MT_ * 256)); } while (0)
#define MOE_ROWS_DMA(E_, MT_, par) do { if (wid == 0) __builtin_amdgcn_global_load_lds((const unsigned*)(LIST + (size_t)(E_) * LISTCAP + (MT_) * 256 + lane * 4), (LAS unsigned*)(lds + L_ROWS + (par) * 1024), 16, 0, 0); } while (0)
#define MOE_ASRC(dst, par, MC_) do { _Pragma("unroll") for (int i = 0; i < 2; ++i) { const int aidr = ((LAS int*)(lds + L_ROWS + (par) * 1024))[min(16 * (2 * wid + i) + (lane >> 2), (MC_) - 1)]; \
      dst[i] = Asrc + ((STAGE == 1) ? (size_t)(aidr >> 3) * D : (size_t)aidr * DE) + cgk; } } while (0)
#define MOE_ISSUE_SL(AS, BS, s, SL) do { LAS unsigned char* sl_ = lds + (SL) * SLOT + (2 * wid) * 1024; \
      __builtin_amdgcn_global_load_lds((const unsigned*)(AS[0] + (s) * 32), (LAS unsigned*)(sl_), 16, 0, 0); \
      __builtin_amdgcn_global_load_lds((const unsigned*)(AS[1] + (s) * 32), (LAS unsigned*)(sl_ + 1024), 16, 0, 0); \
      __builtin_amdgcn_global_load_lds((const unsigned*)(BS + (size_t)(s) * 8192), (LAS unsigned*)(sl_ + 16384), 16, 0, 0); \
      __builtin_amdgcn_global_load_lds((const unsigned*)(BS + (size_t)(s) * 8192 + 512), (LAS unsigned*)(sl_ + 16384 + 1024), 16, 0, 0); } while (0)

  ConvSideLds side; side.init(bid, nb, (STAGE == 1) ? (1u << 24) : 0u, (STAGE == 1) ? (3u << 23) : 0u, tid, lds + L_SIDE + wid * 2048);
  int item = vcu, par = 0;
  int e = 0, mt = 0, mcount = 1, sub = 0;
  const bf16_t* asrc[2]; const bf16_t* bsrc;
  if (item < nitems) {
    MOE_DESC(item, e, mt, mcount, sub);
    MOE_ROWS_DMA(e, mt, 0);
    asm volatile("s_waitcnt vmcnt(0)" ::: "memory"); __syncthreads();
    MOE_ASRC(asrc, 0, mcount);
    bsrc = Bimg + (size_t)(e * NSUB + sub) * NK * 8192 + (2 * wid) * 512 + lane * 8;
    MOE_ISSUE_SL(asrc, bsrc, 0, 0); MOE_ISSUE_SL(asrc, bsrc, 1, 1); MOE_ISSUE_SL(asrc, bsrc, 2, 2);
  }
  while (item < nitems) {
    const int nitem = item + nb; const bool has_next = nitem < nitems;
    int ne = 0, nmt = 0, nmc = 1, nsub = 0;
    const bf16_t* nasrc[2] = {Asrc, Asrc}; const bf16_t* nbsrc = Bimg;
    if (has_next) { MOE_DESC(nitem, ne, nmt, nmc, nsub); nbsrc = Bimg + (size_t)(ne * NSUB + nsub) * NK * 8192 + (2 * wid) * 512 + lane * 8; }
    f32x16 acc[4][2];
#pragma unroll
    for (int m = 0; m < 4; ++m)
#pragma unroll
      for (int n = 0; n < 2; ++n)
#pragma unroll
        for (int r = 0; r < 16; ++r) acc[m][n][r] = 0.f;
#define MOE_STEP(s, SL) do { \
      if ((s) + 2 < NK || has_next) asm volatile("s_waitcnt vmcnt(8)" ::: "memory"); \
      else if ((s) + 1 < NK) asm volatile("s_waitcnt vmcnt(4)" ::: "memory"); \
      else asm volatile("s_waitcnt vmcnt(0)" ::: "memory"); \
      __builtin_amdgcn_s_barrier(); \
      asm volatile("" ::: "memory"); \
      if ((s) + 3 < NK) MOE_ISSUE_SL(asrc, bsrc, (s) + 3, ((SL) + 3) & 3); \
      else if (has_next) { if ((s) + 3 == NK) MOE_ASRC(nasrc, par ^ 1, nmc); MOE_ISSUE_SL(nasrc, nbsrc, (s) + 3 - NK, ((SL) + 3) & 3); } \
      if ((s) == 0 && has_next) MOE_ROWS_DMA(ne, nmt, par ^ 1); \
      const LAS unsigned char* Ab = lds + (SL) * SLOT; const unsigned Bbv = (unsigned)(uintptr_t)(lds + (SL) * SLOT + bbase); \
      bf16x8 af[2][4], bfr[2][2]; s16x4 tq[8]; const unsigned Abv0 = (unsigned)(uintptr_t)(Ab + abase[0]), Abv1 = (unsigned)(uintptr_t)(Ab + abase[1]); \
      asm volatile("ds_read_b64_tr_b16 %0, %1 offset:0" : "=&v"(tq[0]) : "v"(Bbv) : "memory"); \
      asm volatile("ds_read_b64_tr_b16 %0, %1 offset:256" : "=&v"(tq[1]) : "v"(Bbv) : "memory"); \
      asm volatile("ds_read_b64_tr_b16 %0, %1 offset:2048" : "=&v"(tq[2]) : "v"(Bbv) : "memory"); \
      asm volatile("ds_read_b64_tr_b16 %0, %1 offset:2304" : "=&v"(tq[3]) : "v"(Bbv) : "memory"); \
      asm volatile("ds_read_b128 %0, %1 offset:0" : "=&v"(af[0][0]) : "v"(Abv0) : "memory"); \
      asm volatile("ds_read_b128 %0, %1 offset:2048" : "=&v"(af[0][1]) : "v"(Abv0) : "memory"); \
      asm volatile("ds_read_b128 %0, %1 offset:4096" : "=&v"(af[0][2]) : "v"(Abv0) : "memory"); \
      asm volatile("ds_read_b128 %0, %1 offset:6144" : "=&v"(af[0][3]) : "v"(Abv0) : "memory"); \
      asm volatile("ds_read_b64_tr_b16 %0, %1 offset:1024" : "=&v"(tq[4]) : "v"(Bbv) : "memory"); \
      asm volatile("ds_read_b64_tr_b16 %0, %1 offset:1280" : "=&v"(tq[5]) : "v"(Bbv) : "memory"); \
      asm volatile("ds_read_b64_tr_b16 %0, %1 offset:3072" : "=&v"(tq[6]) : "v"(Bbv) : "memory"); \
      asm volatile("ds_read_b64_tr_b16 %0, %1 offset:3328" : "=&v"(tq[7]) : "v"(Bbv) : "memory"); \
      asm volatile("ds_read_b128 %0, %1 offset:0" : "=&v"(af[1][0]) : "v"(Abv1) : "memory"); \
      asm volatile("ds_read_b128 %0, %1 offset:2048" : "=&v"(af[1][1]) : "v"(Abv1) : "memory"); \
      asm volatile("ds_read_b128 %0, %1 offset:4096" : "=&v"(af[1][2]) : "v"(Abv1) : "memory"); \
      asm volatile("ds_read_b128 %0, %1 offset:6144" : "=&v"(af[1][3]) : "v"(Abv1) : "memory"); \
      asm volatile("s_waitcnt lgkmcnt(8)" : "+v"(tq[0]), "+v"(tq[1]), "+v"(tq[2]), "+v"(tq[3]), "+v"(af[0][0]), "+v"(af[0][1]), "+v"(af[0][2]), "+v"(af[0][3]) :: "memory"); __builtin_amdgcn_sched_barrier(0); \
      _Pragma("unroll") for (int n = 0; n < 2; ++n) { const s16x4 l0 = tq[2 * n], h0 = tq[2 * n + 1]; bfr[0][n] = (bf16x8){l0[0], l0[1], l0[2], l0[3], h0[0], h0[1], h0[2], h0[3]}; } \
      __builtin_amdgcn_s_setprio(1); \
      _Pragma("unroll") for (int m = 0; m < 4; ++m) \
        _Pragma("unroll") for (int n = 0; n < 2; ++n) acc[m][n] = __builtin_amdgcn_mfma_f32_32x32x16_bf16(bfr[0][n], af[0][m], acc[m][n], 0, 0, 0); \
      __builtin_amdgcn_sched_barrier(0); \
      asm volatile("s_waitcnt lgkmcnt(0)" : "+v"(tq[4]), "+v"(tq[5]), "+v"(tq[6]), "+v"(tq[7]), "+v"(af[1][0]), "+v"(af[1][1]), "+v"(af[1][2]), "+v"(af[1][3]) :: "memory"); __builtin_amdgcn_sched_barrier(0); \
      _Pragma("unroll") for (int n = 0; n < 2; ++n) { const s16x4 l0 = tq[4 + 2 * n], h0 = tq[4 + 2 * n + 1]; bfr[1][n] = (bf16x8){l0[0], l0[1], l0[2], l0[3], h0[0], h0[1], h0[2], h0[3]}; } \
      _Pragma("unroll") for (int m = 0; m < 4; ++m) \
        _Pragma("unroll") for (int n = 0; n < 2; ++n) acc[m][n] = __builtin_amdgcn_mfma_f32_32x32x16_bf16(bfr[1][n], af[1][m], acc[m][n], 0, 0, 0); \
      __builtin_amdgcn_s_setprio(0); \
      asm volatile("s_waitcnt lgkmcnt(0)" ::: "memory"); } while (0)
    for (int s = 0; s < NK; s += 4) {
      if (STAGE == 1) side.issue(p);
      MOE_STEP(s, 0); MOE_STEP(s + 1, 1);
      if (STAGE == 1) { if (s + 4 < NK || has_next) side.template finish<8>(ws_, lane); else side.template finish<0>(ws_, lane); side.issue(p); }
      MOE_STEP(s + 2, 2); MOE_STEP(s + 3, 3);
      if (STAGE == 1) { if (s + 6 < NK || has_next) side.template finish<8>(ws_, lane); else side.template finish<0>(ws_, lane); }
    }
#undef MOE_STEP
    {
      const LAS int* rw = (const LAS int*)(lds + L_ROWS + par * 1024);
#pragma unroll
      for (int m = 0; m < 4; ++m) {
        const int row = 128 * wm + 32 * m + r32; const bool valid = row < mcount;
        const int aid = rw[min(row, mcount - 1)];
        if (STAGE == 1) {
          bf16_t* hp = (bf16_t*)(ws_ + WS_H) + (size_t)aid * DE + 128 * sub + 32 * wn + 8 * hi;
#pragma unroll
          for (int g = 0; g < 4; g += 2) {
            unsigned a0 = pk2(silu_f(acc[m][0][4 * g]) * acc[m][1][4 * g], silu_f(acc[m][0][4 * g + 1]) * acc[m][1][4 * g + 1]), a1 = pk2(silu_f(acc[m][0][4 * g + 2]) * acc[m][1][4 * g + 2], silu_f(acc[m][0][4 * g + 3]) * acc[m][1][4 * g + 3]);
            unsigned b0 = pk2(silu_f(acc[m][0][4 * g + 4]) * acc[m][1][4 * g + 4], silu_f(acc[m][0][4 * g + 5]) * acc[m][1][4 * g + 5]), b1 = pk2(silu_f(acc[m][0][4 * g + 6]) * acc[m][1][4 * g + 6], silu_f(acc[m][0][4 * g + 7]) * acc[m][1][4 * g + 7]);
            { auto r = __builtin_amdgcn_permlane32_swap(a0, b0, false, false); a0 = r[0]; b0 = r[1]; }
            { auto r = __builtin_amdgcn_permlane32_swap(a1, b1, false, false); a1 = r[0]; b1 = r[1]; }
            if (valid) *(u32x4*)(hp + 8 * g) = (u32x4){a0, a1, b0, b1};
          }
        } else {
          const float w = ((const float*)(ws_ + WS_WTS))[aid];
          bf16_t* sp = (bf16_t*)(ws_ + WS_SLAB) + (size_t)aid * D + 256 * sub + 64 * wn + 8 * hi;
#pragma unroll
          for (int n = 0; n < 2; ++n)
#pragma unroll
            for (int g = 0; g < 4; g += 2) {
              unsigned a0 = pk2(acc[m][n][4 * g] * w, acc[m][n][4 * g + 1] * w), a1 = pk2(acc[m][n][4 * g + 2] * w, acc[m][n][4 * g + 3] * w);
              unsigned b0 = pk2(acc[m][n][4 * g + 4] * w, acc[m][n][4 * g + 5] * w), b1 = pk2(acc[m][n][4 * g + 6] * w, acc[m][n][4 * g + 7] * w);
              { auto r = __builtin_amdgcn_permlane32_swap(a0, b0, false, false); a0 = r[0]; b0 = r[1]; }
              { auto r = __builtin_amdgcn_permlane32_swap(a1, b1, false, false); a1 = r[0]; b1 = r[1]; }
              if (valid) *(u32x4*)(sp + 32 * n + 8 * g) = (u32x4){a0, a1, b0, b1};
            }
        }
      }
    }
    item = nitem; par ^= 1; e = ne; mt = nmt; mcount = nmc; sub = nsub; asrc[0] = nasrc[0]; asrc[1] = nasrc[1]; bsrc = nbsrc;
  }
#undef MOE_DESC
#undef MOE_ROWS_DMA
#undef MOE_ASRC
#undef MOE_ISSUE_SL
  asm volatile("s_waitcnt vmcnt(0)" ::: "memory");
  if (STAGE == 1) while (!side.done()) { side.issue(p); side.template finish<0>(ws_, lane); }
  __syncthreads();
}
}

__device__ __forceinline__ void phase_final_bf(const P& p, int bid, int nb) {
  unsigned char* const ws_ = fresh_ws(p.ws);
  const float* X1 = (const float*)(ws_ + WS_X1); const bf16_t* SL = (const bf16_t*)(ws_ + WS_SLAB); const float* ada = (const float*)(ws_ + WS_ADA);
  const int tid_ = tidx(), lane = tid_ & 63, wave = tid_ >> 6;
  for (int t = bid * NW + wave; t < T; t += nb * NW) {
    const int b = t / SEQ;
    float4 v[4]; float s = 0.f;
#pragma unroll
    for (int j = 0; j < 4; ++j) {
      const int c0 = lane * 4 + 256 * j;
      float4 y = make_float4(0, 0, 0, 0);
#pragma unroll
      for (int k = 0; k < 8; ++k) { const float4 z = ld_bf4(SL + (size_t)(t * 8 + k) * D + c0); y.x += z.x; y.y += z.y; y.z += z.z; y.w += z.w; }
      const float4 gt = *(const float4*)(ada + b * 6144 + 5120 + c0);
      const float4 bx = *(const float4*)(X1 + (size_t)t * D + c0);
      v[j] = make_float4(bx.x + gt.x * y.x, bx.y + gt.y * y.y, bx.z + gt.z * y.z, bx.w + gt.w * y.w);
      s += v[j].x * v[j].x + v[j].y * v[j].y + v[j].z * v[j].z + v[j].w * v[j].w;
    }
    s = wave_sum(s);
    const float rstd = 1.0f / sqrtf(s * (1.0f / D) + 1e-6f);
#pragma unroll
    for (int j = 0; j < 4; ++j) {
      const int c0 = lane * 4 + 256 * j;
      const float4 gg = *(const float4*)(p.g_final + c0);
      *(float4*)(p.out + (size_t)t * D + c0) = make_float4(v[j].x * rstd * gg.x, v[j].y * rstd * gg.y, v[j].z * rstd * gg.z, v[j].w * rstd * gg.w);
    }
  }
}

#define XB_TMO      128
#define XB_XCNT(j)  (256  + 64 * (j))
#define XB_XSUB(j)  (1280 + 64 * (j))
#define XB_XGEN(j)  (2304 + 64 * (j))
#define XB_TOP      3328
#define XB_TOPGEN   3392
#define XCD_BAR_WORDS 3456
#define XB_SPIN_CAP (1u << 22)
__device__ __forceinline__ unsigned xb_ld(unsigned* p)              { return __hip_atomic_load(p, __ATOMIC_RELAXED, __HIP_MEMORY_SCOPE_AGENT); }
__device__ __forceinline__ unsigned xb_add(unsigned* p, unsigned v) { return __hip_atomic_fetch_add(p, v, __ATOMIC_RELAXED, __HIP_MEMORY_SCOPE_AGENT); }
__device__ __forceinline__ unsigned xb_xcc_id() { return (unsigned)__builtin_amdgcn_s_getreg((3 << 11) | 20) & 0xFu; }
#define XB_SPIN(cond, bar) do { unsigned _sp = 0; while (cond) { __builtin_amdgcn_s_sleep(1); \
    if ((++_sp & 255u) == 0u) { if (xb_ld(&(bar)[XB_TMO])) break; if (_sp > XB_SPIN_CAP) { atomicAdd(&(bar)[XB_TMO], 1u); break; } } } } while (0)
struct XcdBarrier { unsigned* bar; unsigned x; volatile LAS unsigned* st; };
__device__ __forceinline__ XcdBarrier xcd_barrier_post(unsigned* bar, volatile LAS unsigned* st) {
    XcdBarrier b; b.bar = bar; b.x = xb_xcc_id(); b.st = st;
    if (threadIdx.x == 0) (void)xb_add(&bar[XB_XCNT(b.x)], 1u);
    return b;
}
__device__ __forceinline__ void xcd_barrier_complete(unsigned* bar, unsigned x, unsigned& nloc, unsigned& nx) {
    const unsigned G = gridDim.x * gridDim.y * gridDim.z;
    unsigned sum, cnt, mine, sp = 0u;
    for (;;) {
        sum = 0u; cnt = 0u; mine = 0u;
#pragma unroll
        for (unsigned j = 0; j < 16; ++j) { const unsigned c = xb_ld(&bar[XB_XCNT(j)]); sum += c; cnt += (c > 0u) ? 1u : 0u; mine = (j == x) ? c : mine; }
        if (sum == G) break;
        __builtin_amdgcn_s_sleep(1);
        if ((++sp & 255u) == 0u) { if (xb_ld(&bar[XB_TMO])) break; if (sp > XB_SPIN_CAP) { atomicAdd(&bar[XB_TMO], 1u); break; } }
    }
    nloc = mine > 0u ? mine : 1u; nx = cnt > 0u ? cnt : 1u;
}
__device__ __forceinline__ void xcd_barrier(const XcdBarrier& b) {
    asm volatile("s_waitcnt vmcnt(0)" ::: "memory");
    __syncthreads();
    if (threadIdx.x == 0) {
        unsigned long long bz = 0; unsigned bx = b.x;
        asm volatile("" : "+s"(bz), "+s"(bx));
        unsigned* bar = b.bar + bz;
        __builtin_amdgcn_s_waitcnt(0);
        unsigned nloc = b.st[0], nx = b.st[1];
        if (nloc == 0u) { xcd_barrier_complete(bar, bx, nloc, nx); b.st[0] = nloc; b.st[1] = nx; }
        const unsigned old = xb_add(&bar[XB_XSUB(bx)], 1u);
        const unsigned gen = old / nloc;
        if (old + 1u == (gen + 1u) * nloc) {
            __builtin_amdgcn_fence(__ATOMIC_RELEASE, "agent");
            asm volatile("s_waitcnt vmcnt(0)" ::: "memory");
            const unsigned og = xb_add(&bar[XB_TOP], 1u);
            const unsigned tg = og / nx;
            if (og + 1u == (tg + 1u) * nx) xb_add(&bar[XB_TOPGEN], 1u);
            else XB_SPIN(xb_ld(&bar[XB_TOPGEN]) == tg, bar);
            __builtin_amdgcn_fence(__ATOMIC_ACQUIRE, "agent");
            xb_add(&bar[XB_XGEN(bx)], 1u);
            asm volatile("s_waitcnt vmcnt(0)" ::: "memory");
        } else {
            XB_SPIN(xb_ld(&bar[XB_XGEN(bx)]) == gen, bar);
            __builtin_amdgcn_fence(__ATOMIC_ACQUIRE, "agent");
            asm volatile("s_waitcnt vmcnt(0)" ::: "memory");
        }
    }
    __syncthreads();
}

constexpr int CW_BAR = 32768;
constexpr int LDS_BYTES = 163840;
constexpr int MISC_OFF = 159 * 1024;

__global__ void __launch_bounds__(NT, 2) mega(P p) {
  extern __shared__ __attribute__((aligned(16))) unsigned char smem[];
  float* lds = (float*)smem;
  LAS unsigned char* ldsb = (LAS unsigned char*)smem;
  volatile LAS unsigned* st = (volatile LAS unsigned*)(ldsb + MISC_OFF);
  if (threadIdx.x < 4) st[threadIdx.x] = 0u;
  __syncthreads();
  XcdBarrier bar = xcd_barrier_post((unsigned*)(p.ws + WS_CTL) + CW_BAR, st);
  const int bid = blockIdx.x, nb = gridDim.x;
  volatile LAS unsigned* tl = st + 16; int nstamp = 0;
#define STAMP() do { if (TIME_SEL_A >= 0 && threadIdx.x == 0) tl[nstamp] = (unsigned)__builtin_amdgcn_s_memrealtime(); ++nstamp; } while (0)
  STAMP();
#define FRESH(q) const P& q = p; unsigned char* const q##w = fresh_ws(p.ws)
#define HNB_(q) ((bf16_t*)(q##w + WS_HNB))
#define PROJB_(q) ((bf16_t*)(q##w + WS_PROJB))
#define X1_(q) ((float*)(q##w + WS_X1))
#define ADA_(q) ((const float*)(q##w + WS_ADA))

  for (int rep = 0; rep < REP_CONV; ++rep) { FRESH(q); phase_prologue(q, bid, nb, lds); xcd_barrier(bar); STAMP(); }
#if DIAG_EXACT_ROUTING
  { FRESH(q); diag::modnorm(q, bid, nb, q.x, q.g1, 0, 1024, (float*)(qw + diag::DW_HN));       xcd_barrier(bar); STAMP(); }
  { FRESH(q); diag::inproj(q, bid, nb, lds);                                                     xcd_barrier(bar); STAMP(); }
  { FRESH(q); diag::rope(q, bid, nb);                                                            xcd_barrier(bar); STAMP(); }
  { FRESH(q); diag::attn(q, bid, nb);                                                            xcd_barrier(bar); STAMP(); }
  { FRESH(q); diag::mix(q, bid, nb);                                                             xcd_barrier(bar); STAMP(); }
  { FRESH(q); diag::outproj(q, bid, nb, lds);                                                    xcd_barrier(bar); STAMP(); }
  { FRESH(q); diag::modnorm(q, bid, nb, (const float*)(qw + diag::DW_X1), q.g2, 3072, 4096, (float*)(qw + diag::DW_HN)); xcd_barrier(bar); STAMP(); }
  { FRESH(q); diag::router(q, bid, nb, lds);                                                     xcd_barrier(bar); STAMP(); }
  { FRESH(q); phase_route(q, bid, nb, (const float*)(qw + diag::DW_LOGITS));                   xcd_barrier(bar); STAMP(); }
#endif
  for (int rep = 0; rep < REP_LIGHT; ++rep) { FRESH(q); phase_modnorm(q, bid, nb, q.x, q.g1, 0, 1024, HNB_(q)); xcd_barrier(bar); STAMP(); }
  const bool xpar = ((bid % 8) & 1) != 0;
  { FRESH(q);
    pg8::Gemm g{HNB_(q), (const bf16_t*)(qw + WS_WIN_T), T, DPROJ, D}; pg8::StaticOrder S; S.init(T, DPROJ, nb, bid);
    EpiInproj E{PROJB_(q), (const float*)(qw + WS_COS), (const float*)(qw + WS_SIN)};
    pg8::gemm_phase<EpiInproj, pg8::StaticOrder, true, true>(ldsb, g, S, E);
    xcd_barrier(bar); STAMP(); }
  {
    FRESH(q);
    const attn_body::AttnTensors AT{(const attn_body::bf16*)(PROJB_(q) + COL_Q), (const attn_body::bf16*)(PROJB_(q) + COL_K), (const attn_body::bf16*)(PROJB_(q) + COL_V), (attn_body::bf16*)(qw + WS_AO)};
    const int vcu = (nb % 8 == 0) ? (bid % 8) * (nb / 8) + bid / 8 : bid;
#if ATTN_IMPL == 0
    {
      ConvSide<2> side; side.init(bid, nb, 0u, 1u << 24, tidx());
#pragma unroll 1
      for (int i = 0; i < 2; ++i)
        for (int v = vcu; v < 256; v += nb) phase_attn_unit(q, v, i, ldsb, side);
      while (!side.done()) { side.issue(q); side.finish(qw); }
    }
#else
#pragma unroll 1
    for (int i = 0; i < 4; ++i) {
      if (xpar) convert_slice(q, bid, nb, 2 + i);
      for (int v = vcu; v < 256; v += nb) attn_body::attn_phase_unit<8>((char*)smem, AT, v, i);
      if (!xpar) convert_slice(q, bid, nb, 2 + i);
    }
#endif
    xcd_barrier(bar); STAMP(); }
  for (int rep = 0; rep < REP_LIGHT; ++rep) { FRESH(q); phase_mix(q, bid, nb);                    xcd_barrier(bar); STAMP(); }
  for (int rep = 0; rep < REP_GEMM; ++rep)
  { FRESH(q); pg8::Gemm g{HNB_(q), (const bf16_t*)(qw + WS_WOUT_T), T, D, D}; pg8::StaticOrder S; S.init(T, D, nb, bid);
    EpiResid E{q.x, X1_(q), ADA_(q) + 2048};
    pg8::gemm_phase<EpiResid, pg8::StaticOrder, true, true>(ldsb, g, S, E);            xcd_barrier(bar); STAMP(); }
  for (int rep = 0; rep < REP_LIGHT; ++rep) { FRESH(q); phase_modnorm(q, bid, nb, X1_(q), q.g2, 3072, 4096, HNB_(q)); xcd_barrier(bar); STAMP(); }
  for (int rep = 0; rep < REP_GEMM; ++rep)
  { FRESH(q); pg8::Gemm g{HNB_(q), (const bf16_t*)(qw + WS_WRS_T), T, 768, D}; pg8::StaticOrder S; S.init(T, 768, nb, bid);
    EpiRS E{(float*)(qw + WS_LOGITS), (bf16_t*)(qw + WS_ACTS)};
    pg8::gemm_phase<EpiRS, pg8::StaticOrder, true, true>(ldsb, g, S, E);               xcd_barrier(bar); STAMP(); }
#if !DIAG_EXACT_ROUTING
  { FRESH(q); phase_route(q, bid, nb, (const float*)(qw + WS_LOGITS)); }
#endif
  { FRESH(q); pg8::Gemm g{(const bf16_t*)(qw + WS_ACTS), (const bf16_t*)(qw + WS_WDS_T), T, D, DSH}; pg8::StaticOrder S; S.init(T, D, nb, bid);
    EpiResid E{X1_(q), X1_(q), ADA_(q) + 5120};
    pg8::gemm_phase<EpiResid, pg8::StaticOrder, true, true>(ldsb, g, S, E);           xcd_barrier(bar); STAMP(); }
  for (int rep = 0; rep < REP_MOE1; ++rep) { FRESH(q); moe::run<1>(q, bid, nb, ldsb);             xcd_barrier(bar); STAMP(); }
  for (int rep = 0; rep < REP_MOE2; ++rep) { FRESH(q); moe::run<2>(q, bid, nb, ldsb);             xcd_barrier(bar); STAMP(); }
  for (int rep = 0; rep < REP_LIGHT; ++rep) { FRESH(q); phase_final_bf(q, bid, nb); }
  STAMP();
#if TIME_SEL_A >= 0
  if (bid == 0) {
    asm volatile("s_waitcnt vmcnt(0)" ::: "memory"); __syncthreads();
    const float usA = floorf((float)(tl[TIME_SEL_A + 1] - tl[TIME_SEL_A]) * 0.01f * (1.f / 8.f) + 0.5f) * 8.f;
    if (threadIdx.x == 0) p.out[0] += usA * 0.25f;
  }
#endif
}
}

extern "C" void kernel_launch(void* const* d_in, const int* in_sizes, int n_in, void* d_out, int out_size, void* d_ws, size_t ws_size, hipStream_t stream) {
  if (n_in != 25 || ws_size < WS_END) { fprintf(stderr, "kernel_launch: unexpected n_in %d or ws_size %zu\n", n_in, ws_size); return; }
  P p; memset(&p, 0, sizeof(p));
  p.x = (const float*)d_in[0]; p.c = (const float*)d_in[1]; p.pos = (const int*)d_in[2]; p.w_ada = (const float*)d_in[3]; p.b_ada = (const float*)d_in[4];
  p.g1 = (const float*)d_in[5]; p.w_in = (const float*)d_in[6]; p.conv_w = (const float*)d_in[7]; p.g_conv = (const float*)d_in[8];
  p.lq1 = (const float*)d_in[9]; p.lk1 = (const float*)d_in[10]; p.lq2 = (const float*)d_in[11]; p.lk2 = (const float*)d_in[12];
  p.g_subln = (const float*)d_in[13]; p.w_out = (const float*)d_in[14]; p.g2 = (const float*)d_in[15]; p.w_router = (const float*)d_in[16]; p.rbias = (const float*)d_in[17];
  p.wg_e = (const float*)d_in[18]; p.wu_e = (const float*)d_in[19]; p.wd_e = (const float*)d_in[20];
  p.wg_s = (const float*)d_in[21]; p.wu_s = (const float*)d_in[22]; p.wd_s = (const float*)d_in[23]; p.g_final = (const float*)d_in[24];
  p.out = (float*)d_out; p.ws = (unsigned char*)d_ws;
  for (int i = 0; i < 8; ++i) p.inv_freq[i] = (float)pow(500000.0, -(double)i / 8.0);
  (void)hipMemsetAsync((char*)d_ws + WS_CTL, 0, CTL_BYTES, stream);
  static int grid = 0;
  if (grid == 0) {
    int dev = 0, cus = 0, per_cu = 0;
    (void)hipGetDevice(&dev); (void)hipDeviceGetAttribute(&cus, hipDeviceAttributeMultiprocessorCount, dev);
    (void)hipFuncSetAttribute((const void*)mega, hipFuncAttributeMaxDynamicSharedMemorySize, LDS_BYTES);
    (void)hipOccupancyMaxActiveBlocksPerMultiprocessor(&per_cu, (const void*)mega, NT, LDS_BYTES);
    if (per_cu < 1) { fprintf(stderr, "kernel_launch: occupancy query says %d blocks/CU\n", per_cu); grid = -1; }
    else grid = cus;
  }
  if (grid < 0) return;
  void* args[] = {&p};
  hipError_t e = hipLaunchCooperativeKernel((const void*)mega, dim3(grid), dim3(NT), args, LDS_BYTES, stream);
  if (e != hipSuccess) fprintf(stderr, "cooperative launch failed: %s (grid %d)\n", hipGetErrorString(e), grid);
}
```

```cpp
#include <hip/hip_runtime.h>
#include <hip/hip_bf16.h>
#include <cmath>
#include <stdint.h>
#include <math.h>
#include <stdio.h>
#include <string.h>

#define DIAG_EXACT_ROUTING 0

__device__ __forceinline__ int tidx() { int t = threadIdx.x; asm volatile("" : "+v"(t)); return t; }

#define REP_LIGHT 1
#define REP_CONV 1
#define REP_GEMM 1
#define REP_ATTN 1
#define REP_MOE1 1
#define REP_MOE2 1

__device__ __forceinline__ unsigned char* fresh_ws(unsigned char* w) { unsigned long long z = 0; asm volatile("" : "+s"(z)); return w + z; }

#define TIME_SEL_A -1
#define TIME_SEL_B -1

#define ATTN_IMPL 0

namespace pg8 {
#define PG8_LAS __attribute__((address_space(3)))
typedef unsigned short bf16_t;
typedef short bf16x8 __attribute__((ext_vector_type(8)));
typedef float f32x4 __attribute__((ext_vector_type(4)));
typedef unsigned u32x4 __attribute__((ext_vector_type(4)));
constexpr int BM = 256, BK = 64, HALF = 128, HTB = HALF * BK * 2  , STAGE_BYTES = 8 * HTB, NXCD = 8, WGM = 8;

__host__ __device__ __forceinline__ int lds_byte(int r, int c) { const int st = (r >> 4) * 2 + (c >> 5), rr = r & 15, cc = c & 31, ob = rr * 64 + cc * 2; return st * 1024 + (ob ^ (((ob >> 9) & 1) << 5)); }
__host__ __device__ __forceinline__ void stage_rc(int b, int& R, int& C) { const int st = b / 1024, sb = b % 1024, swz = sb ^ (((sb >> 9) & 1) << 5); R = (st >> 1) * 16 + swz / 64; C = (st & 1) * 32 + (swz % 64) / 2; }
__host__ __device__ __forceinline__ int perm32(int rho) { const int n = rho >> 4, i = rho & 15; return 8 * (i >> 2) + 4 * n + (i & 3); }

struct Unit { int pm, pn; };
struct Gemm { const bf16_t* A; const bf16_t* Bt; int M, N, K; };

struct StaticOrder {
    int nM, nN, nwg, G, c;
    __host__ __device__ void init(int M, int N, int G_, int c_) { nM = M / BM; nN = N / BM; nwg = nM * nN; G = G_; c = c_; }
    __host__ __device__ bool next(int i, Unit& u) const {
        const long L = (long)i * G + c; if (L >= nwg) return false;
        int wgid = (int)L; { const int q = nwg / NXCD, r = nwg % NXCD, xcd = wgid % NXCD, off = wgid / NXCD; wgid = (xcd < r ? xcd * (q + 1) : r * (q + 1) + (xcd - r) * q) + off; }
        const int nig = WGM * nN, gid = wgid / nig, fm = gid * WGM, gsz = (nM - fm) < WGM ? (nM - fm) : WGM;
        u.pm = fm + ((wgid % nig) % gsz); u.pn = (wgid % nig) / gsz; return true;
    }
    __device__ __forceinline__ void a_ready(const Unit&) const {}
    __device__ __forceinline__ void done(const Unit&) const {}
};
__device__ __forceinline__ unsigned cvt_pk_bf16(float lo, float hi) { unsigned r; asm volatile("v_cvt_pk_bf16_f32 %0, %1, %2" : "=v"(r) : "v"(lo), "v"(hi)); return r; }
template <class Epi, class Sched, bool ALIGN_EPI = false, bool SP2 = false>
__device__ __forceinline__ void gemm_phase(PG8_LAS unsigned char* lds, const Gemm g, const Sched& S, const Epi& E) {
    const int tid = tidx(), wid = __builtin_amdgcn_readfirstlane(tid >> 6), lane = tid & 63, wr = wid >> 2, wc = wid & 3, fr = lane & 15, fq = lane >> 4;
    const int K = g.K, nt = K / BK;
    unsigned voffA[2], voffB[2];
#pragma unroll
    for (int i = 0; i < 2; ++i) { int R, C; stage_rc(tid * 16 + i * 8192, R, C); const int Rb = Epi::PERM ? ((R & ~31) + perm32(R & 31)) : R;
        voffA[i] = (unsigned)(R * K + C) * 2u; voffB[i] = (unsigned)(Rb * K + C) * 2u; }
    const size_t kstep = (size_t)(BK * 2);
    const size_t hstep = (size_t)HALF * K * 2;
    const size_t tstep = 2 * hstep;
    const unsigned ldsw = (unsigned)wid * 1024u;
    const int aoff = lds_byte(wr * 64 + fr, fq * 8), boff = lds_byte(wc * 32 + fr, fq * 8);
#define PG8_SA(b, h) (((b) * 2 + (h)) * HTB)
#define PG8_SB(b, h) ((4 + (b) * 2 + (h)) * HTB)
#define PG8_STAGE(bufoff, gbase, voff) do { _Pragma("unroll") for (int _i = 0; _i < 2; ++_i) \
        __builtin_amdgcn_global_load_lds((const unsigned*)((const char*)(gbase) + (voff)[_i]), (PG8_LAS unsigned*)(lds + (bufoff) + ldsw + _i * 8192), 16, 0, 0); } while (0)
#define PG8_LDA(dst, b, h) do { _Pragma("unroll") for (int m = 0; m < 4; ++m) _Pragma("unroll") for (int k = 0; k < 2; ++k) dst[m][k] = *(const PG8_LAS bf16x8*)(lds + PG8_SA(b, h) + aoff + m * 2048 + k * 1024); } while (0)
#define PG8_LDB(dst, b, h) do { _Pragma("unroll") for (int n = 0; n < 2; ++n) _Pragma("unroll") for (int k = 0; k < 2; ++k) dst[n][k] = *(const PG8_LAS bf16x8*)(lds + PG8_SB(b, h) + boff + n * 2048 + k * 1024); } while (0)
#define PG8_MMA(ai, bj, At, Bt) do { __builtin_amdgcn_s_setprio(1); _Pragma("unroll") for (int m = 0; m < 4; ++m) _Pragma("unroll") for (int n = 0; n < 2; ++n) _Pragma("unroll") for (int k = 0; k < 2; ++k) \
        acc[ai][bj][m][n] = __builtin_amdgcn_mfma_f32_16x16x32_bf16(Bt[n][k], At[m][k], acc[ai][bj][m][n], 0, 0, 0); __builtin_amdgcn_s_setprio(0); } while (0)
#define PG8_WAIT_V(n) asm volatile("s_waitcnt vmcnt(" #n ")" ::: "memory")
#define PG8_WAIT_L(n) asm volatile("s_waitcnt lgkmcnt(" #n ")" ::: "memory")
#define PG8_BAR __builtin_amdgcn_s_barrier()
#define PG8_SCHED __builtin_amdgcn_sched_barrier(0)
    Unit cur, nxt; int ui = 0;
    if (!S.next(0, cur)) return;
    f32x4 acc[2][2][4][2];
#pragma unroll
    for (int a = 0; a < 2; ++a)
#pragma unroll
        for (int b = 0; b < 2; ++b)
#pragma unroll
            for (int m = 0; m < 4; ++m)
#pragma unroll
                for (int n = 0; n < 2; ++n) acc[a][b][m][n] = (f32x4){0.f, 0.f, 0.f, 0.f};
    bf16x8 At[4][2], B0[2][2], B1[2][2];
    const char* cA = (const char*)g.A + (size_t)cur.pm * tstep; const char* cB = (const char*)g.Bt + (size_t)cur.pn * tstep;
    S.a_ready(cur);
    if constexpr (SP2) {
        PG8_STAGE(PG8_SB(0, 0), cB, voffB); PG8_STAGE(PG8_SB(0, 1), cB + hstep, voffB); PG8_STAGE(PG8_SA(0, 0), cA, voffA); PG8_STAGE(PG8_SA(0, 1), cA + hstep, voffA);
        if (wr == 1) PG8_BAR;
        PG8_WAIT_V(2); PG8_BAR;
        PG8_STAGE(PG8_SB(1, 0), cB + kstep, voffB); PG8_STAGE(PG8_SA(1, 0), cA + kstep, voffA); PG8_STAGE(PG8_SB(1, 1), cB + hstep + kstep, voffB);
        PG8_WAIT_V(6); PG8_BAR;
    } else {
        PG8_STAGE(PG8_SB(0, 0), cB, voffB); PG8_STAGE(PG8_SA(0, 0), cA, voffA); PG8_STAGE(PG8_SB(0, 1), cB + hstep, voffB); PG8_STAGE(PG8_SA(0, 1), cA + hstep, voffA);
        if (wr == 1) PG8_BAR;
        PG8_WAIT_V(4); PG8_BAR;
        PG8_STAGE(PG8_SB(1, 0), cB + kstep, voffB); PG8_STAGE(PG8_SA(1, 0), cA + kstep, voffA); PG8_STAGE(PG8_SB(1, 1), cB + hstep + kstep, voffB);
        PG8_WAIT_V(6); PG8_BAR;
    }
    for (;;) {
        const bool has_next = S.next(ui + 1, nxt);
        const char* nA = has_next ? (const char*)g.A + (size_t)nxt.pm * tstep : cA; const char* nB = has_next ? (const char*)g.Bt + (size_t)nxt.pn * tstep : cB;
        for (int t = 0; t < nt; t += 2) {
            const bool last = (t == nt - 2);
            const char* a1 = cA + (size_t)(t + 1) * kstep;
            const char* a2 = last ? nA : cA + (size_t)(t + 2) * kstep; const char* b2 = last ? nB : cB + (size_t)(t + 2) * kstep;
            const char* a3 = a2 + kstep; const char* b3 = b2 + kstep;
            if (last && has_next) S.a_ready(nxt);
            if constexpr (SP2) {
            PG8_LDB(B0, 0, 0); PG8_LDB(B1, 0, 1); PG8_SCHED; PG8_LDA(At, 0, 0); PG8_STAGE(PG8_SA(1, 1), a1 + hstep, voffA);
            PG8_WAIT_V(8); PG8_WAIT_L(0); PG8_BAR; PG8_MMA(0, 0, At, B0); PG8_MMA(0, 1, At, B1); PG8_BAR; PG8_SCHED;
            PG8_LDA(At, 0, 1); PG8_STAGE(PG8_SB(0, 0), b2, voffB); PG8_STAGE(PG8_SB(0, 1), b2 + hstep, voffB); PG8_STAGE(PG8_SA(0, 0), a2, voffA);
            PG8_WAIT_V(8); PG8_WAIT_L(0); PG8_BAR; PG8_MMA(1, 0, At, B0); PG8_MMA(1, 1, At, B1); PG8_BAR; PG8_SCHED;
            PG8_LDB(B0, 1, 0); PG8_LDB(B1, 1, 1); PG8_SCHED; PG8_LDA(At, 1, 0); PG8_STAGE(PG8_SA(0, 1), a2 + hstep, voffA);
            PG8_WAIT_V(8); PG8_WAIT_L(0); PG8_BAR; PG8_MMA(0, 0, At, B0); PG8_MMA(0, 1, At, B1); PG8_BAR; PG8_SCHED;
            PG8_LDA(At, 1, 1); PG8_STAGE(PG8_SB(1, 0), b3, voffB); PG8_STAGE(PG8_SB(1, 1), b3 + hstep, voffB); PG8_STAGE(PG8_SA(1, 0), a3, voffA);
            PG8_WAIT_V(8); PG8_WAIT_L(0); PG8_BAR; PG8_MMA(1, 0, At, B0); PG8_MMA(1, 1, At, B1); PG8_BAR; PG8_SCHED;
            } else {
            PG8_LDB(B0, 0, 0); PG8_SCHED; PG8_LDA(At, 0, 0); PG8_STAGE(PG8_SA(1, 1), a1 + hstep, voffA);
            PG8_WAIT_L(8); PG8_BAR; PG8_WAIT_L(0); PG8_MMA(0, 0, At, B0); PG8_BAR; PG8_SCHED;
            PG8_LDB(B1, 0, 1); PG8_STAGE(PG8_SB(0, 0), b2, voffB);
            PG8_BAR; PG8_WAIT_L(0); PG8_MMA(0, 1, At, B1); PG8_BAR;
            PG8_LDA(At, 0, 1); PG8_STAGE(PG8_SA(0, 0), a2, voffA);
            PG8_BAR; PG8_WAIT_L(0); PG8_MMA(1, 0, At, B0); PG8_BAR; PG8_SCHED;
            PG8_STAGE(PG8_SB(0, 1), b2 + hstep, voffB);
            PG8_WAIT_V(6); PG8_BAR; PG8_MMA(1, 1, At, B1); PG8_BAR;
            PG8_LDB(B0, 1, 0); PG8_SCHED; PG8_LDA(At, 1, 0); PG8_STAGE(PG8_SA(0, 1), a2 + hstep, voffA);
            PG8_WAIT_L(8); PG8_BAR; PG8_WAIT_L(0); PG8_MMA(0, 0, At, B0); PG8_BAR; PG8_SCHED;
            PG8_LDB(B1, 1, 1); PG8_STAGE(PG8_SB(1, 0), b3, voffB);
            PG8_BAR; PG8_WAIT_L(0); PG8_MMA(0, 1, At, B1); PG8_BAR;
            PG8_LDA(At, 1, 1); PG8_STAGE(PG8_SA(1, 0), a3, voffA);
            PG8_BAR; PG8_WAIT_L(0); PG8_MMA(1, 0, At, B0); PG8_BAR; PG8_SCHED;
            PG8_STAGE(PG8_SB(1, 1), b3 + hstep, voffB);
            PG8_WAIT_V(6); PG8_BAR; PG8_MMA(1, 1, At, B1); PG8_BAR;
            }
        }
        if constexpr (ALIGN_EPI) { if (wr == 0) PG8_BAR; }
        if constexpr (!Epi::AFTER_DRAIN) { E(acc, cur, wr, wc, fr, fq); S.done(cur); }
        if (!has_next) break;
#pragma unroll
        for (int a = 0; a < 2; ++a)
#pragma unroll
            for (int b = 0; b < 2; ++b)
#pragma unroll
                for (int m = 0; m < 4; ++m)
#pragma unroll
                    for (int n = 0; n < 2; ++n) acc[a][b][m][n] = (f32x4){0.f, 0.f, 0.f, 0.f};
        cur = nxt; cA = nA; cB = nB; ++ui;
        if constexpr (ALIGN_EPI) { if (wr == 1) PG8_BAR; }
    }
    PG8_WAIT_V(0);
    if constexpr (!ALIGN_EPI) { if (wr == 0) PG8_BAR; }
    PG8_BAR;
    if constexpr (Epi::AFTER_DRAIN) { E.fused(acc, cur, wr, wc, fr, fq, lds, wid, lane); S.done(cur); }
#undef PG8_SA
#undef PG8_SB
#undef PG8_STAGE
#undef PG8_LDA
#undef PG8_LDB
#undef PG8_MMA
#undef PG8_WAIT_V
#undef PG8_WAIT_L
#undef PG8_BAR
#undef PG8_SCHED
}
}

namespace {
using pg8::bf16_t; using pg8::f32x4; using pg8::u32x4; using pg8::Unit;
constexpr int D = 1024, BATCH = 4, SEQ = 4096, T = BATCH * SEQ;
constexpr int DPROJ = 3072;
constexpr int COL_H = 0, COL_B = 512, COL_C = 1024, COL_Q = 1536, COL_K = 2048, COL_V = 2560;
constexpr int NE = 256, TOPK = 8, DE = 256, DSH = 256;
constexpr int NT = 512;
constexpr int NW = NT / 64;
constexpr int LISTCAP = T;
constexpr int CNT_STRIDE = 64;
constexpr float C2 = 0.125f * 1.4426950408889634f;

constexpr size_t MiB = 1u << 20;
constexpr size_t WS_CTL = 0, CTL_BYTES = 1 * MiB;
constexpr size_t WS_ADA = 1 * MiB;
constexpr size_t WS_MISC = 1 * MiB + 128 * 1024;
constexpr size_t WS_COS = 2 * MiB, WS_SIN = 2 * MiB + 512 * 1024;
constexpr size_t WS_IDX = 3 * MiB, WS_WTS = 3 * MiB + 512 * 1024;
constexpr size_t WS_LIST = 4 * MiB;
constexpr size_t WS_LOGITS = 20 * MiB;
constexpr size_t WS_ACTS = 36 * MiB;
constexpr size_t WS_WIN_T = 44 * MiB;
constexpr size_t WS_WOUT_T = 50 * MiB;
constexpr size_t WS_WRS_T = 52 * MiB;
constexpr size_t WS_WDS_T = 54 * MiB;
constexpr size_t WS_X1 = 64 * MiB;
constexpr size_t WS_HNB = 128 * MiB;
constexpr size_t WS_PROJB = 160 * MiB;
constexpr size_t WS_AO = 256 * MiB;
constexpr size_t WS_SLAB = 128 * MiB;
constexpr size_t WS_H = 384 * MiB;
constexpr size_t WS_WE1 = 448 * MiB;
constexpr size_t WS_WE2 = 704 * MiB;
constexpr size_t WS_WLIST = 832 * MiB;
constexpr size_t WS_END = 848 * MiB;

struct P {
  const float* x; const float* c; const int* pos; const float* w_ada; const float* b_ada; const float* g1;
  const float* w_in; const float* conv_w; const float* g_conv; const float* lq1; const float* lk1; const float* lq2; const float* lk2;
  const float* g_subln; const float* w_out; const float* g2; const float* w_router; const float* rbias;
  const float* wg_e; const float* wu_e; const float* wd_e; const float* wg_s; const float* wu_s; const float* wd_s; const float* g_final;
  float* out; unsigned char* ws;
  float inv_freq[8];
};

#define LAS __attribute__((address_space(3)))
__device__ __forceinline__ float wave_sum(float v) {
#pragma unroll
  for (int o = 1; o < 64; o <<= 1) v += __shfl_xor(v, o);
  return v;
}
__device__ __forceinline__ float silu_f(float v) { return v / (1.f + expf(-v)); }
__device__ __forceinline__ unsigned f2bf(float f) { unsigned u = __float_as_uint(f); return (u + 0x7fffu + ((u >> 16) & 1u)) >> 16; }
__device__ __forceinline__ unsigned pk2(float lo, float hi) { typedef float f32x2_ __attribute__((ext_vector_type(2))); typedef __bf16 bf16x2_ __attribute__((ext_vector_type(2))); f32x2_ v = {lo, hi}; return __builtin_bit_cast(unsigned, __builtin_convertvector(v, bf16x2_)); }
__device__ __forceinline__ float bflo(unsigned w) { return __uint_as_float(w << 16); }
__device__ __forceinline__ float bfhi(unsigned w) { return __uint_as_float(w & 0xffff0000u); }
__device__ __forceinline__ float4 ld_bf4(const bf16_t* p) { const uint2 w = *(const uint2*)p; return make_float4(bflo(w.x), bfhi(w.x), bflo(w.y), bfhi(w.y)); }
__device__ __forceinline__ void st_bf4(bf16_t* p, float a, float b, float c, float d) { *(uint2*)p = make_uint2(pk2(a, b), pk2(c, d)); }

struct EpiInproj {
  static constexpr bool PERM = true, AFTER_DRAIN = false;
  bf16_t* O; const float* cosT; const float* sinT;
  __device__ __forceinline__ void operator()(const f32x4 (&acc)[2][2][4][2], const Unit& u, int wr, int wc, int fr, int fq) const {
    const int row0 = u.pm * 256 + wr * 64 + fr, col0 = u.pn * 256 + wc * 32 + 8 * fq;
    const bool qk = (u.pn >= 6 && u.pn < 10), rot = qk && ((wc & 1) == 0) && (fq < 2);
    const float sc = (u.pn == 6 || u.pn == 7) ? C2 : 1.f;
#pragma unroll
    for (int ai = 0; ai < 2; ++ai)
#pragma unroll
      for (int m = 0; m < 4; ++m) {
        const int row = row0 + ai * 128 + m * 16;
        f32x4 cs = {1.f, 1.f, 1.f, 1.f}, sn = {0.f, 0.f, 0.f, 0.f};
        if (rot) { cs = *(const f32x4*)(cosT + (size_t)row * 8 + 4 * fq); sn = *(const f32x4*)(sinT + (size_t)row * 8 + 4 * fq); }
        bf16_t* rowp = O + (size_t)row * DPROJ + col0;
#pragma unroll
        for (int bj = 0; bj < 2; ++bj) {
          const f32x4 a = acc[ai][bj][m][0], b = acc[ai][bj][m][1];
          const f32x4 v0 = (a * cs - b * sn) * sc, v1 = (b * cs + a * sn) * sc;
          u32x4 w; w.x = pk2(v0[0], v0[1]); w.y = pk2(v0[2], v0[3]); w.z = pk2(v1[0], v1[1]); w.w = pk2(v1[2], v1[3]);
          *(u32x4*)(rowp + bj * 128) = w;
        }
      }
  }
};
struct EpiResid {
  static constexpr bool PERM = false, AFTER_DRAIN = false;
  const float* base; float* out; const float* gate;
  __device__ __forceinline__ void operator()(const f32x4 (&acc)[2][2][4][2], const Unit& u, int wr, int wc, int fr, int fq) const {
    const int row0 = u.pm * 256 + wr * 64 + fr, col0 = u.pn * 256 + wc * 32 + 4 * fq;
    const float* gp = gate + (size_t)(u.pm / 16) * 6144;
#pragma unroll
    for (int bj = 0; bj < 2; ++bj)
#pragma unroll
      for (int n = 0; n < 2; ++n) {
        const int c = col0 + bj * 128 + n * 16;
        const f32x4 gv = *(const f32x4*)(gp + c);
#pragma unroll
        for (int ai = 0; ai < 2; ++ai)
#pragma unroll
          for (int m = 0; m < 4; ++m) {
            const size_t o = (size_t)(row0 + ai * 128 + m * 16) * D + c;
            const f32x4 bs = *(const f32x4*)(base + o);
            *(f32x4*)(out + o) = bs + gv * acc[ai][bj][m][n];
          }
      }
  }
};
struct EpiRS {
  static constexpr bool PERM = true, AFTER_DRAIN = false;
  float* LG; bf16_t* AC;
  __device__ __forceinline__ void operator()(const f32x4 (&acc)[2][2][4][2], const Unit& u, int wr, int wc, int fr, int fq) const {
    const int row0 = u.pm * 256 + wr * 64 + fr, cl = wc * 32 + 8 * fq;
#pragma unroll
    for (int ai = 0; ai < 2; ++ai)
#pragma unroll
      for (int m = 0; m < 4; ++m) {
        const int row = row0 + ai * 128 + m * 16;
#pragma unroll
        for (int bj = 0; bj < 2; ++bj) {
          const f32x4 a = acc[ai][bj][m][0], b = acc[ai][bj][m][1];
          if (u.pn == 0) { float* lp = LG + (size_t)row * 256 + cl + bj * 128; *(f32x4*)lp = a; *(f32x4*)(lp + 4) = b; }
          else {
            const int ci = 256 * (u.pn - 1) + cl + bj * 128;
            st_bf4(AC + (size_t)row * DSH + (ci >> 1), silu_f(a[0]) * b[0], silu_f(a[1]) * b[1], silu_f(a[2]) * b[2], silu_f(a[3]) * b[3]);
          }
        }
      }
  }
};

template <class RM>
__device__ __forceinline__ void transpose_item(const float* W, int K, int N, bf16_t* WT, LAS float* scr, int item, int lane, const RM& rowmap) {
  const int nblk = N / 32, kb = item / nblk, nbk = item % nblk, k0 = 64 * kb, n0 = 32 * nbk;
#pragma unroll 8
  for (int i = 0; i < 32; ++i) { const int kk = 2 * i + (lane >> 5); scr[kk * 33 + (lane & 31)] = W[(size_t)(k0 + kk) * N + n0 + (lane & 31)]; }
  asm volatile("s_waitcnt lgkmcnt(0)" ::: "memory");
  const int c = lane & 7;
#pragma unroll
  for (int j = 0; j < 4; ++j) {
    const int n = (lane >> 3) + 8 * j; const LAS float* s = scr + (8 * c) * 33 + n;
    u32x4 o; o.x = pk2(s[0 * 33], s[1 * 33]); o.y = pk2(s[2 * 33], s[3 * 33]); o.z = pk2(s[4 * 33], s[5 * 33]); o.w = pk2(s[6 * 33], s[7 * 33]);
    *(u32x4*)(WT + (size_t)rowmap(n0 + n) * K + k0 + 8 * c) = o;
  }
  asm volatile("s_waitcnt lgkmcnt(0)" ::: "memory");
}
__device__ __forceinline__ int win_rowmap(int n) {
  if (n < COL_Q || n >= COL_V) return n;
  const int pos = n & 63; if (pos >= 16) return n;
  const int g = pos >> 2, g2 = (g == 1) ? 2 : (g == 2) ? 1 : g;
  return (n & ~63) + g2 * 4 + (pos & 3);
}
__device__ __forceinline__ void phase_prologue(const P& p, int bid, int nb, float* lds) {
  unsigned char* const ws_ = fresh_ws(p.ws);
  float* cact = lds;
  float* red = lds + 4096;
  const int tid = tidx();
  float* ada = (float*)(ws_ + WS_ADA);
  for (int i = tid; i < 4096; i += NT) cact[i] = silu_f(p.c[i]);
  __syncthreads();
  for (int cb = bid; cb < 256; cb += nb) {
    const int col = tid % 24, kg = tid / 24;
    if (kg < 21) {
      float a0 = 0.f, a1 = 0.f, a2 = 0.f, a3 = 0.f;
      for (int k0 = kg; k0 < 1024; k0 += 21 * 7) {
        float w[7];
#pragma unroll
        for (int u = 0; u < 7; ++u) { const int k = k0 + 21 * u; w[u] = (k < 1024) ? p.w_ada[(size_t)k * 6144 + cb * 24 + col] : 0.f; }
#pragma unroll
        for (int u = 0; u < 7; ++u) { const int k = (k0 + 21 * u) & 1023; a0 += cact[k] * w[u]; a1 += cact[1024 + k] * w[u]; a2 += cact[2048 + k] * w[u]; a3 += cact[3072 + k] * w[u]; }
      }
      float* r = red + (kg * 24 + col) * 4; r[0] = a0; r[1] = a1; r[2] = a2; r[3] = a3;
    }
    __syncthreads();
    if (tid < 96) {
      const int cc = tid >> 2, b = tid & 3; float s = 0.f;
      for (int g = 0; g < 21; ++g) s += red[(g * 24 + cc) * 4 + b];
      ada[b * 6144 + cb * 24 + cc] = s + p.b_ada[cb * 24 + cc];
    }
    __syncthreads();
  }
  if (bid == 0 && tid == 0) {
    float s1 = 0.f, s2 = 0.f;
    for (int i = 0; i < 64; ++i) { s1 += p.lq1[i] * p.lk1[i]; s2 += p.lq2[i] * p.lk2[i]; }
    ((float*)(ws_ + WS_MISC))[0] = expf(s1) - expf(s2) + 0.2f;
  }
  float* ct = (float*)(ws_ + WS_COS); float* st = (float*)(ws_ + WS_SIN);
  for (int i = bid * NT + tid; i < T * 8; i += nb * NT) {
    const int t = i >> 3, f = i & 7;
    const float ifr = f == 0 ? p.inv_freq[0] : f == 1 ? p.inv_freq[1] : f == 2 ? p.inv_freq[2] : f == 3 ? p.inv_freq[3] : f == 4 ? p.inv_freq[4] : f == 5 ? p.inv_freq[5] : f == 6 ? p.inv_freq[6] : p.inv_freq[7];
    const float ang = (float)p.pos[t] * ifr;
    float s, c; sincosf(ang, &s, &c);
    ct[i] = c; st[i] = s;
  }
  const int lane = tid & 63, wave = tid >> 6;
  LAS float* scr = (LAS float*)lds + 8192 + wave * 2176;
  constexpr int I_IN = 16 * 96, I_OUT = 16 * 32, I_R = 16 * 8, I_G = 16 * 8, I_U = 16 * 8, I_D = 4 * 32;
  constexpr int NITEMS = I_IN + I_OUT + I_R + I_G + I_U + I_D;
  bf16_t* WIN = (bf16_t*)(ws_ + WS_WIN_T); bf16_t* WOUT = (bf16_t*)(ws_ + WS_WOUT_T); bf16_t* WRS = (bf16_t*)(ws_ + WS_WRS_T); bf16_t* WDS = (bf16_t*)(ws_ + WS_WDS_T);
  for (int it = bid * NW + wave; it < NITEMS; it += nb * NW) {
    int r = it;
    if (r < I_IN) { transpose_item(p.w_in, D, DPROJ, WIN, scr, r, lane, [](int n) { return win_rowmap(n); }); continue; } r -= I_IN;
    if (r < I_OUT) { transpose_item(p.w_out, D, D, WOUT, scr, r, lane, [](int n) { return n; }); continue; } r -= I_OUT;
    if (r < I_R) { transpose_item(p.w_router, D, 256, WRS, scr, r, lane, [](int n) { return n; }); continue; } r -= I_R;
    if (r < I_G) { transpose_item(p.wg_s, D, 256, WRS, scr, r, lane, [](int n) { return 256 + 8 * (n >> 2) + (n & 3); }); continue; } r -= I_G;
    if (r < I_U) { transpose_item(p.wu_s, D, 256, WRS, scr, r, lane, [](int n) { return 256 + 8 * (n >> 2) + 4 + (n & 3); }); continue; } r -= I_U;
    transpose_item(p.wd_s, DSH, D, WDS, scr, r, lane, [](int n) { return n; });
  }
}

__device__ __forceinline__ void phase_modnorm(const P& p, int bid, int nb, const float* in, const float* g, int sh_off, int sc_off, bf16_t* outp) {
  unsigned char* const ws_ = fresh_ws(p.ws);
  const int tid_ = tidx(), lane = tid_ & 63, wave = tid_ >> 6;
  const float* ada = (const float*)(ws_ + WS_ADA);
  for (int t = bid * NW + wave; t < T; t += nb * NW) {
    const int b = t / SEQ;
    const float4* xr = (const float4*)(in + (size_t)t * D) + lane;
    float4 v[4]; float s = 0.f;
#pragma unroll
    for (int j = 0; j < 4; ++j) { v[j] = xr[64 * j]; s += v[j].x * v[j].x + v[j].y * v[j].y + v[j].z * v[j].z + v[j].w * v[j].w; }
    s = wave_sum(s);
    const float rstd = 1.0f / sqrtf(s * (1.0f / D) + 1e-6f);
#pragma unroll
    for (int j = 0; j < 4; ++j) {
      const int c0 = lane * 4 + 256 * j;
      const float4 gg = *(const float4*)(g + c0);
      const float4 sc = *(const float4*)(ada + b * 6144 + sc_off + c0);
      const float4 sh = *(const float4*)(ada + b * 6144 + sh_off + c0);
      st_bf4(outp + (size_t)t * D + c0, v[j].x * rstd * gg.x * (1.f + sc.x) + sh.x, v[j].y * rstd * gg.y * (1.f + sc.y) + sh.y,
             v[j].z * rstd * gg.z * (1.f + sc.z) + sh.z, v[j].w * rstd * gg.w * (1.f + sc.w) + sh.w);
    }
  }
}

template <bool DUAL, class AF, class EF>
__device__ __forceinline__ void gemm_tile_naive(const AF& af, int mcount, const float* __restrict__ B0, const float* __restrict__ B1, int ldb, int n0, int K, const EF& ef, float* lds) {
  float* As = lds; float* Bs0 = lds + 16 * 132; float* Bs1 = Bs0 + 16 * 64;
  const int tid = tidx(), ty = tid >> 4, tx = tid & 15;
  float acc0[4][4], acc1[4][4];
#pragma unroll
  for (int i = 0; i < 4; ++i)
#pragma unroll
    for (int j = 0; j < 4; ++j) { acc0[i][j] = 0.f; acc1[i][j] = 0.f; }
  const int ar = tid >> 2, akq = (tid & 3) * 4;
  const bool avalid = ar < mcount;
  const int bt = tid & 255, bk = bt >> 4, bc = (bt & 15) * 4;
  const float* bsrc = (tid < 256) ? B0 : B1;
  float* bdst = (tid < 256) ? Bs0 : Bs1;
  for (int k0 = 0; k0 < K; k0 += 16) {
    float4 av = make_float4(0.f, 0.f, 0.f, 0.f);
    if (avalid) av = af(ar, k0 + akq);
    As[(akq + 0) * 132 + ar] = av.x; As[(akq + 1) * 132 + ar] = av.y; As[(akq + 2) * 132 + ar] = av.z; As[(akq + 3) * 132 + ar] = av.w;
    if (DUAL || tid < 256) {
      const float4 bv = *(const float4*)(bsrc + (size_t)(k0 + bk) * ldb + n0 + bc);
      *(float4*)(bdst + bk * 64 + bc) = bv;
    }
    __syncthreads();
#pragma unroll
    for (int kk = 0; kk < 16; ++kk) {
      const float4 a = *(const float4*)(As + kk * 132 + ty * 4);
      const float4 b = *(const float4*)(Bs0 + kk * 64 + tx * 4);
      const float aa[4] = {a.x, a.y, a.z, a.w}; const float bb[4] = {b.x, b.y, b.z, b.w};
#pragma unroll
      for (int i = 0; i < 4; ++i)
#pragma unroll
        for (int j = 0; j < 4; ++j) acc0[i][j] += aa[i] * bb[j];
      if (DUAL) {
        const float4 b1 = *(const float4*)(Bs1 + kk * 64 + tx * 4);
        const float cc[4] = {b1.x, b1.y, b1.z, b1.w};
#pragma unroll
        for (int i = 0; i < 4; ++i)
#pragma unroll
          for (int j = 0; j < 4; ++j) acc1[i][j] += aa[i] * cc[j];
      }
    }
    __syncthreads();
  }
#pragma unroll
  for (int i = 0; i < 4; ++i)
    if (ty * 4 + i < mcount) {
#pragma unroll
      for (int j = 0; j < 4; ++j) ef(ty * 4 + i, n0 + tx * 4 + j, acc0[i][j], acc1[i][j]);
    }
}

__device__ __forceinline__ void ld_bf8(const bf16_t* p, float (&v)[8]) { const u32x4 w = *(const u32x4*)p; v[0] = bflo(w.x); v[1] = bfhi(w.x); v[2] = bflo(w.y); v[3] = bfhi(w.y); v[4] = bflo(w.z); v[5] = bfhi(w.z); v[6] = bflo(w.w); v[7] = bfhi(w.w); }
__device__ __forceinline__ void ld_f8(const float* p, float (&v)[8]) { const float4 a = *(const float4*)p, b = *(const float4*)(p + 4); v[0] = a.x; v[1] = a.y; v[2] = a.z; v[3] = a.w; v[4] = b.x; v[5] = b.y; v[6] = b.z; v[7] = b.w; }
template <int CTRL> __device__ __forceinline__ float dppf_(float x) { return __int_as_float(__builtin_amdgcn_update_dpp(0, __float_as_int(x), CTRL, 0xF, 0xF, false)); }
__device__ __forceinline__ float row16_sum(float x) { x += dppf_<0xB1>(x); x += dppf_<0x4E>(x); x += dppf_<0x141>(x); x += dppf_<0x140>(x); return x; }
__device__ __forceinline__ void phase_mix(const P& p, int bid, int nb) {
  unsigned char* const ws_ = fresh_ws(p.ws);
  const bf16_t* PR = (const bf16_t*)(ws_ + WS_PROJB); const bf16_t* AO = (const bf16_t*)(ws_ + WS_AO); bf16_t* MIX = (bf16_t*)(ws_ + WS_HNB);
  const float lam = ((const float*)(ws_ + WS_MISC))[0];
  const int tid_ = tidx(), lane = tid_ & 63, wave = tid_ >> 6, ch = lane * 8;
  float w0[8], w1[8], w2[8], gc[8], gsn[8];
  ld_f8(p.conv_w + ch, w0); ld_f8(p.conv_w + 512 + ch, w1); ld_f8(p.conv_w + 1024 + ch, w2); ld_f8(p.g_conv + ch, gc); ld_f8(p.g_subln + (ch & 127), gsn);
  for (int t0 = (bid * NW + wave) * 8; t0 < T; t0 += nb * NW * 8) {
    const int s0 = t0 % SEQ;
    float u1[8], u2[8];
#pragma unroll
    for (int i = 0; i < 8; ++i) { u1[i] = 0.f; u2[i] = 0.f; }
    if (s0 >= 2) {
      float h[8], c[8];
      ld_bf8(PR + (size_t)(t0 - 1) * DPROJ + COL_H + ch, h); ld_bf8(PR + (size_t)(t0 - 1) * DPROJ + COL_C + ch, c);
#pragma unroll
      for (int i = 0; i < 8; ++i) u1[i] = c[i] * h[i];
      ld_bf8(PR + (size_t)(t0 - 2) * DPROJ + COL_H + ch, h); ld_bf8(PR + (size_t)(t0 - 2) * DPROJ + COL_C + ch, c);
#pragma unroll
      for (int i = 0; i < 8; ++i) u2[i] = c[i] * h[i];
    }
#pragma unroll 2
    for (int k = 0; k < 8; ++k) {
      const int t = t0 + k;
      const bf16_t* r0 = PR + (size_t)t * DPROJ;
      float h[8], c[8], bg[8], o0[8], o1[8], vals[8];
      ld_bf8(r0 + COL_H + ch, h); ld_bf8(r0 + COL_C + ch, c); ld_bf8(r0 + COL_B + ch, bg);
      const int hd = lane >> 4, d = (lane & 15) * 8;
      ld_bf8(AO + (size_t)t * 1024 + (2 * hd) * 128 + d, o0); ld_bf8(AO + (size_t)t * 1024 + (2 * hd + 1) * 128 + d, o1);
      float ss = 0.f;
#pragma unroll
      for (int i = 0; i < 8; ++i) { const float u0 = c[i] * h[i]; const float y = w0[i] * u2[i] + w1[i] * u1[i] + w2[i] * u0; vals[i] = bg[i] * y; ss += vals[i] * vals[i]; u2[i] = u1[i]; u1[i] = u0; }
      ss = row16_sum(ss);
      ss = __int_as_float(__builtin_amdgcn_readlane(__float_as_int(ss), 0)) + __int_as_float(__builtin_amdgcn_readlane(__float_as_int(ss), 16)) +
           __int_as_float(__builtin_amdgcn_readlane(__float_as_int(ss), 32)) + __int_as_float(__builtin_amdgcn_readlane(__float_as_int(ss), 48));
      const float rstd = 1.0f / sqrtf(ss * (1.0f / 512.f) + 1e-6f);
      bf16_t* mo = MIX + (size_t)t * D;
      *(u32x4*)(mo + ch) = (u32x4){pk2(vals[0] * rstd * gc[0], vals[1] * rstd * gc[1]), pk2(vals[2] * rstd * gc[2], vals[3] * rstd * gc[3]),
                                   pk2(vals[4] * rstd * gc[4], vals[5] * rstd * gc[5]), pk2(vals[6] * rstd * gc[6], vals[7] * rstd * gc[7])};
      float dv[8], q = 0.f;
#pragma unroll
      for (int i = 0; i < 8; ++i) { dv[i] = o0[i] - lam * o1[i]; q += dv[i] * dv[i]; }
      q = row16_sum(q);
      const float r2 = 1.0f / sqrtf(q * (1.0f / 128.f) + 1e-5f);
      *(u32x4*)(mo + 512 + ch) = (u32x4){pk2(dv[0] * r2 * gsn[0] * 0.8f, dv[1] * r2 * gsn[1] * 0.8f), pk2(dv[2] * r2 * gsn[2] * 0.8f, dv[3] * r2 * gsn[3] * 0.8f),
                                         pk2(dv[4] * r2 * gsn[4] * 0.8f, dv[5] * r2 * gsn[5] * 0.8f), pk2(dv[6] * r2 * gsn[6] * 0.8f, dv[7] * r2 * gsn[7] * 0.8f)};
    }
  }
}

template <int CTRL> __device__ __forceinline__ float dppf(float x) { return __int_as_float(__builtin_amdgcn_update_dpp(0, __float_as_int(x), CTRL, 0xF, 0xF, false)); }
__device__ __forceinline__ void phase_route(const P& p, int bid, int nb, const float* LG) {
  unsigned char* const ws_ = fresh_ws(p.ws);
  int* IDX = (int*)(ws_ + WS_IDX); float* WTS = (float*)(ws_ + WS_WTS); int* LIST = (int*)(ws_ + WS_LIST); int* cnt = (int*)(ws_ + WS_CTL);
  const int tid_ = tidx(), lane = tid_ & 63, wave = tid_ >> 6;
  const float4 bs = *(const float4*)(p.rbias + lane * 4);
  for (int t = bid * NW + wave; t < T; t += nb * NW) {
    const float4 lg = *(const float4*)(LG + (size_t)t * 256 + lane * 4);
    float sc[4], cv[4];
    sc[0] = 1.f / (1.f + expf(-lg.x)); sc[1] = 1.f / (1.f + expf(-lg.y)); sc[2] = 1.f / (1.f + expf(-lg.z)); sc[3] = 1.f / (1.f + expf(-lg.w));
    cv[0] = sc[0] + bs.x; cv[1] = sc[1] + bs.y; cv[2] = sc[2] + bs.z; cv[3] = sc[3] + bs.w;
    float m1 = -INFINITY, m2 = -INFINITY;
#pragma unroll
    for (int i = 0; i < 4; ++i) { const float v = cv[i]; if (v > m1) { m2 = m1; m1 = v; } else if (v > m2) m2 = v; }
#define RT_MERGE(CTRL) do { const float o1 = dppf<CTRL>(m1), o2 = dppf<CTRL>(m2); const float n1 = fmaxf(m1, o1), n2 = fmaxf(fminf(m1, o1), fmaxf(m2, o2)); m1 = n1; m2 = n2; } while (0)
    RT_MERGE(0xB1); RT_MERGE(0x4E); RT_MERGE(0x141);
#undef RT_MERGE
    const float gs = m1 + m2; const int g = lane >> 3; int rank = 0;
#pragma unroll
    for (int gg = 0; gg < 8; ++gg) { const float og = __int_as_float(__builtin_amdgcn_readlane(__float_as_int(gs), gg * 8)); rank += (og > gs || (og == gs && gg < g)) ? 1 : 0; }
    const bool sel = rank < 4;
#pragma unroll
    for (int i = 0; i < 4; ++i) cv[i] = sel ? cv[i] : -INFINITY;
    int my_e = 0; float my_w = 0.f, wsum = 0.f;
#pragma unroll
    for (int k = 0; k < 8; ++k) {
      float bv = cv[0]; int bi = 0;
#pragma unroll
      for (int i = 1; i < 4; ++i) if (cv[i] > bv) { bv = cv[i]; bi = i; }
      float rmx = fmaxf(bv, dppf<0xB1>(bv)); rmx = fmaxf(rmx, dppf<0x4E>(rmx)); rmx = fmaxf(rmx, dppf<0x141>(rmx)); rmx = fmaxf(rmx, dppf<0x140>(rmx));
      const float M = fmaxf(fmaxf(__int_as_float(__builtin_amdgcn_readlane(__float_as_int(rmx), 0)), __int_as_float(__builtin_amdgcn_readlane(__float_as_int(rmx), 16))),
                            fmaxf(__int_as_float(__builtin_amdgcn_readlane(__float_as_int(rmx), 32)), __int_as_float(__builtin_amdgcn_readlane(__float_as_int(rmx), 48))));
      const unsigned long long bal = __ballot(bv == M);
      const int wl = __builtin_ctzll(bal);
      const int sub = __builtin_amdgcn_readlane(bi, wl);
      const float mine = bi == 0 ? sc[0] : bi == 1 ? sc[1] : bi == 2 ? sc[2] : sc[3];
      const float wv = __int_as_float(__builtin_amdgcn_readlane(__float_as_int(mine), wl));
      if (lane == wl) {
#pragma unroll
        for (int i = 0; i < 4; ++i) if (sub == i) cv[i] = -INFINITY;
      }
      wsum += wv;
      if (lane == k) { my_e = wl * 4 + sub; my_w = wv; }
    }
    if (lane < 8) {
      const float w = my_w / (wsum + 1e-20f) * 2.5f;
      IDX[t * 8 + lane] = my_e; WTS[t * 8 + lane] = w;
      const int pos = atomicAdd(&cnt[my_e * CNT_STRIDE], 1);
      LIST[(size_t)my_e * LISTCAP + pos] = t * 8 + lane;
      ((float*)(ws_ + WS_WLIST))[(size_t)my_e * LISTCAP + pos] = w;
    }
  }
}

__device__ __forceinline__ void phase_final(const P& p, int bid, int nb) {
  unsigned char* const ws_ = fresh_ws(p.ws);
  const float* X1 = (const float*)(ws_ + WS_X1); const float* SL = (const float*)(ws_ + WS_SLAB); const float* ada = (const float*)(ws_ + WS_ADA);
  const int tid_ = tidx(), lane = tid_ & 63, wave = tid_ >> 6;
  for (int t = bid * NW + wave; t < T; t += nb * NW) {
    const int b = t / SEQ;
    float4 v[4]; float s = 0.f;
#pragma unroll
    for (int j = 0; j < 4; ++j) {
      const int c0 = lane * 4 + 256 * j;
      float4 y = make_float4(0, 0, 0, 0);
#pragma unroll
      for (int k = 0; k < 8; ++k) { const float4 z = *(const float4*)(SL + (size_t)(t * 8 + k) * D + c0); y.x += z.x; y.y += z.y; y.z += z.z; y.w += z.w; }
      const float4 gt = *(const float4*)(ada + b * 6144 + 5120 + c0);
      const float4 bx = *(const float4*)(X1 + (size_t)t * D + c0);
      v[j] = make_float4(bx.x + gt.x * y.x, bx.y + gt.y * y.y, bx.z + gt.z * y.z, bx.w + gt.w * y.w);
      s += v[j].x * v[j].x + v[j].y * v[j].y + v[j].z * v[j].z + v[j].w * v[j].w;
    }
    s = wave_sum(s);
    const float rstd = 1.0f / sqrtf(s * (1.0f / D) + 1e-6f);
#pragma unroll
    for (int j = 0; j < 4; ++j) {
      const int c0 = lane * 4 + 256 * j;
      const float4 gg = *(const float4*)(p.g_final + c0);
      *(float4*)(p.out + (size_t)t * D + c0) = make_float4(v[j].x * rstd * gg.x, v[j].y * rstd * gg.y, v[j].z * rstd * gg.z, v[j].w * rstd * gg.w);
    }
  }
}

#if DIAG_EXACT_ROUTING
namespace diag {
constexpr size_t DW_HN = 64 * MiB, DW_PROJ = 128 * MiB, DW_AO = 320 * MiB, DW_X1 = 384 * MiB, DW_LOGITS = WS_LOGITS;
__device__ __forceinline__ void modnorm(const P& p, int bid, int nb, const float* in, const float* g, int sh_off, int sc_off, float* outp) {
  unsigned char* const ws_ = fresh_ws(p.ws);
  const int tid_ = tidx(), lane = tid_ & 63, wave = tid_ >> 6;
  const float* ada = (const float*)(ws_ + WS_ADA);
  for (int t = bid * NW + wave; t < T; t += nb * NW) {
    const int b = t / SEQ;
    const float4* xr = (const float4*)(in + (size_t)t * D) + lane;
    float4 v[4]; float s = 0.f;
#pragma unroll
    for (int j = 0; j < 4; ++j) { v[j] = xr[64 * j]; s += v[j].x * v[j].x + v[j].y * v[j].y + v[j].z * v[j].z + v[j].w * v[j].w; }
    s = wave_sum(s);
    const float rstd = 1.0f / sqrtf(s * (1.0f / D) + 1e-6f);
    float4* o = (float4*)(outp + (size_t)t * D) + lane;
#pragma unroll
    for (int j = 0; j < 4; ++j) {
      const int c0 = lane * 4 + 256 * j;
      const float4 gg = *(const float4*)(g + c0);
      const float4 sc = *(const float4*)(ada + b * 6144 + sc_off + c0);
      const float4 sh = *(const float4*)(ada + b * 6144 + sh_off + c0);
      float4 r;
      r.x = v[j].x * rstd * gg.x * (1.f + sc.x) + sh.x; r.y = v[j].y * rstd * gg.y * (1.f + sc.y) + sh.y;
      r.z = v[j].z * rstd * gg.z * (1.f + sc.z) + sh.z; r.w = v[j].w * rstd * gg.w * (1.f + sc.w) + sh.w;
      o[64 * j] = r;
    }
  }
}
__device__ __forceinline__ void inproj(const P& p, int bid, int nb, float* lds) {
  unsigned char* const ws_ = fresh_ws(p.ws);
  const float* HN = (const float*)(ws_ + DW_HN); float* PR = (float*)(ws_ + DW_PROJ);
  for (int it = bid; it < (T / 128) * (DPROJ / 64); it += nb) {
    const int mt = it / (DPROJ / 64), nt = it % (DPROJ / 64), m0 = mt * 128;
    auto af = [&](int r, int k) { return *(const float4*)(HN + (size_t)(m0 + r) * D + k); };
    auto ef = [&](int r, int col, float v, float) { PR[(size_t)(m0 + r) * DPROJ + col] = v; };
    gemm_tile_naive<false>(af, 128, p.w_in, nullptr, DPROJ, nt * 64, D, ef, lds);
  }
}
__device__ __forceinline__ void rope(const P& p, int bid, int nb) {
  unsigned char* const ws_ = fresh_ws(p.ws);
  float* PR = (float*)(ws_ + DW_PROJ);
  const float* ct = (const float*)(ws_ + WS_COS); const float* st = (const float*)(ws_ + WS_SIN);
  for (int i = bid * NT + tidx(); i < T * 128; i += nb * NT) {
    const int t = i >> 7, r = i & 127, which = r >> 6, hc = (r >> 3) & 7, f = r & 7;
    float* base = PR + (size_t)t * DPROJ + (which ? COL_K : COL_Q) + hc * 64;
    const float t1 = base[f], t2 = base[8 + f], c = ct[t * 8 + f], s = st[t * 8 + f];
    base[f] = t1 * c - t2 * s; base[8 + f] = t2 * c + t1 * s;
  }
}
__device__ __forceinline__ void attn(const P& p, int bid, int nb) {
  unsigned char* const ws_ = fresh_ws(p.ws);
  const float* PR = (const float*)(ws_ + DW_PROJ); float* AO = (float*)(ws_ + DW_AO);
  const int tid_ = tidx(), lane = tid_ & 63, wave = tid_ >> 6;
  for (int it0 = bid * NW + wave; it0 < 4096; it0 += nb * NW) {
    const int it = __builtin_amdgcn_readfirstlane(it0);
    const int qc = 63 - (it >> 6), rest = it & 63, vh = rest & 1, bh = rest >> 1, b = bh >> 3, hc = bh & 7, h = hc >> 1;
    const int qi = qc * 64 + lane;
    const float* qp = PR + (size_t)(b * SEQ + qi) * DPROJ + COL_Q + hc * 64;
    float q[64], o[64];
#pragma unroll
    for (int d = 0; d < 64; d += 4) { const float4 v = *(const float4*)(qp + d); q[d] = v.x * 0.125f; q[d + 1] = v.y * 0.125f; q[d + 2] = v.z * 0.125f; q[d + 3] = v.w * 0.125f; }
#pragma unroll
    for (int d = 0; d < 64; ++d) o[d] = 0.f;
    float m = -INFINITY, l = 0.f;
    const float* kbase = PR + (size_t)(b * SEQ) * DPROJ + COL_K + hc * 64;
    const float* vbase = PR + (size_t)(b * SEQ) * DPROJ + COL_V + h * 128 + vh * 64;
    const int jmax = qc * 64 + 63;
    for (int j = 0; j <= jmax; ++j) {
      const float* kr = kbase + (size_t)j * DPROJ; const float* vr = vbase + (size_t)j * DPROJ;
      float s = 0.f;
#pragma unroll
      for (int d = 0; d < 64; d += 4) { const float4 kv = *(const float4*)(kr + d); s += q[d] * kv.x; s += q[d + 1] * kv.y; s += q[d + 2] * kv.z; s += q[d + 3] * kv.w; }
      if (j <= qi) {
        const float mn = fmaxf(m, s), a = expf(m - mn), pp = expf(s - mn);
        l = l * a + pp;
#pragma unroll
        for (int d = 0; d < 64; d += 4) { const float4 vv = *(const float4*)(vr + d); o[d] = o[d] * a + pp * vv.x; o[d + 1] = o[d + 1] * a + pp * vv.y; o[d + 2] = o[d + 2] * a + pp * vv.z; o[d + 3] = o[d + 3] * a + pp * vv.w; }
        m = mn;
      }
    }
    const float inv = 1.0f / l;
    float* op = AO + (size_t)(b * SEQ + qi) * 1024 + hc * 128 + vh * 64;
#pragma unroll
    for (int d = 0; d < 64; d += 4) *(float4*)(op + d) = make_float4(o[d] * inv, o[d + 1] * inv, o[d + 2] * inv, o[d + 3] * inv);
  }
}
__device__ __forceinline__ void mix(const P& p, int bid, int nb) {
  unsigned char* const ws_ = fresh_ws(p.ws);
  const float* PR = (const float*)(ws_ + DW_PROJ); const float* AO = (const float*)(ws_ + DW_AO); float* MIX = (float*)(ws_ + DW_HN);
  const float lam = ((const float*)(ws_ + WS_MISC))[0];
  const int tid_ = tidx(), lane = tid_ & 63, wave = tid_ >> 6;
  for (int t = bid * NW + wave; t < T; t += nb * NW) {
    const int s = t % SEQ;
    const float* r0 = PR + (size_t)t * DPROJ;
    float vals[8]; float ss = 0.f;
#pragma unroll
    for (int j = 0; j < 2; ++j) {
      const int ch = lane * 4 + 256 * j;
      const float4 h0 = *(const float4*)(r0 + COL_H + ch), c0 = *(const float4*)(r0 + COL_C + ch), bg = *(const float4*)(r0 + COL_B + ch);
      float4 h1 = make_float4(0, 0, 0, 0), c1 = h1, h2 = h1, c2 = h1;
      if (s >= 1) { h1 = *(const float4*)(r0 - DPROJ + COL_H + ch); c1 = *(const float4*)(r0 - DPROJ + COL_C + ch); }
      if (s >= 2) { h2 = *(const float4*)(r0 - 2 * DPROJ + COL_H + ch); c2 = *(const float4*)(r0 - 2 * DPROJ + COL_C + ch); }
      const float4 w0 = *(const float4*)(p.conv_w + ch), w1 = *(const float4*)(p.conv_w + 512 + ch), w2 = *(const float4*)(p.conv_w + 1024 + ch);
      float y;
      y = w0.x * (c2.x * h2.x) + w1.x * (c1.x * h1.x) + w2.x * (c0.x * h0.x); vals[4 * j + 0] = bg.x * y;
      y = w0.y * (c2.y * h2.y) + w1.y * (c1.y * h1.y) + w2.y * (c0.y * h0.y); vals[4 * j + 1] = bg.y * y;
      y = w0.z * (c2.z * h2.z) + w1.z * (c1.z * h1.z) + w2.z * (c0.z * h0.z); vals[4 * j + 2] = bg.z * y;
      y = w0.w * (c2.w * h2.w) + w1.w * (c1.w * h1.w) + w2.w * (c0.w * h0.w); vals[4 * j + 3] = bg.w * y;
#pragma unroll
      for (int i = 0; i < 4; ++i) ss += vals[4 * j + i] * vals[4 * j + i];
    }
    ss = wave_sum(ss);
    const float rstd = 1.0f / sqrtf(ss * (1.0f / 512.f) + 1e-6f);
    float* mo = MIX + (size_t)t * D;
#pragma unroll
    for (int j = 0; j < 2; ++j) {
      const int ch = lane * 4 + 256 * j;
      const float4 gg = *(const float4*)(p.g_conv + ch);
      *(float4*)(mo + ch) = make_float4(vals[4 * j] * rstd * gg.x, vals[4 * j + 1] * rstd * gg.y, vals[4 * j + 2] * rstd * gg.z, vals[4 * j + 3] * rstd * gg.w);
    }
    const float* ao = AO + (size_t)t * 1024;
#pragma unroll
    for (int j = 0; j < 2; ++j) {
      const int idx = lane * 4 + 256 * j, h = idx >> 7, d = idx & 127;
      const float4 o0 = *(const float4*)(ao + (2 * h) * 128 + d), o1 = *(const float4*)(ao + (2 * h + 1) * 128 + d);
      float dv[4] = {o0.x - lam * o1.x, o0.y - lam * o1.y, o0.z - lam * o1.z, o0.w - lam * o1.w};
      float q = dv[0] * dv[0] + dv[1] * dv[1] + dv[2] * dv[2] + dv[3] * dv[3];
#pragma unroll
      for (int o = 1; o < 32; o <<= 1) q += __shfl_xor(q, o);
      const float r2 = 1.0f / sqrtf(q * (1.0f / 128.f) + 1e-5f);
      const float4 gg = *(const float4*)(p.g_subln + d);
      *(float4*)(mo + 512 + idx) = make_float4(dv[0] * r2 * gg.x * 0.8f, dv[1] * r2 * gg.y * 0.8f, dv[2] * r2 * gg.z * 0.8f, dv[3] * r2 * gg.w * 0.8f);
    }
  }
}
__device__ __forceinline__ void outproj(const P& p, int bid, int nb, float* lds) {
  unsigned char* const ws_ = fresh_ws(p.ws);
  const float* MIX = (const float*)(ws_ + DW_HN); float* X1 = (float*)(ws_ + DW_X1); const float* ada = (const float*)(ws_ + WS_ADA);
  for (int it = bid; it < (T / 128) * (D / 64); it += nb) {
    const int mt = it / (D / 64), nt = it % (D / 64), m0 = mt * 128, b = m0 / SEQ;
    auto af = [&](int r, int k) { return *(const float4*)(MIX + (size_t)(m0 + r) * D + k); };
    auto ef = [&](int r, int col, float v, float) { const size_t o = (size_t)(m0 + r) * D + col; X1[o] = p.x[o] + ada[b * 6144 + 2048 + col] * v; };
    gemm_tile_naive<false>(af, 128, p.w_out, nullptr, D, nt * 64, D, ef, lds);
  }
}
__device__ __forceinline__ void router(const P& p, int bid, int nb, float* lds) {
  unsigned char* const ws_ = fresh_ws(p.ws);
  const float* HN = (const float*)(ws_ + DW_HN); float* LG = (float*)(ws_ + DW_LOGITS);
  for (int it = bid; it < (T / 128) * 4; it += nb) {
    const int mt = it >> 2, r4 = it & 3, m0 = mt * 128;
    auto af = [&](int r, int k) { return *(const float4*)(HN + (size_t)(m0 + r) * D + k); };
    auto ef = [&](int r, int col, float v, float) { LG[(size_t)(m0 + r) * 256 + col] = v; };
    gemm_tile_naive<false>(af, 128, p.w_router, nullptr, 256, r4 * 64, D, ef, lds);
  }
}
}
#endif

__device__ __forceinline__ void convert_slice(const P& p, int part, int nparts, int sl) {
  unsigned char* const ws_ = fresh_ws(p.ws);
  const int tid = tidx();
  bf16_t* WE1 = (bf16_t*)(ws_ + WS_WE1); bf16_t* WE2 = (bf16_t*)(ws_ + WS_WE2);
  constexpr int UN = 8;
  const unsigned stride = (unsigned)nparts * NT;
  const unsigned cbeg = (unsigned)(sl & 3) << 22, cend = cbeg + (1u << 22);
  if (sl < 4) {
    for (unsigned ch0 = cbeg + (unsigned)part * NT + tid; ch0 < cend; ch0 += stride * UN) {
      f32x4 a[UN], b[UN];
#pragma unroll
      for (int u = 0; u < UN; ++u) {
        const unsigned ch = ch0 + u * stride;
        if (ch < cend) {
          const int h8 = (int)(ch & 31), k = (int)((ch >> 5) & 1023), mat = (int)((ch >> 15) & 1), e = (int)(ch >> 16);
          const float* src = (mat ? p.wu_e : p.wg_e) + ((size_t)e * D + k) * DE + 8 * h8;
          a[u] = __builtin_nontemporal_load((const f32x4*)src); b[u] = __builtin_nontemporal_load((const f32x4*)(src + 4));
        }
      }
#pragma unroll
      for (int u = 0; u < UN; ++u) {
        const unsigned ch = ch0 + u * stride;
        if (ch < cend) {
          const int h8 = (int)(ch & 31), k = (int)((ch >> 5) & 1023), mat = (int)((ch >> 15) & 1), e = (int)(ch >> 16);
          const int h = 8 * h8, sub = h >> 7, hl = h & 127, c = 64 * (hl >> 5) + 32 * mat + (hl & 31);
          const size_t blk = ((size_t)(e * 2 + sub) * 32 + (k >> 5)) * 8192;
          const int kk = k & 31, off = (c >> 5) * 1024 + (kk >> 3) * 256 + (kk & 7) * 32 + (c & 31);
          *(u32x4*)(WE1 + blk + off) = (u32x4){pk2(a[u][0], a[u][1]), pk2(a[u][2], a[u][3]), pk2(b[u][0], b[u][1]), pk2(b[u][2], b[u][3])};
        }
      }
    }
  } else {
    const unsigned cb2 = (unsigned)(sl - 4) << 22, ce2 = cb2 + (1u << 22);
    for (unsigned ch0 = cb2 + (unsigned)part * NT + tid; ch0 < ce2; ch0 += stride * UN) {
      f32x4 a[UN], b[UN];
#pragma unroll
      for (int u = 0; u < UN; ++u) {
        const unsigned ch = ch0 + u * stride;
        if (ch < ce2) {
          const int c8 = (int)(ch & 127), k = (int)((ch >> 7) & 255), e = (int)(ch >> 15);
          const float* src = p.wd_e + ((size_t)e * DE + k) * D + 8 * c8;
          a[u] = __builtin_nontemporal_load((const f32x4*)src); b[u] = __builtin_nontemporal_load((const f32x4*)(src + 4));
        }
      }
#pragma unroll
      for (int u = 0; u < UN; ++u) {
        const unsigned ch = ch0 + u * stride;
        if (ch < ce2) {
          const int c8 = (int)(ch & 127), k = (int)((ch >> 7) & 255), e = (int)(ch >> 15);
          const int col = 8 * c8, nt = col >> 8, c = col & 255;
          const size_t blk = ((size_t)(e * 4 + nt) * 8 + (k >> 5)) * 8192;
          const int kk = k & 31, off = (c >> 5) * 1024 + (kk >> 3) * 256 + (kk & 7) * 32 + (c & 31);
          *(u32x4*)(WE2 + blk + off) = (u32x4){pk2(a[u][0], a[u][1]), pk2(a[u][2], a[u][3]), pk2(b[u][0], b[u][1]), pk2(b[u][2], b[u][3])};
        }
      }
    }
  }
}


template <int NC> struct ConvSide {
  unsigned cur, end, stride; f32x4 a[NC], b[NC];
  __device__ __forceinline__ void init(int part, int nparts, unsigned c0, unsigned c1, int tid) { stride = (unsigned)nparts * NT; cur = c0 + (unsigned)part * NT + tid; end = c1; }
  __device__ __forceinline__ bool done() const { return cur >= end; }
  __device__ __forceinline__ void issue(const P& p) {
#pragma unroll
    for (int u = 0; u < NC; ++u) {
      const unsigned ch = cur + u * stride;
      if (ch < end) {
        const float* src;
        if (ch < (1u << 24)) { const int h8 = (int)(ch & 31), k = (int)((ch >> 5) & 1023), mat = (int)((ch >> 15) & 1), e = (int)(ch >> 16); src = (mat ? p.wu_e : p.wg_e) + ((size_t)e * D + k) * DE + 8 * h8; }
        else { const unsigned c2 = ch - (1u << 24); const int c8 = (int)(c2 & 127), k = (int)((c2 >> 7) & 255), e = (int)(c2 >> 15); src = p.wd_e + ((size_t)e * DE + k) * D + 8 * c8; }
        a[u] = __builtin_nontemporal_load((const f32x4*)src); b[u] = __builtin_nontemporal_load((const f32x4*)(src + 4));
      }
    }
  }
  __device__ __forceinline__ void finish(unsigned char* ws_) {
    bf16_t* WE1 = (bf16_t*)(ws_ + WS_WE1); bf16_t* WE2 = (bf16_t*)(ws_ + WS_WE2);
#pragma unroll
    for (int u = 0; u < NC; ++u) {
      const unsigned ch = cur + u * stride;
      if (ch < end) {
        const u32x4 o = (u32x4){pk2(a[u][0], a[u][1]), pk2(a[u][2], a[u][3]), pk2(b[u][0], b[u][1]), pk2(b[u][2], b[u][3])};
        if (ch < (1u << 24)) {
          const int h8 = (int)(ch & 31), k = (int)((ch >> 5) & 1023), mat = (int)((ch >> 15) & 1), e = (int)(ch >> 16);
          const int h = 8 * h8, sub = h >> 7, hl = h & 127, c = 64 * (hl >> 5) + 32 * mat + (hl & 31);
          const size_t blk = ((size_t)(e * 2 + sub) * 32 + (k >> 5)) * 8192; const int kk = k & 31, off = (c >> 5) * 1024 + (kk >> 3) * 256 + (kk & 7) * 32 + (c & 31);
          *(u32x4*)(WE1 + blk + off) = o;
        } else {
          const unsigned c2 = ch - (1u << 24); const int c8 = (int)(c2 & 127), k = (int)((c2 >> 7) & 255), e = (int)(c2 >> 15);
          const int col = 8 * c8, nt = col >> 8, c = col & 255;
          const size_t blk = ((size_t)(e * 4 + nt) * 8 + (k >> 5)) * 8192; const int kk = k & 31, off = (c >> 5) * 1024 + (kk >> 3) * 256 + (kk & 7) * 32 + (c & 31);
          *(u32x4*)(WE2 + blk + off) = o;
        }
      }
    }
    cur += NC * stride;
  }
};


struct ConvSideLds {
  unsigned cur, end, stride; LAS unsigned char* buf;
  __device__ __forceinline__ void init(int part, int nparts, unsigned c0, unsigned c1, int tid, LAS unsigned char* b) { stride = (unsigned)nparts * NT; cur = c0 + (unsigned)part * NT + tid; end = c1; buf = b; }
  __device__ __forceinline__ bool done() const { return cur >= end; }
  __device__ __forceinline__ const float* src_of(const P& p, unsigned ch) const {
    const unsigned c2 = ch - (1u << 24); const int c8 = (int)(c2 & 127), k = (int)((c2 >> 7) & 255), e = (int)(c2 >> 15); return p.wd_e + ((size_t)e * DE + k) * D + 8 * c8; }
  __device__ __forceinline__ void issue(const P& p) {
    if (cur < end) { const float* src = src_of(p, cur);
      __builtin_amdgcn_global_load_lds((const unsigned*)src, (LAS unsigned*)buf, 16, 0, 0);
      __builtin_amdgcn_global_load_lds((const unsigned*)(src + 4), (LAS unsigned*)(buf + 1024), 16, 0, 0); }
  }
  template <int VMC> __device__ __forceinline__ void finish(unsigned char* ws_, int lane) {
    if (cur < end) {
      if (VMC == 8) asm volatile("s_waitcnt vmcnt(8)" ::: "memory"); else asm volatile("s_waitcnt vmcnt(0)" ::: "memory");
      const f32x4 a = *(const LAS f32x4*)(buf + lane * 16), b = *(const LAS f32x4*)(buf + 1024 + lane * 16);
      const unsigned c2 = cur - (1u << 24); const int c8 = (int)(c2 & 127), k = (int)((c2 >> 7) & 255), e = (int)(c2 >> 15);
      const int col = 8 * c8, nt = col >> 8, c = col & 255;
      const size_t blk = ((size_t)(e * 4 + nt) * 8 + (k >> 5)) * 8192; const int kk = k & 31, off = (c >> 5) * 1024 + (kk >> 3) * 256 + (kk & 7) * 32 + (c & 31);
      *(u32x4*)((bf16_t*)(ws_ + WS_WE2) + blk + off) = (u32x4){pk2(a[0], a[1]), pk2(a[2], a[3]), pk2(b[0], b[1]), pk2(b[2], b[3])};
      asm volatile("s_waitcnt lgkmcnt(0)" ::: "memory");
    }
    cur += stride;
  }
};

namespace att {
typedef short bf16x8 __attribute__((ext_vector_type(8)));
typedef short s16x4 __attribute__((ext_vector_type(4)));
typedef float f32x16 __attribute__((ext_vector_type(16)));
typedef float f32x2_t __attribute__((ext_vector_type(2)));
typedef __bf16 bf16x2_t __attribute__((ext_vector_type(2)));
constexpr int KSLOT = 8192, VSLOT = 16384;
constexpr int L_K = 0, L_V = 2 * KSLOT, L_WS = L_V + 2 * VSLOT, L_END = L_WS + 8 * 64 * 4;
constexpr float THR = 8.0f;
__device__ __forceinline__ int crow(int r, int hi) { return (r & 3) + 8 * (r >> 2) + 4 * hi; }
__device__ __forceinline__ unsigned cvtpk(float lo, float hi) { f32x2_t v = {lo, hi}; bf16x2_t b = __builtin_convertvector(v, bf16x2_t); return __builtin_bit_cast(unsigned, b); }
__device__ __forceinline__ s16x4 vtr(const LAS unsigned char* p) { typedef short v4i16_t __attribute__((ext_vector_type(4))); return __builtin_bit_cast(s16x4, __builtin_amdgcn_ds_read_tr16_b64_v4i16((LAS v4i16_t*)p)); }
__device__ __forceinline__ bf16x8 pack8(const f32x16& x, int s) {
  u32x4 w; w.x = cvtpk(x[8 * s], x[8 * s + 1]); w.y = cvtpk(x[8 * s + 2], x[8 * s + 3]); w.z = cvtpk(x[8 * s + 4], x[8 * s + 5]); w.w = cvtpk(x[8 * s + 6], x[8 * s + 7]);
  return __builtin_bit_cast(bf16x8, w);
}

template <class SIDE>
__device__ __forceinline__ void attn_unit(const P& p, int b, int hc, int qb, LAS unsigned char* lds, SIDE& side) {
  const int tid = tidx(), lane = tid & 63, r32 = lane & 31, hi = lane >> 5; const int wid = __builtin_amdgcn_readfirstlane(tid >> 6);
  unsigned char* const ws_ = fresh_ws(p.ws);
  const bf16_t* PR = (const bf16_t*)(ws_ + WS_PROJB); bf16_t* AO = (bf16_t*)(ws_ + WS_AO);
  const int h = hc >> 1; const size_t rowbase = (size_t)b * SEQ; const int q0w = qb * 256 + wid * 32;
  bf16x8 qr[4];
  { const bf16_t* Qw = PR + (rowbase + q0w + r32) * DPROJ + COL_Q + hc * 64 + hi * 8;
#pragma unroll
    for (int d0 = 0; d0 < 4; ++d0) qr[d0] = *(const bf16x8*)(Qw + d0 * 16); }
  const bf16_t* ksrc = PR + (rowbase + lane) * DPROJ + COL_K + hc * 64 + wid * 8;
  const bf16_t* vsrc = PR + (rowbase + 16 * (wid & 3) + (lane >> 2)) * DPROJ + COL_V + h * 128 + (wid >> 2) * 32 + (lane & 3) * 8;
  LAS unsigned char* kdst = lds + L_K + wid * 1024 + lane * 16;
  LAS unsigned char* vdst = lds + L_V + wid * 1024 + lane * 16;
  LAS float* wsf = (LAS float*)(lds + L_WS) + wid * 64;
  const int NTL = 4 * qb + 4, tl = 4 * qb + (wid >> 1);
  const size_t tstep = (size_t)64 * DPROJ;
  float mhat = 0.f, l = 0.f; f32x16 o[4], negm;
#pragma unroll
  for (int i = 0; i < 16; ++i) { o[0][i] = 0.f; o[1][i] = 0.f; o[2][i] = 0.f; o[3][i] = 0.f; negm[i] = 0.f; }
  u32x4 kreg = *(const u32x4*)ksrc, v0reg = *(const u32x4*)vsrc, v1reg = *(const u32x4*)(vsrc + 64);
  *(LAS u32x4*)kdst = kreg; *(LAS u32x4*)vdst = v0reg; *(LAS u32x4*)(vdst + 8192) = v1reg;
  __syncthreads();
  const int vlane = ((lane >> 4) & 1) * 32 + (lane & 3) * 8 + (4 * hi + ((lane & 15) >> 2)) * 64;
  for (int t = 0; t < NTL; ++t) {
    const int cur = t & 1;
    side.issue(p);
    if (t + 1 < NTL) { const size_t off = (size_t)(t + 1) * tstep; kreg = *(const u32x4*)(ksrc + off); v0reg = *(const u32x4*)(vsrc + off); v1reg = *(const u32x4*)(vsrc + off + 64); }
    if (t <= tl) {
      const LAS unsigned char* kb = lds + L_K + cur * KSLOT + hi * 1024 + r32 * 16;
      bf16x8 kf[8];
#pragma unroll
      for (int d0 = 0; d0 < 4; ++d0) { kf[2 * d0] = *(const LAS bf16x8*)(kb + d0 * 2048); kf[2 * d0 + 1] = *(const LAS bf16x8*)(kb + d0 * 2048 + 512); }
      f32x16 p0 = negm, p1 = negm;
#pragma unroll
      for (int d0 = 0; d0 < 4; ++d0) {
        p0 = __builtin_amdgcn_mfma_f32_32x32x16_bf16(kf[2 * d0], qr[d0], p0, 0, 0, 0);
        p1 = __builtin_amdgcn_mfma_f32_32x32x16_bf16(kf[2 * d0 + 1], qr[d0], p1, 0, 0, 0);
      }
      const LAS unsigned char* vb = lds + L_V + cur * VSLOT + vlane;
      s16x4 vl[8], vh[8];
#pragma unroll
      for (int i = 0; i < 8; ++i) { vl[i] = vtr(vb + (i >> 2) * 4096 + (i & 3) * 1024); vh[i] = vtr(vb + (i >> 2) * 4096 + (i & 3) * 1024 + 512); }
      if (t == tl) {
        const int lim = 32 * (wid & 1) + r32;
#pragma unroll
        for (int r = 0; r < 16; ++r) { const int kk = crow(r, hi); if (kk > lim) p0[r] = -INFINITY; if (kk + 32 > lim) p1[r] = -INFINITY; }
      }
      float rm = fmaxf(p0[0], p1[0]);
#pragma unroll
      for (int r = 1; r < 16; ++r) rm = fmaxf(rm, fmaxf(p0[r], p1[r]));
      { auto rr = __builtin_amdgcn_permlane32_swap(__float_as_uint(rm), __float_as_uint(rm), false, false); rm = fmaxf(__uint_as_float(rr[0]), __uint_as_float(rr[1])); }
      const bool first = (t == 0);
      if (first || __any(rm > THR)) {
        const float dl = first ? rm : fmaxf(rm, 0.f);
        mhat += dl;
#pragma unroll
        for (int r = 0; r < 16; ++r) { p0[r] -= dl; p1[r] -= dl; negm[r] = -mhat; }
        if (!first) {
          const float f = __builtin_amdgcn_exp2f(-dl);
          l *= f;
          if (hi == 0) wsf[r32] = f;
          asm volatile("s_waitcnt lgkmcnt(0)" ::: "memory");
          float fr[16];
#pragma unroll
          for (int r = 0; r < 16; ++r) fr[r] = wsf[crow(r, hi)];
#pragma unroll
          for (int d0 = 0; d0 < 4; ++d0)
#pragma unroll
            for (int r = 0; r < 16; ++r) o[d0][r] *= fr[r];
          asm volatile("s_waitcnt lgkmcnt(0)" ::: "memory");
        }
      }
      float sacc = 0.f;
#pragma unroll
      for (int r = 0; r < 16; ++r) { p0[r] = __builtin_amdgcn_exp2f(p0[r]); p1[r] = __builtin_amdgcn_exp2f(p1[r]); sacc += p0[r] + p1[r]; }
      l += sacc;
      bf16x8 pa[4]; pa[0] = pack8(p0, 0); pa[1] = pack8(p0, 1); pa[2] = pack8(p1, 0); pa[3] = pack8(p1, 1);
#define ATT_VF(i) (bf16x8){vl[i][0], vl[i][1], vl[i][2], vl[i][3], vh[i][0], vh[i][1], vh[i][2], vh[i][3]}
#pragma unroll
      for (int i = 0; i < 8; ++i) o[i >> 2] = __builtin_amdgcn_mfma_f32_32x32x16_bf16(pa[i & 3], ATT_VF(i), o[i >> 2], 0, 0, 0);
#pragma unroll
      for (int i = 0; i < 8; ++i) { vl[i] = vtr(vb + (2 + (i >> 2)) * 4096 + (i & 3) * 1024); vh[i] = vtr(vb + (2 + (i >> 2)) * 4096 + (i & 3) * 1024 + 512); }
#pragma unroll
      for (int i = 0; i < 8; ++i) o[2 + (i >> 2)] = __builtin_amdgcn_mfma_f32_32x32x16_bf16(pa[i & 3], ATT_VF(i), o[2 + (i >> 2)], 0, 0, 0);
#undef ATT_VF
    }
    side.finish(ws_);
    if (t + 1 < NTL) { const int nx = (cur ^ 1); *(LAS u32x4*)(kdst + nx * KSLOT) = kreg; *(LAS u32x4*)(vdst + nx * VSLOT) = v0reg; *(LAS u32x4*)(vdst + nx * VSLOT + 8192) = v1reg; }
    __syncthreads();
  }
  { auto rr = __builtin_amdgcn_permlane32_swap(__float_as_uint(l), __float_as_uint(l), false, false); l = __uint_as_float(rr[0]) + __uint_as_float(rr[1]); }
  if (hi == 0) wsf[32 + r32] = l;
  asm volatile("s_waitcnt lgkmcnt(0)" ::: "memory");
  bf16_t* Ow = AO + (rowbase + q0w) * 1024 + hc * 128 + r32;
#pragma unroll
  for (int r = 0; r < 16; ++r) {
    const int qq = crow(r, hi); const float rl = 1.0f / wsf[32 + qq];
#pragma unroll
    for (int d0 = 0; d0 < 4; ++d0) Ow[(size_t)qq * 1024 + d0 * 32] = (bf16_t)f2bf(o[d0][r] * rl);
  }
  asm volatile("s_waitcnt lgkmcnt(0)" ::: "memory");
}
}
template <class SIDE>
__device__ __forceinline__ void phase_attn_unit(const P& p, int v, int i, LAS unsigned char* lds, SIDE& side) { const int bh = v >> 3, s = v & 7; att::attn_unit(p, bh >> 3, bh & 7, i == 0 ? 15 - s : s, lds, side); }
namespace attn_body {
using bf16=__hip_bfloat16;
using bf16x8=__attribute__((ext_vector_type(8)))short;
using s16x4=__attribute__((ext_vector_type(4)))short;
using f32x16=__attribute__((ext_vector_type(16)))float;
using u32x4=__attribute__((ext_vector_type(4)))unsigned;
constexpr int BATCH=4,NHEAD=8,SEQ=4096,D=64,PQ=3072,PO=1024;
constexpr int NW=8,QBLK=32,QB=QBLK*NW,KVBLK=64,NQB=SEQ/QB;
constexpr int ATTN_UNIT_ROWS=QB;
__device__ __forceinline__ int crow(int r,int hi){return (r&3)+8*(r>>2)+4*hi;}
#define SBAR() __builtin_amdgcn_sched_barrier(0)
__device__ __forceinline__ void cmask(f32x16&p0,f32x16&p1,int jb,int qrel,int hi){
  const float NEG=-INFINITY; int kb=64*jb+4*hi;
  #pragma unroll
  for(int r=0;r<16;++r){int kv=kb+(r&3)+8*(r>>2); if(kv>qrel)p0[r]=NEG; if(kv+32>qrel)p1[r]=NEG;}
}

constexpr int NSLOT=3, SLOTB=8192;
constexpr int LDS_K=0, LDS_V=NSLOT*SLOTB, LDS_WS=2*NSLOT*SLOTB, LDS_OST=LDS_WS+NW*64*4, LDS_BYTES=LDS_OST+NW*4096;
constexpr float C2=0.125f*1.4426950408889634f;
__device__ __forceinline__ void glds16(const void*gsrc,unsigned lds_dst){unsigned keep;
  asm volatile("s_mov_b32 %0, m0\n\ts_mov_b32 m0, %2\n\ts_nop 0\n\tglobal_load_lds_dwordx4 %1, off\n\ts_mov_b32 m0, %0":"=&s"(keep):"v"(gsrc),"s"(lds_dst):"memory");}
__device__ __forceinline__ float max3f(float a,float b,float c){float r;asm("v_max3_f32 %0, %1, %2, %3":"=v"(r):"v"(a),"v"(b),"v"(c));return r;}
__device__ __forceinline__ float max2f(float a,float b){float r;asm("v_max_f32_e32 %0, %1, %2":"=v"(r):"v"(a),"v"(b));return r;}
__device__ __forceinline__ float fadd_s(float a,float b){float r;asm("v_add_f32_e32 %0, %1, %2":"=v"(r):"v"(a),"v"(b));return r;}
__device__ __forceinline__ float fsub_s(float a,float b){float r;asm("v_sub_f32_e32 %0, %1, %2":"=v"(r):"v"(a),"v"(b));return r;}
typedef float f32x2_t __attribute__((ext_vector_type(2))); typedef __bf16 bf16x2_t __attribute__((ext_vector_type(2)));
__device__ __forceinline__ unsigned cvtpk_s(float lo,float hi){f32x2_t v={lo,hi};bf16x2_t b=__builtin_convertvector(v,bf16x2_t);return __builtin_bit_cast(unsigned,b);}
#define WAIT_BAR(N) asm volatile("s_waitcnt vmcnt(" #N ") lgkmcnt(0)\n\ts_barrier":::"memory")

__device__ __forceinline__ void qkt(f32x16&p0,f32x16&p1,const char*Kslot,const bf16x8*qr,const f32x16&negm,int r32,int hi){
  const char*kb=Kslot+hi*1024+r32*16;
  #pragma unroll
  for(int d0=0;d0<4;++d0){
    const bf16x8 b0=*reinterpret_cast<const bf16x8*>(kb+d0*2048);
    const bf16x8 b1=*reinterpret_cast<const bf16x8*>(kb+d0*2048+512);
    if(d0==0){p0=__builtin_amdgcn_mfma_f32_32x32x16_bf16(b0,qr[0],negm,0,0,0);p1=__builtin_amdgcn_mfma_f32_32x32x16_bf16(b1,qr[0],negm,0,0,0);}
    else{p0=__builtin_amdgcn_mfma_f32_32x32x16_bf16(b0,qr[d0],p0,0,0,0);p1=__builtin_amdgcn_mfma_f32_32x32x16_bf16(b1,qr[d0],p1,0,0,0);}}
}
typedef __attribute__((address_space(3))) const char* lds_cptr;
typedef short v4i16_t __attribute__((ext_vector_type(4)));
__device__ __forceinline__ void kload8(bf16x8*kf,lds_cptr kp){
  kf[0]=*(const __attribute__((address_space(3))) bf16x8*)(kp);      kf[1]=*(const __attribute__((address_space(3))) bf16x8*)(kp+512);
  kf[2]=*(const __attribute__((address_space(3))) bf16x8*)(kp+2048); kf[3]=*(const __attribute__((address_space(3))) bf16x8*)(kp+2560);
  kf[4]=*(const __attribute__((address_space(3))) bf16x8*)(kp+4096); kf[5]=*(const __attribute__((address_space(3))) bf16x8*)(kp+4608);
  kf[6]=*(const __attribute__((address_space(3))) bf16x8*)(kp+6144); kf[7]=*(const __attribute__((address_space(3))) bf16x8*)(kp+6656);
}
__device__ __forceinline__ void kload2(bf16x8*kf,lds_cptr kp,int j){ kf[2*j]=*(const __attribute__((address_space(3))) bf16x8*)(kp+j*2048); kf[2*j+1]=*(const __attribute__((address_space(3))) bf16x8*)(kp+j*2048+512); }
__device__ __forceinline__ s16x4 vtr(lds_cptr p){ return __builtin_bit_cast(s16x4,__builtin_amdgcn_ds_read_tr16_b64_v4i16((__attribute__((address_space(3))) v4i16_t*)p)); }
__device__ __forceinline__ float rowmax(const f32x16&p0,const f32x16&p1){
  float a=max3f(p0[0],p0[1],p1[0]),b=max3f(p0[2],p0[3],p1[1]);a=max3f(a,p1[2],p1[3]);
  #pragma unroll
  for(int r=4;r<16;r+=4){a=max3f(a,p0[r],p0[r+1]);b=max3f(b,p0[r+2],p0[r+3]);a=max3f(a,p1[r],p1[r+1]);b=max3f(b,p1[r+2],p1[r+3]);}
  const float m=max2f(a,b);
  auto rr=__builtin_amdgcn_permlane32_swap(__float_as_uint(m),__float_as_uint(m),false,false);
  return max2f(__uint_as_float(rr[0]),__uint_as_float(rr[1]));
}
__device__ __forceinline__ void pv(f32x16*o,int vb,bf16x8 pa0,bf16x8 pa1,bf16x8 pa2,bf16x8 pa3){
  #pragma unroll
  for(int d0=0;d0<2;++d0){s16x4 lo[4],hi[4];
    #pragma unroll
    for(int ks=0;ks<4;++ks){
      asm volatile("ds_read_b64_tr_b16 %0,%1 offset:%c2":"=&v"(lo[ks]):"v"(vb),"i"(d0*4096+ks*1024):"memory");
      asm volatile("ds_read_b64_tr_b16 %0,%1 offset:%c2":"=&v"(hi[ks]):"v"(vb),"i"(d0*4096+ks*1024+512):"memory");}
    asm volatile("s_waitcnt lgkmcnt(0)":::"memory");SBAR();
    #define PK(k) (bf16x8){lo[k][0],lo[k][1],lo[k][2],lo[k][3],hi[k][0],hi[k][1],hi[k][2],hi[k][3]}
    o[d0]=__builtin_amdgcn_mfma_f32_32x32x16_bf16(pa0,PK(0),o[d0],0,0,0);
    o[d0]=__builtin_amdgcn_mfma_f32_32x32x16_bf16(pa1,PK(1),o[d0],0,0,0);
    o[d0]=__builtin_amdgcn_mfma_f32_32x32x16_bf16(pa2,PK(2),o[d0],0,0,0);
    o[d0]=__builtin_amdgcn_mfma_f32_32x32x16_bf16(pa3,PK(3),o[d0],0,0,0);
    #undef PK
  }
}

#ifndef ATTN_STORE16
#define ATTN_STORE16(p,v) (*(u32x4*)(p)=(v))
#endif
template<int THRL> __device__ __forceinline__ void attn_unit(int b,int h,int hv,int ho,int qb,const bf16*Q,const bf16*__restrict__ K,const bf16*__restrict__ V,bf16*O,char*shm){
  const int tid=tidx(),lane=tid&63,r32=lane&31,hi=lane>>5; const int wid=__builtin_amdgcn_readfirstlane(tid>>6);
  const long rowbase=(long)b*SEQ; const int q0=qb*QB;
  const bf16*Qw=Q+(rowbase+q0+wid*QBLK)*PQ+h*D;
  const bf16*Kh=K+rowbase*PQ+h*D,*Vh=V+rowbase*PQ+hv*D;
  const unsigned lds0=(unsigned)(uintptr_t)shm;
  float*wsf=(float*)(shm+LDS_WS)+wid*64;
  const bf16*ksrc=Kh+(long)lane*PQ+wid*8;
  const bf16*vsrc=Vh+(long)(16*(wid&3)+(lane>>2))*PQ+(wid>>2)*32+(lane&3)*8;
  const unsigned kdst=lds0+LDS_K+wid*1024, vdst=lds0+LDS_V+wid*1024;
  #define DMA_K(t,slot) glds16(ksrc+(long)(t)*KVBLK*PQ,(unsigned)__builtin_amdgcn_readfirstlane(kdst+(slot)))
  #define DMA_V(t,slot) glds16(vsrc+(long)(t)*KVBLK*PQ,(unsigned)__builtin_amdgcn_readfirstlane(vdst+(slot)))
  const int vb0=(int)(lds0+LDS_V)+((lane>>4)&1)*32+(lane&3)*8+(4*hi+((lane&15)>>2))*64;
  const char*Kbase=shm+LDS_K; bf16x8 kf[8];
  const lds_cptr shm3=(lds_cptr)shm; const lds_cptr kp0=shm3+LDS_K+hi*1024+r32*16; const lds_cptr vp0=shm3+LDS_V+((lane>>4)&1)*32+(lane&3)*8+(4*hi+((lane&15)>>2))*64;
  const int NT=(q0+QB)/KVBLK;
  DMA_K(0,0);DMA_V(0,0);DMA_K(1,SLOTB);
  bf16x8 qr[4];
  #pragma unroll
  for(int d0=0;d0<4;++d0)qr[d0]=*reinterpret_cast<const bf16x8*>(&Qw[(long)r32*PQ+d0*16+hi*8]);
  float mhat=0.f,l_reg=0.f;f32x16 o[2];o[0]=f32x16{};o[1]=f32x16{};f32x16 negm=f32x16{};asm volatile("":"+v"(negm));
  const int qrel=wid*QBLK+r32;
  #define CMASK(P0,P1,t) do{int jb_=(t)-(NT-4); if(jb_>=0)cmask(P0,P1,jb_,qrel,hi);}while(0)
  bool resc=false;
  #define START(P0,P1) do{ const float rm=rowmax(P0,P1); resc=false; \
    { const float dl=rm; mhat=fadd_s(mhat,dl); \
      _Pragma("unroll") for(int r=0;r<16;++r){P0[r]=fsub_s(P0[r],dl);P1[r]=fsub_s(P1[r],dl);} \
      _Pragma("unroll") for(int r=0;r<16;++r)negm[r]=-mhat; asm volatile("":"+v"(negm)); } \
    _Pragma("unroll") for(int r=0;r<16;++r)P0[r]=__builtin_amdgcn_exp2f(P0[r]); }while(0)
  #define RESC() do{ if(resc){ asm volatile("s_waitcnt lgkmcnt(0)":::"memory"); \
      _Pragma("unroll") for(int d_=0;d_<2;++d_) _Pragma("unroll") for(int r=0;r<16;++r)o[d_][r]*=wsf[crow(r,hi)]; } }while(0)
  f32x16 pA0,pA1,pB0,pB1;
  int sl_prev=0,sl_cur=0,sl_next=SLOTB;
  #define ROT() do{sl_prev=sl_cur;sl_cur=sl_next;sl_next=(sl_next==(NSLOT-1)*SLOTB)?0:sl_next+SLOTB;}while(0)
  DMA_K(2,2*SLOTB);
  WAIT_BAR(3);
  qkt(pA0,pA1,Kbase,qr,negm,r32,hi);asm volatile("s_nop 15\n\ts_nop 7":"+v"(pA0),"+v"(pA1));CMASK(pA0,pA1,0);
  START(pA0,pA1);
  _Pragma("unroll") for(int r=0;r<16;++r)pA1[r]=__builtin_amdgcn_exp2f(pA1[r]);
  WAIT_BAR(0);
  DMA_K(3,0);DMA_V(1,SLOTB);
  ROT();
  kload8(kf,kp0+sl_cur);
  WAIT_BAR(2);
  s16x4 vlo[8],vhi[8]; u32x4 pw0,pw1,pw2,pw3;
  #define PKW(P,B) cvtpk_s(P[B],P[B+1])
  #define PAF(k) __builtin_bit_cast(bf16x8,pw##k)
  #define VFR(i) (bf16x8){vlo[i][0],vlo[i][1],vlo[i][2],vlo[i][3],vhi[i][0],vhi[i][1],vhi[i][2],vhi[i][3]}
  #define PIN(x) asm volatile("":"+v"(x))
  #define MX3(a,b,c) __builtin_fmaxf(__builtin_fmaxf((a),(b)),(c))
  #define GAPA(MF,A0,A1,A2,A3,W0,W1,PW) do{ MF; sacc+=A0; sacc+=A1; sacc+=A2; sacc+=A3; PIN(sacc); W0; W1; PIN(PW); SBAR(); }while(0)
  #define EX(v) __builtin_amdgcn_exp2f(v)
  #define GAPB(MF,X,B) do{ MF; X[B]=EX(X[B]); X[B+1]=EX(X[B+1]); X[B+2]=EX(X[B+2]); X[B+3]=EX(X[B+3]); PIN(X); SBAR(); }while(0)
  #define VRD(i) do{ vlo[i]=vtr(vp_+(((i)>>2)*4096+((i)&3)*1024)); vhi[i]=vtr(vp_+(((i)>>2)*4096+((i)&3)*1024+512)); }while(0)
  #define KRD(G,j) do{ if(G){ kload2(kf,kp0+sl_next,j); SBAR(); } }while(0)
  #define STEP(C0,C1,P0,P1,t,GK,GV,GL) do{ SBAR(); \
    const lds_cptr vp_=vp0+sl_prev; \
    VRD(0); SBAR(); float sacc=(P0[0]+P0[1]); \
    GAPA(C0=__builtin_amdgcn_mfma_f32_32x32x16_bf16(kf[0],qr[0],negm,0,0,0), P0[2],P0[3],P0[4],P0[5],     pw0[0]=PKW(P0,0), pw0[1]=PKW(P0,2), pw0); \
    VRD(4); SBAR(); GAPA(C1=__builtin_amdgcn_mfma_f32_32x32x16_bf16(kf[1],qr[0],negm,0,0,0), P0[6],P0[7],P0[8],P0[9],     pw0[2]=PKW(P0,4), pw0[3]=PKW(P0,6), pw0); \
    VRD(1); SBAR(); GAPA(C0=__builtin_amdgcn_mfma_f32_32x32x16_bf16(kf[2],qr[1],C0,0,0,0),   P0[10],P0[11],P0[12],P0[13], pw1[0]=PKW(P0,8), pw1[1]=PKW(P0,10), pw1); \
    VRD(5); SBAR(); GAPA(C1=__builtin_amdgcn_mfma_f32_32x32x16_bf16(kf[3],qr[1],C1,0,0,0),   P0[14],P0[15],P1[0],P1[1],   pw1[2]=PKW(P0,12),pw1[3]=PKW(P0,14), pw1); \
    VRD(2); SBAR(); GAPA(C0=__builtin_amdgcn_mfma_f32_32x32x16_bf16(kf[4],qr[2],C0,0,0,0),   P1[2],P1[3],P1[4],P1[5],     pw2[0]=PKW(P1,0), pw2[1]=PKW(P1,2), pw2); \
    VRD(6); SBAR(); GAPA(C1=__builtin_amdgcn_mfma_f32_32x32x16_bf16(kf[5],qr[2],C1,0,0,0),   P1[6],P1[7],P1[8],P1[9],     pw2[2]=PKW(P1,4), pw2[3]=PKW(P1,6), pw2); \
    VRD(3); SBAR(); GAPA(C0=__builtin_amdgcn_mfma_f32_32x32x16_bf16(kf[6],qr[3],C0,0,0,0),   P1[10],P1[11],P1[12],P1[13], pw3[0]=PKW(P1,8), pw3[1]=PKW(P1,10), pw3); \
    VRD(7); SBAR(); GAPA(C1=__builtin_amdgcn_mfma_f32_32x32x16_bf16(kf[7],qr[3],C1,0,0,0),   P1[14],P1[15],0.f,0.f,       pw3[2]=PKW(P1,12),pw3[3]=PKW(P1,14), pw3); \
    l_reg+=sacc; \
    if(GK){DMA_K((t)+3,sl_cur);} if(GV){DMA_V((t)+1,sl_next);} \
    CMASK(C0,C1,t); \
    { float a=MX3(C0[0],C0[1],C1[0]),b=MX3(C0[2],C0[3],C1[1]); a=MX3(a,C1[2],C1[3]); \
      _Pragma("unroll") for(int r=4;r<16;r+=4){a=MX3(a,C0[r],C0[r+1]);b=MX3(b,C0[r+2],C0[r+3]);a=MX3(a,C1[r],C1[r+1]);b=MX3(b,C1[r+2],C1[r+3]);} \
      float rm=__builtin_fmaxf(a,b); { auto rr=__builtin_amdgcn_permlane32_swap(__float_as_uint(rm),__float_as_uint(rm),false,false); rm=__builtin_fmaxf(__uint_as_float(rr[0]),__uint_as_float(rr[1])); } \
      resc=false; \
      if(__builtin_expect(__any(rm>(float)THRL),0)){ const float dl=__builtin_fmaxf(rm,0.f); mhat+=dl; \
        _Pragma("unroll") for(int r=0;r<16;++r){C0[r]-=dl;C1[r]-=dl;} \
        _Pragma("unroll") for(int r=0;r<16;++r)negm[r]=-mhat; asm volatile("":"+v"(negm)); \
        const float f=__builtin_amdgcn_exp2f(-dl); l_reg*=f; if(hi==0)wsf[r32]=f; resc=true; } } \
    SBAR(); \
    GAPB(o[0]=__builtin_amdgcn_mfma_f32_32x32x16_bf16(PAF(0),VFR(0),o[0],0,0,0), C0,0); \
    GAPB(o[1]=__builtin_amdgcn_mfma_f32_32x32x16_bf16(PAF(0),VFR(4),o[1],0,0,0), C0,4); \
    KRD(GL,0); GAPB(o[0]=__builtin_amdgcn_mfma_f32_32x32x16_bf16(PAF(1),VFR(1),o[0],0,0,0), C0,8); \
    KRD(GL,1); GAPB(o[1]=__builtin_amdgcn_mfma_f32_32x32x16_bf16(PAF(1),VFR(5),o[1],0,0,0), C0,12); \
    KRD(GL,2); GAPB(o[0]=__builtin_amdgcn_mfma_f32_32x32x16_bf16(PAF(2),VFR(2),o[0],0,0,0), C1,0); \
    KRD(GL,3); GAPB(o[1]=__builtin_amdgcn_mfma_f32_32x32x16_bf16(PAF(2),VFR(6),o[1],0,0,0), C1,4); \
    GAPB(o[0]=__builtin_amdgcn_mfma_f32_32x32x16_bf16(PAF(3),VFR(3),o[0],0,0,0), C1,8); \
    GAPB(o[1]=__builtin_amdgcn_mfma_f32_32x32x16_bf16(PAF(3),VFR(7),o[1],0,0,0), C1,12); \
    }while(0)
  int t=1;
  #undef CMASK
  #define CMASK(P0,P1,t) do{}while(0)
  for(;t+5<NT;t+=2){
    STEP(pB0,pB1,pA0,pA1,t,true,true,true);     WAIT_BAR(2); RESC(); ROT();
    STEP(pA0,pA1,pB0,pB1,t+1,true,true,true);   WAIT_BAR(2); RESC(); ROT();
  }
  #undef CMASK
  #define CMASK(P0,P1,t) do{int jb_=(t)-(NT-4); if(jb_>=0)cmask(P0,P1,jb_,qrel,hi);}while(0)
  #define ENDW(tt) do{ if((tt)+3<NT){WAIT_BAR(2);} else if((tt)+2<NT){WAIT_BAR(1);} else {WAIT_BAR(0);} }while(0)
  for(;t+1<NT;t+=2){
    STEP(pB0,pB1,pA0,pA1,t,(t+3<NT),(t+1<NT),(t+1<NT));       ENDW(t);   RESC(); ROT();
    STEP(pA0,pA1,pB0,pB1,t+1,(t+4<NT),(t+2<NT),(t+2<NT));     ENDW(t+1); RESC(); ROT();
  }
  STEP(pB0,pB1,pA0,pA1,NT-1,false,false,false); RESC();
  { float sacc=pB0[0]+pB0[1]; _Pragma("unroll") for(int r=2;r<16;++r)sacc+=pB0[r]; _Pragma("unroll") for(int r=0;r<16;++r)sacc+=pB1[r]; l_reg+=sacc;
    pw0=(u32x4){PKW(pB0,0),PKW(pB0,2),PKW(pB0,4),PKW(pB0,6)};pw1=(u32x4){PKW(pB0,8),PKW(pB0,10),PKW(pB0,12),PKW(pB0,14)};pw2=(u32x4){PKW(pB1,0),PKW(pB1,2),PKW(pB1,4),PKW(pB1,6)};pw3=(u32x4){PKW(pB1,8),PKW(pB1,10),PKW(pB1,12),PKW(pB1,14)};
    SBAR(); pv(o,vb0+sl_cur,PAF(0),PAF(1),PAF(2),PAF(3)); }
  #undef PKW
  #undef PAF
  #undef VFR
  #undef PIN
  #undef MX3
  #undef GAPA
  #undef GAPB
  #undef EX
  #undef VRD
  #undef KRD
  #undef STEP
  #undef ENDW
  {auto rr=__builtin_amdgcn_permlane32_swap(__float_as_uint(l_reg),__float_as_uint(l_reg),false,false);l_reg=__uint_as_float(rr[0])+__uint_as_float(rr[1]);}
  if(hi==0)wsf[32+r32]=l_reg;asm volatile("s_waitcnt lgkmcnt(0)":::"memory");
  float rli[16];
  #pragma unroll
  for(int r=0;r<16;++r)rli[r]=__builtin_amdgcn_rcpf(wsf[32+crow(r,hi)]);
  bf16*Ow=O+(rowbase+q0+wid*QBLK)*PO+ho*D;
  { bf16*stg=(bf16*)(shm+LDS_OST)+wid*2048;
    #pragma unroll
    for(int r=0;r<16;++r){const int orow=crow(r,hi);
      #pragma unroll
      for(int d0=0;d0<2;++d0)stg[orow*64+d0*32+r32]=__float2bfloat16(o[d0][r]*rli[r]);}
    asm volatile("s_waitcnt lgkmcnt(0)":::"memory");
    #pragma unroll
    for(int i=0;i<4;++i){const int row=i*8+(lane>>3),ch=lane&7; const u32x4 v=*(const u32x4*)(stg+row*64+ch*8); ATTN_STORE16(Ow+(long)row*PO+ch*8,v);} }
  asm volatile("s_waitcnt lgkmcnt(0)\n\ts_barrier":::"memory");
  #undef DMA_K
  #undef DMA_V
  #undef CMASK
  #undef START
  #undef RESC
  #undef ROT
}
constexpr int ATTN_LDS_BYTES=LDS_BYTES;
struct AttnTensors { const bf16* Q; const bf16* K; const bf16* V; bf16* O; };
template<int THRL=8> __device__ __forceinline__ void attn_phase_unit(char*lds,const AttnTensors&T,int vcu,int i){
  const int bh=vcu>>3,s=vcu&7,b=bh>>3,hc=bh&7;
  const int qb=(i<2)?15-s:s, half=i&1; attn_unit<THRL>(b,hc,(hc>>1)*2+half,2*hc+half,qb,T.Q,T.K,T.V,T.O,lds);
}
#undef SBAR
#undef WAIT_BAR
}

namespace moe {
typedef short bf16x8 __attribute__((ext_vector_type(8)));
typedef short s16x4 __attribute__((ext_vector_type(4)));
typedef float f32x16 __attribute__((ext_vector_type(16)));
typedef unsigned u32x2 __attribute__((ext_vector_type(2)));
constexpr int SLOT = 32768, L_ROWS = 131072, L_WROWS = 133120, L_TS = 135168, L_CL = 136448, L_SIDE = 139264;

template <int STAGE>
__device__ __forceinline__ void run(const P& p, int bid, int nb, LAS unsigned char* lds) {
  unsigned char* const ws_ = fresh_ws(p.ws);
  constexpr int NSUB = (STAGE == 1) ? 2 : 4, KTOT = (STAGE == 1) ? D : DE, NK = KTOT / 32;
  const int tid = tidx(), lane = tid & 63, r32 = lane & 31, hi = lane >> 5; const int wid = __builtin_amdgcn_readfirstlane(tid >> 6), wm = wid >> 2, wn = wid & 3;
  const int* cnt = (const int*)(ws_ + WS_CTL); const int* LIST = (const int*)(ws_ + WS_LIST);
  LAS int* ts = (LAS int*)(lds + L_TS); LAS int* cl = (LAS int*)(lds + L_CL);
  __syncthreads();
  if (tid < 256) cl[tid] = cnt[tid * CNT_STRIDE];
  __syncthreads();
  if (tid <= 256) { int a = 0; for (int i = 0; i < tid; ++i) a += (cl[i] + 255) >> 8; ts[tid] = a; }
  __syncthreads();
  const int nitems = ts[256] * NSUB;
  const int vcu = (nb % 8 == 0) ? (bid % 8) * (nb / 8) + bid / 8 : bid;
  const bf16_t* Asrc = (STAGE == 1) ? (const bf16_t*)(ws_ + WS_HNB) : (const bf16_t*)(ws_ + WS_H);
  const bf16_t* Bimg = (STAGE == 1) ? (const bf16_t*)(ws_ + WS_WE1) : (const bf16_t*)(ws_ + WS_WE2);
  const int cgk = ((lane & 3) ^ ((lane >> 4) & 3)) * 8;
  int abase[2];
#pragma unroll
  for (int k16 = 0; k16 < 2; ++k16) abase[k16] = (128 * wm + r32) * 64 + (((2 * k16 + hi) ^ ((r32 >> 2) & 3)) * 16);
  const int bbase = 16384 + (2 * wn) * 2048 + hi * 512 + ((lane & 15) >> 2) * 64 + ((lane >> 4) & 1) * 32 + (lane & 3) * 8;

#define MOE_DESC(it, E_, MT_, MC_, SUB_) do { const int tile_ = (it) / NSUB; SUB_ = (it) % NSUB; int lo_ = 0, hi_ = 256; \
    while (hi_ - lo_ > 1) { const int mid_ = (lo_ + hi_) >> 1; if (ts[mid_] <= tile_) lo_ = mid_; else hi_ = mid_; } \
    E_ = __builtin_amdgcn_readfirstlane(lo_); MT_ = __builtin_amdgcn_readfirstlane(tile_ - ts[lo_]); MC_ = __builtin_amdgcn_readfirstlane(min(256, cl[lo_] - MT_ * 256)); } while (0)
#define MOE_ROWS_DMA(E_, MT_, par) do { if (wid == 0) __builtin_amdgcn_global_load_lds((const unsigned*)(LIST + (size_t)(E_) * LISTCAP + (MT_) * 256 + lane * 4), (LAS unsigned*)(lds + L_ROWS + (par) * 1024), 16, 0, 0); \
    if (STAGE == 2 && wid == 1) __builtin_amdgcn_global_load_lds((const unsigned*)((const float*)(ws_ + WS_WLIST) + (size_t)(E_) * LISTCAP + (MT_) * 256 + lane * 4), (LAS unsigned*)(lds + L_WROWS + (par) * 1024), 16, 0, 0); } while (0)
#define MOE_ASRC(dst, par, MC_) do { _Pragma("unroll") for (int i = 0; i < 2; ++i) { const int aidr = ((LAS int*)(lds + L_ROWS + (par) * 1024))[min(16 * (2 * wid + i) + (lane >> 2), (MC_) - 1)]; \
      dst[i] = Asrc + ((STAGE == 1) ? (size_t)(aidr >> 3) * D : (size_t)aidr * DE) + cgk; } } while (0)
#define MOE_ISSUE_SL(AS, BS, s, SL) do { LAS unsigned char* sl_ = lds + (SL) * SLOT + (2 * wid) * 1024; \
      __builtin_amdgcn_global_load_lds((const unsigned*)(AS[0] + (s) * 32), (LAS unsigned*)(sl_), 16, 0, 0); \
      __builtin_amdgcn_global_load_lds((const unsigned*)(AS[1] + (s) * 32), (LAS unsigned*)(sl_ + 1024), 16, 0, 0); \
      __builtin_amdgcn_global_load_lds((const unsigned*)(BS + (size_t)(s) * 8192), (LAS unsigned*)(sl_ + 16384), 16, 0, 0); \
      __builtin_amdgcn_global_load_lds((const unsigned*)(BS + (size_t)(s) * 8192 + 512), (LAS unsigned*)(sl_ + 16384 + 1024), 16, 0, 0); } while (0)

  ConvSideLds side; side.init(bid, nb, (STAGE == 1) ? (1u << 24) : 0u, (STAGE == 1) ? (3u << 23) : 0u, tid, lds + L_SIDE + wid * 2048);
  int item = vcu, par = 0;
  int e = 0, mt = 0, mcount = 1, sub = 0;
  const bf16_t* asrc[2]; const bf16_t* bsrc;
  if (item < nitems) {
    MOE_DESC(item, e, mt, mcount, sub);
    MOE_ROWS_DMA(e, mt, 0);
    asm volatile("s_waitcnt vmcnt(0)" ::: "memory"); __syncthreads();
    MOE_ASRC(asrc, 0, mcount);
    bsrc = Bimg + (size_t)(e * NSUB + sub) * NK * 8192 + (2 * wid) * 512 + lane * 8;
    MOE_ISSUE_SL(asrc, bsrc, 0, 0); MOE_ISSUE_SL(asrc, bsrc, 1, 1); MOE_ISSUE_SL(asrc, bsrc, 2, 2);
  }
  while (item < nitems) {
    const int nitem = item + nb; const bool has_next = nitem < nitems;
    int ne = 0, nmt = 0, nmc = 1, nsub = 0;
    const bf16_t* nasrc[2] = {Asrc, Asrc}; const bf16_t* nbsrc = Bimg;
    if (has_next) { MOE_DESC(nitem, ne, nmt, nmc, nsub); nbsrc = Bimg + (size_t)(ne * NSUB + nsub) * NK * 8192 + (2 * wid) * 512 + lane * 8; }
    f32x16 acc[4][2];
#pragma unroll
    for (int m = 0; m < 4; ++m)
#pragma unroll
      for (int n = 0; n < 2; ++n)
#pragma unroll
        for (int r = 0; r < 16; ++r) acc[m][n][r] = 0.f;
#define MOE_STEP(s, SL) do { \
      if ((s) + 2 < NK || has_next) asm volatile("s_waitcnt vmcnt(8)" ::: "memory"); \
      else if ((s) + 1 < NK) asm volatile("s_waitcnt vmcnt(4)" ::: "memory"); \
      else asm volatile("s_waitcnt vmcnt(0)" ::: "memory"); \
      __builtin_amdgcn_s_barrier(); \
      asm volatile("" ::: "memory"); \
      if ((s) + 3 < NK) MOE_ISSUE_SL(asrc, bsrc, (s) + 3, ((SL) + 3) & 3); \
      else if (has_next) { if ((s) + 3 == NK) MOE_ASRC(nasrc, par ^ 1, nmc); MOE_ISSUE_SL(nasrc, nbsrc, (s) + 3 - NK, ((SL) + 3) & 3); } \
      if ((s) == 0 && has_next) MOE_ROWS_DMA(ne, nmt, par ^ 1); \
      const LAS unsigned char* Ab = lds + (SL) * SLOT; const unsigned Bbv = (unsigned)(uintptr_t)(lds + (SL) * SLOT + bbase); \
      bf16x8 af[2][4], bfr[2][2]; s16x4 tq[8]; const unsigned Abv0 = (unsigned)(uintptr_t)(Ab + abase[0]), Abv1 = (unsigned)(uintptr_t)(Ab + abase[1]); \
      asm volatile("ds_read_b64_tr_b16 %0, %1 offset:0" : "=&v"(tq[0]) : "v"(Bbv) : "memory"); \
      asm volatile("ds_read_b64_tr_b16 %0, %1 offset:256" : "=&v"(tq[1]) : "v"(Bbv) : "memory"); \
      asm volatile("ds_read_b64_tr_b16 %0, %1 offset:2048" : "=&v"(tq[2]) : "v"(Bbv) : "memory"); \
      asm volatile("ds_read_b64_tr_b16 %0, %1 offset:2304" : "=&v"(tq[3]) : "v"(Bbv) : "memory"); \
      asm volatile("ds_read_b128 %0, %1 offset:0" : "=&v"(af[0][0]) : "v"(Abv0) : "memory"); \
      asm volatile("ds_read_b128 %0, %1 offset:2048" : "=&v"(af[0][1]) : "v"(Abv0) : "memory"); \
      asm volatile("ds_read_b128 %0, %1 offset:4096" : "=&v"(af[0][2]) : "v"(Abv0) : "memory"); \
      asm volatile("ds_read_b128 %0, %1 offset:6144" : "=&v"(af[0][3]) : "v"(Abv0) : "memory"); \
      asm volatile("ds_read_b64_tr_b16 %0, %1 offset:1024" : "=&v"(tq[4]) : "v"(Bbv) : "memory"); \
      asm volatile("ds_read_b64_tr_b16 %0, %1 offset:1280" : "=&v"(tq[5]) : "v"(Bbv) : "memory"); \
      asm volatile("ds_read_b64_tr_b16 %0, %1 offset:3072" : "=&v"(tq[6]) : "v"(Bbv) : "memory"); \
      asm volatile("ds_read_b64_tr_b16 %0, %1 offset:3328" : "=&v"(tq[7]) : "v"(Bbv) : "memory"); \
      asm volatile("ds_read_b128 %0, %1 offset:0" : "=&v"(af[1][0]) : "v"(Abv1) : "memory"); \
      asm volatile("ds_read_b128 %0, %1 offset:2048" : "=&v"(af[1][1]) : "v"(Abv1) : "memory"); \
      asm volatile("ds_read_b128 %0, %1 offset:4096" : "=&v"(af[1][2]) : "v"(Abv1) : "memory"); \
      asm volatile("ds_read_b128 %0, %1 offset:6144" : "=&v"(af[1][3]) : "v"(Abv1) : "memory"); \
      asm volatile("s_waitcnt lgkmcnt(8)" : "+v"(tq[0]), "+v"(tq[1]), "+v"(tq[2]), "+v"(tq[3]), "+v"(af[0][0]), "+v"(af[0][1]), "+v"(af[0][2]), "+v"(af[0][3]) :: "memory"); __builtin_amdgcn_sched_barrier(0); \
      _Pragma("unroll") for (int n = 0; n < 2; ++n) { const s16x4 l0 = tq[2 * n], h0 = tq[2 * n + 1]; bfr[0][n] = (bf16x8){l0[0], l0[1], l0[2], l0[3], h0[0], h0[1], h0[2], h0[3]}; } \
      __builtin_amdgcn_s_setprio(1); \
      _Pragma("unroll") for (int m = 0; m < 4; ++m) \
        _Pragma("unroll") for (int n = 0; n < 2; ++n) acc[m][n] = __builtin_amdgcn_mfma_f32_32x32x16_bf16(bfr[0][n], af[0][m], acc[m][n], 0, 0, 0); \
      __builtin_amdgcn_sched_barrier(0); \
      asm volatile("s_waitcnt lgkmcnt(0)" : "+v"(tq[4]), "+v"(tq[5]), "+v"(tq[6]), "+v"(tq[7]), "+v"(af[1][0]), "+v"(af[1][1]), "+v"(af[1][2]), "+v"(af[1][3]) :: "memory"); __builtin_amdgcn_sched_barrier(0); \
      _Pragma("unroll") for (int n = 0; n < 2; ++n) { const s16x4 l0 = tq[4 + 2 * n], h0 = tq[4 + 2 * n + 1]; bfr[1][n] = (bf16x8){l0[0], l0[1], l0[2], l0[3], h0[0], h0[1], h0[2], h0[3]}; } \
      _Pragma("unroll") for (int m = 0; m < 4; ++m) \
        _Pragma("unroll") for (int n = 0; n < 2; ++n) acc[m][n] = __builtin_amdgcn_mfma_f32_32x32x16_bf16(bfr[1][n], af[1][m], acc[m][n], 0, 0, 0); \
      __builtin_amdgcn_s_setprio(0); \
      asm volatile("s_waitcnt lgkmcnt(0)" ::: "memory"); } while (0)
    for (int s = 0; s < NK; s += 4) {
      if (STAGE == 1) side.issue(p);
      MOE_STEP(s, 0); MOE_STEP(s + 1, 1);
      if (STAGE == 1) { if (s + 4 < NK || has_next) side.template finish<8>(ws_, lane); else side.template finish<0>(ws_, lane); side.issue(p); }
      MOE_STEP(s + 2, 2); MOE_STEP(s + 3, 3);
      if (STAGE == 1) { if (s + 6 < NK || has_next) side.template finish<8>(ws_, lane); else side.template finish<0>(ws_, lane); }
    }
#undef MOE_STEP
    {
      const LAS int* rw = (const LAS int*)(lds + L_ROWS + par * 1024);
#pragma unroll
      for (int m = 0; m < 4; ++m) {
        const int row = 128 * wm + 32 * m + r32; const bool valid = row < mcount;
        const int aid = rw[min(row, mcount - 1)];
        if (STAGE == 1) {
          bf16_t* hp = (bf16_t*)(ws_ + WS_H) + (size_t)aid * DE + 128 * sub + 32 * wn + 8 * hi;
#pragma unroll
          for (int g = 0; g < 4; g += 2) {
            unsigned a0 = pk2(silu_f(acc[m][0][4 * g]) * acc[m][1][4 * g], silu_f(acc[m][0][4 * g + 1]) * acc[m][1][4 * g + 1]), a1 = pk2(silu_f(acc[m][0][4 * g + 2]) * acc[m][1][4 * g + 2], silu_f(acc[m][0][4 * g + 3]) * acc[m][1][4 * g + 3]);
            unsigned b0 = pk2(silu_f(acc[m][0][4 * g + 4]) * acc[m][1][4 * g + 4], silu_f(acc[m][0][4 * g + 5]) * acc[m][1][4 * g + 5]), b1 = pk2(silu_f(acc[m][0][4 * g + 6]) * acc[m][1][4 * g + 6], silu_f(acc[m][0][4 * g + 7]) * acc[m][1][4 * g + 7]);
            { auto r = __builtin_amdgcn_permlane32_swap(a0, b0, false, false); a0 = r[0]; b0 = r[1]; }
            { auto r = __builtin_amdgcn_permlane32_swap(a1, b1, false, false); a1 = r[0]; b1 = r[1]; }
            if (valid) *(u32x4*)(hp + 8 * g) = (u32x4){a0, a1, b0, b1};
          }
        } else {
          const float w = ((const LAS float*)(lds + L_WROWS + par * 1024))[min(row, mcount - 1)];
          bf16_t* sp = (bf16_t*)(ws_ + WS_SLAB) + (size_t)aid * D + 256 * sub + 64 * wn + 8 * hi;
#pragma unroll
          for (int n = 0; n < 2; ++n)
#pragma unroll
            for (int g = 0; g < 4; g += 2) {
              unsigned a0 = pk2(acc[m][n][4 * g] * w, acc[m][n][4 * g + 1] * w), a1 = pk2(acc[m][n][4 * g + 2] * w, acc[m][n][4 * g + 3] * w);
              unsigned b0 = pk2(acc[m][n][4 * g + 4] * w, acc[m][n][4 * g + 5] * w), b1 = pk2(acc[m][n][4 * g + 6] * w, acc[m][n][4 * g + 7] * w);
              { auto r = __builtin_amdgcn_permlane32_swap(a0, b0, false, false); a0 = r[0]; b0 = r[1]; }
              { auto r = __builtin_amdgcn_permlane32_swap(a1, b1, false, false); a1 = r[0]; b1 = r[1]; }
              if (valid) *(u32x4*)(sp + 32 * n + 8 * g) = (u32x4){a0, a1, b0, b1};
            }
        }
      }
    }
    item = nitem; par ^= 1; e = ne; mt = nmt; mcount = nmc; sub = nsub; asrc[0] = nasrc[0]; asrc[1] = nasrc[1]; bsrc = nbsrc;
  }
#undef MOE_DESC
#undef MOE_ROWS_DMA
#undef MOE_ASRC
#undef MOE_ISSUE_SL
  asm volatile("s_waitcnt vmcnt(0)" ::: "memory");
  if (STAGE == 1) while (!side.done()) { side.issue(p); side.template finish<0>(ws_, lane); }
  __syncthreads();
}
}

__device__ __forceinline__ void phase_final_bf(const P& p, int bid, int nb) {
  unsigned char* const ws_ = fresh_ws(p.ws);
  const float* X1 = (const float*)(ws_ + WS_X1); const bf16_t* SL = (const bf16_t*)(ws_ + WS_SLAB); const float* ada = (const float*)(ws_ + WS_ADA);
  const int tid_ = tidx(), lane = tid_ & 63, wave = tid_ >> 6;
  for (int t = bid * NW + wave; t < T; t += nb * NW) {
    const int b = t / SEQ;
    float4 v[4]; float s = 0.f;
#pragma unroll
    for (int j = 0; j < 4; ++j) {
      const int c0 = lane * 4 + 256 * j;
      float4 y = make_float4(0, 0, 0, 0);
#pragma unroll
      for (int k = 0; k < 8; ++k) { const float4 z = ld_bf4(SL + (size_t)(t * 8 + k) * D + c0); y.x += z.x; y.y += z.y; y.z += z.z; y.w += z.w; }
      const float4 gt = *(const float4*)(ada + b * 6144 + 5120 + c0);
      const float4 bx = *(const float4*)(X1 + (size_t)t * D + c0);
      v[j] = make_float4(bx.x + gt.x * y.x, bx.y + gt.y * y.y, bx.z + gt.z * y.z, bx.w + gt.w * y.w);
      s += v[j].x * v[j].x + v[j].y * v[j].y + v[j].z * v[j].z + v[j].w * v[j].w;
    }
    s = wave_sum(s);
    const float rstd = 1.0f / sqrtf(s * (1.0f / D) + 1e-6f);
#pragma unroll
    for (int j = 0; j < 4; ++j) {
      const int c0 = lane * 4 + 256 * j;
      const float4 gg = *(const float4*)(p.g_final + c0);
      *(float4*)(p.out + (size_t)t * D + c0) = make_float4(v[j].x * rstd * gg.x, v[j].y * rstd * gg.y, v[j].z * rstd * gg.z, v[j].w * rstd * gg.w);
    }
  }
}

#define XB_TMO      128
#define XB_XCNT(j)  (256  + 64 * (j))
#define XB_XSUB(j)  (1280 + 64 * (j))
#define XB_XGEN(j)  (2304 + 64 * (j))
#define XB_TOP      3328
#define XB_TOPGEN   3392
#define XCD_BAR_WORDS 3456
#define XB_SPIN_CAP (1u << 22)
__device__ __forceinline__ unsigned xb_ld(unsigned* p)              { return __hip_atomic_load(p, __ATOMIC_RELAXED, __HIP_MEMORY_SCOPE_AGENT); }
__device__ __forceinline__ unsigned xb_add(unsigned* p, unsigned v) { return __hip_atomic_fetch_add(p, v, __ATOMIC_RELAXED, __HIP_MEMORY_SCOPE_AGENT); }
__device__ __forceinline__ unsigned xb_xcc_id() { return (unsigned)__builtin_amdgcn_s_getreg((3 << 11) | 20) & 0xFu; }
#define XB_SPIN(cond, bar) do { unsigned _sp = 0; while (cond) { __builtin_amdgcn_s_sleep(1); \
    if ((++_sp & 255u) == 0u) { if (xb_ld(&(bar)[XB_TMO])) break; if (_sp > XB_SPIN_CAP) { atomicAdd(&(bar)[XB_TMO], 1u); break; } } } } while (0)
struct XcdBarrier { unsigned* bar; unsigned x; volatile LAS unsigned* st; };
__device__ __forceinline__ XcdBarrier xcd_barrier_post(unsigned* bar, volatile LAS unsigned* st) {
    XcdBarrier b; b.bar = bar; b.x = xb_xcc_id(); b.st = st;
    if (threadIdx.x == 0) (void)xb_add(&bar[XB_XCNT(b.x)], 1u);
    return b;
}
__device__ __forceinline__ void xcd_barrier_complete(unsigned* bar, unsigned x, unsigned& nloc, unsigned& nx) {
    const unsigned G = gridDim.x * gridDim.y * gridDim.z;
    unsigned sum, cnt, mine, sp = 0u;
    for (;;) {
        sum = 0u; cnt = 0u; mine = 0u;
#pragma unroll
        for (unsigned j = 0; j < 16; ++j) { const unsigned c = xb_ld(&bar[XB_XCNT(j)]); sum += c; cnt += (c > 0u) ? 1u : 0u; mine = (j == x) ? c : mine; }
        if (sum == G) break;
        __builtin_amdgcn_s_sleep(1);
        if ((++sp & 255u) == 0u) { if (xb_ld(&bar[XB_TMO])) break; if (sp > XB_SPIN_CAP) { atomicAdd(&bar[XB_TMO], 1u); break; } }
    }
    nloc = mine > 0u ? mine : 1u; nx = cnt > 0u ? cnt : 1u;
}
__device__ __forceinline__ void xcd_barrier(const XcdBarrier& b) {
    asm volatile("s_waitcnt vmcnt(0)" ::: "memory");
    __syncthreads();
    if (threadIdx.x == 0) {
        unsigned long long bz = 0; unsigned bx = b.x;
        asm volatile("" : "+s"(bz), "+s"(bx));
        unsigned* bar = b.bar + bz;
        __builtin_amdgcn_s_waitcnt(0);
        unsigned nloc = b.st[0], nx = b.st[1];
        if (nloc == 0u) { xcd_barrier_complete(bar, bx, nloc, nx); b.st[0] = nloc; b.st[1] = nx; }
        const unsigned old = xb_add(&bar[XB_XSUB(bx)], 1u);
        const unsigned gen = old / nloc;
        if (old + 1u == (gen + 1u) * nloc) {
            __builtin_amdgcn_fence(__ATOMIC_RELEASE, "agent");
            asm volatile("s_waitcnt vmcnt(0)" ::: "memory");
            const unsigned og = xb_add(&bar[XB_TOP], 1u);
            const unsigned tg = og / nx;
            if (og + 1u == (tg + 1u) * nx) xb_add(&bar[XB_TOPGEN], 1u);
            else XB_SPIN(xb_ld(&bar[XB_TOPGEN]) == tg, bar);
            __builtin_amdgcn_fence(__ATOMIC_ACQUIRE, "agent");
            xb_add(&bar[XB_XGEN(bx)], 1u);
            asm volatile("s_waitcnt vmcnt(0)" ::: "memory");
        } else {
            XB_SPIN(xb_ld(&bar[XB_XGEN(bx)]) == gen, bar);
            __builtin_amdgcn_fence(__ATOMIC_ACQUIRE, "agent");
            asm volatile("s_waitcnt vmcnt(0)" ::: "memory");
        }
    }
    __syncthreads();
}

constexpr int CW_BAR = 32768;
constexpr int LDS_BYTES = 163840;
constexpr int MISC_OFF = 159 * 1024;

__global__ void __launch_bounds__(NT, 2) mega(P p) {
  extern __shared__ __attribute__((aligned(16))) unsigned char smem[];
  float* lds = (float*)smem;
  LAS unsigned char* ldsb = (LAS unsigned char*)smem;
  volatile LAS unsigned* st = (volatile LAS unsigned*)(ldsb + MISC_OFF);
  if (threadIdx.x < 4) st[threadIdx.x] = 0u;
  __syncthreads();
  XcdBarrier bar = xcd_barrier_post((unsigned*)(p.ws + WS_CTL) + CW_BAR, st);
  const int bid = blockIdx.x, nb = gridDim.x;
  volatile LAS unsigned* tl = st + 16; int nstamp = 0;
#define STAMP() do { if (TIME_SEL_A >= 0 && threadIdx.x == 0) tl[nstamp] = (unsigned)__builtin_amdgcn_s_memrealtime(); ++nstamp; } while (0)
  STAMP();
#define FRESH(q) const P& q = p; unsigned char* const q##w = fresh_ws(p.ws)
#define HNB_(q) ((bf16_t*)(q##w + WS_HNB))
#define PROJB_(q) ((bf16_t*)(q##w + WS_PROJB))
#define X1_(q) ((float*)(q##w + WS_X1))
#define ADA_(q) ((const float*)(q##w + WS_ADA))

  for (int rep = 0; rep < REP_CONV; ++rep) { FRESH(q); phase_prologue(q, bid, nb, lds); xcd_barrier(bar); STAMP(); }
#if DIAG_EXACT_ROUTING
  { FRESH(q); diag::modnorm(q, bid, nb, q.x, q.g1, 0, 1024, (float*)(qw + diag::DW_HN));       xcd_barrier(bar); STAMP(); }
  { FRESH(q); diag::inproj(q, bid, nb, lds);                                                     xcd_barrier(bar); STAMP(); }
  { FRESH(q); diag::rope(q, bid, nb);                                                            xcd_barrier(bar); STAMP(); }
  { FRESH(q); diag::attn(q, bid, nb);                                                            xcd_barrier(bar); STAMP(); }
  { FRESH(q); diag::mix(q, bid, nb);                                                             xcd_barrier(bar); STAMP(); }
  { FRESH(q); diag::outproj(q, bid, nb, lds);                                                    xcd_barrier(bar); STAMP(); }
  { FRESH(q); diag::modnorm(q, bid, nb, (const float*)(qw + diag::DW_X1), q.g2, 3072, 4096, (float*)(qw + diag::DW_HN)); xcd_barrier(bar); STAMP(); }
  { FRESH(q); diag::router(q, bid, nb, lds);                                                     xcd_barrier(bar); STAMP(); }
  { FRESH(q); phase_route(q, bid, nb, (const float*)(qw + diag::DW_LOGITS));                   xcd_barrier(bar); STAMP(); }
#endif
  for (int rep = 0; rep < REP_LIGHT; ++rep) { FRESH(q); phase_modnorm(q, bid, nb, q.x, q.g1, 0, 1024, HNB_(q)); xcd_barrier(bar); STAMP(); }
  const bool xpar = ((bid % 8) & 1) != 0;
  { FRESH(q);
    pg8::Gemm g{HNB_(q), (const bf16_t*)(qw + WS_WIN_T), T, DPROJ, D}; pg8::StaticOrder S; S.init(T, DPROJ, nb, bid);
    EpiInproj E{PROJB_(q), (const float*)(qw + WS_COS), (const float*)(qw + WS_SIN)};
    pg8::gemm_phase<EpiInproj, pg8::StaticOrder, true, true>(ldsb, g, S, E);
    xcd_barrier(bar); STAMP(); }
  {
    FRESH(q);
    const attn_body::AttnTensors AT{(const attn_body::bf16*)(PROJB_(q) + COL_Q), (const attn_body::bf16*)(PROJB_(q) + COL_K), (const attn_body::bf16*)(PROJB_(q) + COL_V), (attn_body::bf16*)(qw + WS_AO)};
    const int vcu = (nb % 8 == 0) ? (bid % 8) * (nb / 8) + bid / 8 : bid;
#if ATTN_IMPL == 0
    {
      ConvSide<2> side; side.init(bid, nb, 0u, 1u << 24, tidx());
#pragma unroll 1
      for (int i = 0; i < 2; ++i)
        for (int v = vcu; v < 256; v += nb) phase_attn_unit(q, v, i, ldsb, side);
      while (!side.done()) { side.issue(q); side.finish(qw); }
    }
#else
#pragma unroll 1
    for (int i = 0; i < 4; ++i) {
      if (xpar) convert_slice(q, bid, nb, 2 + i);
      for (int v = vcu; v < 256; v += nb) attn_body::attn_phase_unit<8>((char*)smem, AT, v, i);
      if (!xpar) convert_slice(q, bid, nb, 2 + i);
    }
#endif
    xcd_barrier(bar); STAMP(); }
  for (int rep = 0; rep < REP_LIGHT; ++rep) { FRESH(q); phase_mix(q, bid, nb);                    xcd_barrier(bar); STAMP(); }
  for (int rep = 0; rep < REP_GEMM; ++rep)
  { FRESH(q); pg8::Gemm g{HNB_(q), (const bf16_t*)(qw + WS_WOUT_T), T, D, D}; pg8::StaticOrder S; S.init(T, D, nb, bid);
    EpiResid E{q.x, X1_(q), ADA_(q) + 2048};
    pg8::gemm_phase<EpiResid, pg8::StaticOrder, true, true>(ldsb, g, S, E);            xcd_barrier(bar); STAMP(); }
  for (int rep = 0; rep < REP_LIGHT; ++rep) { FRESH(q); phase_modnorm(q, bid, nb, X1_(q), q.g2, 3072, 4096, HNB_(q)); xcd_barrier(bar); STAMP(); }
  for (int rep = 0; rep < REP_GEMM; ++rep)
  { FRESH(q); pg8::Gemm g{HNB_(q), (const bf16_t*)(qw + WS_WRS_T), T, 768, D}; pg8::StaticOrder S; S.init(T, 768, nb, bid);
    EpiRS E{(float*)(qw + WS_LOGITS), (bf16_t*)(qw + WS_ACTS)};
    pg8::gemm_phase<EpiRS, pg8::StaticOrder, true, true>(ldsb, g, S, E);               xcd_barrier(bar); STAMP(); }
#if !DIAG_EXACT_ROUTING
  { FRESH(q); phase_route(q, bid, nb, (const float*)(qw + WS_LOGITS)); }
#endif
  { FRESH(q); pg8::Gemm g{(const bf16_t*)(qw + WS_ACTS), (const bf16_t*)(qw + WS_WDS_T), T, D, DSH}; pg8::StaticOrder S; S.init(T, D, nb, bid);
    EpiResid E{X1_(q), X1_(q), ADA_(q) + 5120};
    pg8::gemm_phase<EpiResid, pg8::StaticOrder, true, true>(ldsb, g, S, E);           xcd_barrier(bar); STAMP(); }
  for (int rep = 0; rep < REP_MOE1; ++rep) { FRESH(q); moe::run<1>(q, bid, nb, ldsb);             xcd_barrier(bar); STAMP(); }
  for (int rep = 0; rep < REP_MOE2; ++rep) { FRESH(q); moe::run<2>(q, bid, nb, ldsb);             xcd_barrier(bar); STAMP(); }
  for (int rep = 0; rep < REP_LIGHT; ++rep) { FRESH(q); phase_final_bf(q, bid, nb); }
  STAMP();
#if TIME_SEL_A >= 0
  if (bid == 0) {
    asm volatile("s_waitcnt vmcnt(0)" ::: "memory"); __syncthreads();
    const float usA = floorf((float)(tl[TIME_SEL_A + 1] - tl[TIME_SEL_A]) * 0.01f * (1.f / 8.f) + 0.5f) * 8.f;
    if (threadIdx.x == 0) p.out[0] += usA * 0.25f;
  }
#endif
}
}

extern "C" void kernel_launch(void* const* d_in, const int* in_sizes, int n_in, void* d_out, int out_size, void* d_ws, size_t ws_size, hipStream_t stream) {
  if (n_in != 25 || ws_size < WS_END) { fprintf(stderr, "kernel_launch: unexpected n_in %d or ws_size %zu\n", n_in, ws_size); return; }
  P p; memset(&p, 0, sizeof(p));
  p.x = (const float*)d_in[0]; p.c = (const float*)d_in[1]; p.pos = (const int*)d_in[2]; p.w_ada = (const float*)d_in[3]; p.b_ada = (const float*)d_in[4];
  p.g1 = (const float*)d_in[5]; p.w_in = (const float*)d_in[6]; p.conv_w = (const float*)d_in[7]; p.g_conv = (const float*)d_in[8];
  p.lq1 = (const float*)d_in[9]; p.lk1 = (const float*)d_in[10]; p.lq2 = (const float*)d_in[11]; p.lk2 = (const float*)d_in[12];
  p.g_subln = (const float*)d_in[13]; p.w_out = (const float*)d_in[14]; p.g2 = (const float*)d_in[15]; p.w_router = (const float*)d_in[16]; p.rbias = (const float*)d_in[17];
  p.wg_e = (const float*)d_in[18]; p.wu_e = (const float*)d_in[19]; p.wd_e = (const float*)d_in[20];
  p.wg_s = (const float*)d_in[21]; p.wu_s = (const float*)d_in[22]; p.wd_s = (const float*)d_in[23]; p.g_final = (const float*)d_in[24];
  p.out = (float*)d_out; p.ws = (unsigned char*)d_ws;
  for (int i = 0; i < 8; ++i) p.inv_freq[i] = (float)pow(500000.0, -(double)i / 8.0);
  (void)hipMemsetAsync((char*)d_ws + WS_CTL, 0, CTL_BYTES, stream);
  static int grid = 0;
  if (grid == 0) {
    int dev = 0, cus = 0, per_cu = 0;
    (void)hipGetDevice(&dev); (void)hipDeviceGetAttribute(&cus, hipDeviceAttributeMultiprocessorCount, dev);
    (void)hipFuncSetAttribute((const void*)mega, hipFuncAttributeMaxDynamicSharedMemorySize, LDS_BYTES);
    (void)hipOccupancyMaxActiveBlocksPerMultiprocessor(&per_cu, (const void*)mega, NT, LDS_BYTES);
    if (per_cu < 1) { fprintf(stderr, "kernel_launch: occupancy query says %d blocks/CU\n", per_cu); grid = -1; }
    else grid = cus;
  }
  if (grid < 0) return;
  void* args[] = {&p};
  hipError_t e = hipLaunchCooperativeKernel((const void*)mega, dim3(grid), dim3(NT), args, LDS_BYTES, stream);
  if (e != hipSuccess) fprintf(stderr, "cooperative launch failed: %s (grid %d)\n", hipGetErrorString(e), grid);
}
```
